# Optimizing an MI355X kernel written in HIP

```python
import jax
import jax.numpy as jnp
from jax import lax
import numpy as np

D_MODEL = 2048
BATCH = 2
SEQ = 8192
DEPTH = 4

GRID_W = 64
CTX_LEN = 256
N_MIXERS = 3
EPS = 1e-6
D_FF = 4 * D_MODEL
N_MOD = 6

NA_HEADS = 16
NA_HEAD_DIM = D_MODEL // NA_HEADS
NA_WIN_R = 8
NA_WIN_C = 16

MLA_HEADS = 16
MLA_Q_RANK = 512
MLA_KV_RANK = 512
MLA_NOPE = 128
MLA_ROPE = 64
MLA_V = D_MODEL // MLA_HEADS
ROPE_PAIRS = MLA_ROPE // 4
ROPE_BASE = 10000.0
Q_BLOCK = 128

ML_HEADS = 8
ML_V = D_MODEL // ML_HEADS
ML_QK = ML_V // 2
ML_CHUNK = 64
ML_CONV = 3

kernel_name = 'hybrid_na_mla_mlstm_diffusion_trunk'

F32 = jnp.float32


def rms_norm(x, g):
    xf = x.astype(F32)
    y = xf * lax.rsqrt(jnp.mean(xf * xf, axis=-1, keepdims=True) + EPS)
    return (y * g.astype(F32)).astype(x.dtype)


def modulate(x, shift, scale):
    return x * (1 + scale) + shift


def sq_relu_mlp(a, w1, w2):
    return jnp.square(jax.nn.relu(a @ w1)) @ w2


def dense_attn(q, k, v):
    s = jnp.einsum('bqhd,bkhd->bhqk', q, k, preferred_element_type=F32)
    p = jax.nn.softmax(s, axis=-1).astype(v.dtype)
    return jnp.einsum('bhqk,bkhd->bqhd', p, v)


def axial_rope_angles(length):
    t = jnp.arange(length)
    pos = jnp.stack([t // GRID_W, t % GRID_W], axis=-1).astype(F32)
    freqs = ROPE_BASE ** (-jnp.arange(ROPE_PAIRS, dtype=F32) / ROPE_PAIRS)
    return pos[:, :, None] * freqs


def apply_axial_rope(x, ang):
    xs = x.astype(F32).reshape(*x.shape[:-1], 2, 2, ROPE_PAIRS)
    x1, x2 = xs[..., 0, :], xs[..., 1, :]
    cos, sin = jnp.cos(ang), jnp.sin(ang)
    out = jnp.stack([x1 * cos - x2 * sin, x1 * sin + x2 * cos], axis=-2)
    return out.reshape(x.shape).astype(x.dtype)


def na_mixer(a_ctx, a_lat, w_qkv, rpb, w_o, need_ctx):
    B, S, D = a_lat.shape
    Lc = a_ctx.shape[1]
    rows = S // GRID_W
    kr = min(NA_WIN_R, rows)
    H, dh = NA_HEADS, NA_HEAD_DIM
    scale = dh ** -0.5
    qkv = (a_lat @ w_qkv).reshape(B, rows, GRID_W, 3, H, dh)
    q, k, v = qkv[:, :, :, 0] * scale, qkv[:, :, :, 1], qkv[:, :, :, 2]
    qkv_c = (a_ctx @ w_qkv).reshape(B, Lc, 3, H, dh)
    q_c, k_c, v_c = qkv_c[:, :, 0] * scale, qkv_c[:, :, 1], qkv_c[:, :, 2]

    qcol = np.arange(GRID_W)
    col_start = np.clip(qcol - NA_WIN_C // 2, 0, GRID_W - NA_WIN_C)
    col_mask = (qcol[None, :] >= col_start[:, None]) & (qcol[None, :] < col_start[:, None] + NA_WIN_C)
    dc_idx = np.clip(qcol[None, :] - qcol[:, None], -(NA_WIN_C - 1), NA_WIN_C - 1) + NA_WIN_C - 1
    rpb_cols = rpb[:, :, dc_idx]
    n_win = kr * GRID_W

    def row_block(r):
        rs = jnp.clip(r - kr // 2, 0, rows - kr)
        q_r = lax.dynamic_index_in_dim(q, r, axis=1, keepdims=False)
        k_r = lax.dynamic_slice_in_dim(k, rs, kr, axis=1)
        v_r = lax.dynamic_slice_in_dim(v, rs, kr, axis=1)
        bias = jnp.take(rpb_cols, rs + jnp.arange(kr) - r + NA_WIN_R - 1, axis=1)
        s_win = jnp.einsum('bqhd,brkhd->bhqrk', q_r, k_r, preferred_element_type=F32) + bias.transpose(0, 2, 1, 3).astype(F32)
        s_win = jnp.where(col_mask[:, None, :], s_win, -jnp.inf)
        s_ctx = jnp.einsum('bqhd,bnhd->bhqn', q_r, k_c, preferred_element_type=F32)
        p = jax.nn.softmax(jnp.concatenate([s_win.reshape(B, H, GRID_W, n_win), s_ctx], axis=-1), axis=-1)
        p_win = p[..., :n_win].reshape(B, H, GRID_W, kr, GRID_W).astype(v.dtype)
        p_ctx = p[..., n_win:].astype(v.dtype)
        return jnp.einsum('bhqrk,brkhd->bqhd', p_win, v_r) + jnp.einsum('bhqn,bnhd->bqhd', p_ctx, v_c)

    o = lax.map(row_block, jnp.arange(rows))
    y_lat = jnp.moveaxis(o, 0, 1).reshape(B, S, D) @ w_o
    y_ctx = dense_attn(q_c, k_c, v_c).reshape(B, Lc, D) @ w_o if need_ctx else None
    return y_ctx, y_lat


def mla_mixer(a_ctx, a_lat, w_in, g_q, g_kv, w_uq, w_ukv, w_o, need_ctx):
    B, S, D = a_lat.shape
    Lc = a_ctx.shape[1]
    H = MLA_HEADS
    dqk = MLA_NOPE + MLA_ROPE
    scale = dqk ** -0.5

    def project(a, ang):
        L = a.shape[1]
        z = a @ w_in
        cq, ckv, k_pe = jnp.split(z, [MLA_Q_RANK, MLA_Q_RANK + MLA_KV_RANK], axis=-1)
        qh = (rms_norm(cq, g_q) @ w_uq).reshape(B, L, H, dqk)
        kv = (rms_norm(ckv, g_kv) @ w_ukv).reshape(B, L, H, MLA_NOPE + MLA_V)
        q_nope, q_pe = qh[..., :MLA_NOPE], qh[..., MLA_NOPE:]
        if ang is not None:
            q_pe = apply_axial_rope(q_pe, ang[:, None])
            k_pe = apply_axial_rope(k_pe, ang)
        qh = jnp.concatenate([q_nope, q_pe], axis=-1) * scale
        kh = jnp.concatenate([kv[..., :MLA_NOPE], jnp.broadcast_to(k_pe[:, :, None, :], (B, L, H, MLA_ROPE))], axis=-1)
        return qh, kh, kv[..., MLA_NOPE:]

    q_l, k_l, v_l = project(a_lat, axial_rope_angles(S))
    q_c, k_c, v_c = project(a_ctx, None)
    k_all = jnp.concatenate([k_c, k_l], axis=1).transpose(0, 2, 1, 3)
    v_all = jnp.concatenate([v_c, v_l], axis=1).transpose(0, 2, 1, 3)
    qb = q_l.reshape(B, S // Q_BLOCK, Q_BLOCK, H, dqk).transpose(1, 0, 3, 2, 4)

    def block(q_blk):
        s = jnp.einsum('bhqd,bhkd->bhqk', q_blk, k_all, preferred_element_type=F32)
        p = jax.nn.softmax(s, axis=-1).astype(v_all.dtype)
        return jnp.einsum('bhqk,bhkd->bqhd', p, v_all)

    o = lax.map(block, qb)
    y_lat = jnp.moveaxis(o, 0, 1).reshape(B, S, H * MLA_V) @ w_o
    y_ctx = dense_attn(q_c, k_c, v_c).reshape(B, Lc, H * MLA_V) @ w_o if need_ctx else None
    return y_ctx, y_lat


def depthwise_conv_centred(x, w):
    pad = ML_CONV // 2
    L = x.shape[1]
    xp = jnp.pad(x, ((0, 0), (pad, pad), (0, 0)))
    return sum(xp[:, j:j + L] * w[j] for j in range(ML_CONV))


def mlstm_zero_state(B):
    return (jnp.zeros((B, ML_HEADS, ML_QK, ML_V), F32), jnp.zeros((B, ML_HEADS, ML_QK), F32), jnp.zeros((B, ML_HEADS), F32))


def mlstm_chunk_scan(q, k, v, li, lf, state):
    B, H, L, dk = q.shape
    dv = v.shape[-1]
    n_chunks = L // ML_CHUNK
    tril = jnp.tril(jnp.ones((ML_CHUNK, ML_CHUNK), dtype=bool))

    def chunks(t):
        return jnp.moveaxis(t.reshape(B, H, n_chunks, ML_CHUNK, *t.shape[3:]), 2, 0)

    def step(carry, xs):
        C, n, m = carry
        qc, kc, vc, lic, lfc = xs
        b = jnp.cumsum(lfc, axis=-1)
        log_w = jnp.where(tril, b[..., :, None] - b[..., None, :] + lic[..., None, :], -jnp.inf)
        log_inter = b + m[..., None]
        m_t = jnp.maximum(log_inter, jnp.max(log_w, axis=-1))
        w_inter = jnp.exp(log_inter - m_t)
        s = jnp.einsum('bhtd,bhsd->bhts', qc, kc) * jnp.exp(log_w - m_t[..., None])
        num = w_inter[..., None] * jnp.einsum('bhtd,bhde->bhte', qc, C) + jnp.einsum('bhts,bhse->bhte', s, vc)
        den = w_inter * jnp.einsum('bhtd,bhd->bht', qc, n) + jnp.sum(s, axis=-1)
        h = num / jnp.maximum(jnp.abs(den), jnp.exp(-m_t))[..., None]
        b_end = b[..., -1]
        log_s = b_end[..., None] - b + lic
        m_new = jnp.maximum(b_end + m, jnp.max(log_s, axis=-1))
        decay = jnp.exp(b_end + m - m_new)
        kw = kc * jnp.exp(log_s - m_new[..., None])[..., None]
        C_new = decay[..., None, None] * C + jnp.einsum('bhsd,bhse->bhde', kw, vc)
        n_new = decay[..., None] * n + jnp.sum(kw, axis=2)
        return (C_new, n_new, m_new), h

    state, h = lax.scan(step, state, (chunks(q), chunks(k), chunks(v), chunks(li), chunks(lf)))
    return state, jnp.moveaxis(h, 0, 2).reshape(B, H, L, dv)


def mlstm_mixer(a_ctx, a_lat, w_in, b_gate, conv_w, g_head, w_o, need_ctx):
    H, dk, dv = ML_HEADS, ML_QK, ML_V
    HK = H * dk

    def project(a):
        B, L, _ = a.shape
        z = a @ w_in
        qk, v, o, g = jnp.split(z, [2 * HK, 2 * HK + H * dv, 2 * HK + 2 * H * dv], axis=-1)
        qk = jax.nn.silu(depthwise_conv_centred(qk, conv_w))
        heads = lambda t, d: t.reshape(B, L, H, d).transpose(0, 2, 1, 3).astype(F32)
        g = (g.astype(F32) + b_gate.astype(F32)).reshape(B, L, 4, H).transpose(2, 0, 3, 1)
        return heads(qk[..., :HK], dk) * (dk ** -0.5), heads(qk[..., HK:], dk), heads(v, dv), o, g

    def bidir(q, k, v, g, init_f, init_b):
        st_f, h_f = mlstm_chunk_scan(q, k, v, g[0], jax.nn.log_sigmoid(g[1]), init_f)
        fl = lambda t: jnp.flip(t, axis=2)
        st_b, h_b = mlstm_chunk_scan(fl(q), fl(k), fl(v), jnp.flip(g[2], -1), jax.nn.log_sigmoid(jnp.flip(g[3], -1)), init_b)
        return h_f + fl(h_b), st_f, st_b

    def output(h, o):
        B, _, L, _ = h.shape
        hn = rms_norm(h, g_head.reshape(H, 1, dv)).transpose(0, 2, 1, 3).reshape(B, L, H * dv).astype(o.dtype)
        return (jax.nn.sigmoid(o) * hn) @ w_o

    qc, kc, vc, oc, gc = project(a_ctx)
    ql, kl, vl, ol, gl = project(a_lat)
    zero = mlstm_zero_state(a_lat.shape[0])
    h_c, st_f, st_b = bidir(qc, kc, vc, gc, zero, zero)
    h_l, _, _ = bidir(ql, kl, vl, gl, st_f, st_b)
    y_ctx = output(h_c, oc) if need_ctx else None
    return y_ctx, output(h_l, ol)


def setup_inputs(seed: int = 0) -> dict:
    key = jax.random.key(seed)
    ks = jax.random.split(key, 32)
    D = D_MODEL
    n_na = (DEPTH + N_MIXERS - 1) // N_MIXERS
    n_mla = (DEPTH + N_MIXERS - 2) // N_MIXERS
    n_ml = (DEPTH + N_MIXERS - 3) // N_MIXERS

    def nrm(k, shape, std):
        return std * jax.random.normal(k, shape, F32)

    def lin(k, shape):
        return nrm(k, shape, shape[-2] ** -0.5)

    def gain(k, shape):
        return 1.0 + nrm(k, shape, 0.02)

    mla_in = MLA_Q_RANK + MLA_KV_RANK + MLA_ROPE
    ml_in = 2 * ML_HEADS * ML_QK + 2 * ML_HEADS * ML_V + 4 * ML_HEADS
    i_bias = nrm(ks[20], (n_ml, 2, ML_HEADS), 0.1)
    f_bias = 3.0 + 3.0 * jax.random.uniform(ks[21], (n_ml, 2, ML_HEADS), F32)
    ml_b_gate = jnp.stack([i_bias[:, 0], f_bias[:, 0], i_bias[:, 1], f_bias[:, 1]], axis=1).reshape(n_ml, 4 * ML_HEADS)
    return {
        'x': nrm(ks[0], (BATCH, SEQ, D), 1.0),
        'c': nrm(ks[1], (BATCH, D), 1.0),
        'ctx': nrm(ks[2], (BATCH, CTX_LEN, D), 1.0),
        'c_ctx': nrm(ks[3], (D,), 1.0),
        'ada_w': nrm(ks[4], (DEPTH, D, N_MOD * D), 0.5 * D ** -0.5),
        'ada_b': nrm(ks[5], (DEPTH, N_MOD * D), 0.02),
        'norm_g': gain(ks[6], (DEPTH, 4, D)),
        'ff_w1': lin(ks[7], (DEPTH, D, D_FF)),
        'ff_w2': lin(ks[8], (DEPTH, D_FF, D)),
        'na_w_qkv': lin(ks[9], (n_na, D, 3 * NA_HEADS * NA_HEAD_DIM)),
        'na_rpb': nrm(ks[10], (n_na, NA_HEADS, 2 * NA_WIN_R - 1, 2 * NA_WIN_C - 1), 0.1),
        'na_w_o': lin(ks[11], (n_na, NA_HEADS * NA_HEAD_DIM, D)),
        'mla_w_in': lin(ks[12], (n_mla, D, mla_in)),
        'mla_g_q': gain(ks[13], (n_mla, MLA_Q_RANK)),
        'mla_g_kv': gain(ks[14], (n_mla, MLA_KV_RANK)),
        'mla_w_uq': lin(ks[15], (n_mla, MLA_Q_RANK, MLA_HEADS * (MLA_NOPE + MLA_ROPE))),
        'mla_w_ukv': lin(ks[16], (n_mla, MLA_KV_RANK, MLA_HEADS * (MLA_NOPE + MLA_V))),
        'mla_w_o': lin(ks[17], (n_mla, MLA_HEADS * MLA_V, D)),
        'ml_w_in': lin(ks[18], (n_ml, D, ml_in)),
        'ml_b_gate': ml_b_gate,
        'ml_conv': nrm(ks[22], (n_ml, ML_CONV, 2 * ML_HEADS * ML_QK), ML_CONV ** -0.5),
        'ml_g_head': gain(ks[23], (n_ml, ML_HEADS * ML_V)),
        'ml_w_o': lin(ks[24], (n_ml, ML_HEADS * ML_V, D)),
    }


def reference(x, c, ctx, c_ctx, ada_w, ada_b, norm_g, ff_w1, ff_w2, na_w_qkv, na_rpb, na_w_o, mla_w_in, mla_g_q, mla_g_kv, mla_w_uq, mla_w_ukv, mla_w_o, ml_w_in, ml_b_gate, ml_conv, ml_g_head, ml_w_o):
    h_lat, h_ctx = x, ctx
    s_c, s_cc = jax.nn.silu(c), jax.nn.silu(c_ctx)
    for i in range(DEPTH):
        last = i == DEPTH - 1
        sh1, sc1, g1, sh2, sc2, g2 = jnp.split((s_c @ ada_w[i] + ada_b[i])[:, None, :], N_MOD, axis=-1)
        sh1c, sc1c, g1c, sh2c, sc2c, g2c = jnp.split(s_cc @ ada_w[i] + ada_b[i], N_MOD, axis=-1)
        g_pre1, g_post1, g_pre2, g_post2 = norm_g[i]
        a_l = modulate(rms_norm(h_lat, g_pre1), sh1, sc1)
        a_c = modulate(rms_norm(h_ctx, g_pre1), sh1c, sc1c)
        kind, j = i % N_MIXERS, i // N_MIXERS
        if kind == 0:
            y_c, y_l = na_mixer(a_c, a_l, na_w_qkv[j], na_rpb[j], na_w_o[j], not last)
        elif kind == 1:
            y_c, y_l = mla_mixer(a_c, a_l, mla_w_in[j], mla_g_q[j], mla_g_kv[j], mla_w_uq[j], mla_w_ukv[j], mla_w_o[j], not last)
        else:
            y_c, y_l = mlstm_mixer(a_c, a_l, ml_w_in[j], ml_b_gate[j], ml_conv[j], ml_g_head[j], ml_w_o[j], not last)
        h_lat = h_lat + g1 * rms_norm(y_l, g_post1)
        h_lat = h_lat + g2 * rms_norm(sq_relu_mlp(modulate(rms_norm(h_lat, g_pre2), sh2, sc2), ff_w1[i], ff_w2[i]), g_post2)
        if not last:
            h_ctx = h_ctx + g1c * rms_norm(y_c, g_post1)
            h_ctx = h_ctx + g2c * rms_norm(sq_relu_mlp(modulate(rms_norm(h_ctx, g_pre2), sh2c, sc2c), ff_w1[i], ff_w2[i]), g_post2)
    return h_lat
```

```cpp
#include <hip/hip_runtime.h>
#include <cstdio>
#include <cstdint>
#include <cmath>
namespace pg8 {
#define PG8_LAS __attribute__((address_space(3)))
typedef unsigned short bf16_t;
typedef short bf16x8 __attribute__((ext_vector_type(8)));
typedef float f32x4 __attribute__((ext_vector_type(4)));
typedef unsigned u32x4 __attribute__((ext_vector_type(4)));
constexpr int BM = 256, BK = 64, HALF = 128, HTB = HALF * BK * 2  , STAGE_BYTES = 8 * HTB, NXCD = 8, WGM = 8;

__host__ __device__ __forceinline__ int lds_byte(int r, int c) { const int st = (r >> 4) * 2 + (c >> 5), rr = r & 15, cc = c & 31, ob = rr * 64 + cc * 2; return st * 1024 + (ob ^ (((ob >> 9) & 1) << 5)); }
__host__ __device__ __forceinline__ void stage_rc(int b, int& R, int& C) { const int st = b / 1024, sb = b % 1024, swz = sb ^ (((sb >> 9) & 1) << 5); R = (st >> 1) * 16 + swz / 64; C = (st & 1) * 32 + (swz % 64) / 2; }
__host__ __device__ __forceinline__ int perm32(int rho) { const int n = rho >> 4, i = rho & 15; return 8 * (i >> 2) + 4 * n + (i & 3); }

struct Unit { int pm, pn; };
struct Gemm { const bf16_t* A; const bf16_t* Bt; int M, N, K; };

struct StaticOrder {
    int nM, nN, nwg, G, c;
    __host__ __device__ void init(int M, int N, int G_, int c_) { nM = M / BM; nN = N / BM; nwg = nM * nN; G = G_; c = c_; }
    __host__ __device__ bool next(int i, Unit& u) const {
        const long L = (long)i * G + c; if (L >= nwg) return false;
        int wgid = (int)L; { const int q = nwg / NXCD, r = nwg % NXCD, xcd = wgid % NXCD, off = wgid / NXCD; wgid = (xcd < r ? xcd * (q + 1) : r * (q + 1) + (xcd - r) * q) + off; }
        const int nig = WGM * nN, gid = wgid / nig, fm = gid * WGM, gsz = (nM - fm) < WGM ? (nM - fm) : WGM;
        u.pm = fm + ((wgid % nig) % gsz); u.pn = (wgid % nig) / gsz; return true;
    }
    __device__ __forceinline__ void a_ready(const Unit&) const {}
    __device__ __forceinline__ void done(const Unit&) const {}
};

__device__ __forceinline__ unsigned cvt_pk_bf16(float lo, float hi) { unsigned r; asm volatile("v_cvt_pk_bf16_f32 %0, %1, %2" : "=v"(r) : "v"(lo), "v"(hi)); return r; }
typedef float f32x2 __attribute__((ext_vector_type(2)));
template <int ACT> struct EpiBf16 {
    static constexpr bool PERM = true, AFTER_DRAIN = false;
    bf16_t* O; int ldc;
    __device__ __forceinline__ void operator()(const f32x4 (&acc)[2][2][4][2], const Unit& u, int wr, int wc, int fr, int fq) const {
        const int row0 = u.pm * BM + wr * 64 + fr; const int col0 = u.pn * BM + wc * 32 + 8 * fq;
#pragma unroll
        for (int ai = 0; ai < 2; ++ai)
#pragma unroll
            for (int m = 0; m < 4; ++m) { bf16_t* rowp = O + (size_t)(row0 + ai * HALF + m * 16) * ldc + col0;
#pragma unroll
                for (int bj = 0; bj < 2; ++bj) { f32x4 v0 = acc[ai][bj][m][0], v1 = acc[ai][bj][m][1];
                    if (ACT == 2) {
#pragma unroll
                        for (int e = 0; e < 4; ++e) { const float a = v0[e] > 0.f ? v0[e] : 0.f, b = v1[e] > 0.f ? v1[e] : 0.f; v0[e] = a * a; v1[e] = b * b; } }
                    u32x4 w; w.x = cvt_pk_bf16(v0[0], v0[1]); w.y = cvt_pk_bf16(v0[2], v0[3]); w.z = cvt_pk_bf16(v1[0], v1[1]); w.w = cvt_pk_bf16(v1[2], v1[3]);
                    *(u32x4*)(rowp + bj * HALF) = w; } }
    }
};

template <class Epi, class Sched, bool ALIGN_EPI = false, bool SP2 = false>
__device__ __forceinline__ void gemm_phase(PG8_LAS unsigned char* lds, const Gemm g, const Sched& S, const Epi& E) {
    const int tid = threadIdx.x, wid = __builtin_amdgcn_readfirstlane(tid >> 6), lane = tid & 63, wr = wid >> 2, wc = wid & 3, fr = lane & 15, fq = lane >> 4;
    const int K = g.K, nt = K / BK;
    unsigned voffA[2], voffB[2];
#pragma unroll
    for (int i = 0; i < 2; ++i) { int R, C; stage_rc(tid * 16 + i * 8192, R, C); const int Rb = Epi::PERM ? ((R & ~31) + perm32(R & 31)) : R;
        voffA[i] = (unsigned)(R * K + C) * 2u; voffB[i] = (unsigned)(Rb * K + C) * 2u; }
    const size_t kstep = (size_t)(BK * 2);
    const size_t hstep = (size_t)HALF * K * 2;
    const size_t tstep = 2 * hstep;
    const unsigned ldsw = (unsigned)wid * 1024u;
    const int aoff = lds_byte(wr * 64 + fr, fq * 8), boff = lds_byte(wc * 32 + fr, fq * 8);
#define PG8_SA(b, h) (((b) * 2 + (h)) * HTB)
#define PG8_SB(b, h) ((4 + (b) * 2 + (h)) * HTB)
#define PG8_STAGE(bufoff, gbase, voff) do { _Pragma("unroll") for (int _i = 0; _i < 2; ++_i) \
        __builtin_amdgcn_global_load_lds((const unsigned*)((const char*)(gbase) + (voff)[_i]), (PG8_LAS unsigned*)(lds + (bufoff) + ldsw + _i * 8192), 16, 0, 0); } while (0)
#define PG8_LDA(dst, b, h) do { _Pragma("unroll") for (int m = 0; m < 4; ++m) _Pragma("unroll") for (int k = 0; k < 2; ++k) dst[m][k] = *(const PG8_LAS bf16x8*)(lds + PG8_SA(b, h) + aoff + m * 2048 + k * 1024); } while (0)
#define PG8_LDB(dst, b, h) do { _Pragma("unroll") for (int n = 0; n < 2; ++n) _Pragma("unroll") for (int k = 0; k < 2; ++k) dst[n][k] = *(const PG8_LAS bf16x8*)(lds + PG8_SB(b, h) + boff + n * 2048 + k * 1024); } while (0)
#define PG8_MMA(ai, bj, At, Bt) do { __builtin_amdgcn_s_setprio(1); _Pragma("unroll") for (int m = 0; m < 4; ++m) _Pragma("unroll") for (int n = 0; n < 2; ++n) _Pragma("unroll") for (int k = 0; k < 2; ++k) \
        acc[ai][bj][m][n] = __builtin_amdgcn_mfma_f32_16x16x32_bf16(Bt[n][k], At[m][k], acc[ai][bj][m][n], 0, 0, 0); __builtin_amdgcn_s_setprio(0); } while (0)
#define PG8_WAIT_V(n) asm volatile("s_waitcnt vmcnt(" #n ")" ::: "memory")
#define PG8_WAIT_L(n) asm volatile("s_waitcnt lgkmcnt(" #n ")" ::: "memory")
#define PG8_BAR __builtin_amdgcn_s_barrier()
#define PG8_SCHED __builtin_amdgcn_sched_barrier(0)
    Unit cur, nxt; int ui = 0;
    if (!S.next(0, cur)) return;
    f32x4 acc[2][2][4][2];
#pragma unroll
    for (int a = 0; a < 2; ++a)
#pragma unroll
        for (int b = 0; b < 2; ++b)
#pragma unroll
            for (int m = 0; m < 4; ++m)
#pragma unroll
                for (int n = 0; n < 2; ++n) acc[a][b][m][n] = (f32x4){0.f, 0.f, 0.f, 0.f};
    bf16x8 At[4][2], B0[2][2], B1[2][2];
    const char* cA = (const char*)g.A + (size_t)cur.pm * tstep; const char* cB = (const char*)g.Bt + (size_t)cur.pn * tstep;
    S.a_ready(cur);
    if constexpr (SP2) {
        PG8_STAGE(PG8_SB(0, 0), cB, voffB); PG8_STAGE(PG8_SB(0, 1), cB + hstep, voffB); PG8_STAGE(PG8_SA(0, 0), cA, voffA); PG8_STAGE(PG8_SA(0, 1), cA + hstep, voffA);
        if (wr == 1) PG8_BAR;
        PG8_WAIT_V(2); PG8_BAR;
        PG8_STAGE(PG8_SB(1, 0), cB + kstep, voffB); PG8_STAGE(PG8_SA(1, 0), cA + kstep, voffA); PG8_STAGE(PG8_SB(1, 1), cB + hstep + kstep, voffB);
        PG8_WAIT_V(6); PG8_BAR;
    } else {
        PG8_STAGE(PG8_SB(0, 0), cB, voffB); PG8_STAGE(PG8_SA(0, 0), cA, voffA); PG8_STAGE(PG8_SB(0, 1), cB + hstep, voffB); PG8_STAGE(PG8_SA(0, 1), cA + hstep, voffA);
        if (wr == 1) PG8_BAR;
        PG8_WAIT_V(4); PG8_BAR;
        PG8_STAGE(PG8_SB(1, 0), cB + kstep, voffB); PG8_STAGE(PG8_SA(1, 0), cA + kstep, voffA); PG8_STAGE(PG8_SB(1, 1), cB + hstep + kstep, voffB);
        PG8_WAIT_V(6); PG8_BAR;
    }
    for (;;) {
        const bool has_next = S.next(ui + 1, nxt);
        const char* nA = has_next ? (const char*)g.A + (size_t)nxt.pm * tstep : cA; const char* nB = has_next ? (const char*)g.Bt + (size_t)nxt.pn * tstep : cB;
        for (int t = 0; t < nt; t += 2) {
            const bool last = (t == nt - 2);
            const char* a1 = cA + (size_t)(t + 1) * kstep;
            const char* a2 = last ? nA : cA + (size_t)(t + 2) * kstep; const char* b2 = last ? nB : cB + (size_t)(t + 2) * kstep;
            const char* a3 = a2 + kstep; const char* b3 = b2 + kstep;
            if (last && has_next) S.a_ready(nxt);
            if constexpr (SP2) {
            PG8_LDB(B0, 0, 0); PG8_LDB(B1, 0, 1); PG8_SCHED; PG8_LDA(At, 0, 0); PG8_STAGE(PG8_SA(1, 1), a1 + hstep, voffA);
            PG8_WAIT_V(8); PG8_WAIT_L(0); PG8_BAR; PG8_MMA(0, 0, At, B0); PG8_MMA(0, 1, At, B1); PG8_BAR; PG8_SCHED;
            PG8_LDA(At, 0, 1); PG8_STAGE(PG8_SB(0, 0), b2, voffB); PG8_STAGE(PG8_SB(0, 1), b2 + hstep, voffB); PG8_STAGE(PG8_SA(0, 0), a2, voffA);
            PG8_WAIT_V(8); PG8_WAIT_L(0); PG8_BAR; PG8_MMA(1, 0, At, B0); PG8_MMA(1, 1, At, B1); PG8_BAR; PG8_SCHED;
            PG8_LDB(B0, 1, 0); PG8_LDB(B1, 1, 1); PG8_SCHED; PG8_LDA(At, 1, 0); PG8_STAGE(PG8_SA(0, 1), a2 + hstep, voffA);
            PG8_WAIT_V(8); PG8_WAIT_L(0); PG8_BAR; PG8_MMA(0, 0, At, B0); PG8_MMA(0, 1, At, B1); PG8_BAR; PG8_SCHED;
            PG8_LDA(At, 1, 1); PG8_STAGE(PG8_SB(1, 0), b3, voffB); PG8_STAGE(PG8_SB(1, 1), b3 + hstep, voffB); PG8_STAGE(PG8_SA(1, 0), a3, voffA);
            PG8_WAIT_V(8); PG8_WAIT_L(0); PG8_BAR; PG8_MMA(1, 0, At, B0); PG8_MMA(1, 1, At, B1); PG8_BAR; PG8_SCHED;
            } else {
            PG8_LDB(B0, 0, 0); PG8_SCHED; PG8_LDA(At, 0, 0); PG8_STAGE(PG8_SA(1, 1), a1 + hstep, voffA);
            PG8_WAIT_L(8); PG8_BAR; PG8_WAIT_L(0); PG8_MMA(0, 0, At, B0); PG8_BAR; PG8_SCHED;
            PG8_LDB(B1, 0, 1); PG8_STAGE(PG8_SB(0, 0), b2, voffB);
            PG8_BAR; PG8_WAIT_L(0); PG8_MMA(0, 1, At, B1); PG8_BAR;
            PG8_LDA(At, 0, 1); PG8_STAGE(PG8_SA(0, 0), a2, voffA);
            PG8_BAR; PG8_WAIT_L(0); PG8_MMA(1, 0, At, B0); PG8_BAR; PG8_SCHED;
            PG8_STAGE(PG8_SB(0, 1), b2 + hstep, voffB);
            PG8_WAIT_V(6); PG8_BAR; PG8_MMA(1, 1, At, B1); PG8_BAR;
            PG8_LDB(B0, 1, 0); PG8_SCHED; PG8_LDA(At, 1, 0); PG8_STAGE(PG8_SA(0, 1), a2 + hstep, voffA);
            PG8_WAIT_L(8); PG8_BAR; PG8_WAIT_L(0); PG8_MMA(0, 0, At, B0); PG8_BAR; PG8_SCHED;
            PG8_LDB(B1, 1, 1); PG8_STAGE(PG8_SB(1, 0), b3, voffB);
            PG8_BAR; PG8_WAIT_L(0); PG8_MMA(0, 1, At, B1); PG8_BAR;
            PG8_LDA(At, 1, 1); PG8_STAGE(PG8_SA(1, 0), a3, voffA);
            PG8_BAR; PG8_WAIT_L(0); PG8_MMA(1, 0, At, B0); PG8_BAR; PG8_SCHED;
            PG8_STAGE(PG8_SB(1, 1), b3 + hstep, voffB);
            PG8_WAIT_V(6); PG8_BAR; PG8_MMA(1, 1, At, B1); PG8_BAR;
            }
        }
        if constexpr (ALIGN_EPI) { if (wr == 0) PG8_BAR; }
        if constexpr (!Epi::AFTER_DRAIN) { E(acc, cur, wr, wc, fr, fq); S.done(cur); }
        if (!has_next) break;
#pragma unroll
        for (int a = 0; a < 2; ++a)
#pragma unroll
            for (int b = 0; b < 2; ++b)
#pragma unroll
                for (int m = 0; m < 4; ++m)
#pragma unroll
                    for (int n = 0; n < 2; ++n) acc[a][b][m][n] = (f32x4){0.f, 0.f, 0.f, 0.f};
        cur = nxt; cA = nA; cB = nB; ++ui;
        if constexpr (ALIGN_EPI) { if (wr == 1) PG8_BAR; }
    }
    PG8_WAIT_V(0);
    if constexpr (!ALIGN_EPI) { if (wr == 0) PG8_BAR; }
    PG8_BAR;
    if constexpr (Epi::AFTER_DRAIN) { E.fused(acc, cur, wr, wc, fr, fq, lds, wid, lane); S.done(cur); }
#undef PG8_SA
#undef PG8_SB
#undef PG8_STAGE
#undef PG8_LDA
#undef PG8_LDB
#undef PG8_MMA
#undef PG8_WAIT_V
#undef PG8_WAIT_L
#undef PG8_BAR
#undef PG8_SCHED
}
}
#define GAS __attribute__((address_space(1)))
#define LAS __attribute__((address_space(3)))
typedef unsigned short bf16;
typedef unsigned v4u __attribute__((ext_vector_type(4)));
typedef float f32x4 __attribute__((ext_vector_type(4)));
typedef short bf16x8 __attribute__((ext_vector_type(8)));
typedef GAS unsigned gu32;
typedef GAS unsigned long long gu64;
#define RLX_AGENT __ATOMIC_RELAXED, __HIP_MEMORY_SCOPE_AGENT
#define LDS_WAIT() asm volatile("s_waitcnt lgkmcnt(0)" ::: "memory")
#define VM_WAIT() asm volatile("s_waitcnt vmcnt(0)" ::: "memory")
__device__ __forceinline__ unsigned long long rt() { return __builtin_amdgcn_s_memrealtime(); }
__device__ __forceinline__ unsigned f2bf(float f) { unsigned u = __builtin_bit_cast(unsigned, f); return (u + 0x7fffu + ((u >> 16) & 1u)) >> 16; }
__device__ __forceinline__ unsigned pk2(float lo, float hi) { return f2bf(lo) | (f2bf(hi) << 16); }

#define XB_TMO      128
#define XB_XCNT(j)  (256  + 64 * (j))
#define XB_XSUB(j)  (1280 + 64 * (j))
#define XB_XGEN(j)  (2304 + 64 * (j))
#define XB_TOP      3328
#define XB_TOPGEN   3392
#define XCD_BAR_WORDS 3456
#define XB_SPIN_CAP (1u << 18)

__device__ __forceinline__ unsigned xb_ld(unsigned* p)              { return __hip_atomic_load(p, __ATOMIC_RELAXED, __HIP_MEMORY_SCOPE_AGENT); }
__device__ __forceinline__ unsigned xb_add(unsigned* p, unsigned v) { return __hip_atomic_fetch_add(p, v, __ATOMIC_RELAXED, __HIP_MEMORY_SCOPE_AGENT); }
__device__ __forceinline__ unsigned xb_xcc_id() { return (unsigned)__builtin_amdgcn_s_getreg((3 << 11) | 20) & 0xFu; }
#define XB_SPIN(cond, bar) do { unsigned _sp = 0; while (cond) { __builtin_amdgcn_s_sleep(1); \
    if ((++_sp & 255u) == 0u) { if (xb_ld(&(bar)[XB_TMO])) break; if (_sp > XB_SPIN_CAP) { atomicAdd(&(bar)[XB_TMO], 1u); break; } } } } while (0)

struct XcdBarrier {
    unsigned* bar; unsigned x;
    volatile LAS unsigned* st;
};

__device__ __forceinline__ XcdBarrier xcd_barrier_post(unsigned* bar, volatile LAS unsigned* st) {
    XcdBarrier b; b.bar = bar; b.x = xb_xcc_id(); b.st = st;
    if (threadIdx.x == 0) (void)xb_add(&bar[XB_XCNT(b.x)], 1u);
    return b;
}
__device__ __forceinline__ void xcd_barrier_complete(unsigned* bar, unsigned x, unsigned& nloc, unsigned& nx) {
    const unsigned G = gridDim.x * gridDim.y * gridDim.z;
    unsigned sum, cnt, mine, sp = 0u;
    for (;;) {
        sum = 0u; cnt = 0u; mine = 0u;
#pragma unroll
        for (unsigned j = 0; j < 16; ++j) { const unsigned c = xb_ld(&bar[XB_XCNT(j)]); sum += c; cnt += (c > 0u) ? 1u : 0u; mine = (j == x) ? c : mine; }
        if (sum == G) break;
        __builtin_amdgcn_s_sleep(1);
        if ((++sp & 255u) == 0u) { if (xb_ld(&bar[XB_TMO])) break; if (sp > XB_SPIN_CAP) { atomicAdd(&bar[XB_TMO], 1u); break; } }
    }
    nloc = mine > 0u ? mine : 1u; nx = cnt > 0u ? cnt : 1u;
}

__device__ __forceinline__ void xcd_barrier(const XcdBarrier& b) {
    asm volatile("s_waitcnt vmcnt(0)" ::: "memory");
    __syncthreads();
    if (threadIdx.x == 0) {
        unsigned* bar = b.bar;
        __builtin_amdgcn_s_waitcnt(0);
        unsigned nloc = b.st[0], nx = b.st[1];
        if (nloc == 0u) { xcd_barrier_complete(bar, b.x, nloc, nx); b.st[0] = nloc; b.st[1] = nx; }
        const unsigned old = xb_add(&bar[XB_XSUB(b.x)], 1u);
        const unsigned gen = old / nloc;
        if (old + 1u == (gen + 1u) * nloc) {
            __builtin_amdgcn_fence(__ATOMIC_RELEASE, "agent");
            asm volatile("s_waitcnt vmcnt(0)" ::: "memory");
            const unsigned og = xb_add(&bar[XB_TOP], 1u);
            const unsigned tg = og / nx;
            if (og + 1u == (tg + 1u) * nx) xb_add(&bar[XB_TOPGEN], 1u);
            else XB_SPIN(xb_ld(&bar[XB_TOPGEN]) == tg, bar);
            __builtin_amdgcn_fence(__ATOMIC_ACQUIRE, "agent");
            xb_add(&bar[XB_XGEN(b.x)], 1u);
            asm volatile("s_waitcnt vmcnt(0)" ::: "memory");
        } else {
            XB_SPIN(xb_ld(&bar[XB_XGEN(b.x)]) == gen, bar);
            __builtin_amdgcn_fence(__ATOMIC_ACQUIRE, "agent");
            asm volatile("s_waitcnt vmcnt(0)" ::: "memory");
        }
    }
    __syncthreads();
}
__device__ __forceinline__ float wave_sum(float v) {
#pragma unroll
    for (int o = 1; o < 64; o <<= 1) v += __shfl_xor(v, o);
    return v;
}
__device__ __forceinline__ void p0_transpose_item(const float* W, int K, int N, bf16* WT, int row_off, LAS float* scr, int item, int lane) {
    const int nblk = N / 32, kb = item / nblk, nb = item % nblk, k0 = 64 * kb, n0 = 32 * nb;
#pragma unroll 8
    for (int i = 0; i < 32; ++i) { const int kk = 2 * i + (lane >> 5); scr[kk * 33 + (lane & 31)] = W[(size_t)(k0 + kk) * N + n0 + (lane & 31)]; }
    LDS_WAIT(); asm volatile("" ::: "memory");
    const int c = lane & 7;
#pragma unroll
    for (int j = 0; j < 4; ++j) { const int n = (lane >> 3) + 8 * j; const LAS float* s = scr + (8 * c) * 33 + n;
        v4u o; o.x = pk2(s[0 * 33], s[1 * 33]); o.y = pk2(s[2 * 33], s[3 * 33]); o.z = pk2(s[4 * 33], s[5 * 33]); o.w = pk2(s[6 * 33], s[7 * 33]);
        *(GAS v4u*)(WT + (size_t)(row_off + n0 + n) * K + k0 + 8 * c) = o; }
    LDS_WAIT(); asm volatile("" ::: "memory");
}

constexpr int NWAVES = 8, NTHR = 512;
constexpr int D = 2048, NB = 2, SEQ = 8192, CTXL = 256, DFF = 8192, DEPTH = 4;
constexpr int MLAT = NB * SEQ, MCTX = NB * CTXL, M = MLAT + MCTX;
constexpr float EPS = 1e-6f;
constexpr int NMOD = 6 * D;
constexpr size_t MiB = 1u << 20;
constexpr size_t WS_CTL = 0, CTL_ZERO_BYTES = 1 * MiB;
constexpr size_t WS_MOD = 1 * MiB, WS_ROPE = 2 * MiB, WS_PART = 3 * MiB;
constexpr size_t WS_W1T = 12 * MiB, WS_W2T = WS_W1T + 128 * MiB, WS_NAQKV = WS_W2T + 128 * MiB, WS_NAWO = WS_NAQKV + 48 * MiB;
constexpr size_t WS_MLAIN = WS_NAWO + 16 * MiB, WS_MLAUQ = WS_MLAIN + 5 * MiB, WS_MLAUKV = WS_MLAUQ + 3 * MiB, WS_MLAWO = WS_MLAUKV + 4 * MiB;
constexpr size_t WS_MLIN = WS_MLAWO + 8 * MiB, WS_MLWO = WS_MLIN + 25 * MiB;
constexpr size_t WS_H = WS_MLWO + 8 * MiB, WS_A = WS_H + 132 * MiB, WS_Y = WS_A + 66 * MiB, WS_O = WS_Y + 66 * MiB, WS_BIG = WS_O + 66 * MiB, WS_END = WS_BIG + 276 * MiB;
constexpr size_t BIG_QKV = 0;
constexpr size_t BIG_QH = 0, BIG_MZ = 0, BIG_KV = 99 * MiB, BIG_CQN = 231 * MiB, BIG_CKVN = BIG_CQN + (size_t)M * 512 * 2, BIG_KPE = 264 * MiB;
constexpr size_t BIG_LZ = 0, BIG_LQK = 207 * MiB, BIG_LG = 273 * MiB;
constexpr size_t BIG_HID = 0;
constexpr int CW_BAR = 4096;
constexpr int RING_BYTES = 131072, MISC_OFF = RING_BYTES + 320, LDS_BYTES = 147456;

__device__ __forceinline__ float bf_lo(unsigned w) { return __uint_as_float(w << 16); }
__device__ __forceinline__ float bf_hi(unsigned w) { return __uint_as_float(w & 0xffff0000u); }
__device__ __forceinline__ float bf1(bf16 b) { return __uint_as_float(((unsigned)b) << 16); }
__device__ __forceinline__ unsigned pkbf(float lo, float hi) { return pg8::cvt_pk_bf16(lo, hi); }
__device__ __forceinline__ void unpack8(const v4u w, float* f) { f[0] = bf_lo(w.x); f[1] = bf_hi(w.x); f[2] = bf_lo(w.y); f[3] = bf_hi(w.y); f[4] = bf_lo(w.z); f[5] = bf_hi(w.z); f[6] = bf_lo(w.w); f[7] = bf_hi(w.w); }
__device__ __forceinline__ float sigmoidf_(float x) { return 1.f / (1.f + expf(-x)); }

struct Ctx { LAS unsigned char* lds; int tid, lane, wave, gw, ngw; };

__device__ __forceinline__ void tr_matrix(const Ctx& X, const float* W, int K, int N, bf16* WT) {
    LAS float* scr = (LAS float*)(X.lds + X.wave * 8448);
    const int nitems = (K / 64) * (N / 32);
    for (int it = X.gw; it < nitems; it += X.ngw) p0_transpose_item(W, K, N, WT, 0, scr, it, X.lane);
}
__device__ __forceinline__ void zero_bf16(const Ctx& X, bf16* p, size_t n8) {
    for (size_t i = (size_t)blockIdx.x * NTHR + X.tid; i < n8; i += (size_t)gridDim.x * NTHR) ((v4u*)p)[i] = (v4u){0u, 0u, 0u, 0u};
}
__device__ __forceinline__ void ada_partials(const Ctx& X, const float* c, const float* c_ctx, const float* ada_w, float* part) {
    LAS float* S = (LAS float*)(X.lds + 69632);
    for (int i = X.tid; i < 3 * D; i += NTHR) { const int cls = i / D, k = i % D; const float v = cls < 2 ? c[cls * D + k] : c_ctx[k]; S[i] = v / (1.f + expf(-v)); }
    __syncthreads();
    for (int it = X.gw; it < 4 * 48 * 16; it += X.ngw) {
        const int sl = it & 15, cb = (it >> 4) % 48, l = it / (16 * 48);
        const float* W = ada_w + ((size_t)l * D + sl * 128) * NMOD + cb * 256 + X.lane * 4;
        f32x4 a0 = {0.f, 0.f, 0.f, 0.f}, a1 = a0, a2 = a0;
#pragma unroll 8
        for (int kk = 0; kk < 128; ++kk) { const f32x4 w = *(const f32x4*)(W + (size_t)kk * NMOD); const int k = sl * 128 + kk; a0 += w * S[k]; a1 += w * S[D + k]; a2 += w * S[2 * D + k]; }
        float* P = part + ((size_t)(sl * 4 + l) * 3) * NMOD + cb * 256 + X.lane * 4;
        *(f32x4*)(P) = a0; *(f32x4*)(P + NMOD) = a1; *(f32x4*)(P + 2 * NMOD) = a2;
    }
}
__device__ __forceinline__ void rope_table(const Ctx& X, float* cosT, float* sinT) {
    for (int i = blockIdx.x * NTHR + X.tid; i < 2048; i += gridDim.x * NTHR) {
        const int pos = i >> 4, p = i & 15;
        const double f = exp(-(double)p * (9.210340371976184 / 16.0)); const double ang = (double)pos * f;
        const double k = rint(ang * 0.15915494309189535); const double r = ang - k * 6.283185307179586;
        cosT[i] = (float)cos(r); sinT[i] = (float)sin(r);
    }
}
__device__ __forceinline__ const float* modv(const float* mod, int l, int cls, int chunk) { return mod + ((size_t)(l * 3 + cls) * 6 + chunk) * D; }
__device__ __forceinline__ void vec_setup(const Ctx& X, const float* mod, const float* norm_g, bool has_gate, int l_gate, int chunk_gate, int gi_post, bool has_next, int l_next, int gi_pre, int chunk_sh, int chunk_sc) {
    LAS float* G = (LAS float*)(X.lds); LAS float* A = (LAS float*)(X.lds + 24576); LAS float* S = (LAS float*)(X.lds + 49152);
    for (int i = X.tid; i < 3 * D; i += NTHR) { const int cls = i / D, k = i % D;
        if (has_gate) G[i] = modv(mod, l_gate, cls, chunk_gate)[k] * norm_g[(l_gate * 4 + gi_post) * D + k];
        if (has_next) { A[i] = norm_g[(l_next * 4 + gi_pre) * D + k] * (1.f + modv(mod, l_next, cls, chunk_sc)[k]); S[i] = modv(mod, l_next, cls, chunk_sh)[k]; } }
    __syncthreads();
}
__device__ __forceinline__ void first_norm(const Ctx& X, const float* x, const float* ctx, float* h, bf16* a) {
    const LAS f32x4* A = (const LAS f32x4*)(X.lds + 24576); const LAS f32x4* S = (const LAS f32x4*)(X.lds + 49152);
    for (int row = X.gw; row < M; row += X.ngw) {
        const int cls = row < MLAT ? (row >> 13) : 2;
        const f32x4* src = (const f32x4*)(row < MLAT ? x + (size_t)row * D : ctx + (size_t)(row - MLAT) * D) + X.lane;
        f32x4 v[8]; float ss = 0.f;
#pragma unroll
        for (int j = 0; j < 8; ++j) { v[j] = src[64 * j]; ss += (v[j].x * v[j].x + v[j].y * v[j].y) + (v[j].z * v[j].z + v[j].w * v[j].w); }
        const float rstd = 1.f / sqrtf(wave_sum(ss) * (1.f / D) + EPS);
        f32x4* hp = (f32x4*)(h + (size_t)row * D) + X.lane; unsigned long long* ap = (unsigned long long*)(a + (size_t)row * D) + X.lane;
#pragma unroll
        for (int j = 0; j < 8; ++j) { hp[64 * j] = v[j]; const f32x4 av = A[cls * 512 + 64 * j + X.lane], sv = S[cls * 512 + 64 * j + X.lane]; const f32x4 o = v[j] * rstd * av + sv;
            ap[64 * j] = (unsigned long long)pkbf(o.x, o.y) | ((unsigned long long)pkbf(o.z, o.w) << 32); }
    }
}
template <int MODE> __device__ __forceinline__ void npost(const Ctx& X, const bf16* y, float* h, bf16* a, float* out) {
    const LAS f32x4* G = (const LAS f32x4*)(X.lds); const LAS f32x4* A = (const LAS f32x4*)(X.lds + 24576); const LAS f32x4* S = (const LAS f32x4*)(X.lds + 49152);
    const int nrows = MODE == 1 ? MLAT : M;
    for (int row = X.gw; row < nrows; row += X.ngw) {
        const int cls = row < MLAT ? (row >> 13) : 2;
        f32x4* hp = (f32x4*)(h + (size_t)row * D) + X.lane; const unsigned long long* yp = (const unsigned long long*)(y + (size_t)row * D) + X.lane;
        f32x4 hv[8], yv[8]; float ssy = 0.f;
#pragma unroll
        for (int j = 0; j < 8; ++j) { hv[j] = hp[64 * j]; const unsigned long long w = yp[64 * j]; const unsigned lo = (unsigned)w, hi = (unsigned)(w >> 32);
            yv[j] = (f32x4){bf_lo(lo), bf_hi(lo), bf_lo(hi), bf_hi(hi)}; ssy += (yv[j].x * yv[j].x + yv[j].y * yv[j].y) + (yv[j].z * yv[j].z + yv[j].w * yv[j].w); }
        const float rstd_y = 1.f / sqrtf(wave_sum(ssy) * (1.f / D) + EPS); float ssh = 0.f;
#pragma unroll
        for (int j = 0; j < 8; ++j) { const f32x4 g = G[cls * 512 + 64 * j + X.lane]; hv[j] = hv[j] + g * (yv[j] * rstd_y); ssh += (hv[j].x * hv[j].x + hv[j].y * hv[j].y) + (hv[j].z * hv[j].z + hv[j].w * hv[j].w); }
        if (MODE == 0) {
            const float rstd_h = 1.f / sqrtf(wave_sum(ssh) * (1.f / D) + EPS);
            unsigned long long* ap = (unsigned long long*)(a + (size_t)row * D) + X.lane;
#pragma unroll
            for (int j = 0; j < 8; ++j) { hp[64 * j] = hv[j]; const f32x4 av = A[cls * 512 + 64 * j + X.lane], sv = S[cls * 512 + 64 * j + X.lane]; const f32x4 o = hv[j] * rstd_h * av + sv;
                ap[64 * j] = (unsigned long long)pkbf(o.x, o.y) | ((unsigned long long)pkbf(o.z, o.w) << 32); }
        } else {
            f32x4* op = (f32x4*)(out + (size_t)row * D) + X.lane;
#pragma unroll
            for (int j = 0; j < 8; ++j) op[64 * j] = hv[j];
        }
    }
}
__device__ __forceinline__ void mla_rows(const Ctx& X, const bf16* Z, const float* g_q, const float* g_kv, const float* cosT, const float* sinT, bf16* CQN, bf16* CKVN, bf16* KPE) {
    for (int row = X.gw; row < M; row += X.ngw) {
        const bf16* z = Z + (size_t)row * 1280;
#pragma unroll
        for (int part = 0; part < 2; ++part) {
            const v4u w = *(const v4u*)(z + part * 512 + 8 * X.lane); float f[8]; unpack8(w, f); float ss = 0.f;
#pragma unroll
            for (int i = 0; i < 8; ++i) ss += f[i] * f[i];
            const float rstd = 1.f / sqrtf(wave_sum(ss) * (1.f / 512.f) + EPS); const float* g = (part ? g_kv : g_q) + 8 * X.lane;
            v4u o; o.x = pkbf(f[0] * rstd * g[0], f[1] * rstd * g[1]); o.y = pkbf(f[2] * rstd * g[2], f[3] * rstd * g[3]); o.z = pkbf(f[4] * rstd * g[4], f[5] * rstd * g[5]); o.w = pkbf(f[6] * rstd * g[6], f[7] * rstd * g[7]);
            *(v4u*)((part ? CKVN : CQN) + (size_t)row * 512 + 8 * X.lane) = o;
        }
        const float xv = bf1(z[1024 + X.lane]); float ov = xv;
        const float x1 = __shfl(xv, X.lane & ~16), x2 = __shfl(xv, X.lane | 16);
        if (row < MLAT) { const int s = row & 8191, pos = (X.lane >> 5) ? (s & 63) : (s >> 6), p = X.lane & 15; const float cs = cosT[pos * 16 + p], sn = sinT[pos * 16 + p];
            ov = (X.lane & 16) ? (x1 * sn + x2 * cs) : (x1 * cs - x2 * sn); }
        KPE[(size_t)row * 64 + X.lane] = (bf16)(pkbf(ov, 0.f) & 0xffffu);
    }
}
__device__ __forceinline__ void ml_rows(const Ctx& X, const bf16* Z, const float* conv_w, const float* b_gate, bf16* QK, float* G) {
    for (int row = X.gw; row < M; row += X.ngw) {
        bool hp, hn; if (row < MLAT) { const int s = row & 8191; hp = s > 0; hn = s < 8191; } else { const int n = (row - MLAT) & 255; hp = n > 0; hn = n < 255; }
        const bf16* z = Z + (size_t)row * 6400;
#pragma unroll
        for (int j = 0; j < 4; ++j) { const int col = 8 * X.lane + 512 * j;
            float x0[8], x1[8], x2[8]; const v4u zero = {0u, 0u, 0u, 0u};
            unpack8(hp ? *(const v4u*)(z - 6400 + col) : zero, x0); unpack8(*(const v4u*)(z + col), x1); unpack8(hn ? *(const v4u*)(z + 6400 + col) : zero, x2);
            float o[8];
#pragma unroll
            for (int i = 0; i < 8; ++i) { float v = conv_w[col + i] * x0[i] + conv_w[2048 + col + i] * x1[i] + conv_w[4096 + col + i] * x2[i]; v = v / (1.f + expf(-v)); o[i] = col < 1024 ? v * 0.08838834764831845f : v; }
            v4u w; w.x = pkbf(o[0], o[1]); w.y = pkbf(o[2], o[3]); w.z = pkbf(o[4], o[5]); w.w = pkbf(o[6], o[7]);
            *(v4u*)(QK + (size_t)row * 2048 + col) = w; }
        if (X.lane < 32) { float v = bf1(z[6144 + X.lane]) + b_gate[X.lane]; if ((X.lane >> 3) & 1) v = fminf(v, 0.f) - log1pf(expf(-fabsf(v))); G[(size_t)row * 32 + X.lane] = v; }
    }
}
__device__ __forceinline__ void ml_gate_rows(const Ctx& X, const bf16* Z, const bf16* HF, const bf16* HB, const float* g_head, bf16* O) {
    for (int row = X.gw; row < M; row += X.ngw) {
#pragma unroll
        for (int j = 0; j < 4; ++j) { const int col = 8 * X.lane + 512 * j;
            float a[8], b[8], g[8]; unpack8(*(const v4u*)(HF + (size_t)row * 2048 + col), a); unpack8(*(const v4u*)(HB + (size_t)row * 2048 + col), b); unpack8(*(const v4u*)(Z + (size_t)row * 6400 + 4096 + col), g);
            float ss = 0.f;
#pragma unroll
            for (int i = 0; i < 8; ++i) { a[i] += b[i]; ss += a[i] * a[i]; }
#pragma unroll
            for (int o = 1; o < 32; o <<= 1) ss += __shfl_xor(ss, o);
            const float rstd = 1.f / sqrtf(ss * (1.f / 256.f) + EPS); float o[8];
#pragma unroll
            for (int i = 0; i < 8; ++i) o[i] = a[i] * rstd * g_head[col + i] * sigmoidf_(g[i]);
            v4u w; w.x = pkbf(o[0], o[1]); w.y = pkbf(o[2], o[3]); w.z = pkbf(o[4], o[5]); w.w = pkbf(o[6], o[7]);
            *(v4u*)(O + (size_t)row * 2048 + col) = w; }
    }
}
#define ATT_UPDATE(sc, vptr) do { const float s_ = (sc); const float mn_ = fmaxf(m_run, s_); const float corr_ = __expf(m_run - mn_), p_ = __expf(s_ - mn_); l_run = l_run * corr_ + p_; m_run = mn_; \
    _Pragma("unroll") for (int c_ = 0; c_ < 4; ++c_) { float vf_[8]; unpack8(*(const v4u*)((vptr) + 8 * c_), vf_); _Pragma("unroll") for (int i_ = 0; i_ < 8; ++i_) o[8 * c_ + i_] = o[8 * c_ + i_] * corr_ + p_ * vf_[i_]; } } while (0)
__device__ __forceinline__ float dot32(const bf16* kp, const float* q) { float s = 0.f;
#pragma unroll
    for (int c = 0; c < 4; ++c) { float kf[8]; unpack8(*(const v4u*)(kp + 8 * c), kf);
#pragma unroll
        for (int i = 0; i < 8; ++i) s += q[8 * c + i] * kf[i]; }
    return s; }
__device__ __forceinline__ float quad_sum(float s) { s += __shfl_xor(s, 1); s += __shfl_xor(s, 2); return s; }
__device__ __forceinline__ void store_o32(bf16* op, const float* o, float inv) {
#pragma unroll
    for (int c = 0; c < 4; ++c) { v4u w; w.x = pkbf(o[8 * c] * inv, o[8 * c + 1] * inv); w.y = pkbf(o[8 * c + 2] * inv, o[8 * c + 3] * inv); w.z = pkbf(o[8 * c + 4] * inv, o[8 * c + 5] * inv); w.w = pkbf(o[8 * c + 6] * inv, o[8 * c + 7] * inv); *(v4u*)(op + 8 * c) = w; } }

__device__ __forceinline__ void na_attn_naive(const Ctx& X, const bf16* QKV, const float* rpb, bf16* O, int nrows) {
    const int hd = X.lane >> 2, j = X.lane & 3; const float scale = 0.08838834764831845f;
    for (int row = X.gw; row < nrows; row += X.ngw) {
        float q[32], o[32]; float m_run = -INFINITY, l_run = 0.f;
#pragma unroll
        for (int c = 0; c < 4; ++c) unpack8(*(const v4u*)(QKV + (size_t)row * 6144 + hd * 128 + 32 * j + 8 * c), q + 8 * c);
#pragma unroll
        for (int i = 0; i < 32; ++i) o[i] = 0.f;
        int b;
        if (row < MLAT) {
            b = row >> 13; const int s = row & 8191, r = s >> 6, c = s & 63;
            const int rs = min(max(r - 4, 0), 120), cs = min(max(c - 8, 0), 48);
            for (int jr = 0; jr < 8; ++jr) for (int jc = 0; jc < 16; ++jc) {
                const int kr = rs + jr, kc = cs + jc; const size_t key = (size_t)b * 8192 + kr * 64 + kc;
                const float bias = rpb[(hd * 15 + (kr - r + 7)) * 31 + (kc - c + 15)];
                const bf16* kp = QKV + key * 6144 + 2048 + hd * 128 + 32 * j;
                const float sc = quad_sum(dot32(kp, q)) * scale + bias;
                ATT_UPDATE(sc, kp + 2048);
            }
        } else b = (row - MLAT) >> 8;
        for (int n = 0; n < 256; ++n) {
            const size_t key = (size_t)MLAT + b * 256 + n; const bf16* kp = QKV + key * 6144 + 2048 + hd * 128 + 32 * j;
            const float sc = quad_sum(dot32(kp, q)) * scale;
            ATT_UPDATE(sc, kp + 2048);
        }
        store_o32(O + (size_t)row * 2048 + hd * 128 + 32 * j, o, 1.f / l_run);
    }
}
__device__ __forceinline__ void mla_attn_naive(const Ctx& X, const bf16* QH, const bf16* KV, const bf16* KPE, const float* cosT, const float* sinT, bf16* O) {
    const int hd = X.lane >> 2, j = X.lane & 3; const float scale = 0.07216878364870322f;
    for (int row = X.gw; row < M; row += X.ngw) {
        float q[32], qp[16], o[32]; float m_run = -INFINITY, l_run = 0.f;
        const bf16* qrow = QH + (size_t)row * 3072 + hd * 192;
#pragma unroll
        for (int c = 0; c < 4; ++c) unpack8(*(const v4u*)(qrow + 32 * j + 8 * c), q + 8 * c);
        {
            const int axis = j >> 1; float x1[16], x2[16];
            unpack8(*(const v4u*)(qrow + 128 + axis * 32), x1); unpack8(*(const v4u*)(qrow + 128 + axis * 32 + 8), x1 + 8);
            unpack8(*(const v4u*)(qrow + 128 + axis * 32 + 16), x2); unpack8(*(const v4u*)(qrow + 128 + axis * 32 + 24), x2 + 8);
            if (row < MLAT) { const int s = row & 8191, pos = axis ? (s & 63) : (s >> 6);
#pragma unroll
                for (int p = 0; p < 16; ++p) { const float cs = cosT[pos * 16 + p], sn = sinT[pos * 16 + p]; qp[p] = (j & 1) ? (x1[p] * sn + x2[p] * cs) : (x1[p] * cs - x2[p] * sn); }
            } else {
#pragma unroll
                for (int p = 0; p < 16; ++p) qp[p] = (j & 1) ? x2[p] : x1[p];
            }
        }
#pragma unroll
        for (int i = 0; i < 32; ++i) o[i] = 0.f;
        const int b = row < MLAT ? (row >> 13) : ((row - MLAT) >> 8);
        const int nkeys = row < MLAT ? (256 + 8192) : 256;
        for (int n = 0; n < nkeys; ++n) {
            const size_t key = n < 256 ? (size_t)MLAT + b * 256 + n : (size_t)b * 8192 + (n - 256);
            const bf16* kp = KV + key * 4096 + hd * 256 + 32 * j; const bf16* pp = KPE + key * 64 + 16 * j;
            float s = dot32(kp, q); float kf[16]; unpack8(*(const v4u*)(pp), kf); unpack8(*(const v4u*)(pp + 8), kf + 8);
#pragma unroll
            for (int p = 0; p < 16; ++p) s += qp[p] * kf[p];
            const float sc = quad_sum(s) * scale;
            ATT_UPDATE(sc, kp + 128);
        }
        store_o32(O + (size_t)row * 2048 + hd * 128 + 32 * j, o, 1.f / l_run);
    }
}
__device__ __forceinline__ void ml_scan_naive(const Ctx& X, const bf16* QK, const bf16* Z, const float* G, bf16* HF, bf16* HB) {
    LAS float* L = (LAS float*)X.lds;
    LAS float* q = L; LAS float* k = L + 8256; LAS float* v = L + 16512; LAS float* S = L + 18624; LAS float* C = L + 22784; LAS float* nv = L + 27008;
    LAS float* li = L + 27136; LAS float* lf = L + 27200; LAS float* bc = L + 27264; LAS float* mt = L + 27328; LAS float* ex = L + 27392; LAS float* misc = L + 27456;
    const int tid = X.tid, t = tid >> 3, part = tid & 7;
    for (int u = blockIdx.x; u < 256; u += gridDim.x) {
        const int slice = u & 7, dir = (u >> 3) & 1, hd = (u >> 4) & 7, b = u >> 7;
        for (int i = tid; i < 128 * 33; i += NTHR) C[i] = 0.f;
        if (tid < 128) nv[tid] = 0.f;
        float m_run = 0.f;
        bf16* H = dir ? HB : HF;
        __syncthreads();
        for (int n = 0; n < 132; ++n) {
            int base;
            if (dir == 0) base = n < 4 ? MLAT + b * 256 + 64 * n : b * 8192 + 64 * (n - 4);
            else base = n < 4 ? MLAT + b * 256 + 64 * (3 - n) : b * 8192 + 64 * (131 - n);
            const int row = base + (dir ? 63 - t : t);
            {
                float f[16];
                unpack8(*(const v4u*)(QK + (size_t)row * 2048 + hd * 128 + part * 16), f); unpack8(*(const v4u*)(QK + (size_t)row * 2048 + hd * 128 + part * 16 + 8), f + 8);
#pragma unroll
                for (int i = 0; i < 16; ++i) q[t * 129 + part * 16 + i] = f[i];
                unpack8(*(const v4u*)(QK + (size_t)row * 2048 + 1024 + hd * 128 + part * 16), f); unpack8(*(const v4u*)(QK + (size_t)row * 2048 + 1024 + hd * 128 + part * 16 + 8), f + 8);
#pragma unroll
                for (int i = 0; i < 16; ++i) k[t * 129 + part * 16 + i] = f[i];
                const unsigned long long w = *(const unsigned long long*)(Z + (size_t)row * 6400 + 2048 + hd * 256 + slice * 32 + part * 4); const unsigned lo = (unsigned)w, hi = (unsigned)(w >> 32);
                v[t * 33 + part * 4 + 0] = bf_lo(lo); v[t * 33 + part * 4 + 1] = bf_hi(lo); v[t * 33 + part * 4 + 2] = bf_lo(hi); v[t * 33 + part * 4 + 3] = bf_hi(hi);
                if (tid < 64) { const int row2 = base + (dir ? 63 - tid : tid); li[tid] = G[(size_t)row2 * 32 + dir * 16 + hd]; lf[tid] = G[(size_t)row2 * 32 + dir * 16 + 8 + hd]; }
            }
            __syncthreads();
            if (tid == 0) {
                float bsum = 0.f, pm = -INFINITY;
                for (int s = 0; s < 64; ++s) { bsum += lf[s]; bc[s] = bsum; pm = fmaxf(pm, li[s] - bsum); mt[s] = bsum + fmaxf(m_run, pm); }
                const float m_new = bsum + fmaxf(m_run, pm); misc[0] = m_new; misc[1] = expf(bsum + m_run - m_new);
                for (int s = 0; s < 64; ++s) ex[s] = expf(bsum - bc[s] + li[s] - m_new);
            }
            __syncthreads();
            {
                const float bt = bc[t], mtt = mt[t];
                for (int i = 0; i < 8; ++i) { const int s = part + 8 * i; float r = 0.f;
                    if (s <= t) { float dsum = 0.f; for (int d = 0; d < 128; ++d) dsum += q[t * 129 + d] * k[s * 129 + d]; r = dsum * expf(bt - bc[s] + li[s] - mtt); }
                    S[t * 65 + s] = r; }
            }
            __syncthreads();
            {
                const float mtt = mt[t], winter = expf(bc[t] + m_run - mtt);
                float den = 0.f; for (int d = 0; d < 128; ++d) den += q[t * 129 + d] * nv[d];
                den *= winter; for (int s = 0; s < 64; ++s) den += S[t * 65 + s];
                const float dn = fmaxf(fabsf(den), expf(-mtt)); float hv[4];
#pragma unroll
                for (int i = 0; i < 4; ++i) { const int e = part * 4 + i; float a = 0.f; for (int d = 0; d < 128; ++d) a += q[t * 129 + d] * C[d * 33 + e];
                    a *= winter; for (int s = 0; s < 64; ++s) a += S[t * 65 + s] * v[s * 33 + e]; hv[i] = a / dn; }
                *(unsigned long long*)(H + (size_t)row * 2048 + hd * 256 + slice * 32 + part * 4) = (unsigned long long)pkbf(hv[0], hv[1]) | ((unsigned long long)pkbf(hv[2], hv[3]) << 32);
            }
            __syncthreads();
            { const float e = ex[t];
#pragma unroll
              for (int i = 0; i < 16; ++i) k[t * 129 + part * 16 + i] *= e; }
            __syncthreads();
            {
                const int d = tid >> 2, eg = (tid & 3) * 8; const float decay = misc[1];
#pragma unroll
                for (int i = 0; i < 8; ++i) { const int e = eg + i; float a = 0.f; for (int s = 0; s < 64; ++s) a += k[s * 129 + d] * v[s * 33 + e]; C[d * 33 + e] = decay * C[d * 33 + e] + a; }
                if ((tid & 3) == 0) { float a = 0.f; for (int s = 0; s < 64; ++s) a += k[s * 129 + d]; nv[d] = decay * nv[d] + a; }
                m_run = misc[0];
            }
            __syncthreads();
        }
    }
}

struct Args { const float* in[23]; float* out; unsigned char* ws; int ph_lo, ph_hi; };
constexpr int PH_LAYER0 = 3, PH_PER_LAYER = 9, NPHASES = PH_LAYER0 + DEPTH * PH_PER_LAYER;
__host__ __device__ constexpr bool phase_active(int p) { return p < PH_LAYER0 ? true : !((((p - PH_LAYER0) / PH_PER_LAYER) % 3 == 0) && (((p - PH_LAYER0) % PH_PER_LAYER) == 2 || ((p - PH_LAYER0) % PH_PER_LAYER) == 3)); }

#define IN(k) (lo <= (k) && (k) < hi)
#define SEAM(k) do { if (single && (k) + 1 < hi) xcd_barrier(bar); } while (0)
template <int L> __device__ __forceinline__ void run_layer(const Ctx& X, const Args& args, const XcdBarrier& bar, const int lo, const int hi, const bool single) {
    unsigned char* ws = args.ws; const int G = gridDim.x;
    const float* norm_g = args.in[6];
    float* mod = (float*)(ws + WS_MOD); float* cosT = (float*)(ws + WS_ROPE); float* sinT = cosT + 2048;
    float* h = (float*)(ws + WS_H); bf16* a = (bf16*)(ws + WS_A); bf16* y = (bf16*)(ws + WS_Y); bf16* o = (bf16*)(ws + WS_O); unsigned char* big = ws + WS_BIG;
        constexpr int kind = L % 3, jj = L / 3, pb = PH_LAYER0 + L * PH_PER_LAYER;
        const bf16* wo_t;
        if constexpr (kind == 0) {
            bf16* QKV = (bf16*)(big + BIG_QKV); wo_t = (const bf16*)(ws + WS_NAWO) + (size_t)jj * D * D;
            if (IN(pb + 0)) { pg8::Gemm g{a, (const bf16*)(ws + WS_NAQKV) + (size_t)jj * D * 6144, M, 6144, D}; pg8::StaticOrder S; S.init(M, 6144, G, (int)blockIdx.x); pg8::EpiBf16<0> E{QKV, 6144};
                pg8::gemm_phase<pg8::EpiBf16<0>, pg8::StaticOrder, true, true>(X.lds, g, S, E); SEAM(pb + 0); }
            if (IN(pb + 1)) { na_attn_naive(X, QKV, args.in[10] + (size_t)jj * 16 * 15 * 31, o, M); SEAM(pb + 1); }
        } else if constexpr (kind == 1) {
            bf16* Z = (bf16*)(big + BIG_MZ); bf16* QH = (bf16*)(big + BIG_QH); bf16* KV = (bf16*)(big + BIG_KV); bf16* CQN = (bf16*)(big + BIG_CQN); bf16* CKVN = (bf16*)(big + BIG_CKVN); bf16* KPE = (bf16*)(big + BIG_KPE);
            wo_t = (const bf16*)(ws + WS_MLAWO);
            if (IN(pb + 0)) { pg8::Gemm g{a, (const bf16*)(ws + WS_MLAIN), M, 1280, D}; pg8::StaticOrder S; S.init(M, 1280, G, (int)blockIdx.x); pg8::EpiBf16<0> E{Z, 1280};
                pg8::gemm_phase<pg8::EpiBf16<0>, pg8::StaticOrder, true, true>(X.lds, g, S, E); SEAM(pb + 0); }
            if (IN(pb + 1)) { mla_rows(X, Z, args.in[13], args.in[14], cosT, sinT, CQN, CKVN, KPE); SEAM(pb + 1); }
            if (IN(pb + 2)) {
                { pg8::Gemm g{CQN, (const bf16*)(ws + WS_MLAUQ), M, 3072, 512}; pg8::StaticOrder S; S.init(M, 3072, G, (int)blockIdx.x); pg8::EpiBf16<0> E{QH, 3072};
                  pg8::gemm_phase<pg8::EpiBf16<0>, pg8::StaticOrder, true, true>(X.lds, g, S, E); }
                { pg8::Gemm g{CKVN, (const bf16*)(ws + WS_MLAUKV), M, 4096, 512}; pg8::StaticOrder S; S.init(M, 4096, G, (int)blockIdx.x); pg8::EpiBf16<0> E{KV, 4096};
                  pg8::gemm_phase<pg8::EpiBf16<0>, pg8::StaticOrder, true, true>(X.lds, g, S, E); }
                SEAM(pb + 2); }
            if (IN(pb + 3)) { mla_attn_naive(X, QH, KV, KPE, cosT, sinT, o); SEAM(pb + 3); }
        } else {
            bf16* Z = (bf16*)(big + BIG_LZ); bf16* QK = (bf16*)(big + BIG_LQK); float* GT = (float*)(big + BIG_LG);
            wo_t = (const bf16*)(ws + WS_MLWO);
            if (IN(pb + 0)) { pg8::Gemm g{a, (const bf16*)(ws + WS_MLIN), M, 6400, D}; pg8::StaticOrder S; S.init(M, 6400, G, (int)blockIdx.x); pg8::EpiBf16<0> E{Z, 6400};
                pg8::gemm_phase<pg8::EpiBf16<0>, pg8::StaticOrder, true, true>(X.lds, g, S, E); SEAM(pb + 0); }
            if (IN(pb + 1)) { ml_rows(X, Z, args.in[20], args.in[19], QK, GT); SEAM(pb + 1); }
            if (IN(pb + 2)) { ml_scan_naive(X, QK, Z, GT, y, a); SEAM(pb + 2); }
            if (IN(pb + 3)) { ml_gate_rows(X, Z, y, a, args.in[21], o); SEAM(pb + 3); }
        }
        if (IN(pb + 4)) { pg8::Gemm g{o, wo_t, M, D, D}; pg8::StaticOrder S; S.init(M, D, G, (int)blockIdx.x); pg8::EpiBf16<0> E{y, D};
            pg8::gemm_phase<pg8::EpiBf16<0>, pg8::StaticOrder, true, true>(X.lds, g, S, E); SEAM(pb + 4); }
        if (IN(pb + 5)) { vec_setup(X, mod, norm_g, true, L, 2, 1, true, L, 2, 3, 4); npost<0>(X, y, h, a, nullptr); __syncthreads(); SEAM(pb + 5); }
        bf16* HID = (bf16*)(big + BIG_HID);
        if (IN(pb + 6)) { pg8::Gemm g{a, (const bf16*)(ws + WS_W1T) + (size_t)L * D * DFF, M, DFF, D}; pg8::StaticOrder S; S.init(M, DFF, G, (int)blockIdx.x); pg8::EpiBf16<2> E{HID, DFF};
            pg8::gemm_phase<pg8::EpiBf16<2>, pg8::StaticOrder, true, true>(X.lds, g, S, E); SEAM(pb + 6); }
        if (IN(pb + 7)) { pg8::Gemm g{HID, (const bf16*)(ws + WS_W2T) + (size_t)L * D * DFF, M, D, DFF}; pg8::StaticOrder S; S.init(M, D, G, (int)blockIdx.x); pg8::EpiBf16<0> E{y, D};
            pg8::gemm_phase<pg8::EpiBf16<0>, pg8::StaticOrder, true, true>(X.lds, g, S, E); SEAM(pb + 7); }
        if (IN(pb + 8)) {
            if (L < DEPTH - 1) { vec_setup(X, mod, norm_g, true, L, 5, 3, true, L + 1, 0, 0, 1); npost<0>(X, y, h, a, nullptr); }
            else { vec_setup(X, mod, norm_g, true, L, 5, 3, false, 0, 0, 0, 0); npost<1>(X, y, h, nullptr, args.out); }
            __syncthreads(); SEAM(pb + 8); }
}
__global__ void __launch_bounds__(NTHR, 2) mega_fwd(Args args) {
    extern __shared__ __attribute__((aligned(16))) unsigned char lds_raw[];
    Ctx X; X.lds = (LAS unsigned char*)lds_raw; X.tid = threadIdx.x; X.lane = X.tid & 63; X.wave = __builtin_amdgcn_readfirstlane(X.tid >> 6);
    X.gw = blockIdx.x * NWAVES + X.wave; X.ngw = gridDim.x * NWAVES;
    volatile LAS unsigned* MISC = (volatile LAS unsigned*)(X.lds + MISC_OFF);
    for (int u = X.tid; u < (LDS_BYTES - RING_BYTES) / 4; u += NTHR) ((LAS unsigned*)(X.lds + RING_BYTES))[u] = 0u;
    __syncthreads();
    unsigned char* ws = args.ws;
    const int lo = args.ph_lo, hi = args.ph_hi; const bool single = (hi - lo) > 1;
    XcdBarrier bar; bar.bar = (unsigned*)(ws + WS_CTL) + CW_BAR; bar.x = 0; bar.st = nullptr;
    if (single) bar = xcd_barrier_post((unsigned*)(ws + WS_CTL) + CW_BAR, MISC + 8);
    const float* x = args.in[0]; const float* c = args.in[1]; const float* ctx = args.in[2]; const float* c_ctx = args.in[3]; const float* ada_w = args.in[4]; const float* ada_b = args.in[5]; const float* norm_g = args.in[6];
    float* mod = (float*)(ws + WS_MOD); float* cosT = (float*)(ws + WS_ROPE); float* sinT = cosT + 2048; float* part = (float*)(ws + WS_PART);
    float* h = (float*)(ws + WS_H); bf16* a = (bf16*)(ws + WS_A); bf16* y = (bf16*)(ws + WS_Y); bf16* o = (bf16*)(ws + WS_O); unsigned char* big = ws + WS_BIG;
    const int G = gridDim.x;

    if (IN(0)) {
        ada_partials(X, c, c_ctx, ada_w, part);
        rope_table(X, cosT, sinT);
        zero_bf16(X, (bf16*)(ws + WS_MLAIN) + (size_t)1088 * 2048, (size_t)192 * 2048 / 8);
        zero_bf16(X, (bf16*)(ws + WS_MLIN) + (size_t)6176 * 2048, (size_t)224 * 2048 / 8);
        for (int l = 0; l < 4; ++l) { tr_matrix(X, args.in[7] + (size_t)l * D * DFF, D, DFF, (bf16*)(ws + WS_W1T) + (size_t)l * D * DFF); tr_matrix(X, args.in[8] + (size_t)l * D * DFF, DFF, D, (bf16*)(ws + WS_W2T) + (size_t)l * D * DFF); }
        for (int j = 0; j < 2; ++j) { tr_matrix(X, args.in[9] + (size_t)j * D * 6144, D, 6144, (bf16*)(ws + WS_NAQKV) + (size_t)j * D * 6144); tr_matrix(X, args.in[11] + (size_t)j * D * D, D, D, (bf16*)(ws + WS_NAWO) + (size_t)j * D * D); }
        tr_matrix(X, args.in[12], D, 1088, (bf16*)(ws + WS_MLAIN)); tr_matrix(X, args.in[15], 512, 3072, (bf16*)(ws + WS_MLAUQ)); tr_matrix(X, args.in[16], 512, 4096, (bf16*)(ws + WS_MLAUKV)); tr_matrix(X, args.in[17], D, D, (bf16*)(ws + WS_MLAWO));
        tr_matrix(X, args.in[18], D, 6176, (bf16*)(ws + WS_MLIN)); tr_matrix(X, args.in[22], D, D, (bf16*)(ws + WS_MLWO));
        __syncthreads();
        SEAM(0);
    }
    if (IN(1)) {
        for (int i = blockIdx.x * NTHR + X.tid; i < 4 * 3 * NMOD; i += G * NTHR) { const int l = i / (3 * NMOD), rem = i % (3 * NMOD), j = rem % NMOD; float s = ada_b[l * NMOD + j];
            for (int sl = 0; sl < 16; ++sl) s += part[((size_t)(sl * 4 + l) * 3) * NMOD + rem];
            mod[i] = s; }
        SEAM(1);
    }
    if (IN(2)) {
        vec_setup(X, mod, norm_g, false, 0, 0, 0, true, 0, 0, 0, 1);
        first_norm(X, x, ctx, h, a);
        __syncthreads();
        SEAM(2);
    }
    run_layer<0>(X, args, bar, lo, hi, single); run_layer<1>(X, args, bar, lo, hi, single); run_layer<2>(X, args, bar, lo, hi, single); run_layer<3>(X, args, bar, lo, hi, single);
#undef IN
#undef SEAM
}

#ifndef MK_SINGLE
#define MK_SINGLE 0
#endif
extern "C" void kernel_launch(void* const* d_in, const int* in_sizes, int n_in, void* d_out, int out_size, void* d_ws, size_t ws_size, hipStream_t stream) {
    static int grid = 0;
    if (grid == 0) {
        if (n_in != 23 || in_sizes[0] != MLAT * D || out_size != MLAT * D || ws_size < WS_END) { fprintf(stderr, "kernel_launch: shape mismatch n_in %d in0 %d out %d ws %zu (need %zu)\n", n_in, n_in > 0 ? in_sizes[0] : -1, out_size, ws_size, (size_t)WS_END); grid = -1; return; }
        int dev = 0, cus = 0;
        if (hipGetDevice(&dev) != hipSuccess || hipDeviceGetAttribute(&cus, hipDeviceAttributeMultiprocessorCount, dev) != hipSuccess) { grid = -1; return; }
        if (hipFuncSetAttribute((const void*)mega_fwd, hipFuncAttributeMaxDynamicSharedMemorySize, LDS_BYTES) != hipSuccess) { fprintf(stderr, "kernel_launch: hipFuncSetAttribute failed\n"); grid = -1; return; }
        int per_cu = 0;
        if (hipOccupancyMaxActiveBlocksPerMultiprocessor(&per_cu, (const void*)mega_fwd, NTHR, LDS_BYTES) != hipSuccess || per_cu < 1) fprintf(stderr, "kernel_launch: occupancy query reports %d\n", per_cu);
        (void)hipGetLastError();
        grid = cus;
    }
    if (grid < 0) return;
    if (hipMemsetAsync((char*)d_ws + WS_CTL, 0, CTL_ZERO_BYTES, stream) != hipSuccess) return;
    Args a{};
    for (int i = 0; i < 23; ++i) a.in[i] = (const float*)d_in[i];
    a.out = (float*)d_out; a.ws = (unsigned char*)d_ws;
#if MK_SINGLE
    a.ph_lo = 0; a.ph_hi = NPHASES;
    hipLaunchKernelGGL(mega_fwd, dim3(grid), dim3(NTHR), LDS_BYTES, stream, a);
#else
    for (int p = 0; p < NPHASES; ++p) { if (!phase_active(p)) continue; a.ph_lo = p; a.ph_hi = p + 1; hipLaunchKernelGGL(mega_fwd, dim3(grid), dim3(NTHR), LDS_BYTES, stream, a); }
#endif
    const hipError_t le = hipPeekAtLastError();
    if (le != hipSuccess) fprintf(stderr, "kernel_launch: launch failed: %s\n", hipGetErrorName(le));
}
```

```cpp
#include <hip/hip_runtime.h>
#include <cstdio>
#include <cstdint>
#include <cmath>
namespace pg8 {
#define PG8_LAS __attribute__((address_space(3)))
typedef unsigned short bf16_t;
typedef short bf16x8 __attribute__((ext_vector_type(8)));
typedef float f32x4 __attribute__((ext_vector_type(4)));
typedef unsigned u32x4 __attribute__((ext_vector_type(4)));
constexpr int BM = 256, BK = 64, HALF = 128, HTB = HALF * BK * 2  , STAGE_BYTES = 8 * HTB, NXCD = 8, WGM = 8;

__host__ __device__ __forceinline__ int lds_byte(int r, int c) { const int st = (r >> 4) * 2 + (c >> 5), rr = r & 15, cc = c & 31, ob = rr * 64 + cc * 2; return st * 1024 + (ob ^ (((ob >> 9) & 1) << 5)); }
__host__ __device__ __forceinline__ void stage_rc(int b, int& R, int& C) { const int st = b / 1024, sb = b % 1024, swz = sb ^ (((sb >> 9) & 1) << 5); R = (st >> 1) * 16 + swz / 64; C = (st & 1) * 32 + (swz % 64) / 2; }
__host__ __device__ __forceinline__ int perm32(int rho) { const int n = rho >> 4, i = rho & 15; return 8 * (i >> 2) + 4 * n + (i & 3); }

struct Unit { int pm, pn, pk; };
struct Gemm { const bf16_t* A; const bf16_t* Bt; int M, N, K, ld; };

struct StaticOrder {
    int nM, nN, nwg, G, c, wgm;
    __host__ __device__ void init(int M, int N, int G_, int c_, int wgm_ = WGM) { nM = M / BM; nN = N / BM; nwg = nM * nN; G = G_; c = c_; wgm = wgm_; }
    __host__ __device__ bool next(int i, Unit& u) const {
        const long L = (long)i * G + c; if (L >= nwg) return false;
        int wgid = (int)L; { const int q = nwg / NXCD, r = nwg % NXCD, xcd = wgid % NXCD, off = wgid / NXCD; wgid = (xcd < r ? xcd * (q + 1) : r * (q + 1) + (xcd - r) * q) + off; }
        const int nig = wgm * nN, gid = wgid / nig, fm = gid * wgm, gsz = (nM - fm) < wgm ? (nM - fm) : wgm;
        u.pm = fm + ((wgid % nig) % gsz); u.pn = (wgid % nig) / gsz; u.pk = 0; return true;
    }
    __device__ __forceinline__ void a_ready(const Unit&) const {}
    __device__ __forceinline__ void done(const Unit&) const {}
};

struct SplitKOrder {
    int nN, KS, nitems, G, c;
    __host__ __device__ void init(int M, int N, int KS_, int G_, int c_) { nN = N / BM; KS = KS_; nitems = (M / BM) * nN * KS_; G = G_; c = c_; }
    __host__ __device__ bool next(int i, Unit& u) const { const long L = (long)i * G + c; if (L >= nitems) return false; const int l = (int)L; u.pk = l % KS; const int t = l / KS; u.pn = t % nN; u.pm = t / nN; return true; }
    __device__ __forceinline__ void a_ready(const Unit&) const {}
    __device__ __forceinline__ void done(const Unit&) const {}
};

__device__ __forceinline__ unsigned cvt_pk_bf16(float lo, float hi) { unsigned r; asm volatile("v_cvt_pk_bf16_f32 %0, %1, %2" : "=v"(r) : "v"(lo), "v"(hi)); return r; }
typedef float f32x2 __attribute__((ext_vector_type(2)));
template <int ACT> struct EpiBf16 {
    static constexpr bool PERM = true, AFTER_DRAIN = false;
    bf16_t* O; int ldc;
    __device__ __forceinline__ void operator()(const f32x4 (&acc)[2][2][4][2], const Unit& u, int wr, int wc, int fr, int fq) const {
        const int row0 = u.pm * BM + wr * 64 + fr; const int col0 = u.pn * BM + wc * 32 + 8 * fq;
#pragma unroll
        for (int ai = 0; ai < 2; ++ai)
#pragma unroll
            for (int m = 0; m < 4; ++m) { bf16_t* rowp = O + (size_t)(row0 + ai * HALF + m * 16) * ldc + col0;
#pragma unroll
                for (int bj = 0; bj < 2; ++bj) { f32x4 v0 = acc[ai][bj][m][0], v1 = acc[ai][bj][m][1];
                    if (ACT == 2) {
#pragma unroll
                        for (int e = 0; e < 4; ++e) { const float a = v0[e] > 0.f ? v0[e] : 0.f, b = v1[e] > 0.f ? v1[e] : 0.f; v0[e] = a * a; v1[e] = b * b; } }
                    u32x4 w; w.x = cvt_pk_bf16(v0[0], v0[1]); w.y = cvt_pk_bf16(v0[2], v0[3]); w.z = cvt_pk_bf16(v1[0], v1[1]); w.w = cvt_pk_bf16(v1[2], v1[3]);
                    *(u32x4*)(rowp + bj * HALF) = w; } }
    }
};

struct EpiF32Slab {
    static constexpr bool PERM = false, AFTER_DRAIN = false;
    float* O; int ldc; size_t slab;
    __device__ __forceinline__ void operator()(const f32x4 (&acc)[2][2][4][2], const Unit& u, int wr, int wc, int fr, int fq) const {
        const int row0 = u.pm * BM + wr * 64 + fr; const int col0 = u.pn * BM + wc * 32 + 4 * fq; float* base = O + (size_t)u.pk * slab;
#pragma unroll
        for (int ai = 0; ai < 2; ++ai)
#pragma unroll
            for (int m = 0; m < 4; ++m) { float* rowp = base + (size_t)(row0 + ai * HALF + m * 16) * ldc + col0;
#pragma unroll
                for (int bj = 0; bj < 2; ++bj)
#pragma unroll
                    for (int n = 0; n < 2; ++n) *(f32x4*)(rowp + bj * HALF + n * 16) = acc[ai][bj][m][n]; }
    }
};

template <class Epi, class Sched, bool ALIGN_EPI = false, bool SP2 = false>
__device__ __forceinline__ void gemm_phase(PG8_LAS unsigned char* lds, const Gemm g, const Sched& S, const Epi& E) {
    const int tid = threadIdx.x, wid = __builtin_amdgcn_readfirstlane(tid >> 6), lane = tid & 63, wr = wid >> 2, wc = wid & 3, fr = lane & 15, fq = lane >> 4;
    const int K = g.K, nt = K / BK, ld = g.ld ? g.ld : g.K;
    unsigned voffA[2], voffB[2];
#pragma unroll
    for (int i = 0; i < 2; ++i) { int R, C; stage_rc(tid * 16 + i * 8192, R, C); const int Rb = Epi::PERM ? ((R & ~31) + perm32(R & 31)) : R;
        voffA[i] = (unsigned)(R * ld + C) * 2u; voffB[i] = (unsigned)(Rb * ld + C) * 2u; }
    const size_t kstep = (size_t)(BK * 2);
    const size_t hstep = (size_t)HALF * ld * 2;
    const size_t tstep = 2 * hstep;
    const unsigned ldsw = (unsigned)wid * 1024u;
    const int aoff = lds_byte(wr * 64 + fr, fq * 8), boff = lds_byte(wc * 32 + fr, fq * 8);
#define PG8_SA(b, h) (((b) * 2 + (h)) * HTB)
#define PG8_SB(b, h) ((4 + (b) * 2 + (h)) * HTB)
#define PG8_STAGE(bufoff, gbase, voff) do { _Pragma("unroll") for (int _i = 0; _i < 2; ++_i) \
        __builtin_amdgcn_global_load_lds((const unsigned*)((const char*)(gbase) + (voff)[_i]), (PG8_LAS unsigned*)(lds + (bufoff) + ldsw + _i * 8192), 16, 0, 0); } while (0)
#define PG8_LDA(dst, b, h) do { _Pragma("unroll") for (int m = 0; m < 4; ++m) _Pragma("unroll") for (int k = 0; k < 2; ++k) dst[m][k] = *(const PG8_LAS bf16x8*)(lds + PG8_SA(b, h) + aoff + m * 2048 + k * 1024); } while (0)
#define PG8_LDB(dst, b, h) do { _Pragma("unroll") for (int n = 0; n < 2; ++n) _Pragma("unroll") for (int k = 0; k < 2; ++k) dst[n][k] = *(const PG8_LAS bf16x8*)(lds + PG8_SB(b, h) + boff + n * 2048 + k * 1024); } while (0)
#define PG8_MMA(ai, bj, At, Bt) do { __builtin_amdgcn_s_setprio(1); _Pragma("unroll") for (int m = 0; m < 4; ++m) _Pragma("unroll") for (int n = 0; n < 2; ++n) _Pragma("unroll") for (int k = 0; k < 2; ++k) \
        acc[ai][bj][m][n] = __builtin_amdgcn_mfma_f32_16x16x32_bf16(Bt[n][k], At[m][k], acc[ai][bj][m][n], 0, 0, 0); __builtin_amdgcn_s_setprio(0); } while (0)
#define PG8_WAIT_V(n) asm volatile("s_waitcnt vmcnt(" #n ")" ::: "memory")
#define PG8_WAIT_L(n) asm volatile("s_waitcnt lgkmcnt(" #n ")" ::: "memory")
#define PG8_BAR __builtin_amdgcn_s_barrier()
#define PG8_SCHED __builtin_amdgcn_sched_barrier(0)
    Unit cur, nxt; int ui = 0;
    if (!S.next(0, cur)) return;
    f32x4 acc[2][2][4][2];
#pragma unroll
    for (int a = 0; a < 2; ++a)
#pragma unroll
        for (int b = 0; b < 2; ++b)
#pragma unroll
            for (int m = 0; m < 4; ++m)
#pragma unroll
                for (int n = 0; n < 2; ++n) acc[a][b][m][n] = (f32x4){0.f, 0.f, 0.f, 0.f};
    bf16x8 At[4][2], B0[2][2], B1[2][2];
    const char* cA = (const char*)g.A + (size_t)cur.pm * tstep + (size_t)cur.pk * K * 2; const char* cB = (const char*)g.Bt + (size_t)cur.pn * tstep + (size_t)cur.pk * K * 2;
    S.a_ready(cur);
    if constexpr (SP2) {
        PG8_STAGE(PG8_SB(0, 0), cB, voffB); PG8_STAGE(PG8_SB(0, 1), cB + hstep, voffB); PG8_STAGE(PG8_SA(0, 0), cA, voffA); PG8_STAGE(PG8_SA(0, 1), cA + hstep, voffA);
        if (wr == 1) PG8_BAR;
        PG8_WAIT_V(2); PG8_BAR;
        PG8_STAGE(PG8_SB(1, 0), cB + kstep, voffB); PG8_STAGE(PG8_SA(1, 0), cA + kstep, voffA); PG8_STAGE(PG8_SB(1, 1), cB + hstep + kstep, voffB);
        PG8_WAIT_V(6); PG8_BAR;
    } else {
        PG8_STAGE(PG8_SB(0, 0), cB, voffB); PG8_STAGE(PG8_SA(0, 0), cA, voffA); PG8_STAGE(PG8_SB(0, 1), cB + hstep, voffB); PG8_STAGE(PG8_SA(0, 1), cA + hstep, voffA);
        if (wr == 1) PG8_BAR;
        PG8_WAIT_V(4); PG8_BAR;
        PG8_STAGE(PG8_SB(1, 0), cB + kstep, voffB); PG8_STAGE(PG8_SA(1, 0), cA + kstep, voffA); PG8_STAGE(PG8_SB(1, 1), cB + hstep + kstep, voffB);
        PG8_WAIT_V(6); PG8_BAR;
    }
    for (;;) {
        const bool has_next = S.next(ui + 1, nxt);
        const char* nA = has_next ? (const char*)g.A + (size_t)nxt.pm * tstep + (size_t)nxt.pk * K * 2 : cA; const char* nB = has_next ? (const char*)g.Bt + (size_t)nxt.pn * tstep + (size_t)nxt.pk * K * 2 : cB;
        for (int t = 0; t < nt; t += 2) {
            const bool last = (t == nt - 2);
            const char* a1 = cA + (size_t)(t + 1) * kstep;
            const char* a2 = last ? nA : cA + (size_t)(t + 2) * kstep; const char* b2 = last ? nB : cB + (size_t)(t + 2) * kstep;
            const char* a3 = a2 + kstep; const char* b3 = b2 + kstep;
            if (last && has_next) S.a_ready(nxt);
            if constexpr (SP2) {
            PG8_LDB(B0, 0, 0); PG8_LDB(B1, 0, 1); PG8_SCHED; PG8_LDA(At, 0, 0); PG8_STAGE(PG8_SA(1, 1), a1 + hstep, voffA);
            PG8_WAIT_V(8); PG8_WAIT_L(0); PG8_BAR; PG8_MMA(0, 0, At, B0); PG8_MMA(0, 1, At, B1); PG8_BAR; PG8_SCHED;
            PG8_LDA(At, 0, 1); PG8_STAGE(PG8_SB(0, 0), b2, voffB); PG8_STAGE(PG8_SB(0, 1), b2 + hstep, voffB); PG8_STAGE(PG8_SA(0, 0), a2, voffA);
            PG8_WAIT_V(8); PG8_WAIT_L(0); PG8_BAR; PG8_MMA(1, 0, At, B0); PG8_MMA(1, 1, At, B1); PG8_BAR; PG8_SCHED;
            PG8_LDB(B0, 1, 0); PG8_LDB(B1, 1, 1); PG8_SCHED; PG8_LDA(At, 1, 0); PG8_STAGE(PG8_SA(0, 1), a2 + hstep, voffA);
            PG8_WAIT_V(8); PG8_WAIT_L(0); PG8_BAR; PG8_MMA(0, 0, At, B0); PG8_MMA(0, 1, At, B1); PG8_BAR; PG8_SCHED;
            PG8_LDA(At, 1, 1); PG8_STAGE(PG8_SB(1, 0), b3, voffB); PG8_STAGE(PG8_SB(1, 1), b3 + hstep, voffB); PG8_STAGE(PG8_SA(1, 0), a3, voffA);
            PG8_WAIT_V(8); PG8_WAIT_L(0); PG8_BAR; PG8_MMA(1, 0, At, B0); PG8_MMA(1, 1, At, B1); PG8_BAR; PG8_SCHED;
            } else {
            PG8_LDB(B0, 0, 0); PG8_SCHED; PG8_LDA(At, 0, 0); PG8_STAGE(PG8_SA(1, 1), a1 + hstep, voffA);
            PG8_WAIT_L(8); PG8_BAR; PG8_WAIT_L(0); PG8_MMA(0, 0, At, B0); PG8_BAR; PG8_SCHED;
            PG8_LDB(B1, 0, 1); PG8_STAGE(PG8_SB(0, 0), b2, voffB);
            PG8_BAR; PG8_WAIT_L(0); PG8_MMA(0, 1, At, B1); PG8_BAR;
            PG8_LDA(At, 0, 1); PG8_STAGE(PG8_SA(0, 0), a2, voffA);
            PG8_BAR; PG8_WAIT_L(0); PG8_MMA(1, 0, At, B0); PG8_BAR; PG8_SCHED;
            PG8_STAGE(PG8_SB(0, 1), b2 + hstep, voffB);
            PG8_WAIT_V(6); PG8_BAR; PG8_MMA(1, 1, At, B1); PG8_BAR;
            PG8_LDB(B0, 1, 0); PG8_SCHED; PG8_LDA(At, 1, 0); PG8_STAGE(PG8_SA(0, 1), a2 + hstep, voffA);
            PG8_WAIT_L(8); PG8_BAR; PG8_WAIT_L(0); PG8_MMA(0, 0, At, B0); PG8_BAR; PG8_SCHED;
            PG8_LDB(B1, 1, 1); PG8_STAGE(PG8_SB(1, 0), b3, voffB);
            PG8_BAR; PG8_WAIT_L(0); PG8_MMA(0, 1, At, B1); PG8_BAR;
            PG8_LDA(At, 1, 1); PG8_STAGE(PG8_SA(1, 0), a3, voffA);
            PG8_BAR; PG8_WAIT_L(0); PG8_MMA(1, 0, At, B0); PG8_BAR; PG8_SCHED;
            PG8_STAGE(PG8_SB(1, 1), b3 + hstep, voffB);
            PG8_WAIT_V(6); PG8_BAR; PG8_MMA(1, 1, At, B1); PG8_BAR;
            }
        }
        if constexpr (ALIGN_EPI) { if (wr == 0) PG8_BAR; }
        if constexpr (!Epi::AFTER_DRAIN) { E(acc, cur, wr, wc, fr, fq); S.done(cur); }
        if (!has_next) break;
#pragma unroll
        for (int a = 0; a < 2; ++a)
#pragma unroll
            for (int b = 0; b < 2; ++b)
#pragma unroll
                for (int m = 0; m < 4; ++m)
#pragma unroll
                    for (int n = 0; n < 2; ++n) acc[a][b][m][n] = (f32x4){0.f, 0.f, 0.f, 0.f};
        cur = nxt; cA = nA; cB = nB; ++ui;
        if constexpr (ALIGN_EPI) { if (wr == 1) PG8_BAR; }
    }
    PG8_WAIT_V(0);
    if constexpr (!ALIGN_EPI) { if (wr == 0) PG8_BAR; }
    PG8_BAR;
    if constexpr (Epi::AFTER_DRAIN) { E.fused(acc, cur, wr, wc, fr, fq, lds, wid, lane); S.done(cur); }
#undef PG8_SA
#undef PG8_SB
#undef PG8_STAGE
#undef PG8_LDA
#undef PG8_LDB
#undef PG8_MMA
#undef PG8_WAIT_V
#undef PG8_WAIT_L
#undef PG8_BAR
#undef PG8_SCHED
}
}
#define GAS __attribute__((address_space(1)))
#define LAS __attribute__((address_space(3)))
typedef unsigned short bf16;
typedef unsigned v4u __attribute__((ext_vector_type(4)));
typedef float f32x4 __attribute__((ext_vector_type(4)));
typedef short bf16x8 __attribute__((ext_vector_type(8)));
typedef GAS unsigned gu32;
typedef GAS unsigned long long gu64;
#define RLX_AGENT __ATOMIC_RELAXED, __HIP_MEMORY_SCOPE_AGENT
#define LDS_WAIT() asm volatile("s_waitcnt lgkmcnt(0)" ::: "memory")
#define VM_WAIT() asm volatile("s_waitcnt vmcnt(0)" ::: "memory")
__device__ __forceinline__ unsigned long long rt() { return __builtin_amdgcn_s_memrealtime(); }
__device__ __forceinline__ unsigned f2bf(float f) { unsigned u = __builtin_bit_cast(unsigned, f); return (u + 0x7fffu + ((u >> 16) & 1u)) >> 16; }
__device__ __forceinline__ unsigned pk2(float lo, float hi) { return f2bf(lo) | (f2bf(hi) << 16); }

#define XB_TMO      128
#define XB_XCNT(j)  (256  + 64 * (j))
#define XB_XSUB(j)  (1280 + 64 * (j))
#define XB_XGEN(j)  (2304 + 64 * (j))
#define XB_TOP      3328
#define XB_TOPGEN   3392
#define XCD_BAR_WORDS 3456
#define XB_SPIN_CAP (1u << 18)

__device__ __forceinline__ unsigned xb_ld(unsigned* p)              { return __hip_atomic_load(p, __ATOMIC_RELAXED, __HIP_MEMORY_SCOPE_AGENT); }
__device__ __forceinline__ unsigned xb_add(unsigned* p, unsigned v) { return __hip_atomic_fetch_add(p, v, __ATOMIC_RELAXED, __HIP_MEMORY_SCOPE_AGENT); }
__device__ __forceinline__ unsigned xb_xcc_id() { return (unsigned)__builtin_amdgcn_s_getreg((3 << 11) | 20) & 0xFu; }
#define XB_SPIN(cond, bar) do { unsigned _sp = 0; while (cond) { __builtin_amdgcn_s_sleep(1); \
    if ((++_sp & 255u) == 0u) { if (xb_ld(&(bar)[XB_TMO])) break; if (_sp > XB_SPIN_CAP) { atomicAdd(&(bar)[XB_TMO], 1u); break; } } } } while (0)

struct XcdBarrier {
    unsigned* bar; unsigned x;
    volatile LAS unsigned* st;
};

__device__ __forceinline__ XcdBarrier xcd_barrier_post(unsigned* bar, volatile LAS unsigned* st) {
    XcdBarrier b; b.bar = bar; b.x = xb_xcc_id(); b.st = st;
    if (threadIdx.x == 0) (void)xb_add(&bar[XB_XCNT(b.x)], 1u);
    return b;
}
__device__ __forceinline__ void xcd_barrier_complete(unsigned* bar, unsigned x, unsigned& nloc, unsigned& nx) {
    const unsigned G = gridDim.x * gridDim.y * gridDim.z;
    unsigned sum, cnt, mine, sp = 0u;
    for (;;) {
        sum = 0u; cnt = 0u; mine = 0u;
#pragma unroll
        for (unsigned j = 0; j < 16; ++j) { const unsigned c = xb_ld(&bar[XB_XCNT(j)]); sum += c; cnt += (c > 0u) ? 1u : 0u; mine = (j == x) ? c : mine; }
        if (sum == G) break;
        __builtin_amdgcn_s_sleep(1);
        if ((++sp & 255u) == 0u) { if (xb_ld(&bar[XB_TMO])) break; if (sp > XB_SPIN_CAP) { atomicAdd(&bar[XB_TMO], 1u); break; } }
    }
    nloc = mine > 0u ? mine : 1u; nx = cnt > 0u ? cnt : 1u;
}

__device__ __forceinline__ void xcd_barrier(const XcdBarrier& b) {
    asm volatile("s_waitcnt vmcnt(0)" ::: "memory");
    __syncthreads();
    if (threadIdx.x == 0) {
        unsigned* bar = b.bar;
        __builtin_amdgcn_s_waitcnt(0);
        unsigned nloc = b.st[0], nx = b.st[1];
        if (nloc == 0u) { xcd_barrier_complete(bar, b.x, nloc, nx); b.st[0] = nloc; b.st[1] = nx; }
        const unsigned old = xb_add(&bar[XB_XSUB(b.x)], 1u);
        const unsigned gen = old / nloc;
        if (old + 1u == (gen + 1u) * nloc) {
            __builtin_amdgcn_fence(__ATOMIC_RELEASE, "agent");
            asm volatile("s_waitcnt vmcnt(0)" ::: "memory");
            const unsigned og = xb_add(&bar[XB_TOP], 1u);
            const unsigned tg = og / nx;
            if (og + 1u == (tg + 1u) * nx) xb_add(&bar[XB_TOPGEN], 1u);
            else XB_SPIN(xb_ld(&bar[XB_TOPGEN]) == tg, bar);
            __builtin_amdgcn_fence(__ATOMIC_ACQUIRE, "agent");
            xb_add(&bar[XB_XGEN(b.x)], 1u);
            asm volatile("s_waitcnt vmcnt(0)" ::: "memory");
        } else {
            XB_SPIN(xb_ld(&bar[XB_XGEN(b.x)]) == gen, bar);
            __builtin_amdgcn_fence(__ATOMIC_ACQUIRE, "agent");
            asm volatile("s_waitcnt vmcnt(0)" ::: "memory");
        }
    }
    __syncthreads();
}
__device__ __forceinline__ float wave_sum(float v) {
#pragma unroll
    for (int o = 1; o < 64; o <<= 1) v += __shfl_xor(v, o);
    return v;
}
__device__ __forceinline__ void p0_transpose_item(const float* W, int K, int N, bf16* WT, int row_off, LAS float* scr, int item, int lane) {
    const int nblk = N / 32, kb = item / nblk, nb = item % nblk, k0 = 64 * kb, n0 = 32 * nb;
#pragma unroll 8
    for (int i = 0; i < 32; ++i) { const int kk = 2 * i + (lane >> 5); scr[kk * 33 + (lane & 31)] = W[(size_t)(k0 + kk) * N + n0 + (lane & 31)]; }
    LDS_WAIT(); asm volatile("" ::: "memory");
    const int c = lane & 7;
#pragma unroll
    for (int j = 0; j < 4; ++j) { const int n = (lane >> 3) + 8 * j; const LAS float* s = scr + (8 * c) * 33 + n;
        v4u o; o.x = pk2(s[0 * 33], s[1 * 33]); o.y = pk2(s[2 * 33], s[3 * 33]); o.z = pk2(s[4 * 33], s[5 * 33]); o.w = pk2(s[6 * 33], s[7 * 33]);
        *(GAS v4u*)(WT + (size_t)(row_off + n0 + n) * K + k0 + 8 * c) = o; }
    LDS_WAIT(); asm volatile("" ::: "memory");
}
#ifndef WGM_IN
#define WGM_IN 4
#endif
#ifndef WGM_UQ
#define WGM_UQ 4
#endif
#ifndef WGM_WO
#define WGM_WO 4
#endif
#ifndef WGM_F1
#define WGM_F1 4
#endif
#ifndef WGM_F2
#define WGM_F2 4
#endif
#ifndef REP_IN
#define REP_IN 1
#endif
#ifndef REP_NA
#define REP_NA 1
#endif
#ifndef REP_MLA
#define REP_MLA 1
#endif
#ifndef REP_SCAN
#define REP_SCAN 1
#endif
#ifndef REP_WO
#define REP_WO 1
#endif
#ifndef REP_FFN1
#define REP_FFN1 1
#endif
#ifndef REP_FFN2
#define REP_FFN2 1
#endif
#ifndef REP_P0
#define REP_P0 1
#endif

#if REP_IN == 2
#define REPEAT_REP_IN(...) __VA_ARGS__ __VA_ARGS__
#else
#define REPEAT_REP_IN(...) __VA_ARGS__
#endif
#if REP_NA == 2
#define REPEAT_REP_NA(...) __VA_ARGS__ __VA_ARGS__
#else
#define REPEAT_REP_NA(...) __VA_ARGS__
#endif
#if REP_MLA == 2
#define REPEAT_REP_MLA(...) __VA_ARGS__ __VA_ARGS__
#else
#define REPEAT_REP_MLA(...) __VA_ARGS__
#endif
#if REP_SCAN == 2
#define REPEAT_REP_SCAN(...) __VA_ARGS__ __VA_ARGS__
#else
#define REPEAT_REP_SCAN(...) __VA_ARGS__
#endif
#if REP_WO == 2
#define REPEAT_REP_WO(...) __VA_ARGS__ __VA_ARGS__
#else
#define REPEAT_REP_WO(...) __VA_ARGS__
#endif
#if REP_FFN1 == 2
#define REPEAT_REP_FFN1(...) __VA_ARGS__ __VA_ARGS__
#else
#define REPEAT_REP_FFN1(...) __VA_ARGS__
#endif
#if REP_FFN2 == 2
#define REPEAT_REP_FFN2(...) __VA_ARGS__ __VA_ARGS__
#else
#define REPEAT_REP_FFN2(...) __VA_ARGS__
#endif

constexpr int NWAVES = 8, NTHR = 512;
constexpr int D = 2048, NB = 2, SEQ = 8192, CTXL = 256, DFF = 8192, DEPTH = 4;
constexpr int MLAT = NB * SEQ, MCTX = NB * CTXL, M = MLAT + MCTX;
constexpr float EPS = 1e-6f;
constexpr int NMOD = 6 * D;
constexpr size_t MiB = 1u << 20;
constexpr size_t WS_CTL = 0, CTL_ZERO_BYTES = 1 * MiB;
constexpr size_t WS_MOD = 1 * MiB, WS_ROPE = 2 * MiB, WS_PART = 3 * MiB;
constexpr size_t WS_W1T = 12 * MiB, WS_W2T = WS_W1T + 128 * MiB, WS_NAQKV = WS_W2T + 128 * MiB, WS_NAWO = WS_NAQKV + 48 * MiB;
constexpr size_t WS_MLAIN = WS_NAWO + 16 * MiB, WS_MLAUQ = WS_MLAIN + 5 * MiB, WS_MLAUKV = WS_MLAUQ + 3 * MiB, WS_MLAWO = WS_MLAUKV + 4 * MiB;
constexpr size_t WS_MLIN = WS_MLAWO + 8 * MiB, WS_MLWO = WS_MLIN + 25 * MiB;
constexpr size_t WS_H = WS_MLWO + 8 * MiB, WS_A = WS_H + 132 * MiB, WS_Y = WS_A + 66 * MiB, WS_O = WS_Y + 66 * MiB, WS_BIG = WS_O + 66 * MiB, WS_SLAB = WS_BIG + 276 * MiB, WS_END = WS_SLAB + 64 * MiB;
constexpr size_t BIG_QKV = 0;
constexpr size_t BIG_QH = 0, BIG_MZ = 0, BIG_KV = 99 * MiB, BIG_CQN = 231 * MiB, BIG_CKVN = BIG_CQN + (size_t)M * 512 * 2, BIG_KPE = 264 * MiB;
constexpr size_t BIG_LZ = 0, BIG_LQK = 207 * MiB, BIG_LG = 273 * MiB;
constexpr size_t BIG_HID = 0;
constexpr int CW_BAR = 4096;
constexpr int RING_BYTES = 131072, LDS_BYTES = 147456, MISC_OFF = LDS_BYTES - 256;

__device__ __forceinline__ float bf_lo(unsigned w) { return __uint_as_float(w << 16); }
__device__ __forceinline__ float bf_hi(unsigned w) { return __uint_as_float(w & 0xffff0000u); }
__device__ __forceinline__ float bf1(bf16 b) { return __uint_as_float(((unsigned)b) << 16); }
__device__ __forceinline__ unsigned pkbf(float lo, float hi) { return pg8::cvt_pk_bf16(lo, hi); }
__device__ __forceinline__ void unpack8(const v4u w, float* f) { f[0] = bf_lo(w.x); f[1] = bf_hi(w.x); f[2] = bf_lo(w.y); f[3] = bf_hi(w.y); f[4] = bf_lo(w.z); f[5] = bf_hi(w.z); f[6] = bf_lo(w.w); f[7] = bf_hi(w.w); }
__device__ __forceinline__ float sigmoidf_(float x) { return 1.f / (1.f + expf(-x)); }

typedef _Float16 hfp;
typedef _Float16 hfp4 __attribute__((ext_vector_type(4)));
struct Ctx { LAS unsigned char* lds; int tid, lane, wave, gw, ngw; };

__device__ __forceinline__ void tr_matrix(const Ctx& X, const float* W, int K, int N, bf16* WT) {
    LAS float* scr = (LAS float*)(X.lds + X.wave * 8448);
    const int nitems = (K / 64) * (N / 32);
    for (int it = X.gw; it < nitems; it += X.ngw) p0_transpose_item(W, K, N, WT, 0, scr, it, X.lane);
}
struct TrDesc { const float* W; bf16* WT; int K, N, Npad, base; };
constexpr int TR_NMAT = 18, TR_LDS_OFF = 132096;
__device__ __forceinline__ void tr_decode(const LAS TrDesc* tab, int g, const float*& W, bf16*& WT, int& K, int& N, int& k0, int& n0) {
    int mi = 0;
#pragma unroll 1
    for (int i = 1; i < TR_NMAT; ++i) if (g >= tab[i].base) mi = i;
    const LAS TrDesc* d = tab + mi; const int it = g - d->base, nb = d->Npad >> 8; W = d->W; WT = d->WT; K = d->K; N = d->N; k0 = (it / nb) * 64; n0 = (it % nb) * 256;
}
struct TrItem { const float* W; bf16* WT; int K, N, k0, n0; };
__device__ __forceinline__ void tr_all(const Ctx& X, const LAS TrDesc* tab, int total, const int first, const int G) {
    LAS float* T = (LAS float*)X.lds; const int q = X.tid & 63, rr = X.tid >> 6, c = X.tid & 7;
    if (first >= total) return;
#define TR_LOAD(v_, I_) do { _Pragma("unroll") for (int i = 0; i < 8; ++i) { const int n = (I_).n0 + 4 * q; v_[i] = n < (I_).N ? *(const f32x4*)((I_).W + (size_t)((I_).k0 + rr + 8 * i) * (I_).N + n) : (f32x4){0.f, 0.f, 0.f, 0.f}; } } while (0)
#define TR_PUT(v_) do { _Pragma("unroll") for (int i = 0; i < 8; ++i) *(LAS f32x4*)(T + (rr + 8 * i) * 256 + 4 * (q ^ i)) = v_[i]; } while (0)
#define TR_STORE(I_) do { _Pragma("unroll") for (int j = 0; j < 4; ++j) { const int nn = (X.tid >> 3) + 64 * j; const LAS float* s = T + (8 * c) * 256 + (nn ^ (4 * c)); \
        v4u o; o.x = pk2(s[0 * 256], s[1 * 256]); o.y = pk2(s[2 * 256], s[3 * 256]); o.z = pk2(s[4 * 256], s[5 * 256]); o.w = pk2(s[6 * 256], s[7 * 256]); \
        *(GAS v4u*)((I_).WT + (size_t)((I_).n0 + nn) * (I_).K + (I_).k0 + 8 * c) = o; } } while (0)
    TrItem A, B, Cn; f32x4 va[8], vb[8];
    int g = first;
    tr_decode(tab, g, A.W, A.WT, A.K, A.N, A.k0, A.n0); TR_LOAD(va, A);
    bool hasB = g + G < total; B = A; if (hasB) { tr_decode(tab, g + G, B.W, B.WT, B.K, B.N, B.k0, B.n0); TR_LOAD(vb, B); }
    for (;;) {
        const bool hasC = g + 2 * G < total; Cn = A; if (hasC) tr_decode(tab, g + 2 * G, Cn.W, Cn.WT, Cn.K, Cn.N, Cn.k0, Cn.n0);
        TR_PUT(va); __syncthreads();
        const TrItem cur = A;
        if (hasC) { A = Cn; TR_LOAD(va, A); }
        TR_STORE(cur); __syncthreads();
        if (!hasB) break;
        const bool hasD = g + 3 * G < total; Cn = B; if (hasD) tr_decode(tab, g + 3 * G, Cn.W, Cn.WT, Cn.K, Cn.N, Cn.k0, Cn.n0);
        TR_PUT(vb); __syncthreads();
        const TrItem cur2 = B;
        if (hasD) { B = Cn; TR_LOAD(vb, B); }
        TR_STORE(cur2); __syncthreads();
        if (!hasC) break;
        hasB = hasD; g += 2 * G;
    }
#undef TR_LOAD
#undef TR_PUT
#undef TR_STORE
}
__device__ __forceinline__ void zero_bf16(const Ctx& X, bf16* p, size_t n8) {
    for (size_t i = (size_t)blockIdx.x * NTHR + X.tid; i < n8; i += (size_t)gridDim.x * NTHR) ((v4u*)p)[i] = (v4u){0u, 0u, 0u, 0u};
}
__device__ __forceinline__ void ada_partials(const Ctx& X, const float* c, const float* c_ctx, const float* ada_w, float* part) {
    LAS float* S = (LAS float*)(X.lds + 69632);
    for (int i = X.tid; i < 3 * D; i += NTHR) { const int cls = i / D, k = i % D; const float v = cls < 2 ? c[cls * D + k] : c_ctx[k]; S[i] = v / (1.f + expf(-v)); }
    __syncthreads();
    for (int it = X.gw; it < 4 * 48 * 16; it += X.ngw) {
        const int sl = it & 15, cb = (it >> 4) % 48, l = it / (16 * 48);
        const float* W = ada_w + ((size_t)l * D + sl * 128) * NMOD + cb * 256 + X.lane * 4;
        f32x4 a0 = {0.f, 0.f, 0.f, 0.f}, a1 = a0, a2 = a0;
#pragma unroll 8
        for (int kk = 0; kk < 128; ++kk) { const f32x4 w = *(const f32x4*)(W + (size_t)kk * NMOD); const int k = sl * 128 + kk; a0 += w * S[k]; a1 += w * S[D + k]; a2 += w * S[2 * D + k]; }
        float* P = part + ((size_t)(sl * 4 + l) * 3) * NMOD + cb * 256 + X.lane * 4;
        *(f32x4*)(P) = a0; *(f32x4*)(P + NMOD) = a1; *(f32x4*)(P + 2 * NMOD) = a2;
    }
}
__device__ __forceinline__ void rope_table(const Ctx& X, float* cosT, float* sinT) {
    for (int i = blockIdx.x * NTHR + X.tid; i < 2048; i += gridDim.x * NTHR) {
        const int pos = i >> 4, p = i & 15;
        const double f = exp(-(double)p * (9.210340371976184 / 16.0)); const double ang = (double)pos * f;
        const double k = rint(ang * 0.15915494309189535); const double r = ang - k * 6.283185307179586;
        cosT[i] = (float)cos(r); sinT[i] = (float)sin(r);
    }
}
__device__ __forceinline__ const float* modv(const float* mod, int l, int cls, int chunk) { return mod + ((size_t)(l * 3 + cls) * 6 + chunk) * D; }
__device__ __forceinline__ void vec_setup(const Ctx& X, const float* mod, const float* norm_g, bool has_gate, int l_gate, int chunk_gate, int gi_post, bool has_next, int l_next, int gi_pre, int chunk_sh, int chunk_sc) {
    LAS float* G = (LAS float*)(X.lds); LAS float* A = (LAS float*)(X.lds + 24576); LAS float* S = (LAS float*)(X.lds + 49152);
    for (int i = X.tid; i < 3 * D; i += NTHR) { const int cls = i / D, k = i % D;
        if (has_gate) G[i] = modv(mod, l_gate, cls, chunk_gate)[k] * norm_g[(l_gate * 4 + gi_post) * D + k];
        if (has_next) { A[i] = norm_g[(l_next * 4 + gi_pre) * D + k] * (1.f + modv(mod, l_next, cls, chunk_sc)[k]); S[i] = modv(mod, l_next, cls, chunk_sh)[k]; } }
    __syncthreads();
}
__device__ __forceinline__ void first_norm(const Ctx& X, const float* x, const float* ctx, hfp* h, bf16* a) {
    const LAS f32x4* A = (const LAS f32x4*)(X.lds + 24576); const LAS f32x4* S = (const LAS f32x4*)(X.lds + 49152);
    for (int row = X.gw; row < M; row += X.ngw) {
        const int cls = row < MLAT ? (row >> 13) : 2;
        const f32x4* src = (const f32x4*)(row < MLAT ? x + (size_t)row * D : ctx + (size_t)(row - MLAT) * D) + X.lane;
        f32x4 v[8]; float ss = 0.f;
#pragma unroll
        for (int j = 0; j < 8; ++j) { v[j] = src[64 * j]; ss += (v[j].x * v[j].x + v[j].y * v[j].y) + (v[j].z * v[j].z + v[j].w * v[j].w); }
        const float rstd = 1.f / sqrtf(wave_sum(ss) * (1.f / D) + EPS);
        hfp4* hp = (hfp4*)(h + (size_t)row * D) + X.lane; unsigned long long* ap = (unsigned long long*)(a + (size_t)row * D) + X.lane;
#pragma unroll
        for (int j = 0; j < 8; ++j) { hp[64 * j] = __builtin_convertvector(v[j], hfp4); const f32x4 av = A[cls * 512 + 64 * j + X.lane], sv = S[cls * 512 + 64 * j + X.lane]; const f32x4 o = v[j] * rstd * av + sv;
            ap[64 * j] = (unsigned long long)pkbf(o.x, o.y) | ((unsigned long long)pkbf(o.z, o.w) << 32); }
    }
}
template <int MODE, bool SLAB> __device__ __forceinline__ void npost(const Ctx& X, const bf16* y, hfp* h, bf16* a, float* out, const float* slab, const int KS, const int row_lo, const int row_hi) {
    const LAS f32x4* G = (const LAS f32x4*)(X.lds); const LAS f32x4* A = (const LAS f32x4*)(X.lds + 24576); const LAS f32x4* S = (const LAS f32x4*)(X.lds + 49152);
    for (int row = row_lo + X.gw; row < row_hi; row += X.ngw) {
        const int cls = row < MLAT ? (row >> 13) : 2;
        hfp4* hp = (hfp4*)(h + (size_t)row * D) + X.lane;
        f32x4 hv[8], yv[8]; float ssy = 0.f;
        if (!SLAB) {
            const unsigned long long* yp = (const unsigned long long*)(y + (size_t)row * D) + X.lane;
#pragma unroll
            for (int j = 0; j < 8; ++j) { const unsigned long long w = yp[64 * j]; const unsigned lo = (unsigned)w, hi = (unsigned)(w >> 32); yv[j] = (f32x4){bf_lo(lo), bf_hi(lo), bf_lo(hi), bf_hi(hi)}; }
        } else {
            const f32x4* sp = (const f32x4*)(slab + (size_t)(row - MLAT) * D) + X.lane;
#pragma unroll
            for (int j = 0; j < 8; ++j) yv[j] = sp[64 * j];
#pragma unroll 1
            for (int k = 1; k < KS; ++k) { sp += (MCTX * D / 4);
#pragma unroll
                for (int j = 0; j < 8; ++j) yv[j] += sp[64 * j]; }
        }
#pragma unroll
        for (int j = 0; j < 8; ++j) { hv[j] = __builtin_convertvector(hp[64 * j], f32x4); ssy += (yv[j].x * yv[j].x + yv[j].y * yv[j].y) + (yv[j].z * yv[j].z + yv[j].w * yv[j].w); }
        const float rstd_y = 1.f / sqrtf(wave_sum(ssy) * (1.f / D) + EPS); float ssh = 0.f;
#pragma unroll
        for (int j = 0; j < 8; ++j) { const f32x4 g = G[cls * 512 + 64 * j + X.lane]; hv[j] = hv[j] + g * (yv[j] * rstd_y); ssh += (hv[j].x * hv[j].x + hv[j].y * hv[j].y) + (hv[j].z * hv[j].z + hv[j].w * hv[j].w); }
        if (MODE == 0) {
            const float rstd_h = 1.f / sqrtf(wave_sum(ssh) * (1.f / D) + EPS);
            unsigned long long* ap = (unsigned long long*)(a + (size_t)row * D) + X.lane;
#pragma unroll
            for (int j = 0; j < 8; ++j) { hp[64 * j] = __builtin_convertvector(hv[j], hfp4); const f32x4 av = A[cls * 512 + 64 * j + X.lane], sv = S[cls * 512 + 64 * j + X.lane]; const f32x4 o = hv[j] * rstd_h * av + sv;
                ap[64 * j] = (unsigned long long)pkbf(o.x, o.y) | ((unsigned long long)pkbf(o.z, o.w) << 32); }
        } else {
            f32x4* op = (f32x4*)(out + (size_t)row * D) + X.lane;
#pragma unroll
            for (int j = 0; j < 8; ++j) op[64 * j] = hv[j];
        }
    }
}
__device__ __forceinline__ void mla_rows(const Ctx& X, const bf16* Z, const float* g_q, const float* g_kv, const float* cosT, const float* sinT, bf16* CQN, bf16* CKVN, bf16* KPE) {
    for (int row = X.gw; row < M; row += X.ngw) {
        const bf16* z = Z + (size_t)row * 1280;
#pragma unroll
        for (int part = 0; part < 2; ++part) {
            const v4u w = *(const v4u*)(z + part * 512 + 8 * X.lane); float f[8]; unpack8(w, f); float ss = 0.f;
#pragma unroll
            for (int i = 0; i < 8; ++i) ss += f[i] * f[i];
            const float rstd = 1.f / sqrtf(wave_sum(ss) * (1.f / 512.f) + EPS); const float* g = (part ? g_kv : g_q) + 8 * X.lane;
            v4u o; o.x = pkbf(f[0] * rstd * g[0], f[1] * rstd * g[1]); o.y = pkbf(f[2] * rstd * g[2], f[3] * rstd * g[3]); o.z = pkbf(f[4] * rstd * g[4], f[5] * rstd * g[5]); o.w = pkbf(f[6] * rstd * g[6], f[7] * rstd * g[7]);
            *(v4u*)((part ? CKVN : CQN) + (size_t)row * 512 + 8 * X.lane) = o;
        }
        const float xv = bf1(z[1024 + X.lane]); float ov = xv;
        const float x1 = __shfl(xv, X.lane & ~16), x2 = __shfl(xv, X.lane | 16);
        if (row < MLAT) { const int s = row & 8191, pos = (X.lane >> 5) ? (s & 63) : (s >> 6), p = X.lane & 15; const float cs = cosT[pos * 16 + p], sn = sinT[pos * 16 + p];
            ov = (X.lane & 16) ? (x1 * sn + x2 * cs) : (x1 * cs - x2 * sn); }
        KPE[(size_t)row * 64 + X.lane] = (bf16)(pkbf(ov, 0.f) & 0xffffu);
    }
}
__device__ __forceinline__ void ml_rows(const Ctx& X, const bf16* Z, const float* conv_w, const float* b_gate, bf16* QK, float* G) {
    for (int row = X.gw; row < M; row += X.ngw) {
        bool hp, hn; if (row < MLAT) { const int s = row & 8191; hp = s > 0; hn = s < 8191; } else { const int n = (row - MLAT) & 255; hp = n > 0; hn = n < 255; }
        const bf16* z = Z + (size_t)row * 6400;
#pragma unroll
        for (int j = 0; j < 4; ++j) { const int col = 8 * X.lane + 512 * j;
            float x0[8], x1[8], x2[8]; const v4u zero = {0u, 0u, 0u, 0u};
            unpack8(hp ? *(const v4u*)(z - 6400 + col) : zero, x0); unpack8(*(const v4u*)(z + col), x1); unpack8(hn ? *(const v4u*)(z + 6400 + col) : zero, x2);
            float o[8];
#pragma unroll
            for (int i = 0; i < 8; ++i) { float v = conv_w[col + i] * x0[i] + conv_w[2048 + col + i] * x1[i] + conv_w[4096 + col + i] * x2[i]; v = v / (1.f + expf(-v)); o[i] = col < 1024 ? v * 0.08838834764831845f : v; }
            v4u w; w.x = pkbf(o[0], o[1]); w.y = pkbf(o[2], o[3]); w.z = pkbf(o[4], o[5]); w.w = pkbf(o[6], o[7]);
            *(v4u*)(QK + (size_t)row * 2048 + col) = w; }
        if (X.lane < 32) { float v = bf1(z[6144 + X.lane]) + b_gate[X.lane]; if ((X.lane >> 3) & 1) v = fminf(v, 0.f) - log1pf(expf(-fabsf(v))); G[(size_t)row * 32 + X.lane] = v; }
    }
}
__device__ __forceinline__ void ml_gate_rows(const Ctx& X, const bf16* Z, const bf16* HF, const bf16* HB, const float* g_head, bf16* O) {
    for (int row = X.gw; row < M; row += X.ngw) {
#pragma unroll
        for (int j = 0; j < 4; ++j) { const int col = 8 * X.lane + 512 * j;
            float a[8], b[8], g[8]; unpack8(*(const v4u*)(HF + (size_t)row * 2048 + col), a); unpack8(*(const v4u*)(HB + (size_t)row * 2048 + col), b); unpack8(*(const v4u*)(Z + (size_t)row * 6400 + 4096 + col), g);
            float ss = 0.f;
#pragma unroll
            for (int i = 0; i < 8; ++i) { a[i] += b[i]; ss += a[i] * a[i]; }
#pragma unroll
            for (int o = 1; o < 32; o <<= 1) ss += __shfl_xor(ss, o);
            const float rstd = 1.f / sqrtf(ss * (1.f / 256.f) + EPS); float o[8];
#pragma unroll
            for (int i = 0; i < 8; ++i) o[i] = a[i] * rstd * g_head[col + i] * sigmoidf_(g[i]);
            v4u w; w.x = pkbf(o[0], o[1]); w.y = pkbf(o[2], o[3]); w.z = pkbf(o[4], o[5]); w.w = pkbf(o[6], o[7]);
            *(v4u*)(O + (size_t)row * 2048 + col) = w; }
    }
}
#define ATT_UPDATE(sc, vptr) do { const float s_ = (sc); const float mn_ = fmaxf(m_run, s_); const float corr_ = __expf(m_run - mn_), p_ = __expf(s_ - mn_); l_run = l_run * corr_ + p_; m_run = mn_; \
    _Pragma("unroll") for (int c_ = 0; c_ < 4; ++c_) { float vf_[8]; unpack8(*(const v4u*)((vptr) + 8 * c_), vf_); _Pragma("unroll") for (int i_ = 0; i_ < 8; ++i_) o[8 * c_ + i_] = o[8 * c_ + i_] * corr_ + p_ * vf_[i_]; } } while (0)
__device__ __forceinline__ float dot32(const bf16* kp, const float* q) { float s = 0.f;
#pragma unroll
    for (int c = 0; c < 4; ++c) { float kf[8]; unpack8(*(const v4u*)(kp + 8 * c), kf);
#pragma unroll
        for (int i = 0; i < 8; ++i) s += q[8 * c + i] * kf[i]; }
    return s; }
__device__ __forceinline__ float quad_sum(float s) { s += __shfl_xor(s, 1); s += __shfl_xor(s, 2); return s; }
__device__ __forceinline__ void store_o32(bf16* op, const float* o, float inv) {
#pragma unroll
    for (int c = 0; c < 4; ++c) { v4u w; w.x = pkbf(o[8 * c] * inv, o[8 * c + 1] * inv); w.y = pkbf(o[8 * c + 2] * inv, o[8 * c + 3] * inv); w.z = pkbf(o[8 * c + 4] * inv, o[8 * c + 5] * inv); w.w = pkbf(o[8 * c + 6] * inv, o[8 * c + 7] * inv); *(v4u*)(op + 8 * c) = w; } }

__device__ __forceinline__ void na_attn_naive(const Ctx& X, const bf16* QKV, const float* rpb, bf16* O, int nrows) {
    const int hd = X.lane >> 2, j = X.lane & 3; const float scale = 0.08838834764831845f;
    for (int row = X.gw; row < nrows; row += X.ngw) {
        float q[32], o[32]; float m_run = -INFINITY, l_run = 0.f;
#pragma unroll
        for (int c = 0; c < 4; ++c) unpack8(*(const v4u*)(QKV + (size_t)row * 6144 + hd * 128 + 32 * j + 8 * c), q + 8 * c);
#pragma unroll
        for (int i = 0; i < 32; ++i) o[i] = 0.f;
        int b;
        if (row < MLAT) {
            b = row >> 13; const int s = row & 8191, r = s >> 6, c = s & 63;
            const int rs = min(max(r - 4, 0), 120), cs = min(max(c - 8, 0), 48);
            for (int jr = 0; jr < 8; ++jr) for (int jc = 0; jc < 16; ++jc) {
                const int kr = rs + jr, kc = cs + jc; const size_t key = (size_t)b * 8192 + kr * 64 + kc;
                const float bias = rpb[(hd * 15 + (kr - r + 7)) * 31 + (kc - c + 15)];
                const bf16* kp = QKV + key * 6144 + 2048 + hd * 128 + 32 * j;
                const float sc = quad_sum(dot32(kp, q)) * scale + bias;
                ATT_UPDATE(sc, kp + 2048);
            }
        } else b = (row - MLAT) >> 8;
        for (int n = 0; n < 256; ++n) {
            const size_t key = (size_t)MLAT + b * 256 + n; const bf16* kp = QKV + key * 6144 + 2048 + hd * 128 + 32 * j;
            const float sc = quad_sum(dot32(kp, q)) * scale;
            ATT_UPDATE(sc, kp + 2048);
        }
        store_o32(O + (size_t)row * 2048 + hd * 128 + 32 * j, o, 1.f / l_run);
    }
}
__device__ __forceinline__ void mla_attn_naive(const Ctx& X, const bf16* QH, const bf16* KV, const bf16* KPE, const float* cosT, const float* sinT, bf16* O) {
    const int hd = X.lane >> 2, j = X.lane & 3; const float scale = 0.07216878364870322f;
    for (int row = X.gw; row < M; row += X.ngw) {
        float q[32], qp[16], o[32]; float m_run = -INFINITY, l_run = 0.f;
        const bf16* qrow = QH + (size_t)row * 3072 + hd * 192;
#pragma unroll
        for (int c = 0; c < 4; ++c) unpack8(*(const v4u*)(qrow + 32 * j + 8 * c), q + 8 * c);
        {
            const int axis = j >> 1; float x1[16], x2[16];
            unpack8(*(const v4u*)(qrow + 128 + axis * 32), x1); unpack8(*(const v4u*)(qrow + 128 + axis * 32 + 8), x1 + 8);
            unpack8(*(const v4u*)(qrow + 128 + axis * 32 + 16), x2); unpack8(*(const v4u*)(qrow + 128 + axis * 32 + 24), x2 + 8);
            if (row < MLAT) { const int s = row & 8191, pos = axis ? (s & 63) : (s >> 6);
#pragma unroll
                for (int p = 0; p < 16; ++p) { const float cs = cosT[pos * 16 + p], sn = sinT[pos * 16 + p]; qp[p] = (j & 1) ? (x1[p] * sn + x2[p] * cs) : (x1[p] * cs - x2[p] * sn); }
            } else {
#pragma unroll
                for (int p = 0; p < 16; ++p) qp[p] = (j & 1) ? x2[p] : x1[p];
            }
        }
#pragma unroll
        for (int i = 0; i < 32; ++i) o[i] = 0.f;
        const int b = row < MLAT ? (row >> 13) : ((row - MLAT) >> 8);
        const int nkeys = row < MLAT ? (256 + 8192) : 256;
        for (int n = 0; n < nkeys; ++n) {
            const size_t key = n < 256 ? (size_t)MLAT + b * 256 + n : (size_t)b * 8192 + (n - 256);
            const bf16* kp = KV + key * 4096 + hd * 256 + 32 * j; const bf16* pp = KPE + key * 64 + 16 * j;
            float s = dot32(kp, q); float kf[16]; unpack8(*(const v4u*)(pp), kf); unpack8(*(const v4u*)(pp + 8), kf + 8);
#pragma unroll
            for (int p = 0; p < 16; ++p) s += qp[p] * kf[p];
            const float sc = quad_sum(s) * scale;
            ATT_UPDATE(sc, kp + 128);
        }
        store_o32(O + (size_t)row * 2048 + hd * 128 + 32 * j, o, 1.f / l_run);
    }
}
__device__ __forceinline__ void ml_scan_naive(const Ctx& X, const bf16* QK, const bf16* Z, const float* G, bf16* HF, bf16* HB) {
    LAS float* L = (LAS float*)X.lds;
    LAS float* q = L; LAS float* k = L + 8256; LAS float* v = L + 16512; LAS float* S = L + 18624; LAS float* C = L + 22784; LAS float* nv = L + 27008;
    LAS float* li = L + 27136; LAS float* lf = L + 27200; LAS float* bc = L + 27264; LAS float* mt = L + 27328; LAS float* ex = L + 27392; LAS float* misc = L + 27456;
    const int tid = X.tid, t = tid >> 3, part = tid & 7;
    for (int u = blockIdx.x; u < 256; u += gridDim.x) {
        const int slice = u & 7, dir = (u >> 3) & 1, hd = (u >> 4) & 7, b = u >> 7;
        for (int i = tid; i < 128 * 33; i += NTHR) C[i] = 0.f;
        if (tid < 128) nv[tid] = 0.f;
        float m_run = 0.f;
        bf16* H = dir ? HB : HF;
        __syncthreads();
        for (int n = 0; n < 132; ++n) {
            int base;
            if (dir == 0) base = n < 4 ? MLAT + b * 256 + 64 * n : b * 8192 + 64 * (n - 4);
            else base = n < 4 ? MLAT + b * 256 + 64 * (3 - n) : b * 8192 + 64 * (131 - n);
            const int row = base + (dir ? 63 - t : t);
            {
                float f[16];
                unpack8(*(const v4u*)(QK + (size_t)row * 2048 + hd * 128 + part * 16), f); unpack8(*(const v4u*)(QK + (size_t)row * 2048 + hd * 128 + part * 16 + 8), f + 8);
#pragma unroll
                for (int i = 0; i < 16; ++i) q[t * 129 + part * 16 + i] = f[i];
                unpack8(*(const v4u*)(QK + (size_t)row * 2048 + 1024 + hd * 128 + part * 16), f); unpack8(*(const v4u*)(QK + (size_t)row * 2048 + 1024 + hd * 128 + part * 16 + 8), f + 8);
#pragma unroll
                for (int i = 0; i < 16; ++i) k[t * 129 + part * 16 + i] = f[i];
                const unsigned long long w = *(const unsigned long long*)(Z + (size_t)row * 6400 + 2048 + hd * 256 + slice * 32 + part * 4); const unsigned lo = (unsigned)w, hi = (unsigned)(w >> 32);
                v[t * 33 + part * 4 + 0] = bf_lo(lo); v[t * 33 + part * 4 + 1] = bf_hi(lo); v[t * 33 + part * 4 + 2] = bf_lo(hi); v[t * 33 + part * 4 + 3] = bf_hi(hi);
                if (tid < 64) { const int row2 = base + (dir ? 63 - tid : tid); li[tid] = G[(size_t)row2 * 32 + dir * 16 + hd]; lf[tid] = G[(size_t)row2 * 32 + dir * 16 + 8 + hd]; }
            }
            __syncthreads();
            if (tid == 0) {
                float bsum = 0.f, pm = -INFINITY;
                for (int s = 0; s < 64; ++s) { bsum += lf[s]; bc[s] = bsum; pm = fmaxf(pm, li[s] - bsum); mt[s] = bsum + fmaxf(m_run, pm); }
                const float m_new = bsum + fmaxf(m_run, pm); misc[0] = m_new; misc[1] = expf(bsum + m_run - m_new);
                for (int s = 0; s < 64; ++s) ex[s] = expf(bsum - bc[s] + li[s] - m_new);
            }
            __syncthreads();
            {
                const float bt = bc[t], mtt = mt[t];
                for (int i = 0; i < 8; ++i) { const int s = part + 8 * i; float r = 0.f;
                    if (s <= t) { float dsum = 0.f; for (int d = 0; d < 128; ++d) dsum += q[t * 129 + d] * k[s * 129 + d]; r = dsum * expf(bt - bc[s] + li[s] - mtt); }
                    S[t * 65 + s] = r; }
            }
            __syncthreads();
            {
                const float mtt = mt[t], winter = expf(bc[t] + m_run - mtt);
                float den = 0.f; for (int d = 0; d < 128; ++d) den += q[t * 129 + d] * nv[d];
                den *= winter; for (int s = 0; s < 64; ++s) den += S[t * 65 + s];
                const float dn = fmaxf(fabsf(den), expf(-mtt)); float hv[4];
#pragma unroll
                for (int i = 0; i < 4; ++i) { const int e = part * 4 + i; float a = 0.f; for (int d = 0; d < 128; ++d) a += q[t * 129 + d] * C[d * 33 + e];
                    a *= winter; for (int s = 0; s < 64; ++s) a += S[t * 65 + s] * v[s * 33 + e]; hv[i] = a / dn; }
                *(unsigned long long*)(H + (size_t)row * 2048 + hd * 256 + slice * 32 + part * 4) = (unsigned long long)pkbf(hv[0], hv[1]) | ((unsigned long long)pkbf(hv[2], hv[3]) << 32);
            }
            __syncthreads();
            { const float e = ex[t];
#pragma unroll
              for (int i = 0; i < 16; ++i) k[t * 129 + part * 16 + i] *= e; }
            __syncthreads();
            {
                const int d = tid >> 2, eg = (tid & 3) * 8; const float decay = misc[1];
#pragma unroll
                for (int i = 0; i < 8; ++i) { const int e = eg + i; float a = 0.f; for (int s = 0; s < 64; ++s) a += k[s * 129 + d] * v[s * 33 + e]; C[d * 33 + e] = decay * C[d * 33 + e] + a; }
                if ((tid & 3) == 0) { float a = 0.f; for (int s = 0; s < 64; ++s) a += k[s * 129 + d]; nv[d] = decay * nv[d] + a; }
                m_run = misc[0];
            }
            __syncthreads();
        }
    }
}

namespace fa {
using f32x16 = __attribute__((ext_vector_type(16))) float;
using s16x4  = __attribute__((ext_vector_type(4))) short;
#define FA_KSWZ(row, colB) ((row) * 256 + ((colB) ^ (((row) & 7) << 4)))
#define FA_PSWZ(row, colB) ((row) * 128 + ((colB) ^ (((row) & 7) << 4)))
#define FA_SBAR() __builtin_amdgcn_sched_barrier(0)
__device__ __forceinline__ int crow(int r, int hi) { return (r & 3) + 8 * (r >> 2) + 4 * hi; }
__device__ __forceinline__ unsigned cvtpk(float lo, float hi) { return pg8::cvt_pk_bf16(lo, hi); }
constexpr float THR = 8.f;
__device__ __forceinline__ void partialSM(f32x16& p0, f32x16& p1, float& m_reg, float& mn, float& alpha, const float SCALE) {
  const float C = SCALE * 1.4426950408889634f;
  float pmax = p0[0];
#pragma unroll
  for (int r = 1; r < 16; ++r) pmax = fmaxf(pmax, p0[r]);
#pragma unroll
  for (int r = 0; r < 16; ++r) pmax = fmaxf(pmax, p1[r]);
  { auto rr = __builtin_amdgcn_permlane32_swap(__float_as_uint(pmax), __float_as_uint(pmax), false, false);
    pmax = fmaxf(__uint_as_float(rr[0]), __uint_as_float(rr[1])); }
  if (__builtin_expect(__all(pmax - m_reg <= THR / SCALE), 1)) { mn = m_reg; alpha = 1.f; }
  else { mn = fmaxf(m_reg, pmax); alpha = __builtin_amdgcn_exp2f((m_reg - mn) * C); m_reg = mn; }
  const float mnC = -mn * C;
#pragma unroll
  for (int r = 0; r < 16; ++r) p0[r] = fmaf(p0[r], C, mnC);
#pragma unroll
  for (int r = 0; r < 16; ++r) p1[r] = fmaf(p1[r], C, mnC);
#pragma unroll
  for (int r = 0; r < 16; ++r) p0[r] = __builtin_amdgcn_exp2f(p0[r]);
}
__device__ __forceinline__ void finishSM(f32x16& p0, f32x16& p1, float alpha, float& l_reg, bf16x8& pa0, bf16x8& pa1, bf16x8& pa2, bf16x8& pa3) {
#pragma unroll
  for (int r = 0; r < 16; ++r) p1[r] = __builtin_amdgcn_exp2f(p1[r]);
  float ps = 0;
#pragma unroll
  for (int r = 0; r < 16; ++r) ps += p0[r];
#pragma unroll
  for (int r = 0; r < 16; ++r) ps += p1[r];
  { auto rr = __builtin_amdgcn_permlane32_swap(__float_as_uint(ps), __float_as_uint(ps), false, false);
    ps = __uint_as_float(rr[0]) + __uint_as_float(rr[1]); }
  l_reg = l_reg * alpha + ps;
#define FA_PK4(P, BASE, OUT) do { unsigned a0 = cvtpk(P[BASE + 0], P[BASE + 1]), a1 = cvtpk(P[BASE + 2], P[BASE + 3]);   \
    unsigned b0 = cvtpk(P[BASE + 4], P[BASE + 5]), b1 = cvtpk(P[BASE + 6], P[BASE + 7]);                              \
    auto r0 = __builtin_amdgcn_permlane32_swap(a0, b0, false, false); auto r1 = __builtin_amdgcn_permlane32_swap(a1, b1, false, false); \
    v4u w = {r0[0], r1[0], r0[1], r1[1]}; OUT = __builtin_bit_cast(bf16x8, w); } while (0)
  FA_PK4(p0, 0, pa0); FA_PK4(p0, 8, pa1); FA_PK4(p1, 0, pa2); FA_PK4(p1, 8, pa3);
#undef FA_PK4
}
__device__ __forceinline__ int v_st(int k, int c) { const int kk = (k & ~0xC) | ((k & 4) << 1) | ((k & 8) >> 1); return ((kk >> 3) * 4 + (c >> 5)) * 512 + ((kk & 7) * 32 + (c & 31)) * 2; }
__device__ __forceinline__ int v_rd_base(int lane) { return ((lane & 3) << 3) | (((lane >> 2) & 3) << 6) | (((lane >> 4) & 1) << 5) | (((lane >> 5) & 1) << 8); }
constexpr int v_rd_off(int d0, int ks, int half) { return d0 * 512 + ks * 4096 + half * 2048; }
template <int OFF> __device__ __forceinline__ s16x4 tr_read(int vb) {
  s16x4 r; asm volatile("ds_read_b64_tr_b16 %0, %1 offset:%2" : "=&v"(r) : "v"(vb), "i"(OFF) : "memory"); return r;
}
template <int D0> __device__ __forceinline__ void pv_one(f32x16& od, int vb, bf16x8 pa0, bf16x8 pa1, bf16x8 pa2, bf16x8 pa3) {
  const s16x4 l0 = tr_read<v_rd_off(D0, 0, 0)>(vb), h0 = tr_read<v_rd_off(D0, 0, 1)>(vb), l1 = tr_read<v_rd_off(D0, 1, 0)>(vb), h1 = tr_read<v_rd_off(D0, 1, 1)>(vb);
  const s16x4 l2 = tr_read<v_rd_off(D0, 2, 0)>(vb), h2 = tr_read<v_rd_off(D0, 2, 1)>(vb), l3 = tr_read<v_rd_off(D0, 3, 0)>(vb), h3 = tr_read<v_rd_off(D0, 3, 1)>(vb);
  asm volatile("s_waitcnt lgkmcnt(0)" ::: "memory"); FA_SBAR();
#define FA_PK(L, H) (bf16x8){L[0], L[1], L[2], L[3], H[0], H[1], H[2], H[3]}
  od = __builtin_amdgcn_mfma_f32_32x32x16_bf16(pa0, FA_PK(l0, h0), od, 0, 0, 0);
  od = __builtin_amdgcn_mfma_f32_32x32x16_bf16(pa1, FA_PK(l1, h1), od, 0, 0, 0);
  od = __builtin_amdgcn_mfma_f32_32x32x16_bf16(pa2, FA_PK(l2, h2), od, 0, 0, 0);
  od = __builtin_amdgcn_mfma_f32_32x32x16_bf16(pa3, FA_PK(l3, h3), od, 0, 0, 0);
#undef FA_PK
}
__device__ __forceinline__ void pv_d0(f32x16* o, int vb, bf16x8 pa0, bf16x8 pa1, bf16x8 pa2, bf16x8 pa3) {
  pv_one<0>(o[0], vb, pa0, pa1, pa2, pa3); pv_one<1>(o[1], vb, pa0, pa1, pa2, pa3); pv_one<2>(o[2], vb, pa0, pa1, pa2, pa3); pv_one<3>(o[3], vb, pa0, pa1, pa2, pa3);
}
constexpr int SHM_V = 16384, SHM_K = 16384, SHM_P = 8192, OFF_V = 0, OFF_K = 49152, OFF_P = 98304, OFF_WS = 122880, OFF_QP = 124928;
#define FA_DMA(gp, lp) __builtin_amdgcn_global_load_lds((const unsigned*)(gp), (LAS unsigned*)(lp), 16, 0, 0)

__device__ __forceinline__ void mla_unit(LAS unsigned char* lds, const bf16* __restrict__ QH, const bf16* __restrict__ KV, const bf16* __restrict__ KPE, const float* __restrict__ cosT, const float* __restrict__ sinT,
                                         bf16* __restrict__ O, const int qrow0, const bool latq, const int b, const int h) {
  constexpr float SCALE = 0.07216878364870322f;
  int tid_ = threadIdx.x; asm volatile("" : "+v"(tid_));
  const int tid = tid_, wid = __builtin_amdgcn_readfirstlane(tid >> 6), lane = tid & 63, r32 = lane & 31, hi = lane >> 5;
  LAS char* V_lds = (LAS char*)lds + OFF_V; LAS char* K_lds = (LAS char*)lds + OFF_K; LAS char* P_lds = (LAS char*)lds + OFF_P;
  LAS float* ws = (LAS float*)(lds + OFF_WS) + wid * 64; LAS float* li_l = ws; LAS float* al_l = ws + 32;
  unsigned offK[2], offV[2], offP;
#pragma unroll
  for (int i = 0; i < 2; ++i) { const int Lb = (2 * wid + i) * 1024 + 16 * lane;
    { const int row = Lb >> 8, colB = (Lb & 255) ^ ((row & 7) << 4); offK[i] = (unsigned)(row * 4096 + (colB >> 1)) * 2u; }
    { const int sub = Lb >> 9, w_ = Lb & 511, kk = (sub >> 2) * 8 + (w_ >> 6), c = (sub & 3) * 32 + ((w_ & 63) >> 1), k = (kk & ~0xC) | ((kk & 4) << 1) | ((kk & 8) >> 1); offV[i] = (unsigned)(k * 4096 + 128 + c) * 2u; } }
  { const int Lb = wid * 1024 + 16 * lane, row = Lb >> 7, colB = (Lb & 127) ^ ((row & 7) << 4); offP = (unsigned)(row * 64 + (colB >> 1)) * 2u; }
  const int NT = latq ? 132 : 4;
  const int ctx0 = MLAT + b * 256, lat0 = b * 8192 - 256;
  const bf16* KVh = KV + h * 256;
#define DMA_STEP(tk, tv, sK, sV) do { const int tk_ = (tk) < NT ? (tk) : NT - 1, tv_ = (tv) < NT ? (tv) : NT - 1; const int kb_ = (tk_ < 4 ? ctx0 : lat0) + 64 * tk_, vb_ = (tv_ < 4 ? ctx0 : lat0) + 64 * tv_; \
    const char* gk_ = (const char*)(KVh + (size_t)kb_ * 4096); const char* gp_ = (const char*)(KPE + (size_t)kb_ * 64); const char* gv_ = (const char*)(KVh + (size_t)vb_ * 4096); \
    FA_DMA(gk_ + offK[0], K_lds + (sK) * SHM_K + (2 * wid) * 1024); FA_DMA(gk_ + offK[1], K_lds + (sK) * SHM_K + (2 * wid + 1) * 1024); FA_DMA(gp_ + offP, P_lds + (sK) * SHM_P + wid * 1024); \
    FA_DMA(gv_ + offV[0], V_lds + (sV) * SHM_V + (2 * wid) * 1024); FA_DMA(gv_ + offV[1], V_lds + (sV) * SHM_V + (2 * wid + 1) * 1024); } while (0)
  DMA_STEP(0, 0, 0, 0); DMA_STEP(1, 0, 1, 2);
  float m_reg = -1e30f, l_reg = 0; f32x16 o[4] = {}; bf16x8 qr[12];
  const int qrow = qrow0 + wid * 32 + r32;
  const bf16* Qw = QH + (size_t)qrow * 3072 + h * 192 + hi * 8;
#pragma unroll
  for (int d0 = 0; d0 < 12; ++d0) qr[d0] = *(const bf16x8*)(Qw + d0 * 16);
  if (latq) {
    const int s = qrow & 8191;
#pragma unroll
    for (int ax = 0; ax < 2; ++ax) { const int pos = ax ? (s & 63) : (s >> 6); const float* ct = cosT + pos * 16 + 8 * hi; const float* st = sinT + pos * 16 + 8 * hi;
      float x1[8], x2[8]; unpack8(__builtin_bit_cast(v4u, qr[8 + 2 * ax]), x1); unpack8(__builtin_bit_cast(v4u, qr[9 + 2 * ax]), x2); float y1[8], y2[8];
#pragma unroll
      for (int i = 0; i < 8; ++i) { const float cs = ct[i], sn = st[i]; y1[i] = x1[i] * cs - x2[i] * sn; y2[i] = x1[i] * sn + x2[i] * cs; }
      const v4u w1 = {cvtpk(y1[0], y1[1]), cvtpk(y1[2], y1[3]), cvtpk(y1[4], y1[5]), cvtpk(y1[6], y1[7])}, w2 = {cvtpk(y2[0], y2[1]), cvtpk(y2[2], y2[3]), cvtpk(y2[4], y2[5]), cvtpk(y2[6], y2[7])};
      qr[8 + 2 * ax] = __builtin_bit_cast(bf16x8, w1); qr[9 + 2 * ax] = __builtin_bit_cast(bf16x8, w2); }
  }
  const int zsw = ((r32 & 7) ^ hi) << 4;
  const LAS char* kA0 = K_lds + r32 * 256 + (0 ^ zsw); const LAS char* kA1 = K_lds + r32 * 256 + (32 ^ zsw); const LAS char* kA2 = K_lds + r32 * 256 + (64 ^ zsw); const LAS char* kA3 = K_lds + r32 * 256 + (96 ^ zsw);
  const LAS char* pA0_ = P_lds + r32 * 128 + (0 ^ zsw); const LAS char* pA1_ = P_lds + r32 * 128 + (32 ^ zsw); const LAS char* pA2_ = P_lds + r32 * 128 + (64 ^ zsw); const LAS char* pA3_ = P_lds + r32 * 128 + (96 ^ zsw);
  const int vb0 = (int)(unsigned)(uintptr_t)V_lds + v_rd_base(lane);
#define QK1(p0, p1, KA, OFF, QV) do { const bf16x8 b0 = *(const LAS bf16x8*)((KA) + (OFF)); const bf16x8 b1 = *(const LAS bf16x8*)((KA) + (OFF) + 8192); \
    p0 = __builtin_amdgcn_mfma_f32_32x32x16_bf16(b0, QV, p0, 0, 0, 0); p1 = __builtin_amdgcn_mfma_f32_32x32x16_bf16(b1, QV, p1, 0, 0, 0); } while (0)
#define QP1(p0, p1, PA, OFF, QV) do { const bf16x8 b0 = *(const LAS bf16x8*)((PA) + (OFF)); const bf16x8 b1 = *(const LAS bf16x8*)((PA) + (OFF) + 4096); \
    p0 = __builtin_amdgcn_mfma_f32_32x32x16_bf16(b0, QV, p0, 0, 0, 0); p1 = __builtin_amdgcn_mfma_f32_32x32x16_bf16(b1, QV, p1, 0, 0, 0); } while (0)
#define QKT(p0, p1, s) do { p0 = f32x16{}; p1 = f32x16{}; const int ko_ = (s) * SHM_K, po_ = (s) * SHM_P; \
    QK1(p0, p1, kA0, ko_, qr[0]); QK1(p0, p1, kA1, ko_, qr[1]); QK1(p0, p1, kA2, ko_, qr[2]); QK1(p0, p1, kA3, ko_, qr[3]); \
    QK1(p0, p1, kA0, ko_ + 128, qr[4]); QK1(p0, p1, kA1, ko_ + 128, qr[5]); QK1(p0, p1, kA2, ko_ + 128, qr[6]); QK1(p0, p1, kA3, ko_ + 128, qr[7]); \
    QP1(p0, p1, pA0_, po_, qr[8]); QP1(p0, p1, pA1_, po_, qr[9]); QP1(p0, p1, pA2_, po_, qr[10]); QP1(p0, p1, pA3_, po_, qr[11]); } while (0)
#define RESC(a) do { if (__any((a) < 1.f)) { if (hi == 0) al_l[r32] = (a); asm volatile("s_waitcnt lgkmcnt(0)" ::: "memory"); \
    _Pragma("unroll") for (int d = 0; d < 4; ++d) _Pragma("unroll") for (int r = 0; r < 16; ++r) o[d][r] *= al_l[crow(r, hi)]; } } while (0)
#define STEP_END() do { asm volatile("s_waitcnt vmcnt(5) lgkmcnt(0)" ::: "memory"); __builtin_amdgcn_s_barrier(); asm volatile("" ::: "memory"); } while (0)
  f32x16 pA0, pA1, pB0, pB1; float mnA, mnB, alA, alB; bf16x8 pa0, pa1, pa2, pa3;
  STEP_END();
  int s0 = 0, s1 = 1, s2 = 2;
  DMA_STEP(2, 1, s2, s1);
  QKT(pA0, pA1, s0); partialSM(pA0, pA1, m_reg, mnA, alA, SCALE);
  STEP_END();
  for (int j = 1; j + 1 < NT; j += 2) {
    { const int t_ = s0; s0 = s1; s1 = s2; s2 = t_; }
    DMA_STEP(j + 2, j + 1, s2, s1);
    FA_SBAR(); QKT(pB0, pB1, s0);
    finishSM(pA0, pA1, alA, l_reg, pa0, pa1, pa2, pa3); FA_SBAR();
    pv_d0(o, vb0 + s2 * SHM_V, pa0, pa1, pa2, pa3); partialSM(pB0, pB1, m_reg, mnB, alB, SCALE);
    RESC(alB); STEP_END();
    { const int t_ = s0; s0 = s1; s1 = s2; s2 = t_; }
    DMA_STEP(j + 3, j + 2, s2, s1);
    FA_SBAR(); QKT(pA0, pA1, s0);
    finishSM(pB0, pB1, alB, l_reg, pa0, pa1, pa2, pa3); FA_SBAR();
    pv_d0(o, vb0 + s2 * SHM_V, pa0, pa1, pa2, pa3); partialSM(pA0, pA1, m_reg, mnA, alA, SCALE);
    RESC(alA); STEP_END();
  }
  { const int t_ = s0; s0 = s1; s1 = s2; s2 = t_; }
  DMA_STEP(NT, NT, s2, s1);
  FA_SBAR(); QKT(pB0, pB1, s0);
  finishSM(pA0, pA1, alA, l_reg, pa0, pa1, pa2, pa3); FA_SBAR();
  pv_d0(o, vb0 + s2 * SHM_V, pa0, pa1, pa2, pa3); partialSM(pB0, pB1, m_reg, mnB, alB, SCALE);
  RESC(alB); asm volatile("s_waitcnt vmcnt(0) lgkmcnt(0)" ::: "memory"); __builtin_amdgcn_s_barrier(); asm volatile("" ::: "memory");
  finishSM(pB0, pB1, alB, l_reg, pa0, pa1, pa2, pa3); FA_SBAR();
  pv_d0(o, vb0 + s0 * SHM_V, pa0, pa1, pa2, pa3);
  if (hi == 0) li_l[r32] = l_reg; asm volatile("s_waitcnt lgkmcnt(0)" ::: "memory");
  bf16* Ow = O + (size_t)(qrow0 + wid * 32) * 2048 + h * 128 + r32;
#pragma unroll
  for (int r = 0; r < 16; ++r) { const int orow = crow(r, hi); const float rli = __builtin_amdgcn_rcpf(li_l[orow]);
#pragma unroll
    for (int d0 = 0; d0 < 4; ++d0) Ow[(size_t)orow * 2048 + d0 * 32] = (bf16)(cvtpk(o[d0][r] * rli, 0.f) & 0xffffu); }
  asm volatile("s_waitcnt vmcnt(0)" ::: "memory"); __syncthreads();
#undef DMA_STEP
#undef QKT
#undef QK1
#undef QP1
#undef RESC
#undef STEP_END
}
__device__ __forceinline__ void mla_attn_phase(LAS unsigned char* lds, const bf16* QH, const bf16* KV, const bf16* KPE, const float* cosT, const float* sinT, bf16* O) {
  const int G = gridDim.x, bx = blockIdx.x;
  const int nu = (G == 256) ? (bx < 32 ? 5 : 4) : (1056 - bx + G - 1) / G;
  for (int i = 0; i < nu; ++i) {
    int bh, q0; bool latq;
    if (G == 256) { if (i < 4) { bh = i * 8 + (bx & 7); q0 = (bh >> 4) * 8192 + (bx >> 3) * 256; latq = true; } else { bh = bx; q0 = MLAT + (bh >> 4) * 256; latq = false; } }
    else { const int u = bx + i * G; if (u < 1024) { bh = u >> 5; q0 = (bh >> 4) * 8192 + (u & 31) * 256; latq = true; } else { bh = u - 1024; q0 = MLAT + (bh >> 4) * 256; latq = false; } }
    mla_unit(lds, QH, KV, KPE, cosT, sinT, O, q0, latq, bh >> 4, bh & 15);
  }
}

__device__ __forceinline__ void partialSM_m(f32x16& p0, f32x16& p1, float& m_reg, float& mn, float& alpha, const float SCALE, const int mode) {
  const float C = SCALE * 1.4426950408889634f;
  float pmax = fmaxf(fmaxf(p0[12], p0[13]), fmaxf(p0[14], p0[15]));
#pragma unroll
  for (int r = 0; r < 4; ++r) pmax = fmaxf(pmax, p1[r]);
  if (mode != 2) {
#pragma unroll
    for (int r = 0; r < 12; ++r) pmax = fmaxf(pmax, p0[r]); }
  if (mode != 1) {
#pragma unroll
    for (int r = 4; r < 16; ++r) pmax = fmaxf(pmax, p1[r]); }
  { auto rr = __builtin_amdgcn_permlane32_swap(__float_as_uint(pmax), __float_as_uint(pmax), false, false);
    pmax = fmaxf(__uint_as_float(rr[0]), __uint_as_float(rr[1])); }
  if (__builtin_expect(__all(pmax - m_reg <= THR / SCALE), 1)) { mn = m_reg; alpha = 1.f; }
  else { mn = fmaxf(m_reg, pmax); alpha = __builtin_amdgcn_exp2f((m_reg - mn) * C); m_reg = mn; }
  const float mnC = -mn * C;
#pragma unroll
  for (int r = 12; r < 16; ++r) p0[r] = __builtin_amdgcn_exp2f(fmaf(p0[r], C, mnC));
#pragma unroll
  for (int r = 0; r < 4; ++r) p1[r] = fmaf(p1[r], C, mnC);
  if (mode != 2) {
#pragma unroll
    for (int r = 0; r < 12; ++r) p0[r] = __builtin_amdgcn_exp2f(fmaf(p0[r], C, mnC)); }
  else {
#pragma unroll
    for (int r = 8; r < 12; ++r) p0[r] = 0.f; }
  if (mode != 1) {
#pragma unroll
    for (int r = 4; r < 16; ++r) p1[r] = fmaf(p1[r], C, mnC); }
}
__device__ __forceinline__ void finishSM_m(f32x16& p0, f32x16& p1, float alpha, float& l_reg, bf16x8& pa0, bf16x8& pa1, bf16x8& pa2, bf16x8& pa3, const int mode) {
  float ps = (p0[12] + p0[13]) + (p0[14] + p0[15]);
#pragma unroll
  for (int r = 0; r < 4; ++r) { p1[r] = __builtin_amdgcn_exp2f(p1[r]); ps += p1[r]; }
  if (mode != 2) {
#pragma unroll
    for (int r = 0; r < 12; ++r) ps += p0[r]; }
  if (mode != 1) {
#pragma unroll
    for (int r = 4; r < 16; ++r) { p1[r] = __builtin_amdgcn_exp2f(p1[r]); ps += p1[r]; } }
  else {
#pragma unroll
    for (int r = 4; r < 8; ++r) p1[r] = 0.f; }
  { auto rr = __builtin_amdgcn_permlane32_swap(__float_as_uint(ps), __float_as_uint(ps), false, false);
    ps = __uint_as_float(rr[0]) + __uint_as_float(rr[1]); }
  l_reg = l_reg * alpha + ps;
#define FA_PK4(P, BASE, OUT) do { unsigned a0 = cvtpk(P[BASE + 0], P[BASE + 1]), a1 = cvtpk(P[BASE + 2], P[BASE + 3]);   \
    unsigned b0 = cvtpk(P[BASE + 4], P[BASE + 5]), b1 = cvtpk(P[BASE + 6], P[BASE + 7]);                              \
    auto r0 = __builtin_amdgcn_permlane32_swap(a0, b0, false, false); auto r1 = __builtin_amdgcn_permlane32_swap(a1, b1, false, false); \
    v4u w = {r0[0], r1[0], r0[1], r1[1]}; OUT = __builtin_bit_cast(bf16x8, w); } while (0)
  if (mode != 2) FA_PK4(p0, 0, pa0);
  FA_PK4(p0, 8, pa1); FA_PK4(p1, 0, pa2);
  if (mode != 1) FA_PK4(p1, 8, pa3);
#undef FA_PK4
}
template <int D0> __device__ __forceinline__ void pv_one_m(f32x16& od, int vb, bf16x8 pa0, bf16x8 pa1, bf16x8 pa2, bf16x8 pa3, const int mode) {
  s16x4 l0, h0, l3, h3;
  if (mode != 2) { l0 = tr_read<v_rd_off(D0, 0, 0)>(vb); h0 = tr_read<v_rd_off(D0, 0, 1)>(vb); }
  const s16x4 l1 = tr_read<v_rd_off(D0, 1, 0)>(vb), h1 = tr_read<v_rd_off(D0, 1, 1)>(vb), l2 = tr_read<v_rd_off(D0, 2, 0)>(vb), h2 = tr_read<v_rd_off(D0, 2, 1)>(vb);
  if (mode != 1) { l3 = tr_read<v_rd_off(D0, 3, 0)>(vb); h3 = tr_read<v_rd_off(D0, 3, 1)>(vb); }
  asm volatile("s_waitcnt lgkmcnt(0)" ::: "memory"); FA_SBAR();
#define FA_PK(L, H) (bf16x8){L[0], L[1], L[2], L[3], H[0], H[1], H[2], H[3]}
  if (mode != 2) od = __builtin_amdgcn_mfma_f32_32x32x16_bf16(pa0, FA_PK(l0, h0), od, 0, 0, 0);
  od = __builtin_amdgcn_mfma_f32_32x32x16_bf16(pa1, FA_PK(l1, h1), od, 0, 0, 0);
  od = __builtin_amdgcn_mfma_f32_32x32x16_bf16(pa2, FA_PK(l2, h2), od, 0, 0, 0);
  if (mode != 1) od = __builtin_amdgcn_mfma_f32_32x32x16_bf16(pa3, FA_PK(l3, h3), od, 0, 0, 0);
#undef FA_PK
}
__device__ __forceinline__ void pv_d0_m(f32x16* o, int vb, bf16x8 pa0, bf16x8 pa1, bf16x8 pa2, bf16x8 pa3, const int mode) {
  pv_one_m<0>(o[0], vb, pa0, pa1, pa2, pa3, mode); pv_one_m<1>(o[1], vb, pa0, pa1, pa2, pa3, mode); pv_one_m<2>(o[2], vb, pa0, pa1, pa2, pa3, mode); pv_one_m<3>(o[3], vb, pa0, pa1, pa2, pa3, mode);
}
__device__ __forceinline__ void na_unit(LAS unsigned char* lds, const bf16* __restrict__ QKV, const float* __restrict__ rpb_h, bf16* __restrict__ O, const int qrow0, const bool ctxq, const int b, const int h, const int r0) {
  constexpr float SCALE = 0.08838834764831845f, ISCALE = 11.313708498984761f;
  const int tid = threadIdx.x, wid = __builtin_amdgcn_readfirstlane(tid >> 6), lane = tid & 63, r32 = lane & 31, hi = lane >> 5;
  LAS char* V_lds = (LAS char*)lds + OFF_V; LAS char* K_lds = (LAS char*)lds + OFF_K;
  LAS float* ws = (LAS float*)(lds + OFF_WS) + wid * 64; LAS float* li_l = ws; LAS float* al_l = ws + 32;
  LAS float* rpbL = (LAS float*)(lds + OFF_QP + 1024);
  unsigned offK[2], offV[2];
#pragma unroll
  for (int i = 0; i < 2; ++i) { const int Lb = (2 * wid + i) * 1024 + 16 * lane;
    { const int row = Lb >> 8, colB = (Lb & 255) ^ ((row & 7) << 4); offK[i] = (unsigned)(row * 6144 + (colB >> 1)) * 2u; }
    { const int sub = Lb >> 9, w_ = Lb & 511, kk = (sub >> 2) * 8 + (w_ >> 6), c = (sub & 3) * 32 + ((w_ & 63) >> 1), k = (kk & ~0xC) | ((kk & 4) << 1) | ((kk & 8) >> 1); offV[i] = (unsigned)(k * 6144 + c) * 2u; } }
  const int R0 = min(max(r0 - 4, 0), 120), R1 = min(max(r0 + 3 - 4, 0), 120) + 7;
  const int nW = ctxq ? 0 : (R1 - R0 + 1), NT = nW + 4;
  const int wbase = b * 8192 + R0 * 64, cbase = MLAT + b * 256;
  const bf16* Kh = QKV + 2048 + h * 128; const bf16* Vh = QKV + 4096 + h * 128;
#define NA_KB(t) (((t) < nW) ? wbase + 64 * (t) : cbase + 64 * ((t) - nW))
#define DMA_K(t, bf) do { const int tt_ = (t) < NT ? (t) : NT - 1; const char* gk_ = (const char*)(Kh + (size_t)NA_KB(tt_) * 6144); FA_DMA(gk_ + offK[0], K_lds + (bf) * SHM_K + (2 * wid) * 1024); FA_DMA(gk_ + offK[1], K_lds + (bf) * SHM_K + (2 * wid + 1) * 1024); } while (0)
#define DMA_V(t, bf) do { const int tt_ = (t) < NT ? (t) : NT - 1; const char* gv_ = (const char*)(Vh + (size_t)NA_KB(tt_) * 6144); FA_DMA(gv_ + offV[0], V_lds + (bf) * SHM_V + (2 * wid) * 1024); FA_DMA(gv_ + offV[1], V_lds + (bf) * SHM_V + (2 * wid + 1) * 1024); } while (0)
  DMA_K(0, 0); DMA_V(0, 0); DMA_K(1, 1); DMA_V(1, 1);
  if (!ctxq) for (int i = tid; i < 15 * 31; i += NTHR) rpbL[i] = rpb_h[i] * ISCALE;
  float m_reg = -1e30f, l_reg = 0; f32x16 o[4] = {}; bf16x8 qr[8];
  const int qrow = qrow0 + wid * 32 + r32;
  const bf16* Qw = QKV + (size_t)qrow * 6144 + h * 128 + hi * 8;
#pragma unroll
  for (int d0 = 0; d0 < 8; ++d0) qr[d0] = *(const bf16x8*)(Qw + d0 * 16);
  const int vb0 = (int)(unsigned)(uintptr_t)V_lds + v_rd_base(lane);
  const int zsw = ((r32 & 7) ^ hi) << 4;
  const LAS char* kA0 = K_lds + r32 * 256 + (0 ^ zsw); const LAS char* kA1 = K_lds + r32 * 256 + (32 ^ zsw); const LAS char* kA2 = K_lds + r32 * 256 + (64 ^ zsw); const LAS char* kA3 = K_lds + r32 * 256 + (96 ^ zsw);
  const int rq = r0 + (wid >> 1), wa = ctxq ? 0 : (min(max(rq - 4, 0), 120) - R0), we = ctxq ? 0 : wa + 8;
  const int cq = 32 * (wid & 1) + r32, cs = min(max(cq - 8, 0), 48);
  const bool wodd = (wid & 1) != 0;
#define ACT(t) ((t) < NT && ((t) >= nW || ((t) >= wa && (t) < we)))
#define QK1(p0, p1, KA, OFF, QV) do { const bf16x8 b0 = *(const LAS bf16x8*)((KA) + (OFF)); const bf16x8 b1 = *(const LAS bf16x8*)((KA) + (OFF) + 8192); \
    p0 = __builtin_amdgcn_mfma_f32_32x32x16_bf16(b0, QV, p0, 0, 0, 0); p1 = __builtin_amdgcn_mfma_f32_32x32x16_bf16(b1, QV, p1, 0, 0, 0); } while (0)
#define QKT(p0, p1, t, bf) do { if ((t) < nW) { const int dr_ = R0 + (t) - rq + 7; const LAS float* bp_ = rpbL + dr_ * 31 + (15 - cq) + 4 * hi; \
      _Pragma("unroll") for (int i_ = 12; i_ < 16; ++i_) { const int kc_ = crow(i_, hi); const float v0_ = bp_[8 * (i_ >> 2) + (i_ & 3)]; p0[i_] = (kc_ >= cs && kc_ < cs + 16) ? v0_ : -INFINITY; } \
      _Pragma("unroll") for (int i_ = 0; i_ < 4; ++i_) { const int kc_ = crow(i_, hi); const float v1_ = bp_[32 + 8 * (i_ >> 2) + (i_ & 3)]; p1[i_] = (kc_ + 32 >= cs && kc_ + 32 < cs + 16) ? v1_ : -INFINITY; } \
      if (!wodd) { _Pragma("unroll") for (int i_ = 0; i_ < 12; ++i_) { const int kc_ = crow(i_, hi); const float v0_ = bp_[8 * (i_ >> 2) + (i_ & 3)]; p0[i_] = (kc_ >= cs && kc_ < cs + 16) ? v0_ : -INFINITY; } } \
      else { _Pragma("unroll") for (int i_ = 4; i_ < 16; ++i_) { const int kc_ = crow(i_, hi); const float v1_ = bp_[32 + 8 * (i_ >> 2) + (i_ & 3)]; p1[i_] = (kc_ + 32 >= cs && kc_ + 32 < cs + 16) ? v1_ : -INFINITY; } } \
      } else { p0 = f32x16{}; p1 = f32x16{}; } \
    QK1(p0, p1, kA0, (bf) * SHM_K, qr[0]); QK1(p0, p1, kA1, (bf) * SHM_K, qr[1]); QK1(p0, p1, kA2, (bf) * SHM_K, qr[2]); QK1(p0, p1, kA3, (bf) * SHM_K, qr[3]); \
    QK1(p0, p1, kA0, (bf) * SHM_K + 128, qr[4]); QK1(p0, p1, kA1, (bf) * SHM_K + 128, qr[5]); QK1(p0, p1, kA2, (bf) * SHM_K + 128, qr[6]); QK1(p0, p1, kA3, (bf) * SHM_K + 128, qr[7]); } while (0)
#define RESC(a) do { if (__any((a) < 1.f)) { if (hi == 0) al_l[r32] = (a); asm volatile("s_waitcnt lgkmcnt(0)" ::: "memory"); \
    _Pragma("unroll") for (int d = 0; d < 4; ++d) _Pragma("unroll") for (int r = 0; r < 16; ++r) o[d][r] *= al_l[crow(r, hi)]; } } while (0)
#define STEP_END() do { FA_SBAR(); asm volatile("s_waitcnt vmcnt(4) lgkmcnt(0)" ::: "memory"); __builtin_amdgcn_s_barrier(); asm volatile("" ::: "memory"); } while (0)
  f32x16 pA0 = {}, pA1 = {}; float mnA, alA = 1.f; bf16x8 pa0 = {}, pa1 = {}, pa2 = {}, pa3 = {};
  STEP_END();
  int s0 = 0, s1 = 1, s2 = 2;
  for (int t = 0; t < NT; ++t) {
    DMA_K(t + 2, s2); DMA_V(t + 2, s2);
    FA_SBAR();
    if (ACT(t)) { const int mode = (t < nW) ? (wodd ? 2 : 1) : 0;
      QKT(pA0, pA1, t, s0); partialSM_m(pA0, pA1, m_reg, mnA, alA, SCALE, mode); RESC(alA);
      finishSM_m(pA0, pA1, alA, l_reg, pa0, pa1, pa2, pa3, mode); FA_SBAR(); pv_d0_m(o, vb0 + s0 * SHM_V, pa0, pa1, pa2, pa3, mode); }
    STEP_END();
    { const int t_ = s0; s0 = s1; s1 = s2; s2 = t_; }
  }
  asm volatile("s_waitcnt vmcnt(0)" ::: "memory");
  if (hi == 0) li_l[r32] = l_reg; asm volatile("s_waitcnt lgkmcnt(0)" ::: "memory");
  bf16* Ow = O + (size_t)(qrow0 + wid * 32) * 2048 + h * 128 + r32;
#pragma unroll
  for (int r = 0; r < 16; ++r) { const int orow = crow(r, hi); const float rli = __builtin_amdgcn_rcpf(li_l[orow]);
#pragma unroll
    for (int d0 = 0; d0 < 4; ++d0) Ow[(size_t)orow * 2048 + d0 * 32] = (bf16)(cvtpk(o[d0][r] * rli, 0.f) & 0xffffu); }
  __syncthreads();
#undef NA_KB
#undef DMA_K
#undef DMA_V
#undef ACT
#undef QK1
#undef QKT
#undef RESC
#undef STEP_END
}
__device__ __forceinline__ void na_attn_phase(LAS unsigned char* lds, const bf16* QKV, const float* rpb, bf16* O, const bool need_ctx) {
  const int G = gridDim.x, bx = blockIdx.x; const int ntot = need_ctx ? 1056 : 1024;
  const int nu = (G == 256) ? ((need_ctx && bx < 32) ? 5 : 4) : (ntot - bx + G - 1) / G;
  for (int i = 0; i < nu; ++i) {
    int bh, q0, r0; bool ctxq;
    if (G == 256) { if (i < 4) { bh = i * 8 + (bx & 7); r0 = (bx >> 3) * 4; q0 = (bh >> 4) * 8192 + r0 * 64; ctxq = false; } else { bh = bx; r0 = 0; q0 = MLAT + (bh >> 4) * 256; ctxq = true; } }
    else { const int u = bx + i * G; if (u < 1024) { bh = u >> 5; r0 = (u & 31) * 4; q0 = (bh >> 4) * 8192 + r0 * 64; ctxq = false; } else { bh = u - 1024; r0 = 0; q0 = MLAT + (bh >> 4) * 256; ctxq = true; } }
    na_unit(lds, QKV, rpb + (size_t)(bh & 15) * 15 * 31, O, q0, ctxq, bh >> 4, bh & 15, r0);
  }
}
}

namespace m16 {
using fa::f32x16; using fa::cvtpk;
typedef float f32x4q __attribute__((ext_vector_type(4)));
typedef short v4i16q __attribute__((ext_vector_type(4)));
constexpr int VROW = 256, SHM_V = 64 * VROW, SHM_K = 16384, SHM_P = 8192, OFF_V = 0, OFF_K = 3 * SHM_V, OFF_P = OFF_K + 3 * SHM_K, OFF_WS = OFF_P + 3 * SHM_P;
static_assert(OFF_WS + 8 * 256 <= 131072, "MLA LDS map");
#define M16_DMA(gp, lp) __builtin_amdgcn_global_load_lds((const unsigned*)(gp), (LAS unsigned*)(lp), 16, 0, 0)
__device__ __forceinline__ float xor16(float v) { return __int_as_float(__builtin_amdgcn_ds_swizzle(__float_as_int(v), 0x401F)); }
__device__ __forceinline__ float xor32_max(float v) { auto rr = __builtin_amdgcn_permlane32_swap(__float_as_uint(v), __float_as_uint(v), false, false); return fmaxf(__uint_as_float(rr[0]), __uint_as_float(rr[1])); }
__device__ __forceinline__ float xor32_sum(float v) { auto rr = __builtin_amdgcn_permlane32_swap(__float_as_uint(v), __float_as_uint(v), false, false); return __uint_as_float(rr[0]) + __uint_as_float(rr[1]); }

__device__ __forceinline__ void mla_unit16(LAS unsigned char* lds, const bf16* __restrict__ QH, const bf16* __restrict__ KV, const bf16* __restrict__ KPE, const float* __restrict__ cosT, const float* __restrict__ sinT,
                                           bf16* __restrict__ O, const int qrow0, const bool latq, const int b, const int h) {
  constexpr float SCALE = 0.07216878364870322f, C = SCALE * 1.4426950408889634f, THR2 = 8.f * 1.4426950408889634f;
  int tid_ = threadIdx.x; asm volatile("" : "+v"(tid_));
  const int tid = tid_, wid = __builtin_amdgcn_readfirstlane(tid >> 6), lane = tid & 63, l15 = lane & 15, kg = lane >> 4;
  LAS char* V_lds = (LAS char*)lds + OFF_V; LAS char* K_lds = (LAS char*)lds + OFF_K; LAS char* P_lds = (LAS char*)lds + OFF_P;
  LAS float* ws = (LAS float*)(lds + OFF_WS) + wid * 64;
  unsigned offK[2], offV[2], offP;
#pragma unroll
  for (int i = 0; i < 2; ++i) { const int Lb = (2 * wid + i) * 1024 + 16 * lane, row = Lb >> 8, colB = (Lb & 255) ^ ((row & 15) << 4); offK[i] = (unsigned)(row * 4096 + (colB >> 1)) * 2u; }
  { const int Lb = wid * 1024 + 16 * lane, row = Lb >> 7, colB = (Lb & 127) ^ ((row & 7) << 4); offP = (unsigned)(row * 64 + (colB >> 1)) * 2u; }
#pragma unroll
  for (int i = 0; i < 2; ++i) { const int Lb = (2 * wid + i) * 1024 + 16 * lane, row = Lb >> 8, colB = (Lb & 255) ^ ((row & 7) << 5); offV[i] = (unsigned)(row * 4096 + 128 + (colB >> 1)) * 2u; }
  const int NT = latq ? 132 : 4;
  const int ctx0 = MLAT + b * 256, lat0 = b * 8192 - 256;
  const bf16* KVh = KV + h * 256;
#define DMA_K(tk, sK) do { const int tk_ = (tk) < NT ? (tk) : NT - 1; const int kb_ = (tk_ < 4 ? ctx0 : lat0) + 64 * tk_; \
    const char* gk_ = (const char*)(KVh + (size_t)kb_ * 4096); const char* gp_ = (const char*)(KPE + (size_t)kb_ * 64); \
    M16_DMA(gk_ + offK[0], K_lds + (sK) * SHM_K + (2 * wid) * 1024); M16_DMA(gk_ + offK[1], K_lds + (sK) * SHM_K + (2 * wid + 1) * 1024); M16_DMA(gp_ + offP, P_lds + (sK) * SHM_P + wid * 1024); } while (0)
#define DMA_V(tv, sV) do { const int tv_ = (tv) < NT ? (tv) : NT - 1; const int vb_ = (tv_ < 4 ? ctx0 : lat0) + 64 * tv_; const char* gv_ = (const char*)(KVh + (size_t)vb_ * 4096); \
    M16_DMA(gv_ + offV[0], V_lds + (sV) * SHM_V + (2 * wid) * 1024); M16_DMA(gv_ + offV[1], V_lds + (sV) * SHM_V + (2 * wid + 1) * 1024); } while (0)
  DMA_K(0, 0); DMA_K(1, 1); DMA_V(0, 0);
  bf16x8 qf[2][6];
#pragma unroll
  for (int qb = 0; qb < 2; ++qb) { const int qrow = qrow0 + wid * 32 + 16 * qb + l15; const bf16* Qw = QH + (size_t)qrow * 3072 + h * 192 + 8 * kg;
#pragma unroll
    for (int s = 0; s < 4; ++s) { float f[8]; unpack8(*(const v4u*)(Qw + 32 * s), f);
      const v4u w = {cvtpk(f[0] * C, f[1] * C), cvtpk(f[2] * C, f[3] * C), cvtpk(f[4] * C, f[5] * C), cvtpk(f[6] * C, f[7] * C)}; qf[qb][s] = __builtin_bit_cast(bf16x8, w); }
    const int sp = qrow & 8191;
#pragma unroll
    for (int ax = 0; ax < 2; ++ax) { const v4u own = *(const v4u*)(Qw + 128 + 32 * ax), oth = *(const v4u*)(Qw + 128 + 32 * ax + (kg < 2 ? 16 : -16));
      v4u res;
      if (!latq) { float f[8]; unpack8(own, f); res = (v4u){cvtpk(f[0] * C, f[1] * C), cvtpk(f[2] * C, f[3] * C), cvtpk(f[4] * C, f[5] * C), cvtpk(f[6] * C, f[7] * C)}; }
      else { const int pos = ax ? (sp & 63) : (sp >> 6); const float* ct = cosT + pos * 16 + 8 * (kg & 1); const float* st = sinT + pos * 16 + 8 * (kg & 1);
        float x1[8], x2[8], yv[8]; if (kg < 2) { unpack8(own, x1); unpack8(oth, x2); } else { unpack8(oth, x1); unpack8(own, x2); }
#pragma unroll
        for (int i = 0; i < 8; ++i) yv[i] = kg < 2 ? x1[i] * ct[i] - x2[i] * st[i] : x1[i] * st[i] + x2[i] * ct[i];
        res = (v4u){cvtpk(yv[0] * C, yv[1] * C), cvtpk(yv[2] * C, yv[3] * C), cvtpk(yv[4] * C, yv[5] * C), cvtpk(yv[6] * C, yv[7] * C)}; }
      qf[qb][4 + ax] = __builtin_bit_cast(bf16x8, res); } }
  const int zsw = (l15 & 7) << 4;
  const LAS char* kS0 = K_lds + l15 * 256 + ((16 * kg) ^ (l15 << 4)); const LAS char* kS1 = K_lds + l15 * 256 + ((64 + 16 * kg) ^ (l15 << 4));
  const LAS char* kS2 = K_lds + l15 * 256 + ((128 + 16 * kg) ^ (l15 << 4)); const LAS char* kS3 = K_lds + l15 * 256 + ((192 + 16 * kg) ^ (l15 << 4));
  const LAS char* pE = P_lds + l15 * 128 + ((16 * kg) ^ zsw); const LAS char* pO = P_lds + l15 * 128 + (((16 * kg) ^ zsw) ^ 64);
  unsigned vBc[8];
#pragma unroll
  for (int c = 0; c < 8; ++c) vBc[c] = (unsigned)(uintptr_t)V_lds + (unsigned)((4 * kg + (l15 >> 2)) * VROW + 8 * (l15 & 3) + 32 * (c ^ ((4 * (kg & 1) + (l15 >> 2)) & 7)));
  float m0 = 0.f, m1 = 0.f, lr0 = 0.f, lr1 = 0.f; f32x4q o[2][8];
  f32x4q nm0 = {0.f, 0.f, 0.f, 0.f}, nm1 = {0.f, 0.f, 0.f, 0.f};
#pragma unroll
  for (int qb = 0; qb < 2; ++qb)
#pragma unroll
    for (int c = 0; c < 8; ++c) o[qb][c] = (f32x4q){0.f, 0.f, 0.f, 0.f};
  struct Tile { f32x4q s[4][2]; };
#define M16_RD2(d0_, d1_, A_, O0_, O1_) do { asm volatile("ds_read_b128 %0, %1 offset:%2" : "=v"(d0_) : "v"(A_), "i"(O0_)); asm volatile("ds_read_b128 %0, %1 offset:%2" : "=v"(d1_) : "v"(A_), "i"(O1_)); } while (0)
#define M16_W2(x_, y_) asm volatile("s_waitcnt lgkmcnt(2)" : "+v"(x_), "+v"(y_))
#define M16_W0(x_, y_) asm volatile("s_waitcnt lgkmcnt(0)" : "+v"(x_), "+v"(y_))
#define M16_MM(T_, KB_, x_, y_, S_) do { T_.s[KB_][0] = __builtin_amdgcn_mfma_f32_16x16x32_bf16(x_, qf[0][S_], T_.s[KB_][0], 0, 0, 0); T_.s[KB_][1] = __builtin_amdgcn_mfma_f32_16x16x32_bf16(x_, qf[1][S_], T_.s[KB_][1], 0, 0, 0); \
    T_.s[KB_ + 1][0] = __builtin_amdgcn_mfma_f32_16x16x32_bf16(y_, qf[0][S_], T_.s[KB_ + 1][0], 0, 0, 0); T_.s[KB_ + 1][1] = __builtin_amdgcn_mfma_f32_16x16x32_bf16(y_, qf[1][S_], T_.s[KB_ + 1][1], 0, 0, 0); } while (0)
#define QK16(T_, sl) do { const unsigned ko_ = (unsigned)((sl) * SHM_K), po_ = (unsigned)((sl) * SHM_P); \
    const unsigned a0_ = (unsigned)(uintptr_t)kS0 + ko_, a1_ = (unsigned)(uintptr_t)kS1 + ko_, a2_ = (unsigned)(uintptr_t)kS2 + ko_, a3_ = (unsigned)(uintptr_t)kS3 + ko_, pe_ = (unsigned)(uintptr_t)pE + po_, pq_ = (unsigned)(uintptr_t)pO + po_; \
    _Pragma("unroll") for (int kb = 0; kb < 4; ++kb) { T_.s[kb][0] = nm0; T_.s[kb][1] = nm1; } \
    bf16x8 e0_, e1_, f0_, f1_; \
    M16_RD2(e0_, e1_, a0_, 0, 4096); \
    M16_RD2(f0_, f1_, a0_, 8192, 12288);          M16_W2(e0_, e1_); M16_MM(T_, 0, e0_, e1_, 0); \
    M16_RD2(e0_, e1_, a1_, 0, 4096);              M16_W2(f0_, f1_); M16_MM(T_, 2, f0_, f1_, 0); \
    M16_RD2(f0_, f1_, a1_, 8192, 12288);          M16_W2(e0_, e1_); M16_MM(T_, 0, e0_, e1_, 1); \
    M16_RD2(e0_, e1_, a2_, 0, 4096);              M16_W2(f0_, f1_); M16_MM(T_, 2, f0_, f1_, 1); \
    M16_RD2(f0_, f1_, a2_, 8192, 12288);          M16_W2(e0_, e1_); M16_MM(T_, 0, e0_, e1_, 2); \
    M16_RD2(e0_, e1_, a3_, 0, 4096);              M16_W2(f0_, f1_); M16_MM(T_, 2, f0_, f1_, 2); \
    M16_RD2(f0_, f1_, a3_, 8192, 12288);          M16_W2(e0_, e1_); M16_MM(T_, 0, e0_, e1_, 3); \
    M16_RD2(e0_, e1_, pe_, 0, 2048);              M16_W2(f0_, f1_); M16_MM(T_, 2, f0_, f1_, 3); \
    M16_RD2(f0_, f1_, pe_, 4096, 6144);           M16_W2(e0_, e1_); M16_MM(T_, 0, e0_, e1_, 4); \
    M16_RD2(e0_, e1_, pq_, 0, 2048);              M16_W2(f0_, f1_); M16_MM(T_, 2, f0_, f1_, 4); \
    M16_RD2(f0_, f1_, pq_, 4096, 6144);           M16_W2(e0_, e1_); M16_MM(T_, 0, e0_, e1_, 5); \
                                                  M16_W0(f0_, f1_); M16_MM(T_, 2, f0_, f1_, 5); } while (0)
#define SOFT16(T_, al0_, al1_, FIRST_) do { float x0 = T_.s[0][0][0], x1 = T_.s[0][1][0]; \
    _Pragma("unroll") for (int kb = 0; kb < 4; ++kb) _Pragma("unroll") for (int i = 0; i < 4; ++i) { x0 = fmaxf(x0, T_.s[kb][0][i]); x1 = fmaxf(x1, T_.s[kb][1][i]); } \
    al0_ = 1.f; al1_ = 1.f;                                                                    \
    if ((FIRST_) || !__builtin_expect(__all(x0 <= THR2 && x1 <= THR2), 1)) {                  \
      x0 = fmaxf(x0, xor16(x0)); x1 = fmaxf(x1, xor16(x1)); x0 = xor32_max(x0); x1 = xor32_max(x1); \
      const float d0 = (FIRST_) ? x0 : fmaxf(x0, 0.f), d1 = (FIRST_) ? x1 : fmaxf(x1, 0.f); \
      if (!(FIRST_)) { al0_ = __builtin_amdgcn_exp2f(-d0); al1_ = __builtin_amdgcn_exp2f(-d1); } \
      m0 += d0; m1 += d1; nm0 = (f32x4q){-m0, -m0, -m0, -m0}; nm1 = (f32x4q){-m1, -m1, -m1, -m1}; \
      _Pragma("unroll") for (int kb = 0; kb < 4; ++kb) _Pragma("unroll") for (int i = 0; i < 4; ++i) { T_.s[kb][0][i] -= d0; T_.s[kb][1][i] -= d1; } } \
    float y0 = 0.f, y1 = 0.f; \
    _Pragma("unroll") for (int kb = 0; kb < 4; ++kb) _Pragma("unroll") for (int i = 0; i < 4; ++i) { T_.s[kb][0][i] = __builtin_amdgcn_exp2f(T_.s[kb][0][i]); T_.s[kb][1][i] = __builtin_amdgcn_exp2f(T_.s[kb][1][i]); \
      y0 += T_.s[kb][0][i]; y1 += T_.s[kb][1][i]; } \
    lr0 = lr0 * al0_ + y0; lr1 = lr1 * al1_ + y1;                                             \
    _Pragma("unroll") for (int qb = 0; qb < 2; ++qb) _Pragma("unroll") for (int ks = 0; ks < 2; ++ks) { \
      const v4u w_ = {cvtpk(T_.s[2 * ks][qb][0], T_.s[2 * ks][qb][1]), cvtpk(T_.s[2 * ks][qb][2], T_.s[2 * ks][qb][3]), cvtpk(T_.s[2 * ks + 1][qb][0], T_.s[2 * ks + 1][qb][1]), cvtpk(T_.s[2 * ks + 1][qb][2], T_.s[2 * ks + 1][qb][3])}; \
      pa[qb][ks] = __builtin_bit_cast(bf16x8, w_); } } while (0)
#define RESC16(al0_, al1_) do { if (__any((al0_) < 1.f || (al1_) < 1.f)) { if (kg == 0) { ws[l15] = (al0_); ws[16 + l15] = (al1_); } asm volatile("s_waitcnt lgkmcnt(0)" ::: "memory"); \
    const f32x4q a0_ = *(const LAS f32x4q*)(ws + 4 * kg), a1_ = *(const LAS f32x4q*)(ws + 16 + 4 * kg); \
    _Pragma("unroll") for (int c = 0; c < 8; ++c) { o[0][c] *= a0_; o[1][c] *= a1_; } } } while (0)
#define M16_TR4(a_, b_, c_, d_, A_, C_) do { const unsigned ad_ = vBc[C_] + (A_); asm volatile("ds_read_b64_tr_b16 %0, %1 offset:%2" : "=v"(a_) : "v"(ad_), "i"(0)); asm volatile("ds_read_b64_tr_b16 %0, %1 offset:%2" : "=v"(b_) : "v"(ad_), "i"(16 * VROW)); \
    asm volatile("ds_read_b64_tr_b16 %0, %1 offset:%2" : "=v"(c_) : "v"(ad_), "i"(32 * VROW)); asm volatile("ds_read_b64_tr_b16 %0, %1 offset:%2" : "=v"(d_) : "v"(ad_), "i"(48 * VROW)); } while (0)
#define M16_WV4(a_, b_, c_, d_) asm volatile("s_waitcnt lgkmcnt(4)" : "+v"(a_), "+v"(b_), "+v"(c_), "+v"(d_))
#define M16_WV0(a_, b_, c_, d_) asm volatile("s_waitcnt lgkmcnt(0)" : "+v"(a_), "+v"(b_), "+v"(c_), "+v"(d_))
#define M16_PM(C_, a_, b_, c_, d_) do { const bf16x8 v0_ = __builtin_bit_cast(bf16x8, __builtin_shufflevector(a_, b_, 0, 1, 2, 3, 4, 5, 6, 7)), v1_ = __builtin_bit_cast(bf16x8, __builtin_shufflevector(c_, d_, 0, 1, 2, 3, 4, 5, 6, 7)); \
    o[0][C_] = __builtin_amdgcn_mfma_f32_16x16x32_bf16(pa[0][0], v0_, o[0][C_], 0, 0, 0); o[1][C_] = __builtin_amdgcn_mfma_f32_16x16x32_bf16(pa[1][0], v0_, o[1][C_], 0, 0, 0); \
    o[0][C_] = __builtin_amdgcn_mfma_f32_16x16x32_bf16(pa[0][1], v1_, o[0][C_], 0, 0, 0); o[1][C_] = __builtin_amdgcn_mfma_f32_16x16x32_bf16(pa[1][1], v1_, o[1][C_], 0, 0, 0); } while (0)
#define PV16(sl) do { const unsigned va_ = (unsigned)((sl) * SHM_V); v4i16q a_, b_, c_, d_, e_, f_, g_, h_; \
    M16_TR4(a_, b_, c_, d_, va_, 0); \
    M16_TR4(e_, f_, g_, h_, va_, 1); M16_WV4(a_, b_, c_, d_); M16_PM(0, a_, b_, c_, d_); \
    M16_TR4(a_, b_, c_, d_, va_, 2); M16_WV4(e_, f_, g_, h_); M16_PM(1, e_, f_, g_, h_); \
    M16_TR4(e_, f_, g_, h_, va_, 3); M16_WV4(a_, b_, c_, d_); M16_PM(2, a_, b_, c_, d_); \
    M16_TR4(a_, b_, c_, d_, va_, 4); M16_WV4(e_, f_, g_, h_); M16_PM(3, e_, f_, g_, h_); \
    M16_TR4(e_, f_, g_, h_, va_, 5); M16_WV4(a_, b_, c_, d_); M16_PM(4, a_, b_, c_, d_); \
    M16_TR4(a_, b_, c_, d_, va_, 6); M16_WV4(e_, f_, g_, h_); M16_PM(5, e_, f_, g_, h_); \
    M16_TR4(e_, f_, g_, h_, va_, 7); M16_WV4(a_, b_, c_, d_); M16_PM(6, a_, b_, c_, d_); \
                                     M16_WV0(e_, f_, g_, h_); M16_PM(7, e_, f_, g_, h_); } while (0)
#define M16_WK(n_, x_, y_) asm volatile("s_waitcnt lgkmcnt(" #n_ ")" : "+v"(x_), "+v"(y_))
#define M16_WV(n_, a_, b_, c_, d_) asm volatile("s_waitcnt lgkmcnt(" #n_ ")" : "+v"(a_), "+v"(b_), "+v"(c_), "+v"(d_))
#define MSEG16(T_, slK, slV) do { const unsigned ko_ = (unsigned)((slK) * SHM_K), po_ = (unsigned)((slK) * SHM_P), va_ = (unsigned)((slV) * SHM_V); \
    const unsigned a0_ = (unsigned)(uintptr_t)kS0 + ko_, a1_ = (unsigned)(uintptr_t)kS1 + ko_, a2_ = (unsigned)(uintptr_t)kS2 + ko_, a3_ = (unsigned)(uintptr_t)kS3 + ko_, pe_ = (unsigned)(uintptr_t)pE + po_, pq_ = (unsigned)(uintptr_t)pO + po_; \
    _Pragma("unroll") for (int kb = 0; kb < 4; ++kb) { T_.s[kb][0] = nm0; T_.s[kb][1] = nm1; } \
    bf16x8 e0_, e1_, f0_, f1_, g0_, g1_; v4i16q va0_, va1_, va2_, va3_, vb0_, vb1_, vb2_, vb3_, vc0_, vc1_, vc2_, vc3_; \
    M16_RD2(e0_, e1_, a0_, 0, 4096); M16_RD2(f0_, f1_, a0_, 8192, 12288); \
    M16_RD2(g0_, g1_, a1_, 0, 4096); M16_WK(4, e0_, e1_); M16_MM(T_, 0, e0_, e1_, 0); \
    M16_RD2(e0_, e1_, a1_, 8192, 12288); M16_WK(4, f0_, f1_); M16_MM(T_, 2, f0_, f1_, 0); \
    M16_RD2(f0_, f1_, a2_, 0, 4096); M16_WK(4, g0_, g1_); M16_MM(T_, 0, g0_, g1_, 1); \
    M16_RD2(g0_, g1_, a2_, 8192, 12288); M16_WK(4, e0_, e1_); M16_MM(T_, 2, e0_, e1_, 1); \
    M16_RD2(e0_, e1_, a3_, 0, 4096); M16_WK(4, f0_, f1_); M16_MM(T_, 0, f0_, f1_, 2); \
    M16_RD2(f0_, f1_, a3_, 8192, 12288); M16_WK(4, g0_, g1_); M16_MM(T_, 2, g0_, g1_, 2); \
    M16_RD2(g0_, g1_, pe_, 0, 2048); M16_WK(4, e0_, e1_); M16_MM(T_, 0, e0_, e1_, 3); \
    M16_RD2(e0_, e1_, pe_, 4096, 6144); M16_WK(4, f0_, f1_); M16_MM(T_, 2, f0_, f1_, 3); \
    M16_RD2(f0_, f1_, pq_, 0, 2048); M16_WK(4, g0_, g1_); M16_MM(T_, 0, g0_, g1_, 4); \
    M16_RD2(g0_, g1_, pq_, 4096, 6144); M16_WK(4, e0_, e1_); M16_MM(T_, 2, e0_, e1_, 4); \
    M16_TR4(va0_, va1_, va2_, va3_, va_, 0); M16_WK(6, f0_, f1_); M16_MM(T_, 0, f0_, f1_, 5); \
    M16_TR4(vb0_, vb1_, vb2_, vb3_, va_, 1); M16_WK(8, g0_, g1_); M16_MM(T_, 2, g0_, g1_, 5); \
    M16_TR4(vc0_, vc1_, vc2_, vc3_, va_, 2); M16_WV(8, va0_, va1_, va2_, va3_); M16_PM(0, va0_, va1_, va2_, va3_); \
    M16_TR4(va0_, va1_, va2_, va3_, va_, 3); M16_WV(8, vb0_, vb1_, vb2_, vb3_); M16_PM(1, vb0_, vb1_, vb2_, vb3_); \
    M16_TR4(vb0_, vb1_, vb2_, vb3_, va_, 4); M16_WV(8, vc0_, vc1_, vc2_, vc3_); M16_PM(2, vc0_, vc1_, vc2_, vc3_); \
    M16_TR4(vc0_, vc1_, vc2_, vc3_, va_, 5); M16_WV(8, va0_, va1_, va2_, va3_); M16_PM(3, va0_, va1_, va2_, va3_); \
    M16_TR4(va0_, va1_, va2_, va3_, va_, 6); M16_WV(8, vb0_, vb1_, vb2_, vb3_); M16_PM(4, vb0_, vb1_, vb2_, vb3_); \
    M16_TR4(vb0_, vb1_, vb2_, vb3_, va_, 7); M16_WV(8, vc0_, vc1_, vc2_, vc3_); M16_PM(5, vc0_, vc1_, vc2_, vc3_); \
    M16_WV(4, va0_, va1_, va2_, va3_); M16_PM(6, va0_, va1_, va2_, va3_); \
    M16_WV(0, vb0_, vb1_, vb2_, vb3_); M16_PM(7, vb0_, vb1_, vb2_, vb3_); } while (0)
#define SEG_END_M() do { FA_SBAR(); asm volatile("s_waitcnt vmcnt(0) lgkmcnt(0)" ::: "memory"); __builtin_amdgcn_s_barrier(); asm volatile("" ::: "memory"); FA_SBAR(); } while (0)
#define SEG_END_V() do { FA_SBAR(); asm volatile("s_waitcnt lgkmcnt(0)" ::: "memory"); __builtin_amdgcn_s_barrier(); asm volatile("" ::: "memory"); FA_SBAR(); } while (0)
  Tile tS; bf16x8 pa[2][2]; float al0, al1;
  SEG_END_M();
  if (wid >= 4) { __builtin_amdgcn_s_barrier(); asm volatile("" ::: "memory"); }
  FA_SBAR();
  QK16(tS, 0);
  SEG_END_M();
  DMA_K(2, 2); DMA_V(1, 1);
  SOFT16(tS, al0, al1, true);
  SEG_END_V();
  int s0 = 0, s1 = 1, s2 = 2;
  for (int k = 0; k + 1 < NT; ++k) {
    MSEG16(tS, s1, s0);
    SEG_END_M();
    DMA_K(k + 3, s0); DMA_V(k + 2, s2);
    SOFT16(tS, al0, al1, false);
    RESC16(al0, al1);
    SEG_END_V();
    { const int t_ = s0; s0 = s1; s1 = s2; s2 = t_; }
  }
  PV16(s0);
  SEG_END_M();
  if (wid < 4) { __builtin_amdgcn_s_barrier(); asm volatile("" ::: "memory"); }
  lr0 += xor16(lr0); lr1 += xor16(lr1); lr0 = xor32_sum(lr0); lr1 = xor32_sum(lr1);
  if (kg == 0) { ws[32 + l15] = lr0; ws[48 + l15] = lr1; } asm volatile("s_waitcnt lgkmcnt(0)" ::: "memory");
#pragma unroll
  for (int qb = 0; qb < 2; ++qb) { const f32x4q lv = *(const LAS f32x4q*)(ws + 32 + 16 * qb + 4 * kg);
    bf16* Ow = O + (size_t)(qrow0 + wid * 32 + 16 * qb + 4 * kg) * 2048 + h * 128 + l15;
#pragma unroll
    for (int i = 0; i < 4; ++i) { const float rl = __builtin_amdgcn_rcpf(lv[i]);
#pragma unroll
      for (int c = 0; c < 8; ++c) Ow[(size_t)i * 2048 + 16 * c] = (bf16)(cvtpk(o[qb][c][i] * rl, 0.f) & 0xffffu); } }
  asm volatile("s_waitcnt vmcnt(0)" ::: "memory"); __syncthreads();
#undef DMA_K
#undef DMA_V
#undef QK16
#undef M16_RD2
#undef M16_W2
#undef M16_W0
#undef M16_MM
#undef SOFT16
#undef RESC16
#undef PV16
#undef MSEG16
#undef M16_WK
#undef M16_WV
#undef M16_TR4
#undef M16_WV4
#undef M16_WV0
#undef M16_PM
#undef SEG_END_M
#undef SEG_END_V
}
__device__ __forceinline__ void mla_attn_phase16(LAS unsigned char* lds, const bf16* QH, const bf16* KV, const bf16* KPE, const float* cosT, const float* sinT, bf16* O) {
  const int G = gridDim.x, bx = blockIdx.x;
  const int nu = (G == 256) ? (bx < 32 ? 5 : 4) : (1056 - bx + G - 1) / G;
  for (int i = 0; i < nu; ++i) {
    int bh, q0; bool latq;
    if (G == 256) { if (i < 4) { bh = i * 8 + (bx & 7); q0 = (bh >> 4) * 8192 + (bx >> 3) * 256; latq = true; } else { bh = bx; q0 = MLAT + (bh >> 4) * 256; latq = false; } }
    else { const int u = bx + i * G; if (u < 1024) { bh = u >> 5; q0 = (bh >> 4) * 8192 + (u & 31) * 256; latq = true; } else { bh = u - 1024; q0 = MLAT + (bh >> 4) * 256; latq = false; } }
    mla_unit16(lds, QH, KV, KPE, cosT, sinT, O, q0, latq, bh >> 4, bh & 15);
  }
}
}

namespace ml {
using fa::f32x16; using fa::s16x4; using fa::crow; using fa::cvtpk;
typedef float f32x4m __attribute__((ext_vector_type(4)));
constexpr int TQ = 17408, ROWB = 272, SPS = 144;
constexpr int OFF_Q = 0, OFF_K = 2 * TQ, OFF_V = 4 * TQ, OFF_KW = OFF_V + 32768, OFF_SP = OFF_KW + 16384, OFF_QN = OFF_SP + 64 * SPS, OFF_N32 = OFF_QN + 256, OFF_NB = OFF_N32 + 512, OFF_WV = OFF_NB + 256, ML_LDS_END = OFF_WV + 8 * 1280;
#define ML_DMA(gp, lp) __builtin_amdgcn_global_load_lds((const unsigned*)(gp), (LAS unsigned*)(lp), 16, 0, 0)
#define ML_TR(dst, vb, OFF) asm volatile("ds_read_b64_tr_b16 %0, %1 offset:%2" : "=&v"(dst) : "v"(vb), "i"(OFF) : "memory")
#define ML_PK(L, H) (bf16x8){L[0], L[1], L[2], L[3], H[0], H[1], H[2], H[3]}
__device__ __forceinline__ int chunk_base(int n, int dir, int b) { return dir == 0 ? (n < 4 ? MLAT + b * 256 + 64 * n : b * 8192 + 64 * (n - 4)) : (n < 4 ? MLAT + b * 256 + 64 * (3 - n) : b * 8192 + 64 * (131 - n)); }
template <int CTRL, int RM> __device__ __forceinline__ float dppf(float old, float src) { return __int_as_float(__builtin_amdgcn_update_dpp(__float_as_int(old), __float_as_int(src), CTRL, RM, 0xf, false)); }
__device__ __forceinline__ float scan_add(float v) {
  v += dppf<0x111, 0xf>(0.f, v); v += dppf<0x112, 0xf>(0.f, v); v += dppf<0x114, 0xf>(0.f, v); v += dppf<0x118, 0xf>(0.f, v);
  v += dppf<0x142, 0xa>(0.f, v); v += dppf<0x143, 0xc>(0.f, v); return v; }
__device__ __forceinline__ float scan_max(float v) {
  const float NI = -INFINITY;
  v = fmaxf(v, dppf<0x111, 0xf>(NI, v)); v = fmaxf(v, dppf<0x112, 0xf>(NI, v)); v = fmaxf(v, dppf<0x114, 0xf>(NI, v)); v = fmaxf(v, dppf<0x118, 0xf>(NI, v));
  v = fmaxf(v, dppf<0x142, 0xa>(NI, v)); v = fmaxf(v, dppf<0x143, 0xc>(NI, v)); return v; }

constexpr int NGRP = 8;
__host__ __device__ constexpr int grp_start(int g) { return g <= 4 ? 17 * g : 68 + 16 * (g - 4); }
constexpr int OFF_TAB = ML_LDS_END;
template <int MODE> __device__ __forceinline__ void scan_chain(LAS unsigned char* lds, const bf16* __restrict__ QK, const bf16* __restrict__ Z, const float* __restrict__ G, bf16* __restrict__ H, float* __restrict__ Ub, float* __restrict__ Nb, const int chain, const int grp) {
  const int dir = chain & 1, hd = (chain >> 1) & 7, b = chain >> 4; const int n0 = grp_start(grp), n1 = grp_start(grp + 1);
  int tid_ = threadIdx.x; asm volatile("" : "+v"(tid_)); const int tid = tid_, wid = __builtin_amdgcn_readfirstlane(tid >> 6), lane_ = tid & 63;
  LAS char* Lc = (LAS char*)lds;
  LAS float* QN = (LAS float*)(lds + OFF_QN); LAS float* N32 = (LAS float*)(lds + OFF_N32); LAS bf16* NB = (LAS bf16*)(lds + OFF_NB);
  const int lane = lane_;
  unsigned offQ[2], offQx, offV[4];
#pragma unroll
  for (int i = 0; i < 2; ++i) { const int Lb = (2 * wid + i) * 1024 + 16 * lane, row = Lb / ROWB, cB = Lb % ROWB, colB = cB < 256 ? cB : 0; const int srow = dir ? 63 - row : row; offQ[i] = (unsigned)((srow * 2048 + hd * 128) * 2 + colB); }
  { const int Lb = 16 * 1024 + 16 * lane, row = Lb / ROWB, cB = Lb % ROWB, colB = cB < 256 ? cB : 0; const int srow = dir ? 63 - row : row; offQx = (unsigned)((srow * 2048 + hd * 128) * 2 + colB); }
#pragma unroll
  for (int p = 0; p < 4; ++p) { const int Lb = p * 1024 + 16 * lane, sub = Lb >> 9, w_ = Lb & 511, kk = sub * 8 + (w_ >> 6), c = (w_ & 63) >> 1, k = (kk & ~0xC) | ((kk & 4) << 1) | ((kk & 8) >> 1); const int srow = dir ? 63 - k : k;
    offV[p] = (unsigned)((srow * 6400 + 2048 + hd * 256 + 32 * wid + c) * 2); }
  const int grow_off = dir ? 63 - lane : lane;
#define DMA_Q(n, slot) do { const char* g_ = (const char*)(QK + (size_t)chunk_base((n), dir, b) * 2048); LAS char* d_ = Lc + OFF_Q + (slot) * TQ; \
    ML_DMA(g_ + offQ[0], d_ + (2 * wid) * 1024); ML_DMA(g_ + offQ[1], d_ + (2 * wid + 1) * 1024); if (wid == 0) ML_DMA(g_ + offQx, d_ + 16 * 1024); } while (0)
#define DMA_K(n, slot) do { const char* g_ = (const char*)(QK + (size_t)chunk_base((n), dir, b) * 2048 + 1024); LAS char* d_ = Lc + OFF_K + (slot) * TQ; \
    ML_DMA(g_ + offQ[0], d_ + (2 * wid) * 1024); ML_DMA(g_ + offQ[1], d_ + (2 * wid + 1) * 1024); if (wid == 0) ML_DMA(g_ + offQx, d_ + 16 * 1024); } while (0)
#define DMA_VS(n) do { const char* g_ = (const char*)(Z + (size_t)chunk_base((n), dir, b) * 6400); LAS char* d_ = Lc + OFF_V + wid * 4096; \
    ML_DMA(g_ + offV[0], d_); ML_DMA(g_ + offV[1], d_ + 1024); ML_DMA(g_ + offV[2], d_ + 2048); ML_DMA(g_ + offV[3], d_ + 3072); } while (0)
#define LOAD_G(n, li_, lf_) do { const float* g_ = G + (size_t)(chunk_base((n), dir, b) + grow_off) * 32 + dir * 16 + hd; li_ = g_[0]; lf_ = g_[8]; } while (0)
#define BAR_LDS() do { asm volatile("s_waitcnt lgkmcnt(0)" ::: "memory"); __builtin_amdgcn_s_barrier(); asm volatile("" ::: "memory"); } while (0)
  LAS float* TB = (LAS float*)(lds + OFF_TAB); LAS float* TP = TB + 132; LAS float* TM = TB + 264; LAS float* TC = TB + 397;
  { float gl_[17], gf_[17];
#pragma unroll
    for (int i = 0; i < 17; ++i) { const int c = wid + 8 * i; gl_[i] = 0.f; gf_[i] = 0.f; if (c < 132) LOAD_G(c, gl_[i], gf_[i]); }
#pragma unroll
    for (int i = 0; i < 17; ++i) { const int c = wid + 8 * i; const float cb_ = scan_add(gf_[i]), pm_ = scan_max(gl_[i] - cb_); if (c < 132 && lane == 63) { TB[c] = cb_; TP[c] = pm_; } } }
  __syncthreads();
  if (tid == 0) { float m_ = 0.f, bc_ = 0.f;
#pragma unroll 12
    for (int c = 0; c < 132; ++c) { const float tb_ = TB[c], tp_ = TP[c]; TM[c] = m_; TC[c] = bc_; m_ = tb_ + fmaxf(m_, tp_); bc_ += tb_; }
    TM[132] = m_; TC[132] = bc_; }
  __syncthreads();
  if (MODE == 1) { DMA_Q(n0, 0); DMA_Q(n0 + 1, 1); }
  DMA_K(n0, 0); DMA_K(n0 + 1, 1); DMA_VS(n0);
  float li, lf; LOAD_G(n0, li, lf);
  f32x16 C[4];
#pragma unroll
  for (int i = 0; i < 4; ++i) C[i] = f32x16{};
  float nacc = 0.f;
  if (MODE == 1) {
#pragma unroll 1
    for (int j = 0; j < grp; ++j) { const int s1 = grp_start(j + 1); const float w = __expf(TC[n0] - TC[s1] + TM[s1] - TM[n0]);
      const float* up = Ub + ((size_t)(chain * NGRP + j) * 8 + wid) * 4096 + lane;
#pragma unroll
      for (int q = 0; q < 4; ++q) {
#pragma unroll
        for (int r = 0; r < 16; ++r) C[q][r] += w * up[(q * 16 + r) * 64];
        __builtin_amdgcn_sched_barrier(0); }
      if (tid < 128) nacc += w * Nb[(size_t)(chain * NGRP + j) * 128 + tid]; }
  }
  if (tid < 128) { N32[tid] = nacc; NB[tid] = (bf16)(cvtpk(nacc, 0.f) & 0xffffu); }
  float m_prev = TM[n0];
  asm volatile("s_waitcnt vmcnt(0)" ::: "memory"); BAR_LDS();
  float cumb = scan_add(lf), av = li - cumb, pm = scan_max(av);
  unsigned hp[16];
#pragma unroll
  for (int i = 0; i < 16; ++i) hp[i] = 0u;
  for (int n = n0; n < n1; ++n) {
    const int slot = (n - n0) & 1;
    const LAS char* Qs = Lc + OFF_Q + slot * TQ; const LAS char* Ks = Lc + OFF_K + slot * TQ;
    const float mx = fmaxf(m_prev, pm), wint = __expf(m_prev - mx), m_t = cumb + mx;
    const float mx63 = __int_as_float(__builtin_amdgcn_readlane(__float_as_int(mx), 63)), b_end = __int_as_float(__builtin_amdgcn_readlane(__float_as_int(cumb), 63)), m_new = b_end + mx63, decay = __expf(m_prev - mx63);
    { LAS float* WVt = (LAS float*)(lds + OFF_WV + wid * 1280); WVt[128 + lane] = -mx; WVt[192 + lane] = av; WVt[256 + lane] = __expf(av - mx63); }
    if (MODE == 1 && n > n0) {
      int lo_ = lane_; asm volatile("" : "+v"(lo_)); const int cbr = chunk_base(n - 1, dir, b); const int hi_ = lo_ >> 5;
      const unsigned loff = (unsigned)(2 * (lo_ & 31) + (dir ? 1 - hi_ : hi_) * 4 * 4096); char* const Hb = (char*)(H + hd * 256 + 32 * wid);
#pragma unroll
      for (int k = 0; k < 16; ++k) { const int i0 = 2 * (k & 7), tk = 32 * (k >> 3) + (i0 & 3) + 8 * (i0 >> 2); char* const r0 = Hb + (size_t)(cbr + (dir ? 63 - tk - 4 : tk)) * 4096; char* const r1 = dir ? r0 - 4096 : r0 + 4096;
        *(bf16*)(r0 + loff) = (bf16)(hp[k] & 0xffffu); *(bf16*)(r1 + loff) = (bf16)(hp[k] >> 16); }
    }
    __builtin_amdgcn_sched_barrier(0);
    {
      int lane = lane_; asm volatile("" : "+v"(lane));
      const int l15 = lane & 15, kg = lane >> 4;
      if (MODE == 1) {
      const int tb = wid >> 1;
      bf16x8 qa[4];
#pragma unroll
      for (int ks = 0; ks < 4; ++ks) qa[ks] = *(const LAS bf16x8*)(Qs + (16 * tb + l15) * ROWB + kg * 16 + ks * 64);
#pragma unroll
      for (int e = 0; e < 2; ++e) { const int sb = 2 * (wid & 1) + e; f32x4m acc = {0.f, 0.f, 0.f, 0.f};
        if (sb <= tb) {
#pragma unroll
          for (int ks = 0; ks < 4; ++ks) { const bf16x8 kb = *(const LAS bf16x8*)(Ks + (16 * sb + l15) * ROWB + kg * 16 + ks * 64); acc = __builtin_amdgcn_mfma_f32_16x16x32_bf16(qa[ks], kb, acc, 0, 0, 0); }
        }
        const int s = 16 * sb + l15; const LAS float* WVt = (const LAS float*)(lds + OFF_WV + wid * 1280); const float a_s = WVt[192 + s]; const f32x4m e1v = *(const LAS f32x4m*)(WVt + 128 + 16 * tb + 4 * kg);
#pragma unroll
        for (int i = 0; i < 4; ++i) { const int t = 16 * tb + 4 * kg + i; const float v = (s <= t) ? acc[i] * __expf(e1v[i] + a_s) : 0.f;
          *(LAS bf16*)(Lc + OFF_SP + t * SPS + s * 2) = (bf16)(cvtpk(v, 0.f) & 0xffffu); } }
      if (wid < 4) {
        f32x4m acc = {0.f, 0.f, 0.f, 0.f};
#pragma unroll
        for (int ks = 0; ks < 4; ++ks) { const bf16x8 qq = *(const LAS bf16x8*)(Qs + (16 * wid + l15) * ROWB + kg * 16 + ks * 64); const bf16x8 nn = *(const LAS bf16x8*)((const LAS char*)NB + kg * 16 + ks * 64);
          acc = __builtin_amdgcn_mfma_f32_16x16x32_bf16(qq, nn, acc, 0, 0, 0); }
        if (l15 == 0) { *(LAS f32x4m*)(QN + 16 * wid + 4 * kg) = acc; }
      }
      }
      {
        const int s = wid * 8 + (lane >> 3), part = lane & 7; const float es = ((const LAS float*)(lds + OFF_WV + wid * 1280))[256 + s];
        const v4u w0 = *(const LAS v4u*)(Ks + s * ROWB + part * 32), w1 = *(const LAS v4u*)(Ks + s * ROWB + part * 32 + 16);
        float f[16]; unpack8(w0, f); unpack8(w1, f + 8);
        v4u o0 = {cvtpk(f[0] * es, f[1] * es), cvtpk(f[2] * es, f[3] * es), cvtpk(f[4] * es, f[5] * es), cvtpk(f[6] * es, f[7] * es)};
        v4u o1 = {cvtpk(f[8] * es, f[9] * es), cvtpk(f[10] * es, f[11] * es), cvtpk(f[12] * es, f[13] * es), cvtpk(f[14] * es, f[15] * es)};
        *(LAS v4u*)(Lc + OFF_KW + fa::v_st(s, part * 16)) = o0; *(LAS v4u*)(Lc + OFF_KW + fa::v_st(s, part * 16 + 8)) = o1;
      }
    }
    BAR_LDS();
    int lane = lane_; asm volatile("" : "+v"(lane));
    const int r32 = lane & 31, hi = lane >> 5;
    const int vbV = (int)(unsigned)(uintptr_t)(Lc + OFF_V + wid * 4096) + fa::v_rd_base(lane);
    const int vbK = (int)(unsigned)(uintptr_t)(Lc + OFF_KW) + fa::v_rd_base(lane);
    LAS float* WV = (LAS float*)(lds + OFF_WV + wid * 1280);
    s16x4 vl0, vh0, vl1, vh1, vl2, vh2, vl3, vh3;
    ML_TR(vl0, vbV, 0); ML_TR(vh0, vbV, 512); ML_TR(vl1, vbV, 1024); ML_TR(vh1, vbV, 1536); ML_TR(vl2, vbV, 2048); ML_TR(vh2, vbV, 2560); ML_TR(vl3, vbV, 3072); ML_TR(vh3, vbV, 3584);
    asm volatile("s_waitcnt lgkmcnt(0)" ::: "memory"); __builtin_amdgcn_sched_barrier(0);
    const bf16x8 vf0 = ML_PK(vl0, vh0), vf1 = ML_PK(vl1, vh1), vf2 = ML_PK(vl2, vh2), vf3 = ML_PK(vl3, vh3);
    float li_n = 0.f, lf_n = 0.f;
    if (n + 1 < n1) { DMA_VS(n + 1); LOAD_G(n + 1, li_n, lf_n); }
    if (n + 2 < n1) DMA_K(n + 2, slot);
    if (MODE == 1) {
    {
      float rs = 0.f;
#pragma unroll
      for (int j = 0; j < 8; ++j) { float f[8]; unpack8(*(const LAS v4u*)(Lc + OFF_SP + lane * SPS + 16 * j), f);
#pragma unroll
        for (int i = 0; i < 8; ++i) rs += f[i]; }
      const float den = wint * QN[lane] + rs; const float rinv = 1.f / fmaxf(fabsf(den), __expf(-m_t));
      WV[lane] = wint; WV[64 + lane] = rinv;
    }
    __builtin_amdgcn_sched_barrier(0);
    f32x16 aI0 = f32x16{}, aI1 = f32x16{};
#pragma unroll
    for (int dkb = 0; dkb < 4; ++dkb) {
#pragma unroll
      for (int jj = 0; jj < 2; ++jj) {
        const v4u cw = {cvtpk(C[dkb][8 * jj + 0], C[dkb][8 * jj + 1]), cvtpk(C[dkb][8 * jj + 2], C[dkb][8 * jj + 3]), cvtpk(C[dkb][8 * jj + 4], C[dkb][8 * jj + 5]), cvtpk(C[dkb][8 * jj + 6], C[dkb][8 * jj + 7])};
        const bf16x8 cb = __builtin_bit_cast(bf16x8, cw);
        const LAS char* qp = Qs + r32 * ROWB + (32 * dkb + 16 * jj + 4 * hi) * 2;
        typedef unsigned u32x2m __attribute__((ext_vector_type(2)));
        const u32x2m a0 = *(const LAS u32x2m*)(qp), a1 = *(const LAS u32x2m*)(qp + 16), b0 = *(const LAS u32x2m*)(qp + 32 * ROWB), b1 = *(const LAS u32x2m*)(qp + 32 * ROWB + 16);
        const v4u qa0 = {a0.x, a0.y, a1.x, a1.y}, qa1 = {b0.x, b0.y, b1.x, b1.y};
        aI0 = __builtin_amdgcn_mfma_f32_32x32x16_bf16(__builtin_bit_cast(bf16x8, qa0), cb, aI0, 0, 0, 0);
        aI1 = __builtin_amdgcn_mfma_f32_32x32x16_bf16(__builtin_bit_cast(bf16x8, qa1), cb, aI1, 0, 0, 0);
      }
      __builtin_amdgcn_sched_barrier(0);
    }
#pragma unroll
    for (int g = 0; g < 4; ++g) { const f32x4m w0 = *(const LAS f32x4m*)(WV + 8 * g + 4 * hi), w1 = *(const LAS f32x4m*)(WV + 32 + 8 * g + 4 * hi);
#pragma unroll
      for (int i = 0; i < 4; ++i) { aI0[4 * g + i] *= w0[i]; aI1[4 * g + i] *= w1[i]; } }
    {
      const LAS char* sp = Lc + OFF_SP + r32 * SPS + hi * 16;
#define ML_INTRA(ks, vf) do { const bf16x8 s0 = *(const LAS bf16x8*)(sp + (ks) * 32), s1 = *(const LAS bf16x8*)(sp + 32 * SPS + (ks) * 32); \
      aI0 = __builtin_amdgcn_mfma_f32_32x32x16_bf16(s0, vf, aI0, 0, 0, 0); aI1 = __builtin_amdgcn_mfma_f32_32x32x16_bf16(s1, vf, aI1, 0, 0, 0); } while (0)
      ML_INTRA(0, vf0); ML_INTRA(1, vf1); ML_INTRA(2, vf2); ML_INTRA(3, vf3);
#undef ML_INTRA
    }
    __builtin_amdgcn_sched_barrier(0);
    {
#pragma unroll
      for (int tb = 0; tb < 2; ++tb)
#pragma unroll
        for (int g = 0; g < 4; ++g) { const int t0 = 32 * tb + 8 * g + 4 * hi; const f32x4m rv = *(const LAS f32x4m*)(WV + 64 + t0);
          const float h0 = (tb ? aI1[4 * g + 0] : aI0[4 * g + 0]) * rv[0], h1 = (tb ? aI1[4 * g + 1] : aI0[4 * g + 1]) * rv[1], h2 = (tb ? aI1[4 * g + 2] : aI0[4 * g + 2]) * rv[2], h3 = (tb ? aI1[4 * g + 3] : aI0[4 * g + 3]) * rv[3];
          hp[8 * tb + 2 * g] = cvtpk(h0, h1); hp[8 * tb + 2 * g + 1] = cvtpk(h2, h3); }
    }
    __builtin_amdgcn_sched_barrier(0);
    __builtin_amdgcn_sched_barrier(0);
    __builtin_amdgcn_sched_barrier(0);
    }
    {
      int tid_o = tid; asm volatile("" : "+v"(tid_o)); const int d = tid_o >> 2, q4 = tid_o & 3; float a = 0.f;
#pragma unroll
      for (int j = 0; j < 16; ++j) a += bf1(*(const LAS bf16*)(Lc + OFF_KW + fa::v_st(16 * q4 + j, d)));
      a += __shfl_xor(a, 1); a += __shfl_xor(a, 2);
      if (q4 == 0) { const float nn = decay * N32[d] + a; N32[d] = nn; NB[d] = (bf16)(cvtpk(nn, 0.f) & 0xffffu); }
    }
    __builtin_amdgcn_sched_barrier(0);
#pragma unroll
    for (int dkb = 0; dkb < 4; ++dkb) {
#pragma unroll
      for (int r = 0; r < 16; ++r) { float c_ = C[dkb][r]; asm("v_mul_f32 %0, %1, %2" : "=v"(c_) : "v"(c_), "v"(decay)); C[dkb][r] = c_; }
    }
#define ML_U(DKB) do { s16x4 kl0, kh0, kl1, kh1, kl2, kh2, kl3, kh3; \
      ML_TR(kl0, vbK, fa::v_rd_off(DKB, 0, 0)); ML_TR(kh0, vbK, fa::v_rd_off(DKB, 0, 1)); ML_TR(kl1, vbK, fa::v_rd_off(DKB, 1, 0)); ML_TR(kh1, vbK, fa::v_rd_off(DKB, 1, 1)); \
      ML_TR(kl2, vbK, fa::v_rd_off(DKB, 2, 0)); ML_TR(kh2, vbK, fa::v_rd_off(DKB, 2, 1)); ML_TR(kl3, vbK, fa::v_rd_off(DKB, 3, 0)); ML_TR(kh3, vbK, fa::v_rd_off(DKB, 3, 1)); \
      asm volatile("s_waitcnt lgkmcnt(0)" ::: "memory"); __builtin_amdgcn_sched_barrier(0); \
      C[DKB] = __builtin_amdgcn_mfma_f32_32x32x16_bf16(ML_PK(kl0, kh0), vf0, C[DKB], 0, 0, 0); C[DKB] = __builtin_amdgcn_mfma_f32_32x32x16_bf16(ML_PK(kl1, kh1), vf1, C[DKB], 0, 0, 0); \
      C[DKB] = __builtin_amdgcn_mfma_f32_32x32x16_bf16(ML_PK(kl2, kh2), vf2, C[DKB], 0, 0, 0); C[DKB] = __builtin_amdgcn_mfma_f32_32x32x16_bf16(ML_PK(kl3, kh3), vf3, C[DKB], 0, 0, 0); } while (0)
    ML_U(0); ML_U(1); ML_U(2); ML_U(3);
#undef ML_U
    m_prev = m_new;
    if (n + 1 < n1) { cumb = scan_add(lf_n); av = li_n - cumb; pm = scan_max(av); }
    asm volatile("s_waitcnt vmcnt(0)" ::: "memory"); BAR_LDS();
    if (MODE == 1 && n + 2 < n1) DMA_Q(n + 2, slot);
  }
  if (MODE == 1) { int lo_ = lane_; asm volatile("" : "+v"(lo_)); const int cbr = chunk_base(n1 - 1, dir, b); const int hi_ = lo_ >> 5;
    const unsigned loff = (unsigned)(2 * (lo_ & 31) + (dir ? 1 - hi_ : hi_) * 4 * 4096); char* const Hb = (char*)(H + hd * 256 + 32 * wid);
#pragma unroll
    for (int k = 0; k < 16; ++k) { const int i0 = 2 * (k & 7), tk = 32 * (k >> 3) + (i0 & 3) + 8 * (i0 >> 2); char* const r0 = Hb + (size_t)(cbr + (dir ? 63 - tk - 4 : tk)) * 4096; char* const r1 = dir ? r0 - 4096 : r0 + 4096;
      *(bf16*)(r0 + loff) = (bf16)(hp[k] & 0xffffu); *(bf16*)(r1 + loff) = (bf16)(hp[k] >> 16); } }
  if (MODE == 0) {
    float* up = Ub + ((size_t)(chain * NGRP + grp) * 8 + wid) * 4096 + lane;
#pragma unroll
    for (int q = 0; q < 4; ++q)
#pragma unroll
      for (int r = 0; r < 16; ++r) up[(q * 16 + r) * 64] = C[q][r];
    if (tid < 128) Nb[(size_t)(chain * NGRP + grp) * 128 + tid] = N32[tid];
  }
  asm volatile("s_waitcnt vmcnt(0)" ::: "memory"); __syncthreads();
#undef DMA_Q
#undef DMA_K
#undef DMA_VS
#undef LOAD_G
#undef BAR_LDS
}
__device__ __forceinline__ void scan_phase_a(LAS unsigned char* lds, const bf16* QK, const bf16* Z, const float* G, float* Ub, float* Nb) {
  for (int u = blockIdx.x; u < 32 * (NGRP - 1); u += gridDim.x) { const int chain = u / (NGRP - 1), grp = u % (NGRP - 1); scan_chain<0>(lds, QK, Z, G, nullptr, Ub, Nb, chain, grp); }
}
__device__ __forceinline__ void scan_phase_b(LAS unsigned char* lds, const bf16* QK, const bf16* Z, const float* G, bf16* HF, bf16* HB, float* Ub, float* Nb) {
  for (int u = blockIdx.x; u < 32 * NGRP; u += gridDim.x) { const int chain = u / NGRP, grp = u % NGRP; scan_chain<1>(lds, QK, Z, G, (chain & 1) ? HB : HF, Ub, Nb, chain, grp); }
}
}

#define TRD_BEGIN(tab_) int nm_ = 0, base_ = 0; LAS TrDesc* const tb_ = (tab_); for (int i_ = 0; i_ < TR_NMAT; ++i_) tb_[i_].base = 0x7fffffff
#define TRD(W_, K_, N_, NP_, WT_) do { tb_[nm_].W = (W_); tb_[nm_].WT = (WT_); tb_[nm_].K = (K_); tb_[nm_].N = (N_); tb_[nm_].Npad = (NP_); tb_[nm_].base = base_; base_ += ((K_) / 64) * ((NP_) / 256); ++nm_; } while (0)
#define TRD_END() (((LAS int*)(X.lds + TR_LDS_OFF + TR_NMAT * 32))[0] = base_)
#define TRD_TOTAL() (((const LAS int*)(X.lds + TR_LDS_OFF + TR_NMAT * 32))[0])
struct Args { const float* in[23]; float* out; unsigned char* ws; int ph_lo, ph_hi; };
constexpr int PH_LAYER0 = 3, PH_PER_LAYER = 10, NPHASES = PH_LAYER0 + DEPTH * PH_PER_LAYER;
__host__ __device__ constexpr bool phase_active(int p) { return p < PH_LAYER0 ? true : ((((p - PH_LAYER0) / PH_PER_LAYER) % 3 == 0) ? !(((p - PH_LAYER0) % PH_PER_LAYER) >= 2 && ((p - PH_LAYER0) % PH_PER_LAYER) <= 4) : ((((p - PH_LAYER0) / PH_PER_LAYER) % 3 == 1) ? ((p - PH_LAYER0) % PH_PER_LAYER) != 4 : true)); }

#define IN(k) (lo <= (k) && (k) < hi)
#define SEAM(k) do { if (single && (k) + 1 < hi) xcd_barrier(bar); } while (0)
template <int L> __device__ __forceinline__ void run_layer(const Ctx& X, const Args& args, const XcdBarrier& bar, const int lo, const int hi, const bool single) {
    unsigned char* ws = args.ws; const int G = gridDim.x;
    const float* norm_g = args.in[6];
    float* mod = (float*)(ws + WS_MOD); float* cosT = (float*)(ws + WS_ROPE); float* sinT = cosT + 2048;
    hfp* h = (hfp*)(ws + WS_H); bf16* a = (bf16*)(ws + WS_A); bf16* y = (bf16*)(ws + WS_Y); bf16* o = (bf16*)(ws + WS_O); unsigned char* big = ws + WS_BIG;
        constexpr int kind = L % 3, jj = L / 3, pb = PH_LAYER0 + L * PH_PER_LAYER;
        const bf16* wo_t;
        if constexpr (kind == 0) {
            bf16* QKV = (bf16*)(big + BIG_QKV); wo_t = (const bf16*)(ws + WS_NAWO) + (size_t)jj * D * D;
            if (IN(pb + 0)) { pg8::Gemm g{a, (const bf16*)(ws + WS_NAQKV) + (size_t)jj * D * 6144, M, 6144, D}; pg8::StaticOrder S; S.init(M, 6144, G, (int)blockIdx.x, WGM_IN); pg8::EpiBf16<0> E{QKV, 6144};
                REPEAT_REP_IN(pg8::gemm_phase<pg8::EpiBf16<0>, pg8::StaticOrder, true, true>(X.lds, g, S, E);)
                if (L == 0) { if (G == 256 && (int)blockIdx.x >= 48) { LAS TrDesc* tab = (LAS TrDesc*)(X.lds + TR_LDS_OFF); if (X.tid == 0) { TRD_BEGIN(tab); TRD(args.in[12], D, 1088, 1280, (bf16*)(ws + WS_MLAIN)); TRD(args.in[15], 512, 3072, 3072, (bf16*)(ws + WS_MLAUQ)); TRD(args.in[16], 512, 4096, 4096, (bf16*)(ws + WS_MLAUKV)); TRD(args.in[17], D, D, D, (bf16*)(ws + WS_MLAWO)); TRD_END(); } __syncthreads(); tr_all(X, tab, TRD_TOTAL(), (int)blockIdx.x - 48, 256 - 48); } } SEAM(pb + 0); }
            if (IN(pb + 1)) { REPEAT_REP_NA(fa::na_attn_phase(X.lds, QKV, args.in[10] + (size_t)jj * 16 * 15 * 31, o, L < DEPTH - 1);) SEAM(pb + 1); }
        } else if constexpr (kind == 1) {
            bf16* Z = (bf16*)(big + BIG_MZ); bf16* QH = (bf16*)(big + BIG_QH); bf16* KV = (bf16*)(big + BIG_KV); bf16* CQN = (bf16*)(big + BIG_CQN); bf16* CKVN = (bf16*)(big + BIG_CKVN); bf16* KPE = (bf16*)(big + BIG_KPE);
            wo_t = (const bf16*)(ws + WS_MLAWO);
            if (IN(pb + 0)) { pg8::Gemm g{a, (const bf16*)(ws + WS_MLAIN), M, 1280, D}; pg8::StaticOrder S; S.init(M, 1280, G, (int)blockIdx.x, WGM_IN); pg8::EpiBf16<0> E{Z, 1280};
                REPEAT_REP_IN(pg8::gemm_phase<pg8::EpiBf16<0>, pg8::StaticOrder, true, true>(X.lds, g, S, E);)
                if (G == 256 && (int)blockIdx.x >= 74) { LAS TrDesc* tab = (LAS TrDesc*)(X.lds + TR_LDS_OFF); if (X.tid == 0) { TRD_BEGIN(tab); TRD(args.in[18], D, 6176, 6400, (bf16*)(ws + WS_MLIN)); TRD(args.in[22], D, D, D, (bf16*)(ws + WS_MLWO)); TRD_END(); } __syncthreads(); tr_all(X, tab, TRD_TOTAL(), (int)blockIdx.x - 74, 256 - 74); } SEAM(pb + 0); }
            if (IN(pb + 1)) { mla_rows(X, Z, args.in[13], args.in[14], cosT, sinT, CQN, CKVN, KPE); SEAM(pb + 1); }
            if (IN(pb + 2)) {
                { pg8::Gemm g{CQN, (const bf16*)(ws + WS_MLAUQ), M, 3072, 512}; pg8::StaticOrder S; S.init(M, 3072, G, (int)blockIdx.x, WGM_UQ); pg8::EpiBf16<0> E{QH, 3072};
                  pg8::gemm_phase<pg8::EpiBf16<0>, pg8::StaticOrder, true, true>(X.lds, g, S, E); }
                { pg8::Gemm g{CKVN, (const bf16*)(ws + WS_MLAUKV), M, 4096, 512}; pg8::StaticOrder S; S.init(M, 4096, G, (int)blockIdx.x, WGM_UQ); pg8::EpiBf16<0> E{KV, 4096};
                  pg8::gemm_phase<pg8::EpiBf16<0>, pg8::StaticOrder, true, true>(X.lds, g, S, E); }
                SEAM(pb + 2); }
            if (IN(pb + 3)) { m16::mla_attn_phase16(X.lds, QH, KV, KPE, cosT, sinT, o); SEAM(pb + 3); }
        } else {
            bf16* Z = (bf16*)(big + BIG_LZ); bf16* QK = (bf16*)(big + BIG_LQK); float* GT = (float*)(big + BIG_LG);
            wo_t = (const bf16*)(ws + WS_MLWO);
            if (IN(pb + 0)) { pg8::Gemm g{a, (const bf16*)(ws + WS_MLIN), M, 6400, D}; pg8::StaticOrder S; S.init(M, 6400, G, (int)blockIdx.x, WGM_IN); pg8::EpiBf16<0> E{Z, 6400};
                REPEAT_REP_IN(pg8::gemm_phase<pg8::EpiBf16<0>, pg8::StaticOrder, true, true>(X.lds, g, S, E);)
                if (G == 256 && (int)blockIdx.x >= 114) { LAS TrDesc* tab = (LAS TrDesc*)(X.lds + TR_LDS_OFF); if (X.tid == 0) { TRD_BEGIN(tab); TRD(args.in[9] + (size_t)D * 6144, D, 6144, 6144, (bf16*)(ws + WS_NAQKV) + (size_t)D * 6144); TRD(args.in[11] + (size_t)D * D, D, D, D, (bf16*)(ws + WS_NAWO) + (size_t)D * D); TRD_END(); } __syncthreads(); tr_all(X, tab, TRD_TOTAL(), (int)blockIdx.x - 114, 256 - 114); } SEAM(pb + 0); }
            if (IN(pb + 1)) { ml_rows(X, Z, args.in[20], args.in[19], QK, GT); SEAM(pb + 1); }
            float* Ub = (float*)(ws + WS_SLAB); float* Nb = Ub + (size_t)32 * ml::NGRP * 8 * 4096;
            if (IN(pb + 2)) { ml::scan_phase_a(X.lds, QK, Z, GT, Ub, Nb); SEAM(pb + 2); }
            if (IN(pb + 3)) { ml::scan_phase_b(X.lds, QK, Z, GT, y, a, Ub, Nb); SEAM(pb + 3); }
            if (IN(pb + 4)) { ml_gate_rows(X, Z, y, a, args.in[21], o); SEAM(pb + 4); }
        }
        constexpr bool LASTL = (L == DEPTH - 1); float* slab = (float*)(ws + WS_SLAB);
        if (IN(pb + 5)) { { pg8::Gemm g{o, wo_t, MLAT, D, D}; pg8::StaticOrder S; S.init(MLAT, D, G, (int)blockIdx.x, WGM_WO); pg8::EpiBf16<0> E{y, D};
            REPEAT_REP_WO(pg8::gemm_phase<pg8::EpiBf16<0>, pg8::StaticOrder, true, true>(X.lds, g, S, E);) }
            if (!LASTL) { pg8::Gemm g{o + (size_t)MLAT * D, wo_t, MCTX, D, 256, D}; pg8::SplitKOrder S; S.init(MCTX, D, 8, G, (int)blockIdx.x); pg8::EpiF32Slab E{slab, D, (size_t)MCTX * D};
                pg8::gemm_phase<pg8::EpiF32Slab, pg8::SplitKOrder, true, true>(X.lds, g, S, E); }
            SEAM(pb + 5); }
        if (IN(pb + 6)) { vec_setup(X, mod, norm_g, true, L, 2, 1, true, L, 2, 3, 4); npost<0, false>(X, y, h, a, nullptr, slab, 0, 0, MLAT); if (!LASTL) npost<0, true>(X, y, h, a, nullptr, slab, 8, MLAT, M); __syncthreads(); SEAM(pb + 6); }
        bf16* HID = (bf16*)(big + BIG_HID);
        if (IN(pb + 7)) { constexpr int MR = LASTL ? MLAT : M; pg8::Gemm g{a, (const bf16*)(ws + WS_W1T) + (size_t)L * D * DFF, MR, DFF, D}; pg8::StaticOrder S; S.init(MR, DFF, G, (int)blockIdx.x, WGM_F1); pg8::EpiBf16<2> E{HID, DFF};
            const bool tailwg = !LASTL && G == 256 && blockIdx.x >= 64; const int r_ = (int)blockIdx.x - 64; const int npre = tailwg ? 2 * (((int)blockIdx.x & 7) >> 1) : 0; const bool pre = npre > 0;
            LAS TrDesc* tab = (LAS TrDesc*)(X.lds + TR_LDS_OFF);
            if (tailwg) {
                if (X.tid == 0) { for (int i = 0; i < TR_NMAT; ++i) tab[i].base = 0x7fffffff;
                    tab[0].W = args.in[7] + (size_t)(L + 1) * D * DFF; tab[0].WT = (bf16*)(ws + WS_W1T) + (size_t)(L + 1) * D * DFF; tab[0].K = D; tab[0].N = DFF; tab[0].Npad = DFF; tab[0].base = 0;
                    tab[1].W = args.in[8] + (size_t)(L + 1) * D * DFF; tab[1].WT = (bf16*)(ws + WS_W2T) + (size_t)(L + 1) * D * DFF; tab[1].K = DFF; tab[1].N = D; tab[1].Npad = D; tab[1].base = 1024; }
                __syncthreads();
                if (pre) tr_all(X, tab, min(2048, r_ + 192 * npre), r_, 192); }
            REPEAT_REP_FFN1(pg8::gemm_phase<pg8::EpiBf16<2>, pg8::StaticOrder, true, true>(X.lds, g, S, E);)
            if (tailwg) tr_all(X, tab, 2048, r_ + 192 * npre, 192);
            SEAM(pb + 7); }
        if (IN(pb + 8)) { { pg8::Gemm g{HID, (const bf16*)(ws + WS_W2T) + (size_t)L * D * DFF, MLAT, D, DFF}; pg8::StaticOrder S; S.init(MLAT, D, G, (int)blockIdx.x, WGM_F2); pg8::EpiBf16<0> E{y, D};
            REPEAT_REP_FFN2(pg8::gemm_phase<pg8::EpiBf16<0>, pg8::StaticOrder, true, true>(X.lds, g, S, E);) }
            if (!LASTL) { pg8::Gemm g{HID + (size_t)MLAT * DFF, (const bf16*)(ws + WS_W2T) + (size_t)L * D * DFF, MCTX, D, 512, DFF}; pg8::SplitKOrder S; S.init(MCTX, D, 16, G, (int)blockIdx.x); pg8::EpiF32Slab E{slab, D, (size_t)MCTX * D};
                pg8::gemm_phase<pg8::EpiF32Slab, pg8::SplitKOrder, true, true>(X.lds, g, S, E); }
            SEAM(pb + 8); }
        if (IN(pb + 9)) {
            if (L < DEPTH - 1) { vec_setup(X, mod, norm_g, true, L, 5, 3, true, L + 1, 0, 0, 1); npost<0, false>(X, y, h, a, nullptr, slab, 0, 0, MLAT); npost<0, true>(X, y, h, a, nullptr, slab, 16, MLAT, M); }
            else { vec_setup(X, mod, norm_g, true, L, 5, 3, false, 0, 0, 0, 0); npost<1, false>(X, y, h, nullptr, args.out, slab, 0, 0, MLAT); }
            __syncthreads(); SEAM(pb + 9); }
}
__global__ void __launch_bounds__(NTHR, 2) mega_fwd(Args args) {
    extern __shared__ __attribute__((aligned(16))) unsigned char lds_raw[];
    Ctx X; X.lds = (LAS unsigned char*)lds_raw; X.tid = threadIdx.x; X.lane = X.tid & 63; X.wave = __builtin_amdgcn_readfirstlane(X.tid >> 6);
    X.gw = blockIdx.x * NWAVES + X.wave; X.ngw = gridDim.x * NWAVES;
    volatile LAS unsigned* MISC = (volatile LAS unsigned*)(X.lds + MISC_OFF);
    for (int u = X.tid; u < (LDS_BYTES - RING_BYTES) / 4; u += NTHR) ((LAS unsigned*)(X.lds + RING_BYTES))[u] = 0u;
    __syncthreads();
    unsigned char* ws = args.ws;
    const int lo = args.ph_lo, hi = args.ph_hi; const bool single = (hi - lo) > 1;
    XcdBarrier bar; bar.bar = (unsigned*)(ws + WS_CTL) + CW_BAR; bar.x = 0; bar.st = nullptr;
    if (single) bar = xcd_barrier_post((unsigned*)(ws + WS_CTL) + CW_BAR, MISC + 8);
    const float* x = args.in[0]; const float* c = args.in[1]; const float* ctx = args.in[2]; const float* c_ctx = args.in[3]; const float* ada_w = args.in[4]; const float* ada_b = args.in[5]; const float* norm_g = args.in[6];
    float* mod = (float*)(ws + WS_MOD); float* cosT = (float*)(ws + WS_ROPE); float* sinT = cosT + 2048; float* part = (float*)(ws + WS_PART);
    hfp* h = (hfp*)(ws + WS_H); bf16* a = (bf16*)(ws + WS_A); bf16* y = (bf16*)(ws + WS_Y); bf16* o = (bf16*)(ws + WS_O); unsigned char* big = ws + WS_BIG;
    const int G = gridDim.x;

    if (IN(0)) { for (int rep_ = 0; rep_ < REP_P0; ++rep_) {
        ada_partials(X, c, c_ctx, ada_w, part);
        rope_table(X, cosT, sinT);
        { LAS TrDesc* tab = (LAS TrDesc*)(X.lds + TR_LDS_OFF);
          if (X.tid == 0) { TRD_BEGIN(tab); const bool all = gridDim.x != 256;
            for (int l = 0; l < (all ? 4 : 1); ++l) { TRD(args.in[7] + (size_t)l * D * DFF, D, DFF, DFF, (bf16*)(ws + WS_W1T) + (size_t)l * D * DFF); TRD(args.in[8] + (size_t)l * D * DFF, DFF, D, D, (bf16*)(ws + WS_W2T) + (size_t)l * D * DFF); }
            for (int j = 0; j < (all ? 2 : 1); ++j) { TRD(args.in[9] + (size_t)j * D * 6144, D, 6144, 6144, (bf16*)(ws + WS_NAQKV) + (size_t)j * D * 6144); TRD(args.in[11] + (size_t)j * D * D, D, D, D, (bf16*)(ws + WS_NAWO) + (size_t)j * D * D); }
            if (all) { TRD(args.in[12], D, 1088, 1280, (bf16*)(ws + WS_MLAIN)); TRD(args.in[15], 512, 3072, 3072, (bf16*)(ws + WS_MLAUQ)); TRD(args.in[16], 512, 4096, 4096, (bf16*)(ws + WS_MLAUKV)); TRD(args.in[17], D, D, D, (bf16*)(ws + WS_MLAWO));
                       TRD(args.in[18], D, 6176, 6400, (bf16*)(ws + WS_MLIN)); TRD(args.in[22], D, D, D, (bf16*)(ws + WS_MLWO)); }
            TRD_END(); }
          __syncthreads();
          tr_all(X, tab, TRD_TOTAL(), (int)blockIdx.x, (int)gridDim.x); }
        __syncthreads(); }
        SEAM(0);
    }
    if (IN(1)) {
        for (int i = blockIdx.x * NTHR + X.tid; i < 4 * 3 * NMOD; i += G * NTHR) { const int l = i / (3 * NMOD), rem = i % (3 * NMOD), j = rem % NMOD; float s = ada_b[l * NMOD + j];
            for (int sl = 0; sl < 16; ++sl) s += part[((size_t)(sl * 4 + l) * 3) * NMOD + rem];
            mod[i] = s; }
        SEAM(1);
    }
    if (IN(2)) {
        vec_setup(X, mod, norm_g, false, 0, 0, 0, true, 0, 0, 0, 1);
        first_norm(X, x, ctx, h, a);
        __syncthreads();
        SEAM(2);
    }
    run_layer<0>(X, args, bar, lo, hi, single); run_layer<1>(X, args, bar, lo, hi, single); run_layer<2>(X, args, bar, lo, hi, single); run_layer<3>(X, args, bar, lo, hi, single);
#undef IN
#undef SEAM
}

#ifndef MK_SINGLE
#define MK_SINGLE 1
#endif
extern "C" void kernel_launch(void* const* d_in, const int* in_sizes, int n_in, void* d_out, int out_size, void* d_ws, size_t ws_size, hipStream_t stream) {
    static int grid = 0;
    if (grid == 0) {
        if (n_in != 23 || in_sizes[0] != MLAT * D || out_size != MLAT * D || ws_size < WS_END) { fprintf(stderr, "kernel_launch: shape mismatch n_in %d in0 %d out %d ws %zu (need %zu)\n", n_in, n_in > 0 ? in_sizes[0] : -1, out_size, ws_size, (size_t)WS_END); grid = -1; return; }
        int dev = 0, cus = 0;
        if (hipGetDevice(&dev) != hipSuccess || hipDeviceGetAttribute(&cus, hipDeviceAttributeMultiprocessorCount, dev) != hipSuccess) { grid = -1; return; }
        if (hipFuncSetAttribute((const void*)mega_fwd, hipFuncAttributeMaxDynamicSharedMemorySize, LDS_BYTES) != hipSuccess) { fprintf(stderr, "kernel_launch: hipFuncSetAttribute failed\n"); grid = -1; return; }
        int per_cu = 0;
        if (hipOccupancyMaxActiveBlocksPerMultiprocessor(&per_cu, (const void*)mega_fwd, NTHR, LDS_BYTES) != hipSuccess || per_cu < 1) fprintf(stderr, "kernel_launch: occupancy query reports %d\n", per_cu);
        (void)hipGetLastError();
        grid = cus;
    }
    if (grid < 0) return;
    if (hipMemsetAsync((char*)d_ws + WS_CTL, 0, CTL_ZERO_BYTES, stream) != hipSuccess) return;
    Args a{};
    for (int i = 0; i < 23; ++i) a.in[i] = (const float*)d_in[i];
    a.out = (float*)d_out; a.ws = (unsigned char*)d_ws;
#if MK_SINGLE
    a.ph_lo = 0; a.ph_hi = NPHASES;
    hipLaunchKernelGGL(mega_fwd, dim3(grid), dim3(NTHR), LDS_BYTES, stream, a);
#else
    for (int p = 0; p < NPHASES; ++p) { if (!phase_active(p)) continue; a.ph_lo = p; a.ph_hi = p + 1; hipLaunchKernelGGL(mega_fwd, dim3(grid), dim3(NTHR), LDS_BYTES, stream, a); }
#endif
    const hipError_t le = hipPeekAtLastError();
    if (le != hipSuccess) fprintf(stderr, "kernel_launch: launch failed: %s\n", hipGetErrorName(le));
}
```

```cpp
#include <hip/hip_runtime.h>
#include <cstdio>
#include <cstdint>
#include <cmath>
namespace pg8 {
#define PG8_LAS __attribute__((address_space(3)))
typedef unsigned short bf16_t;
typedef short bf16x8 __attribute__((ext_vector_type(8)));
typedef float f32x4 __attribute__((ext_vector_type(4)));
typedef unsigned u32x4 __attribute__((ext_vector_type(4)));
constexpr int BM = 256, BK = 64, HALF = 128, HTB = HALF * BK * 2  , STAGE_BYTES = 8 * HTB, NXCD = 8, WGM = 8;

__host__ __device__ __forceinline__ int lds_byte(int r, int c) { const int st = (r >> 4) * 2 + (c >> 5), rr = r & 15, cc = c & 31, ob = rr * 64 + cc * 2; return st * 1024 + (ob ^ (((ob >> 9) & 1) << 5)); }
__host__ __device__ __forceinline__ void stage_rc(int b, int& R, int& C) { const int st = b / 1024, sb = b % 1024, swz = sb ^ (((sb >> 9) & 1) << 5); R = (st >> 1) * 16 + swz / 64; C = (st & 1) * 32 + (swz % 64) / 2; }
__host__ __device__ __forceinline__ int perm32(int rho) { const int n = rho >> 4, i = rho & 15; return 8 * (i >> 2) + 4 * n + (i & 3); }

struct Unit { int pm, pn, pk; };
struct Gemm { const bf16_t* A; const bf16_t* Bt; int M, N, K, ld; };

struct StaticOrder {
    int nM, nN, nwg, G, c, wgm;
    __host__ __device__ void init(int M, int N, int G_, int c_, int wgm_ = WGM) { nM = M / BM; nN = N / BM; nwg = nM * nN; G = G_; c = c_; wgm = wgm_; }
    __host__ __device__ bool next(int i, Unit& u) const {
        const long L = (long)i * G + c; if (L >= nwg) return false;
        int wgid = (int)L; { const int q = nwg / NXCD, r = nwg % NXCD, xcd = wgid % NXCD, off = wgid / NXCD; wgid = (xcd < r ? xcd * (q + 1) : r * (q + 1) + (xcd - r) * q) + off; }
        const int nig = wgm * nN, gid = wgid / nig, fm = gid * wgm, gsz = (nM - fm) < wgm ? (nM - fm) : wgm;
        u.pm = fm + ((wgid % nig) % gsz); u.pn = (wgid % nig) / gsz; u.pk = 0; return true;
    }
    __device__ __forceinline__ void a_ready(const Unit&) const {}
    __device__ __forceinline__ void done(const Unit&) const {}
};

struct SplitKOrder {
    int nN, KS, nitems, G, c;
    __host__ __device__ void init(int M, int N, int KS_, int G_, int c_) { nN = N / BM; KS = KS_; nitems = (M / BM) * nN * KS_; G = G_; c = c_; }
    __host__ __device__ bool next(int i, Unit& u) const { const long L = (long)i * G + c; if (L >= nitems) return false; const int l = (int)L; u.pk = l % KS; const int t = l / KS; u.pn = t % nN; u.pm = t / nN; return true; }
    __device__ __forceinline__ void a_ready(const Unit&) const {}
    __device__ __forceinline__ void done(const Unit&) const {}
};

__device__ __forceinline__ unsigned cvt_pk_bf16(float lo, float hi) { unsigned r; asm volatile("v_cvt_pk_bf16_f32 %0, %1, %2" : "=v"(r) : "v"(lo), "v"(hi)); return r; }
typedef float f32x2 __attribute__((ext_vector_type(2)));
template <int ACT> struct EpiBf16 {
    static constexpr bool PERM = true, AFTER_DRAIN = false;
    bf16_t* O; int ldc;
    __device__ __forceinline__ void operator()(const f32x4 (&acc)[2][2][4][2], const Unit& u, int wr, int wc, int fr, int fq) const {
        const int row0 = u.pm * BM + wr * 64 + fr; const int col0 = u.pn * BM + wc * 32 + 8 * fq;
#pragma unroll
        for (int ai = 0; ai < 2; ++ai)
#pragma unroll
            for (int m = 0; m < 4; ++m) { bf16_t* rowp = O + (size_t)(row0 + ai * HALF + m * 16) * ldc + col0;
#pragma unroll
                for (int bj = 0; bj < 2; ++bj) { f32x4 v0 = acc[ai][bj][m][0], v1 = acc[ai][bj][m][1];
                    if (ACT == 2) {
#pragma unroll
                        for (int e = 0; e < 4; ++e) { const float a = v0[e] > 0.f ? v0[e] : 0.f, b = v1[e] > 0.f ? v1[e] : 0.f; v0[e] = a * a; v1[e] = b * b; } }
                    u32x4 w; w.x = cvt_pk_bf16(v0[0], v0[1]); w.y = cvt_pk_bf16(v0[2], v0[3]); w.z = cvt_pk_bf16(v1[0], v1[1]); w.w = cvt_pk_bf16(v1[2], v1[3]);
                    *(u32x4*)(rowp + bj * HALF) = w; } }
    }
};

struct EpiF32Slab {
    static constexpr bool PERM = false, AFTER_DRAIN = false;
    float* O; int ldc; size_t slab;
    __device__ __forceinline__ void operator()(const f32x4 (&acc)[2][2][4][2], const Unit& u, int wr, int wc, int fr, int fq) const {
        const int row0 = u.pm * BM + wr * 64 + fr; const int col0 = u.pn * BM + wc * 32 + 4 * fq; float* base = O + (size_t)u.pk * slab;
#pragma unroll
        for (int ai = 0; ai < 2; ++ai)
#pragma unroll
            for (int m = 0; m < 4; ++m) { float* rowp = base + (size_t)(row0 + ai * HALF + m * 16) * ldc + col0;
#pragma unroll
                for (int bj = 0; bj < 2; ++bj)
#pragma unroll
                    for (int n = 0; n < 2; ++n) *(f32x4*)(rowp + bj * HALF + n * 16) = acc[ai][bj][m][n]; }
    }
};

template <class Epi, class Sched, bool ALIGN_EPI = false, bool SP2 = false>
__device__ __forceinline__ void gemm_phase(PG8_LAS unsigned char* lds, const Gemm g, const Sched& S, const Epi& E) {
    const int tid = threadIdx.x, wid = __builtin_amdgcn_readfirstlane(tid >> 6), lane = tid & 63, wr = wid >> 2, wc = wid & 3, fr = lane & 15, fq = lane >> 4;
    const int K = g.K, nt = K / BK, ld = g.ld ? g.ld : g.K;
    unsigned voffA[2], voffB[2];
#pragma unroll
    for (int i = 0; i < 2; ++i) { int R, C; stage_rc(tid * 16 + i * 8192, R, C); const int Rb = Epi::PERM ? ((R & ~31) + perm32(R & 31)) : R;
        voffA[i] = (unsigned)(R * ld + C) * 2u; voffB[i] = (unsigned)(Rb * ld + C) * 2u; }
    const size_t kstep = (size_t)(BK * 2);
    const size_t hstep = (size_t)HALF * ld * 2;
    const size_t tstep = 2 * hstep;
    const unsigned ldsw = (unsigned)wid * 1024u;
    const int aoff = lds_byte(wr * 64 + fr, fq * 8), boff = lds_byte(wc * 32 + fr, fq * 8);
#define PG8_SA(b, h) (((b) * 2 + (h)) * HTB)
#define PG8_SB(b, h) ((4 + (b) * 2 + (h)) * HTB)
#define PG8_STAGE(bufoff, gbase, voff) do { _Pragma("unroll") for (int _i = 0; _i < 2; ++_i) \
        __builtin_amdgcn_global_load_lds((const unsigned*)((const char*)(gbase) + (voff)[_i]), (PG8_LAS unsigned*)(lds + (bufoff) + ldsw + _i * 8192), 16, 0, 0); } while (0)
#define PG8_LDA(dst, b, h) do { _Pragma("unroll") for (int m = 0; m < 4; ++m) _Pragma("unroll") for (int k = 0; k < 2; ++k) dst[m][k] = *(const PG8_LAS bf16x8*)(lds + PG8_SA(b, h) + aoff + m * 2048 + k * 1024); } while (0)
#define PG8_LDB(dst, b, h) do { _Pragma("unroll") for (int n = 0; n < 2; ++n) _Pragma("unroll") for (int k = 0; k < 2; ++k) dst[n][k] = *(const PG8_LAS bf16x8*)(lds + PG8_SB(b, h) + boff + n * 2048 + k * 1024); } while (0)
#define PG8_MMA(ai, bj, At, Bt) do { __builtin_amdgcn_s_setprio(1); _Pragma("unroll") for (int m = 0; m < 4; ++m) _Pragma("unroll") for (int n = 0; n < 2; ++n) _Pragma("unroll") for (int k = 0; k < 2; ++k) \
        acc[ai][bj][m][n] = __builtin_amdgcn_mfma_f32_16x16x32_bf16(Bt[n][k], At[m][k], acc[ai][bj][m][n], 0, 0, 0); __builtin_amdgcn_s_setprio(0); } while (0)
#define PG8_WAIT_V(n) asm volatile("s_waitcnt vmcnt(" #n ")" ::: "memory")
#define PG8_WAIT_L(n) asm volatile("s_waitcnt lgkmcnt(" #n ")" ::: "memory")
#define PG8_BAR __builtin_amdgcn_s_barrier()
#define PG8_SCHED __builtin_amdgcn_sched_barrier(0)
    Unit cur, nxt; int ui = 0;
    if (!S.next(0, cur)) return;
    f32x4 acc[2][2][4][2];
#pragma unroll
    for (int a = 0; a < 2; ++a)
#pragma unroll
        for (int b = 0; b < 2; ++b)
#pragma unroll
            for (int m = 0; m < 4; ++m)
#pragma unroll
                for (int n = 0; n < 2; ++n) acc[a][b][m][n] = (f32x4){0.f, 0.f, 0.f, 0.f};
    bf16x8 At[4][2], B0[2][2], B1[2][2];
    const char* cA = (const char*)g.A + (size_t)cur.pm * tstep + (size_t)cur.pk * K * 2; const char* cB = (const char*)g.Bt + (size_t)cur.pn * tstep + (size_t)cur.pk * K * 2;
    S.a_ready(cur);
    if constexpr (SP2) {
        PG8_STAGE(PG8_SB(0, 0), cB, voffB); PG8_STAGE(PG8_SB(0, 1), cB + hstep, voffB); PG8_STAGE(PG8_SA(0, 0), cA, voffA); PG8_STAGE(PG8_SA(0, 1), cA + hstep, voffA);
        if (wr == 1) PG8_BAR;
        PG8_WAIT_V(2); PG8_BAR;
        PG8_STAGE(PG8_SB(1, 0), cB + kstep, voffB); PG8_STAGE(PG8_SA(1, 0), cA + kstep, voffA); PG8_STAGE(PG8_SB(1, 1), cB + hstep + kstep, voffB);
        PG8_WAIT_V(6); PG8_BAR;
    } else {
        PG8_STAGE(PG8_SB(0, 0), cB, voffB); PG8_STAGE(PG8_SA(0, 0), cA, voffA); PG8_STAGE(PG8_SB(0, 1), cB + hstep, voffB); PG8_STAGE(PG8_SA(0, 1), cA + hstep, voffA);
        if (wr == 1) PG8_BAR;
        PG8_WAIT_V(4); PG8_BAR;
        PG8_STAGE(PG8_SB(1, 0), cB + kstep, voffB); PG8_STAGE(PG8_SA(1, 0), cA + kstep, voffA); PG8_STAGE(PG8_SB(1, 1), cB + hstep + kstep, voffB);
        PG8_WAIT_V(6); PG8_BAR;
    }
    for (;;) {
        const bool has_next = S.next(ui + 1, nxt);
        const char* nA = has_next ? (const char*)g.A + (size_t)nxt.pm * tstep + (size_t)nxt.pk * K * 2 : cA; const char* nB = has_next ? (const char*)g.Bt + (size_t)nxt.pn * tstep + (size_t)nxt.pk * K * 2 : cB;
        for (int t = 0; t < nt; t += 2) {
            const bool last = (t == nt - 2);
            const char* a1 = cA + (size_t)(t + 1) * kstep;
            const char* a2 = last ? nA : cA + (size_t)(t + 2) * kstep; const char* b2 = last ? nB : cB + (size_t)(t + 2) * kstep;
            const char* a3 = a2 + kstep; const char* b3 = b2 + kstep;
            if (last && has_next) S.a_ready(nxt);
            if constexpr (SP2) {
            PG8_LDB(B0, 0, 0); PG8_LDB(B1, 0, 1); PG8_SCHED; PG8_LDA(At, 0, 0); PG8_STAGE(PG8_SA(1, 1), a1 + hstep, voffA);
            PG8_WAIT_V(8); PG8_WAIT_L(0); PG8_BAR; PG8_MMA(0, 0, At, B0); PG8_MMA(0, 1, At, B1); PG8_BAR; PG8_SCHED;
            PG8_LDA(At, 0, 1); PG8_STAGE(PG8_SB(0, 0), b2, voffB); PG8_STAGE(PG8_SB(0, 1), b2 + hstep, voffB); PG8_STAGE(PG8_SA(0, 0), a2, voffA);
            PG8_WAIT_V(8); PG8_WAIT_L(0); PG8_BAR; PG8_MMA(1, 0, At, B0); PG8_MMA(1, 1, At, B1); PG8_BAR; PG8_SCHED;
            PG8_LDB(B0, 1, 0); PG8_LDB(B1, 1, 1); PG8_SCHED; PG8_LDA(At, 1, 0); PG8_STAGE(PG8_SA(0, 1), a2 + hstep, voffA);
            PG8_WAIT_V(8); PG8_WAIT_L(0); PG8_BAR; PG8_MMA(0, 0, At, B0); PG8_MMA(0, 1, At, B1); PG8_BAR; PG8_SCHED;
            PG8_LDA(At, 1, 1); PG8_STAGE(PG8_SB(1, 0), b3, voffB); PG8_STAGE(PG8_SB(1, 1), b3 + hstep, voffB); PG8_STAGE(PG8_SA(1, 0), a3, voffA);
            PG8_WAIT_V(8); PG8_WAIT_L(0); PG8_BAR; PG8_MMA(1, 0, At, B0); PG8_MMA(1, 1, At, B1); PG8_BAR; PG8_SCHED;
            } else {
            PG8_LDB(B0, 0, 0); PG8_SCHED; PG8_LDA(At, 0, 0); PG8_STAGE(PG8_SA(1, 1), a1 + hstep, voffA);
            PG8_WAIT_L(8); PG8_BAR; PG8_WAIT_L(0); PG8_MMA(0, 0, At, B0); PG8_BAR; PG8_SCHED;
            PG8_LDB(B1, 0, 1); PG8_STAGE(PG8_SB(0, 0), b2, voffB);
            PG8_BAR; PG8_WAIT_L(0); PG8_MMA(0, 1, At, B1); PG8_BAR;
            PG8_LDA(At, 0, 1); PG8_STAGE(PG8_SA(0, 0), a2, voffA);
            PG8_BAR; PG8_WAIT_L(0); PG8_MMA(1, 0, At, B0); PG8_BAR; PG8_SCHED;
            PG8_STAGE(PG8_SB(0, 1), b2 + hstep, voffB);
            PG8_WAIT_V(6); PG8_BAR; PG8_MMA(1, 1, At, B1); PG8_BAR;
            PG8_LDB(B0, 1, 0); PG8_SCHED; PG8_LDA(At, 1, 0); PG8_STAGE(PG8_SA(0, 1), a2 + hstep, voffA);
            PG8_WAIT_L(8); PG8_BAR; PG8_WAIT_L(0); PG8_MMA(0, 0, At, B0); PG8_BAR; PG8_SCHED;
            PG8_LDB(B1, 1, 1); PG8_STAGE(PG8_SB(1, 0), b3, voffB);
            PG8_BAR; PG8_WAIT_L(0); PG8_MMA(0, 1, At, B1); PG8_BAR;
            PG8_LDA(At, 1, 1); PG8_STAGE(PG8_SA(1, 0), a3, voffA);
            PG8_BAR; PG8_WAIT_L(0); PG8_MMA(1, 0, At, B0); PG8_BAR; PG8_SCHED;
            PG8_STAGE(PG8_SB(1, 1), b3 + hstep, voffB);
            PG8_WAIT_V(6); PG8_BAR; PG8_MMA(1, 1, At, B1); PG8_BAR;
            }
        }
        if constexpr (ALIGN_EPI) { if (wr == 0) PG8_BAR; }
        if constexpr (!Epi::AFTER_DRAIN) { E(acc, cur, wr, wc, fr, fq); S.done(cur); }
        if (!has_next) break;
#pragma unroll
        for (int a = 0; a < 2; ++a)
#pragma unroll
            for (int b = 0; b < 2; ++b)
#pragma unroll
                for (int m = 0; m < 4; ++m)
#pragma unroll
                    for (int n = 0; n < 2; ++n) acc[a][b][m][n] = (f32x4){0.f, 0.f, 0.f, 0.f};
        cur = nxt; cA = nA; cB = nB; ++ui;
        if constexpr (ALIGN_EPI) { if (wr == 1) PG8_BAR; }
    }
    PG8_WAIT_V(0);
    if constexpr (!ALIGN_EPI) { if (wr == 0) PG8_BAR; }
    PG8_BAR;
    if constexpr (Epi::AFTER_DRAIN) { E.fused(acc, cur, wr, wc, fr, fq, lds, wid, lane); S.done(cur); }
#undef PG8_SA
#undef PG8_SB
#undef PG8_STAGE
#undef PG8_LDA
#undef PG8_LDB
#undef PG8_MMA
#undef PG8_WAIT_V
#undef PG8_WAIT_L
#undef PG8_BAR
#undef PG8_SCHED
}
}
#define GAS __attribute__((address_space(1)))
#define LAS __attribute__((address_space(3)))
typedef unsigned short bf16;
typedef unsigned v4u __attribute__((ext_vector_type(4)));
typedef float f32x4 __attribute__((ext_vector_type(4)));
typedef short bf16x8 __attribute__((ext_vector_type(8)));
typedef GAS unsigned gu32;
typedef GAS unsigned long long gu64;
#define RLX_AGENT __ATOMIC_RELAXED, __HIP_MEMORY_SCOPE_AGENT
#define LDS_WAIT() asm volatile("s_waitcnt lgkmcnt(0)" ::: "memory")
#define VM_WAIT() asm volatile("s_waitcnt vmcnt(0)" ::: "memory")
__device__ __forceinline__ unsigned long long rt() { return __builtin_amdgcn_s_memrealtime(); }
__device__ __forceinline__ unsigned f2bf(float f) { unsigned u = __builtin_bit_cast(unsigned, f); return (u + 0x7fffu + ((u >> 16) & 1u)) >> 16; }
__device__ __forceinline__ unsigned pk2(float lo, float hi) { return f2bf(lo) | (f2bf(hi) << 16); }

#define XB_TMO      128
#define XB_XCNT(j)  (256  + 64 * (j))
#define XB_XSUB(j)  (1280 + 64 * (j))
#define XB_XGEN(j)  (2304 + 64 * (j))
#define XB_TOP      3328
#define XB_TOPGEN   3392
#define XCD_BAR_WORDS 3456
#define XB_SPIN_CAP (1u << 18)

__device__ __forceinline__ unsigned xb_ld(unsigned* p)              { return __hip_atomic_load(p, __ATOMIC_RELAXED, __HIP_MEMORY_SCOPE_AGENT); }
__device__ __forceinline__ unsigned xb_add(unsigned* p, unsigned v) { return __hip_atomic_fetch_add(p, v, __ATOMIC_RELAXED, __HIP_MEMORY_SCOPE_AGENT); }
__device__ __forceinline__ unsigned xb_xcc_id() { return (unsigned)__builtin_amdgcn_s_getreg((3 << 11) | 20) & 0xFu; }
#define XB_SPIN(cond, bar) do { unsigned _sp = 0; while (cond) { __builtin_amdgcn_s_sleep(1); \
    if ((++_sp & 255u) == 0u) { if (xb_ld(&(bar)[XB_TMO])) break; if (_sp > XB_SPIN_CAP) { atomicAdd(&(bar)[XB_TMO], 1u); break; } } } } while (0)

struct XcdBarrier {
    unsigned* bar; unsigned x;
    volatile LAS unsigned* st;
};

__device__ __forceinline__ XcdBarrier xcd_barrier_post(unsigned* bar, volatile LAS unsigned* st) {
    XcdBarrier b; b.bar = bar; b.x = xb_xcc_id(); b.st = st;
    if (threadIdx.x == 0) (void)xb_add(&bar[XB_XCNT(b.x)], 1u);
    return b;
}
__device__ __forceinline__ void xcd_barrier_complete(unsigned* bar, unsigned x, unsigned& nloc, unsigned& nx) {
    const unsigned G = gridDim.x * gridDim.y * gridDim.z;
    unsigned sum, cnt, mine, sp = 0u;
    for (;;) {
        sum = 0u; cnt = 0u; mine = 0u;
#pragma unroll
        for (unsigned j = 0; j < 16; ++j) { const unsigned c = xb_ld(&bar[XB_XCNT(j)]); sum += c; cnt += (c > 0u) ? 1u : 0u; mine = (j == x) ? c : mine; }
        if (sum == G) break;
        __builtin_amdgcn_s_sleep(1);
        if ((++sp & 255u) == 0u) { if (xb_ld(&bar[XB_TMO])) break; if (sp > XB_SPIN_CAP) { atomicAdd(&bar[XB_TMO], 1u); break; } }
    }
    nloc = mine > 0u ? mine : 1u; nx = cnt > 0u ? cnt : 1u;
}

__device__ __forceinline__ void xcd_barrier(const XcdBarrier& b) {
    asm volatile("s_waitcnt vmcnt(0)" ::: "memory");
    __syncthreads();
    if (threadIdx.x == 0) {
        unsigned* bar = b.bar;
        __builtin_amdgcn_s_waitcnt(0);
        unsigned nloc = b.st[0], nx = b.st[1];
        if (nloc == 0u) { xcd_barrier_complete(bar, b.x, nloc, nx); b.st[0] = nloc; b.st[1] = nx; }
        const unsigned old = xb_add(&bar[XB_XSUB(b.x)], 1u);
        const unsigned gen = old / nloc;
        if (old + 1u == (gen + 1u) * nloc) {
            __builtin_amdgcn_fence(__ATOMIC_RELEASE, "agent");
            asm volatile("s_waitcnt vmcnt(0)" ::: "memory");
            const unsigned og = xb_add(&bar[XB_TOP], 1u);
            const unsigned tg = og / nx;
            if (og + 1u == (tg + 1u) * nx) xb_add(&bar[XB_TOPGEN], 1u);
            else XB_SPIN(xb_ld(&bar[XB_TOPGEN]) == tg, bar);
            __builtin_amdgcn_fence(__ATOMIC_ACQUIRE, "agent");
            xb_add(&bar[XB_XGEN(b.x)], 1u);
            asm volatile("s_waitcnt vmcnt(0)" ::: "memory");
        } else {
            XB_SPIN(xb_ld(&bar[XB_XGEN(b.x)]) == gen, bar);
            __builtin_amdgcn_fence(__ATOMIC_ACQUIRE, "agent");
            asm volatile("s_waitcnt vmcnt(0)" ::: "memory");
        }
    }
    __syncthreads();
}
__device__ __forceinline__ float wave_sum(float v) {
#pragma unroll
    for (int o = 1; o < 64; o <<= 1) v += __shfl_xor(v, o);
    return v;
}
__device__ __forceinline__ void p0_transpose_item(const float* W, int K, int N, bf16* WT, int row_off, LAS float* scr, int item, int lane) {
    const int nblk = N / 32, kb = item / nblk, nb = item % nblk, k0 = 64 * kb, n0 = 32 * nb;
#pragma unroll 8
    for (int i = 0; i < 32; ++i) { const int kk = 2 * i + (lane >> 5); scr[kk * 33 + (lane & 31)] = W[(size_t)(k0 + kk) * N + n0 + (lane & 31)]; }
    LDS_WAIT(); asm volatile("" ::: "memory");
    const int c = lane & 7;
#pragma unroll
    for (int j = 0; j < 4; ++j) { const int n = (lane >> 3) + 8 * j; const LAS float* s = scr + (8 * c) * 33 + n;
        v4u o; o.x = pk2(s[0 * 33], s[1 * 33]); o.y = pk2(s[2 * 33], s[3 * 33]); o.z = pk2(s[4 * 33], s[5 * 33]); o.w = pk2(s[6 * 33], s[7 * 33]);
        *(GAS v4u*)(WT + (size_t)(row_off + n0 + n) * K + k0 + 8 * c) = o; }
    LDS_WAIT(); asm volatile("" ::: "memory");
}
#ifndef WGM_IN
#define WGM_IN 4
#endif
#ifndef WGM_UQ
#define WGM_UQ 4
#endif
#ifndef WGM_WO
#define WGM_WO 4
#endif
#ifndef WGM_F1
#define WGM_F1 4
#endif
#ifndef WGM_F2
#define WGM_F2 4
#endif
#ifndef REP_IN
#define REP_IN 1
#endif
#ifndef REP_NA
#define REP_NA 1
#endif
#ifndef REP_MLA
#define REP_MLA 1
#endif
#ifndef REP_SCAN
#define REP_SCAN 1
#endif
#ifndef REP_WO
#define REP_WO 1
#endif
#ifndef REP_FFN1
#define REP_FFN1 1
#endif
#ifndef REP_FFN2
#define REP_FFN2 1
#endif
#ifndef REP_P0
#define REP_P0 1
#endif

#if REP_IN == 2
#define REPEAT_REP_IN(...) __VA_ARGS__ __VA_ARGS__
#else
#define REPEAT_REP_IN(...) __VA_ARGS__
#endif
#if REP_NA == 2
#define REPEAT_REP_NA(...) __VA_ARGS__ __VA_ARGS__
#else
#define REPEAT_REP_NA(...) __VA_ARGS__
#endif
#if REP_MLA == 2
#define REPEAT_REP_MLA(...) __VA_ARGS__ __VA_ARGS__
#else
#define REPEAT_REP_MLA(...) __VA_ARGS__
#endif
#if REP_SCAN == 2
#define REPEAT_REP_SCAN(...) __VA_ARGS__ __VA_ARGS__
#else
#define REPEAT_REP_SCAN(...) __VA_ARGS__
#endif
#if REP_WO == 2
#define REPEAT_REP_WO(...) __VA_ARGS__ __VA_ARGS__
#else
#define REPEAT_REP_WO(...) __VA_ARGS__
#endif
#if REP_FFN1 == 2
#define REPEAT_REP_FFN1(...) __VA_ARGS__ __VA_ARGS__
#else
#define REPEAT_REP_FFN1(...) __VA_ARGS__
#endif
#if REP_FFN2 == 2
#define REPEAT_REP_FFN2(...) __VA_ARGS__ __VA_ARGS__
#else
#define REPEAT_REP_FFN2(...) __VA_ARGS__
#endif

constexpr int NWAVES = 8, NTHR = 512;
constexpr int D = 2048, NB = 2, SEQ = 8192, CTXL = 256, DFF = 8192, DEPTH = 4;
constexpr int MLAT = NB * SEQ, MCTX = NB * CTXL, M = MLAT + MCTX;
constexpr float EPS = 1e-6f;
constexpr int NMOD = 6 * D;
constexpr size_t MiB = 1u << 20;
constexpr size_t WS_CTL = 0, CTL_ZERO_BYTES = 1 * MiB;
constexpr size_t WS_MOD = 1 * MiB, WS_ROPE = 2 * MiB, WS_PART = 3 * MiB;
constexpr size_t WS_W1T = 12 * MiB, WS_W2T = WS_W1T + 128 * MiB, WS_NAQKV = WS_W2T + 128 * MiB, WS_NAWO = WS_NAQKV + 48 * MiB;
constexpr size_t WS_MLAIN = WS_NAWO + 16 * MiB, WS_MLAUQ = WS_MLAIN + 5 * MiB, WS_MLAUKV = WS_MLAUQ + 3 * MiB, WS_MLAWO = WS_MLAUKV + 4 * MiB;
constexpr size_t WS_MLIN = WS_MLAWO + 8 * MiB, WS_MLWO = WS_MLIN + 25 * MiB;
constexpr size_t WS_H = WS_MLWO + 8 * MiB, WS_A = WS_H + 132 * MiB, WS_Y = WS_A + 66 * MiB, WS_O = WS_Y + 66 * MiB, WS_BIG = WS_O + 66 * MiB, WS_SLAB = WS_BIG + 276 * MiB, WS_END = WS_SLAB + 64 * MiB;
constexpr size_t BIG_QKV = 0;
constexpr size_t BIG_QH = 0, BIG_MZ = 0, BIG_KV = 99 * MiB, BIG_CQN = 231 * MiB, BIG_CKVN = BIG_CQN + (size_t)M * 512 * 2, BIG_KPE = 264 * MiB;
constexpr size_t BIG_LZ = 0, BIG_LQK = 207 * MiB, BIG_LG = 273 * MiB;
constexpr size_t BIG_HID = 0;
constexpr int CW_BAR = 4096;
constexpr int RING_BYTES = 131072, LDS_BYTES = 147456, MISC_OFF = LDS_BYTES - 256;

__device__ __forceinline__ float bf_lo(unsigned w) { return __uint_as_float(w << 16); }
__device__ __forceinline__ float bf_hi(unsigned w) { return __uint_as_float(w & 0xffff0000u); }
__device__ __forceinline__ float bf1(bf16 b) { return __uint_as_float(((unsigned)b) << 16); }
__device__ __forceinline__ unsigned pkbf(float lo, float hi) { return pg8::cvt_pk_bf16(lo, hi); }
__device__ __forceinline__ void unpack8(const v4u w, float* f) { f[0] = bf_lo(w.x); f[1] = bf_hi(w.x); f[2] = bf_lo(w.y); f[3] = bf_hi(w.y); f[4] = bf_lo(w.z); f[5] = bf_hi(w.z); f[6] = bf_lo(w.w); f[7] = bf_hi(w.w); }
__device__ __forceinline__ float sigmoidf_(float x) { return 1.f / (1.f + expf(-x)); }

typedef _Float16 hfp;
typedef _Float16 hfp4 __attribute__((ext_vector_type(4)));
struct Ctx { LAS unsigned char* lds; int tid, lane, wave, gw, ngw; };

__device__ __forceinline__ void tr_matrix(const Ctx& X, const float* W, int K, int N, bf16* WT) {
    LAS float* scr = (LAS float*)(X.lds + X.wave * 8448);
    const int nitems = (K / 64) * (N / 32);
    for (int it = X.gw; it < nitems; it += X.ngw) p0_transpose_item(W, K, N, WT, 0, scr, it, X.lane);
}
struct TrDesc { const float* W; bf16* WT; int K, N, Npad, base; };
constexpr int TR_NMAT = 18, TR_LDS_OFF = 132096;
__device__ __forceinline__ void tr_decode(const LAS TrDesc* tab, int g, const float*& W, bf16*& WT, int& K, int& N, int& k0, int& n0) {
    int mi = 0;
#pragma unroll 1
    for (int i = 1; i < TR_NMAT; ++i) if (g >= tab[i].base) mi = i;
    const LAS TrDesc* d = tab + mi; const int it = g - d->base, nb = d->Npad >> 8; W = d->W; WT = d->WT; K = d->K; N = d->N; k0 = (it / nb) * 64; n0 = (it % nb) * 256;
}
struct TrItem { const float* W; bf16* WT; int K, N, k0, n0; };
__device__ __forceinline__ void tr_all(const Ctx& X, const LAS TrDesc* tab, int total, const int first, const int G) {
    LAS float* T = (LAS float*)X.lds; const int q = X.tid & 63, rr = X.tid >> 6, c = X.tid & 7;
    if (first >= total) return;
#define TR_LOAD(v_, I_) do { _Pragma("unroll") for (int i = 0; i < 8; ++i) { const int n = (I_).n0 + 4 * q; v_[i] = n < (I_).N ? *(const f32x4*)((I_).W + (size_t)((I_).k0 + rr + 8 * i) * (I_).N + n) : (f32x4){0.f, 0.f, 0.f, 0.f}; } } while (0)
#define TR_PUT(v_) do { _Pragma("unroll") for (int i = 0; i < 8; ++i) *(LAS f32x4*)(T + (rr + 8 * i) * 256 + 4 * (q ^ i)) = v_[i]; } while (0)
#define TR_STORE(I_) do { _Pragma("unroll") for (int j = 0; j < 4; ++j) { const int nn = (X.tid >> 3) + 64 * j; const LAS float* s = T + (8 * c) * 256 + (nn ^ (4 * c)); \
        v4u o; o.x = pk2(s[0 * 256], s[1 * 256]); o.y = pk2(s[2 * 256], s[3 * 256]); o.z = pk2(s[4 * 256], s[5 * 256]); o.w = pk2(s[6 * 256], s[7 * 256]); \
        *(GAS v4u*)((I_).WT + (size_t)((I_).n0 + nn) * (I_).K + (I_).k0 + 8 * c) = o; } } while (0)
    TrItem A, B, Cn; f32x4 va[8], vb[8];
    int g = first;
    tr_decode(tab, g, A.W, A.WT, A.K, A.N, A.k0, A.n0); TR_LOAD(va, A);
    bool hasB = g + G < total; B = A; if (hasB) { tr_decode(tab, g + G, B.W, B.WT, B.K, B.N, B.k0, B.n0); TR_LOAD(vb, B); }
    for (;;) {
        const bool hasC = g + 2 * G < total; Cn = A; if (hasC) tr_decode(tab, g + 2 * G, Cn.W, Cn.WT, Cn.K, Cn.N, Cn.k0, Cn.n0);
        TR_PUT(va); __syncthreads();
        const TrItem cur = A;
        if (hasC) { A = Cn; TR_LOAD(va, A); }
        TR_STORE(cur); __syncthreads();
        if (!hasB) break;
        const bool hasD = g + 3 * G < total; Cn = B; if (hasD) tr_decode(tab, g + 3 * G, Cn.W, Cn.WT, Cn.K, Cn.N, Cn.k0, Cn.n0);
        TR_PUT(vb); __syncthreads();
        const TrItem cur2 = B;
        if (hasD) { B = Cn; TR_LOAD(vb, B); }
        TR_STORE(cur2); __syncthreads();
        if (!hasC) break;
        hasB = hasD; g += 2 * G;
    }
#undef TR_LOAD
#undef TR_PUT
#undef TR_STORE
}
__device__ __forceinline__ void zero_bf16(const Ctx& X, bf16* p, size_t n8) {
    for (size_t i = (size_t)blockIdx.x * NTHR + X.tid; i < n8; i += (size_t)gridDim.x * NTHR) ((v4u*)p)[i] = (v4u){0u, 0u, 0u, 0u};
}
__device__ __forceinline__ void ada_partials(const Ctx& X, const float* c, const float* c_ctx, const float* ada_w, float* part) {
    LAS float* S = (LAS float*)(X.lds + 69632);
    for (int i = X.tid; i < 3 * D; i += NTHR) { const int cls = i / D, k = i % D; const float v = cls < 2 ? c[cls * D + k] : c_ctx[k]; S[i] = v / (1.f + expf(-v)); }
    __syncthreads();
    for (int it = X.gw; it < 4 * 48 * 16; it += X.ngw) {
        const int sl = it & 15, cb = (it >> 4) % 48, l = it / (16 * 48);
        const float* W = ada_w + ((size_t)l * D + sl * 128) * NMOD + cb * 256 + X.lane * 4;
        f32x4 a0 = {0.f, 0.f, 0.f, 0.f}, a1 = a0, a2 = a0;
#pragma unroll 8
        for (int kk = 0; kk < 128; ++kk) { const f32x4 w = *(const f32x4*)(W + (size_t)kk * NMOD); const int k = sl * 128 + kk; a0 += w * S[k]; a1 += w * S[D + k]; a2 += w * S[2 * D + k]; }
        float* P = part + ((size_t)(sl * 4 + l) * 3) * NMOD + cb * 256 + X.lane * 4;
        *(f32x4*)(P) = a0; *(f32x4*)(P + NMOD) = a1; *(f32x4*)(P + 2 * NMOD) = a2;
    }
}
__device__ __forceinline__ void rope_table(const Ctx& X, float* cosT, float* sinT) {
    for (int i = blockIdx.x * NTHR + X.tid; i < 2048; i += gridDim.x * NTHR) {
        const int pos = i >> 4, p = i & 15;
        const double f = exp(-(double)p * (9.210340371976184 / 16.0)); const double ang = (double)pos * f;
        const double k = rint(ang * 0.15915494309189535); const double r = ang - k * 6.283185307179586;
        cosT[i] = (float)cos(r); sinT[i] = (float)sin(r);
    }
}
__device__ __forceinline__ const float* modv(const float* mod, int l, int cls, int chunk) { return mod + ((size_t)(l * 3 + cls) * 6 + chunk) * D; }
__device__ __forceinline__ void vec_setup(const Ctx& X, const float* mod, const float* norm_g, bool has_gate, int l_gate, int chunk_gate, int gi_post, bool has_next, int l_next, int gi_pre, int chunk_sh, int chunk_sc) {
    LAS float* G = (LAS float*)(X.lds); LAS float* A = (LAS float*)(X.lds + 24576); LAS float* S = (LAS float*)(X.lds + 49152);
    for (int i = X.tid; i < 3 * D; i += NTHR) { const int cls = i / D, k = i % D;
        if (has_gate) G[i] = modv(mod, l_gate, cls, chunk_gate)[k] * norm_g[(l_gate * 4 + gi_post) * D + k];
        if (has_next) { A[i] = norm_g[(l_next * 4 + gi_pre) * D + k] * (1.f + modv(mod, l_next, cls, chunk_sc)[k]); S[i] = modv(mod, l_next, cls, chunk_sh)[k]; } }
    __syncthreads();
}
__device__ __forceinline__ void first_norm(const Ctx& X, const float* x, const float* ctx, hfp* h, bf16* a) {
    const LAS f32x4* A = (const LAS f32x4*)(X.lds + 24576); const LAS f32x4* S = (const LAS f32x4*)(X.lds + 49152);
    for (int row = X.gw; row < M; row += X.ngw) {
        const int cls = row < MLAT ? (row >> 13) : 2;
        const f32x4* src = (const f32x4*)(row < MLAT ? x + (size_t)row * D : ctx + (size_t)(row - MLAT) * D) + X.lane;
        f32x4 v[8]; float ss = 0.f;
#pragma unroll
        for (int j = 0; j < 8; ++j) { v[j] = src[64 * j]; ss += (v[j].x * v[j].x + v[j].y * v[j].y) + (v[j].z * v[j].z + v[j].w * v[j].w); }
        const float rstd = 1.f / sqrtf(wave_sum(ss) * (1.f / D) + EPS);
        hfp4* hp = (hfp4*)(h + (size_t)row * D) + X.lane; unsigned long long* ap = (unsigned long long*)(a + (size_t)row * D) + X.lane;
#pragma unroll
        for (int j = 0; j < 8; ++j) { hp[64 * j] = __builtin_convertvector(v[j], hfp4); const f32x4 av = A[cls * 512 + 64 * j + X.lane], sv = S[cls * 512 + 64 * j + X.lane]; const f32x4 o = v[j] * rstd * av + sv;
            ap[64 * j] = (unsigned long long)pkbf(o.x, o.y) | ((unsigned long long)pkbf(o.z, o.w) << 32); }
    }
}
template <int MODE, bool SLAB> __device__ __forceinline__ void npost(const Ctx& X, const bf16* y, hfp* h, bf16* a, float* out, const float* slab, const int KS, const int row_lo, const int row_hi) {
    const LAS f32x4* G = (const LAS f32x4*)(X.lds); const LAS f32x4* A = (const LAS f32x4*)(X.lds + 24576); const LAS f32x4* S = (const LAS f32x4*)(X.lds + 49152);
    for (int row = row_lo + X.gw; row < row_hi; row += X.ngw) {
        const int cls = row < MLAT ? (row >> 13) : 2;
        hfp4* hp = (hfp4*)(h + (size_t)row * D) + X.lane;
        f32x4 hv[8], yv[8]; float ssy = 0.f;
        if (!SLAB) {
            const unsigned long long* yp = (const unsigned long long*)(y + (size_t)row * D) + X.lane;
#pragma unroll
            for (int j = 0; j < 8; ++j) { const unsigned long long w = yp[64 * j]; const unsigned lo = (unsigned)w, hi = (unsigned)(w >> 32); yv[j] = (f32x4){bf_lo(lo), bf_hi(lo), bf_lo(hi), bf_hi(hi)}; }
        } else {
            const f32x4* sp = (const f32x4*)(slab + (size_t)(row - MLAT) * D) + X.lane;
#pragma unroll
            for (int j = 0; j < 8; ++j) yv[j] = sp[64 * j];
#pragma unroll 1
            for (int k = 1; k < KS; ++k) { sp += (MCTX * D / 4);
#pragma unroll
                for (int j = 0; j < 8; ++j) yv[j] += sp[64 * j]; }
        }
#pragma unroll
        for (int j = 0; j < 8; ++j) { hv[j] = __builtin_convertvector(hp[64 * j], f32x4); ssy += (yv[j].x * yv[j].x + yv[j].y * yv[j].y) + (yv[j].z * yv[j].z + yv[j].w * yv[j].w); }
        const float rstd_y = 1.f / sqrtf(wave_sum(ssy) * (1.f / D) + EPS); float ssh = 0.f;
#pragma unroll
        for (int j = 0; j < 8; ++j) { const f32x4 g = G[cls * 512 + 64 * j + X.lane]; hv[j] = hv[j] + g * (yv[j] * rstd_y); ssh += (hv[j].x * hv[j].x + hv[j].y * hv[j].y) + (hv[j].z * hv[j].z + hv[j].w * hv[j].w); }
        if (MODE == 0) {
            const float rstd_h = 1.f / sqrtf(wave_sum(ssh) * (1.f / D) + EPS);
            unsigned long long* ap = (unsigned long long*)(a + (size_t)row * D) + X.lane;
#pragma unroll
            for (int j = 0; j < 8; ++j) { hp[64 * j] = __builtin_convertvector(hv[j], hfp4); const f32x4 av = A[cls * 512 + 64 * j + X.lane], sv = S[cls * 512 + 64 * j + X.lane]; const f32x4 o = hv[j] * rstd_h * av + sv;
                ap[64 * j] = (unsigned long long)pkbf(o.x, o.y) | ((unsigned long long)pkbf(o.z, o.w) << 32); }
        } else {
            f32x4* op = (f32x4*)(out + (size_t)row * D) + X.lane;
#pragma unroll
            for (int j = 0; j < 8; ++j) op[64 * j] = hv[j];
        }
    }
}
__device__ __forceinline__ void mla_rows(const Ctx& X, const bf16* Z, const float* g_q, const float* g_kv, const float* cosT, const float* sinT, bf16* CQN, bf16* CKVN, bf16* KPE) {
    for (int row = X.gw; row < M; row += X.ngw) {
        const bf16* z = Z + (size_t)row * 1280;
#pragma unroll
        for (int part = 0; part < 2; ++part) {
            const v4u w = *(const v4u*)(z + part * 512 + 8 * X.lane); float f[8]; unpack8(w, f); float ss = 0.f;
#pragma unroll
            for (int i = 0; i < 8; ++i) ss += f[i] * f[i];
            const float rstd = 1.f / sqrtf(wave_sum(ss) * (1.f / 512.f) + EPS); const float* g = (part ? g_kv : g_q) + 8 * X.lane;
            v4u o; o.x = pkbf(f[0] * rstd * g[0], f[1] * rstd * g[1]); o.y = pkbf(f[2] * rstd * g[2], f[3] * rstd * g[3]); o.z = pkbf(f[4] * rstd * g[4], f[5] * rstd * g[5]); o.w = pkbf(f[6] * rstd * g[6], f[7] * rstd * g[7]);
            *(v4u*)((part ? CKVN : CQN) + (size_t)row * 512 + 8 * X.lane) = o;
        }
        const float xv = bf1(z[1024 + X.lane]); float ov = xv;
        const float x1 = __shfl(xv, X.lane & ~16), x2 = __shfl(xv, X.lane | 16);
        if (row < MLAT) { const int s = row & 8191, pos = (X.lane >> 5) ? (s & 63) : (s >> 6), p = X.lane & 15; const float cs = cosT[pos * 16 + p], sn = sinT[pos * 16 + p];
            ov = (X.lane & 16) ? (x1 * sn + x2 * cs) : (x1 * cs - x2 * sn); }
        KPE[(size_t)row * 64 + X.lane] = (bf16)(pkbf(ov, 0.f) & 0xffffu);
    }
}
__device__ __forceinline__ void ml_rows(const Ctx& X, const bf16* Z, const float* conv_w, const float* b_gate, bf16* QK, float* G) {
    for (int row = X.gw; row < M; row += X.ngw) {
        bool hp, hn; if (row < MLAT) { const int s = row & 8191; hp = s > 0; hn = s < 8191; } else { const int n = (row - MLAT) & 255; hp = n > 0; hn = n < 255; }
        const bf16* z = Z + (size_t)row * 6400;
#pragma unroll
        for (int j = 0; j < 4; ++j) { const int col = 8 * X.lane + 512 * j;
            float x0[8], x1[8], x2[8]; const v4u zero = {0u, 0u, 0u, 0u};
            unpack8(hp ? *(const v4u*)(z - 6400 + col) : zero, x0); unpack8(*(const v4u*)(z + col), x1); unpack8(hn ? *(const v4u*)(z + 6400 + col) : zero, x2);
            float o[8];
#pragma unroll
            for (int i = 0; i < 8; ++i) { float v = conv_w[col + i] * x0[i] + conv_w[2048 + col + i] * x1[i] + conv_w[4096 + col + i] * x2[i]; v = v / (1.f + expf(-v)); o[i] = col < 1024 ? v * 0.08838834764831845f : v; }
            v4u w; w.x = pkbf(o[0], o[1]); w.y = pkbf(o[2], o[3]); w.z = pkbf(o[4], o[5]); w.w = pkbf(o[6], o[7]);
            *(v4u*)(QK + (size_t)row * 2048 + col) = w; }
        if (X.lane < 32) { float v = bf1(z[6144 + X.lane]) + b_gate[X.lane]; if ((X.lane >> 3) & 1) v = fminf(v, 0.f) - log1pf(expf(-fabsf(v))); G[(size_t)row * 32 + X.lane] = v; }
    }
}
__device__ __forceinline__ void ml_gate_rows(const Ctx& X, const bf16* Z, const bf16* HF, const bf16* HB, const float* g_head, bf16* O) {
    for (int row = X.gw; row < M; row += X.ngw) {
#pragma unroll
        for (int j = 0; j < 4; ++j) { const int col = 8 * X.lane + 512 * j;
            float a[8], b[8], g[8]; unpack8(*(const v4u*)(HF + (size_t)row * 2048 + col), a); unpack8(*(const v4u*)(HB + (size_t)row * 2048 + col), b); unpack8(*(const v4u*)(Z + (size_t)row * 6400 + 4096 + col), g);
            float ss = 0.f;
#pragma unroll
            for (int i = 0; i < 8; ++i) { a[i] += b[i]; ss += a[i] * a[i]; }
#pragma unroll
            for (int o = 1; o < 32; o <<= 1) ss += __shfl_xor(ss, o);
            const float rstd = 1.f / sqrtf(ss * (1.f / 256.f) + EPS); float o[8];
#pragma unroll
            for (int i = 0; i < 8; ++i) o[i] = a[i] * rstd * g_head[col + i] * sigmoidf_(g[i]);
            v4u w; w.x = pkbf(o[0], o[1]); w.y = pkbf(o[2], o[3]); w.z = pkbf(o[4], o[5]); w.w = pkbf(o[6], o[7]);
            *(v4u*)(O + (size_t)row * 2048 + col) = w; }
    }
}
#define ATT_UPDATE(sc, vptr) do { const float s_ = (sc); const float mn_ = fmaxf(m_run, s_); const float corr_ = __expf(m_run - mn_), p_ = __expf(s_ - mn_); l_run = l_run * corr_ + p_; m_run = mn_; \
    _Pragma("unroll") for (int c_ = 0; c_ < 4; ++c_) { float vf_[8]; unpack8(*(const v4u*)((vptr) + 8 * c_), vf_); _Pragma("unroll") for (int i_ = 0; i_ < 8; ++i_) o[8 * c_ + i_] = o[8 * c_ + i_] * corr_ + p_ * vf_[i_]; } } while (0)
__device__ __forceinline__ float dot32(const bf16* kp, const float* q) { float s = 0.f;
#pragma unroll
    for (int c = 0; c < 4; ++c) { float kf[8]; unpack8(*(const v4u*)(kp + 8 * c), kf);
#pragma unroll
        for (int i = 0; i < 8; ++i) s += q[8 * c + i] * kf[i]; }
    return s; }
__device__ __forceinline__ float quad_sum(float s) { s += __shfl_xor(s, 1); s += __shfl_xor(s, 2); return s; }
__device__ __forceinline__ void store_o32(bf16* op, const float* o, float inv) {
#pragma unroll
    for (int c = 0; c < 4; ++c) { v4u w; w.x = pkbf(o[8 * c] * inv, o[8 * c + 1] * inv); w.y = pkbf(o[8 * c + 2] * inv, o[8 * c + 3] * inv); w.z = pkbf(o[8 * c + 4] * inv, o[8 * c + 5] * inv); w.w = pkbf(o[8 * c + 6] * inv, o[8 * c + 7] * inv); *(v4u*)(op + 8 * c) = w; } }

__device__ __forceinline__ void na_attn_naive(const Ctx& X, const bf16* QKV, const float* rpb, bf16* O, int nrows) {
    const int hd = X.lane >> 2, j = X.lane & 3; const float scale = 0.08838834764831845f;
    for (int row = X.gw; row < nrows; row += X.ngw) {
        float q[32], o[32]; float m_run = -INFINITY, l_run = 0.f;
#pragma unroll
        for (int c = 0; c < 4; ++c) unpack8(*(const v4u*)(QKV + (size_t)row * 6144 + hd * 128 + 32 * j + 8 * c), q + 8 * c);
#pragma unroll
        for (int i = 0; i < 32; ++i) o[i] = 0.f;
        int b;
        if (row < MLAT) {
            b = row >> 13; const int s = row & 8191, r = s >> 6, c = s & 63;
            const int rs = min(max(r - 4, 0), 120), cs = min(max(c - 8, 0), 48);
            for (int jr = 0; jr < 8; ++jr) for (int jc = 0; jc < 16; ++jc) {
                const int kr = rs + jr, kc = cs + jc; const size_t key = (size_t)b * 8192 + kr * 64 + kc;
                const float bias = rpb[(hd * 15 + (kr - r + 7)) * 31 + (kc - c + 15)];
                const bf16* kp = QKV + key * 6144 + 2048 + hd * 128 + 32 * j;
                const float sc = quad_sum(dot32(kp, q)) * scale + bias;
                ATT_UPDATE(sc, kp + 2048);
            }
        } else b = (row - MLAT) >> 8;
        for (int n = 0; n < 256; ++n) {
            const size_t key = (size_t)MLAT + b * 256 + n; const bf16* kp = QKV + key * 6144 + 2048 + hd * 128 + 32 * j;
            const float sc = quad_sum(dot32(kp, q)) * scale;
            ATT_UPDATE(sc, kp + 2048);
        }
        store_o32(O + (size_t)row * 2048 + hd * 128 + 32 * j, o, 1.f / l_run);
    }
}
__device__ __forceinline__ void mla_attn_naive(const Ctx& X, const bf16* QH, const bf16* KV, const bf16* KPE, const float* cosT, const float* sinT, bf16* O) {
    const int hd = X.lane >> 2, j = X.lane & 3; const float scale = 0.07216878364870322f;
    for (int row = X.gw; row < M; row += X.ngw) {
        float q[32], qp[16], o[32]; float m_run = -INFINITY, l_run = 0.f;
        const bf16* qrow = QH + (size_t)row * 3072 + hd * 192;
#pragma unroll
        for (int c = 0; c < 4; ++c) unpack8(*(const v4u*)(qrow + 32 * j + 8 * c), q + 8 * c);
        {
            const int axis = j >> 1; float x1[16], x2[16];
            unpack8(*(const v4u*)(qrow + 128 + axis * 32), x1); unpack8(*(const v4u*)(qrow + 128 + axis * 32 + 8), x1 + 8);
            unpack8(*(const v4u*)(qrow + 128 + axis * 32 + 16), x2); unpack8(*(const v4u*)(qrow + 128 + axis * 32 + 24), x2 + 8);
            if (row < MLAT) { const int s = row & 8191, pos = axis ? (s & 63) : (s >> 6);
#pragma unroll
                for (int p = 0; p < 16; ++p) { const float cs = cosT[pos * 16 + p], sn = sinT[pos * 16 + p]; qp[p] = (j & 1) ? (x1[p] * sn + x2[p] * cs) : (x1[p] * cs - x2[p] * sn); }
            } else {
#pragma unroll
                for (int p = 0; p < 16; ++p) qp[p] = (j & 1) ? x2[p] : x1[p];
            }
        }
#pragma unroll
        for (int i = 0; i < 32; ++i) o[i] = 0.f;
        const int b = row < MLAT ? (row >> 13) : ((row - MLAT) >> 8);
        const int nkeys = row < MLAT ? (256 + 8192) : 256;
        for (int n = 0; n < nkeys; ++n) {
            const size_t key = n < 256 ? (size_t)MLAT + b * 256 + n : (size_t)b * 8192 + (n - 256);
            const bf16* kp = KV + key * 4096 + hd * 256 + 32 * j; const bf16* pp = KPE + key * 64 + 16 * j;
            float s = dot32(kp, q); float kf[16]; unpack8(*(const v4u*)(pp), kf); unpack8(*(const v4u*)(pp + 8), kf + 8);
#pragma unroll
            for (int p = 0; p < 16; ++p) s += qp[p] * kf[p];
            const float sc = quad_sum(s) * scale;
            ATT_UPDATE(sc, kp + 128);
        }
        store_o32(O + (size_t)row * 2048 + hd * 128 + 32 * j, o, 1.f / l_run);
    }
}
__device__ __forceinline__ void ml_scan_naive(const Ctx& X, const bf16* QK, const bf16* Z, const float* G, bf16* HF, bf16* HB) {
    LAS float* L = (LAS float*)X.lds;
    LAS float* q = L; LAS float* k = L + 8256; LAS float* v = L + 16512; LAS float* S = L + 18624; LAS float* C = L + 22784; LAS float* nv = L + 27008;
    LAS float* li = L + 27136; LAS float* lf = L + 27200; LAS float* bc = L + 27264; LAS float* mt = L + 27328; LAS float* ex = L + 27392; LAS float* misc = L + 27456;
    const int tid = X.tid, t = tid >> 3, part = tid & 7;
    for (int u = blockIdx.x; u < 256; u += gridDim.x) {
        const int slice = u & 7, dir = (u >> 3) & 1, hd = (u >> 4) & 7, b = u >> 7;
        for (int i = tid; i < 128 * 33; i += NTHR) C[i] = 0.f;
        if (tid < 128) nv[tid] = 0.f;
        float m_run = 0.f;
        bf16* H = dir ? HB : HF;
        __syncthreads();
        for (int n = 0; n < 132; ++n) {
            int base;
            if (dir == 0) base = n < 4 ? MLAT + b * 256 + 64 * n : b * 8192 + 64 * (n - 4);
            else base = n < 4 ? MLAT + b * 256 + 64 * (3 - n) : b * 8192 + 64 * (131 - n);
            const int row = base + (dir ? 63 - t : t);
            {
                float f[16];
                unpack8(*(const v4u*)(QK + (size_t)row * 2048 + hd * 128 + part * 16), f); unpack8(*(const v4u*)(QK + (size_t)row * 2048 + hd * 128 + part * 16 + 8), f + 8);
#pragma unroll
                for (int i = 0; i < 16; ++i) q[t * 129 + part * 16 + i] = f[i];
                unpack8(*(const v4u*)(QK + (size_t)row * 2048 + 1024 + hd * 128 + part * 16), f); unpack8(*(const v4u*)(QK + (size_t)row * 2048 + 1024 + hd * 128 + part * 16 + 8), f + 8);
#pragma unroll
                for (int i = 0; i < 16; ++i) k[t * 129 + part * 16 + i] = f[i];
                const unsigned long long w = *(const unsigned long long*)(Z + (size_t)row * 6400 + 2048 + hd * 256 + slice * 32 + part * 4); const unsigned lo = (unsigned)w, hi = (unsigned)(w >> 32);
                v[t * 33 + part * 4 + 0] = bf_lo(lo); v[t * 33 + part * 4 + 1] = bf_hi(lo); v[t * 33 + part * 4 + 2] = bf_lo(hi); v[t * 33 + part * 4 + 3] = bf_hi(hi);
                if (tid < 64) { const int row2 = base + (dir ? 63 - tid : tid); li[tid] = G[(size_t)row2 * 32 + dir * 16 + hd]; lf[tid] = G[(size_t)row2 * 32 + dir * 16 + 8 + hd]; }
            }
            __syncthreads();
            if (tid == 0) {
                float bsum = 0.f, pm = -INFINITY;
                for (int s = 0; s < 64; ++s) { bsum += lf[s]; bc[s] = bsum; pm = fmaxf(pm, li[s] - bsum); mt[s] = bsum + fmaxf(m_run, pm); }
                const float m_new = bsum + fmaxf(m_run, pm); misc[0] = m_new; misc[1] = expf(bsum + m_run - m_new);
                for (int s = 0; s < 64; ++s) ex[s] = expf(bsum - bc[s] + li[s] - m_new);
            }
            __syncthreads();
            {
                const float bt = bc[t], mtt = mt[t];
                for (int i = 0; i < 8; ++i) { const int s = part + 8 * i; float r = 0.f;
                    if (s <= t) { float dsum = 0.f; for (int d = 0; d < 128; ++d) dsum += q[t * 129 + d] * k[s * 129 + d]; r = dsum * expf(bt - bc[s] + li[s] - mtt); }
                    S[t * 65 + s] = r; }
            }
            __syncthreads();
            {
                const float mtt = mt[t], winter = expf(bc[t] + m_run - mtt);
                float den = 0.f; for (int d = 0; d < 128; ++d) den += q[t * 129 + d] * nv[d];
                den *= winter; for (int s = 0; s < 64; ++s) den += S[t * 65 + s];
                const float dn = fmaxf(fabsf(den), expf(-mtt)); float hv[4];
#pragma unroll
                for (int i = 0; i < 4; ++i) { const int e = part * 4 + i; float a = 0.f; for (int d = 0; d < 128; ++d) a += q[t * 129 + d] * C[d * 33 + e];
                    a *= winter; for (int s = 0; s < 64; ++s) a += S[t * 65 + s] * v[s * 33 + e]; hv[i] = a / dn; }
                *(unsigned long long*)(H + (size_t)row * 2048 + hd * 256 + slice * 32 + part * 4) = (unsigned long long)pkbf(hv[0], hv[1]) | ((unsigned long long)pkbf(hv[2], hv[3]) << 32);
            }
            __syncthreads();
            { const float e = ex[t];
#pragma unroll
              for (int i = 0; i < 16; ++i) k[t * 129 + part * 16 + i] *= e; }
            __syncthreads();
            {
                const int d = tid >> 2, eg = (tid & 3) * 8; const float decay = misc[1];
#pragma unroll
                for (int i = 0; i < 8; ++i) { const int e = eg + i; float a = 0.f; for (int s = 0; s < 64; ++s) a += k[s * 129 + d] * v[s * 33 + e]; C[d * 33 + e] = decay * C[d * 33 + e] + a; }
                if ((tid & 3) == 0) { float a = 0.f; for (int s = 0; s < 64; ++s) a += k[s * 129 + d]; nv[d] = decay * nv[d] + a; }
                m_run = misc[0];
            }
            __syncthreads();
        }
    }
}

namespace fa {
using f32x16 = __attribute__((ext_vector_type(16))) float;
using s16x4  = __attribute__((ext_vector_type(4))) short;
#define FA_KSWZ(row, colB) ((row) * 256 + ((colB) ^ (((row) & 7) << 4)))
#define FA_PSWZ(row, colB) ((row) * 128 + ((colB) ^ (((row) & 7) << 4)))
#define FA_SBAR() __builtin_amdgcn_sched_barrier(0)
__device__ __forceinline__ int crow(int r, int hi) { return (r & 3) + 8 * (r >> 2) + 4 * hi; }
__device__ __forceinline__ unsigned cvtpk(float lo, float hi) { return pg8::cvt_pk_bf16(lo, hi); }
constexpr float THR = 8.f;
__device__ __forceinline__ void partialSM(f32x16& p0, f32x16& p1, float& m_reg, float& mn, float& alpha, const float SCALE) {
  const float C = SCALE * 1.4426950408889634f;
  float pmax = p0[0];
#pragma unroll
  for (int r = 1; r < 16; ++r) pmax = fmaxf(pmax, p0[r]);
#pragma unroll
  for (int r = 0; r < 16; ++r) pmax = fmaxf(pmax, p1[r]);
  { auto rr = __builtin_amdgcn_permlane32_swap(__float_as_uint(pmax), __float_as_uint(pmax), false, false);
    pmax = fmaxf(__uint_as_float(rr[0]), __uint_as_float(rr[1])); }
  if (__builtin_expect(__all(pmax - m_reg <= THR / SCALE), 1)) { mn = m_reg; alpha = 1.f; }
  else { mn = fmaxf(m_reg, pmax); alpha = __builtin_amdgcn_exp2f((m_reg - mn) * C); m_reg = mn; }
  const float mnC = -mn * C;
#pragma unroll
  for (int r = 0; r < 16; ++r) p0[r] = fmaf(p0[r], C, mnC);
#pragma unroll
  for (int r = 0; r < 16; ++r) p1[r] = fmaf(p1[r], C, mnC);
#pragma unroll
  for (int r = 0; r < 16; ++r) p0[r] = __builtin_amdgcn_exp2f(p0[r]);
}
__device__ __forceinline__ void finishSM(f32x16& p0, f32x16& p1, float alpha, float& l_reg, bf16x8& pa0, bf16x8& pa1, bf16x8& pa2, bf16x8& pa3) {
#pragma unroll
  for (int r = 0; r < 16; ++r) p1[r] = __builtin_amdgcn_exp2f(p1[r]);
  float ps = 0;
#pragma unroll
  for (int r = 0; r < 16; ++r) ps += p0[r];
#pragma unroll
  for (int r = 0; r < 16; ++r) ps += p1[r];
  { auto rr = __builtin_amdgcn_permlane32_swap(__float_as_uint(ps), __float_as_uint(ps), false, false);
    ps = __uint_as_float(rr[0]) + __uint_as_float(rr[1]); }
  l_reg = l_reg * alpha + ps;
#define FA_PK4(P, BASE, OUT) do { unsigned a0 = cvtpk(P[BASE + 0], P[BASE + 1]), a1 = cvtpk(P[BASE + 2], P[BASE + 3]);   \
    unsigned b0 = cvtpk(P[BASE + 4], P[BASE + 5]), b1 = cvtpk(P[BASE + 6], P[BASE + 7]);                              \
    auto r0 = __builtin_amdgcn_permlane32_swap(a0, b0, false, false); auto r1 = __builtin_amdgcn_permlane32_swap(a1, b1, false, false); \
    v4u w = {r0[0], r1[0], r0[1], r1[1]}; OUT = __builtin_bit_cast(bf16x8, w); } while (0)
  FA_PK4(p0, 0, pa0); FA_PK4(p0, 8, pa1); FA_PK4(p1, 0, pa2); FA_PK4(p1, 8, pa3);
#undef FA_PK4
}
__device__ __forceinline__ int v_st(int k, int c) { const int kk = (k & ~0xC) | ((k & 4) << 1) | ((k & 8) >> 1); return ((kk >> 3) * 4 + (c >> 5)) * 512 + ((kk & 7) * 32 + (c & 31)) * 2; }
__device__ __forceinline__ int v_rd_base(int lane) { return ((lane & 3) << 3) | (((lane >> 2) & 3) << 6) | (((lane >> 4) & 1) << 5) | (((lane >> 5) & 1) << 8); }
constexpr int v_rd_off(int d0, int ks, int half) { return d0 * 512 + ks * 4096 + half * 2048; }
template <int OFF> __device__ __forceinline__ s16x4 tr_read(int vb) {
  s16x4 r; asm volatile("ds_read_b64_tr_b16 %0, %1 offset:%2" : "=&v"(r) : "v"(vb), "i"(OFF) : "memory"); return r;
}
template <int D0> __device__ __forceinline__ void pv_one(f32x16& od, int vb, bf16x8 pa0, bf16x8 pa1, bf16x8 pa2, bf16x8 pa3) {
  const s16x4 l0 = tr_read<v_rd_off(D0, 0, 0)>(vb), h0 = tr_read<v_rd_off(D0, 0, 1)>(vb), l1 = tr_read<v_rd_off(D0, 1, 0)>(vb), h1 = tr_read<v_rd_off(D0, 1, 1)>(vb);
  const s16x4 l2 = tr_read<v_rd_off(D0, 2, 0)>(vb), h2 = tr_read<v_rd_off(D0, 2, 1)>(vb), l3 = tr_read<v_rd_off(D0, 3, 0)>(vb), h3 = tr_read<v_rd_off(D0, 3, 1)>(vb);
  asm volatile("s_waitcnt lgkmcnt(0)" ::: "memory"); FA_SBAR();
#define FA_PK(L, H) (bf16x8){L[0], L[1], L[2], L[3], H[0], H[1], H[2], H[3]}
  od = __builtin_amdgcn_mfma_f32_32x32x16_bf16(pa0, FA_PK(l0, h0), od, 0, 0, 0);
  od = __builtin_amdgcn_mfma_f32_32x32x16_bf16(pa1, FA_PK(l1, h1), od, 0, 0, 0);
  od = __builtin_amdgcn_mfma_f32_32x32x16_bf16(pa2, FA_PK(l2, h2), od, 0, 0, 0);
  od = __builtin_amdgcn_mfma_f32_32x32x16_bf16(pa3, FA_PK(l3, h3), od, 0, 0, 0);
#undef FA_PK
}
__device__ __forceinline__ void pv_d0(f32x16* o, int vb, bf16x8 pa0, bf16x8 pa1, bf16x8 pa2, bf16x8 pa3) {
  pv_one<0>(o[0], vb, pa0, pa1, pa2, pa3); pv_one<1>(o[1], vb, pa0, pa1, pa2, pa3); pv_one<2>(o[2], vb, pa0, pa1, pa2, pa3); pv_one<3>(o[3], vb, pa0, pa1, pa2, pa3);
}
constexpr int SHM_V = 16384, SHM_K = 16384, SHM_P = 8192, OFF_V = 0, OFF_K = 49152, OFF_P = 98304, OFF_WS = 122880, OFF_QP = 124928;
#define FA_DMA(gp, lp) __builtin_amdgcn_global_load_lds((const unsigned*)(gp), (LAS unsigned*)(lp), 16, 0, 0)

__device__ __forceinline__ void mla_unit(LAS unsigned char* lds, const bf16* __restrict__ QH, const bf16* __restrict__ KV, const bf16* __restrict__ KPE, const float* __restrict__ cosT, const float* __restrict__ sinT,
                                         bf16* __restrict__ O, const int qrow0, const bool latq, const int b, const int h) {
  constexpr float SCALE = 0.07216878364870322f;
  int tid_ = threadIdx.x; asm volatile("" : "+v"(tid_));
  const int tid = tid_, wid = __builtin_amdgcn_readfirstlane(tid >> 6), lane = tid & 63, r32 = lane & 31, hi = lane >> 5;
  LAS char* V_lds = (LAS char*)lds + OFF_V; LAS char* K_lds = (LAS char*)lds + OFF_K; LAS char* P_lds = (LAS char*)lds + OFF_P;
  LAS float* ws = (LAS float*)(lds + OFF_WS) + wid * 64; LAS float* li_l = ws; LAS float* al_l = ws + 32;
  unsigned offK[2], offV[2], offP;
#pragma unroll
  for (int i = 0; i < 2; ++i) { const int Lb = (2 * wid + i) * 1024 + 16 * lane;
    { const int row = Lb >> 8, colB = (Lb & 255) ^ ((row & 7) << 4); offK[i] = (unsigned)(row * 4096 + (colB >> 1)) * 2u; }
    { const int sub = Lb >> 9, w_ = Lb & 511, kk = (sub >> 2) * 8 + (w_ >> 6), c = (sub & 3) * 32 + ((w_ & 63) >> 1), k = (kk & ~0xC) | ((kk & 4) << 1) | ((kk & 8) >> 1); offV[i] = (unsigned)(k * 4096 + 128 + c) * 2u; } }
  { const int Lb = wid * 1024 + 16 * lane, row = Lb >> 7, colB = (Lb & 127) ^ ((row & 7) << 4); offP = (unsigned)(row * 64 + (colB >> 1)) * 2u; }
  const int NT = latq ? 132 : 4;
  const int ctx0 = MLAT + b * 256, lat0 = b * 8192 - 256;
  const bf16* KVh = KV + h * 256;
#define DMA_STEP(tk, tv, sK, sV) do { const int tk_ = (tk) < NT ? (tk) : NT - 1, tv_ = (tv) < NT ? (tv) : NT - 1; const int kb_ = (tk_ < 4 ? ctx0 : lat0) + 64 * tk_, vb_ = (tv_ < 4 ? ctx0 : lat0) + 64 * tv_; \
    const char* gk_ = (const char*)(KVh + (size_t)kb_ * 4096); const char* gp_ = (const char*)(KPE + (size_t)kb_ * 64); const char* gv_ = (const char*)(KVh + (size_t)vb_ * 4096); \
    FA_DMA(gk_ + offK[0], K_lds + (sK) * SHM_K + (2 * wid) * 1024); FA_DMA(gk_ + offK[1], K_lds + (sK) * SHM_K + (2 * wid + 1) * 1024); FA_DMA(gp_ + offP, P_lds + (sK) * SHM_P + wid * 1024); \
    FA_DMA(gv_ + offV[0], V_lds + (sV) * SHM_V + (2 * wid) * 1024); FA_DMA(gv_ + offV[1], V_lds + (sV) * SHM_V + (2 * wid + 1) * 1024); } while (0)
  DMA_STEP(0, 0, 0, 0); DMA_STEP(1, 0, 1, 2);
  float m_reg = -1e30f, l_reg = 0; f32x16 o[4] = {}; bf16x8 qr[12];
  const int qrow = qrow0 + wid * 32 + r32;
  const bf16* Qw = QH + (size_t)qrow * 3072 + h * 192 + hi * 8;
#pragma unroll
  for (int d0 = 0; d0 < 12; ++d0) qr[d0] = *(const bf16x8*)(Qw + d0 * 16);
  if (latq) {
    const int s = qrow & 8191;
#pragma unroll
    for (int ax = 0; ax < 2; ++ax) { const int pos = ax ? (s & 63) : (s >> 6); const float* ct = cosT + pos * 16 + 8 * hi; const float* st = sinT + pos * 16 + 8 * hi;
      float x1[8], x2[8]; unpack8(__builtin_bit_cast(v4u, qr[8 + 2 * ax]), x1); unpack8(__builtin_bit_cast(v4u, qr[9 + 2 * ax]), x2); float y1[8], y2[8];
#pragma unroll
      for (int i = 0; i < 8; ++i) { const float cs = ct[i], sn = st[i]; y1[i] = x1[i] * cs - x2[i] * sn; y2[i] = x1[i] * sn + x2[i] * cs; }
      const v4u w1 = {cvtpk(y1[0], y1[1]), cvtpk(y1[2], y1[3]), cvtpk(y1[4], y1[5]), cvtpk(y1[6], y1[7])}, w2 = {cvtpk(y2[0], y2[1]), cvtpk(y2[2], y2[3]), cvtpk(y2[4], y2[5]), cvtpk(y2[6], y2[7])};
      qr[8 + 2 * ax] = __builtin_bit_cast(bf16x8, w1); qr[9 + 2 * ax] = __builtin_bit_cast(bf16x8, w2); }
  }
  const int zsw = ((r32 & 7) ^ hi) << 4;
  const LAS char* kA0 = K_lds + r32 * 256 + (0 ^ zsw); const LAS char* kA1 = K_lds + r32 * 256 + (32 ^ zsw); const LAS char* kA2 = K_lds + r32 * 256 + (64 ^ zsw); const LAS char* kA3 = K_lds + r32 * 256 + (96 ^ zsw);
  const LAS char* pA0_ = P_lds + r32 * 128 + (0 ^ zsw); const LAS char* pA1_ = P_lds + r32 * 128 + (32 ^ zsw); const LAS char* pA2_ = P_lds + r32 * 128 + (64 ^ zsw); const LAS char* pA3_ = P_lds + r32 * 128 + (96 ^ zsw);
  const int vb0 = (int)(unsigned)(uintptr_t)V_lds + v_rd_base(lane);
#define QK1(p0, p1, KA, OFF, QV) do { const bf16x8 b0 = *(const LAS bf16x8*)((KA) + (OFF)); const bf16x8 b1 = *(const LAS bf16x8*)((KA) + (OFF) + 8192); \
    p0 = __builtin_amdgcn_mfma_f32_32x32x16_bf16(b0, QV, p0, 0, 0, 0); p1 = __builtin_amdgcn_mfma_f32_32x32x16_bf16(b1, QV, p1, 0, 0, 0); } while (0)
#define QP1(p0, p1, PA, OFF, QV) do { const bf16x8 b0 = *(const LAS bf16x8*)((PA) + (OFF)); const bf16x8 b1 = *(const LAS bf16x8*)((PA) + (OFF) + 4096); \
    p0 = __builtin_amdgcn_mfma_f32_32x32x16_bf16(b0, QV, p0, 0, 0, 0); p1 = __builtin_amdgcn_mfma_f32_32x32x16_bf16(b1, QV, p1, 0, 0, 0); } while (0)
#define QKT(p0, p1, s) do { p0 = f32x16{}; p1 = f32x16{}; const int ko_ = (s) * SHM_K, po_ = (s) * SHM_P; \
    QK1(p0, p1, kA0, ko_, qr[0]); QK1(p0, p1, kA1, ko_, qr[1]); QK1(p0, p1, kA2, ko_, qr[2]); QK1(p0, p1, kA3, ko_, qr[3]); \
    QK1(p0, p1, kA0, ko_ + 128, qr[4]); QK1(p0, p1, kA1, ko_ + 128, qr[5]); QK1(p0, p1, kA2, ko_ + 128, qr[6]); QK1(p0, p1, kA3, ko_ + 128, qr[7]); \
    QP1(p0, p1, pA0_, po_, qr[8]); QP1(p0, p1, pA1_, po_, qr[9]); QP1(p0, p1, pA2_, po_, qr[10]); QP1(p0, p1, pA3_, po_, qr[11]); } while (0)
#define RESC(a) do { if (__any((a) < 1.f)) { if (hi == 0) al_l[r32] = (a); asm volatile("s_waitcnt lgkmcnt(0)" ::: "memory"); \
    _Pragma("unroll") for (int d = 0; d < 4; ++d) _Pragma("unroll") for (int r = 0; r < 16; ++r) o[d][r] *= al_l[crow(r, hi)]; } } while (0)
#define STEP_END() do { asm volatile("s_waitcnt vmcnt(5) lgkmcnt(0)" ::: "memory"); __builtin_amdgcn_s_barrier(); asm volatile("" ::: "memory"); } while (0)
  f32x16 pA0, pA1, pB0, pB1; float mnA, mnB, alA, alB; bf16x8 pa0, pa1, pa2, pa3;
  STEP_END();
  int s0 = 0, s1 = 1, s2 = 2;
  DMA_STEP(2, 1, s2, s1);
  QKT(pA0, pA1, s0); partialSM(pA0, pA1, m_reg, mnA, alA, SCALE);
  STEP_END();
  for (int j = 1; j + 1 < NT; j += 2) {
    { const int t_ = s0; s0 = s1; s1 = s2; s2 = t_; }
    DMA_STEP(j + 2, j + 1, s2, s1);
    FA_SBAR(); QKT(pB0, pB1, s0);
    finishSM(pA0, pA1, alA, l_reg, pa0, pa1, pa2, pa3); FA_SBAR();
    pv_d0(o, vb0 + s2 * SHM_V, pa0, pa1, pa2, pa3); partialSM(pB0, pB1, m_reg, mnB, alB, SCALE);
    RESC(alB); STEP_END();
    { const int t_ = s0; s0 = s1; s1 = s2; s2 = t_; }
    DMA_STEP(j + 3, j + 2, s2, s1);
    FA_SBAR(); QKT(pA0, pA1, s0);
    finishSM(pB0, pB1, alB, l_reg, pa0, pa1, pa2, pa3); FA_SBAR();
    pv_d0(o, vb0 + s2 * SHM_V, pa0, pa1, pa2, pa3); partialSM(pA0, pA1, m_reg, mnA, alA, SCALE);
    RESC(alA); STEP_END();
  }
  { const int t_ = s0; s0 = s1; s1 = s2; s2 = t_; }
  DMA_STEP(NT, NT, s2, s1);
  FA_SBAR(); QKT(pB0, pB1, s0);
  finishSM(pA0, pA1, alA, l_reg, pa0, pa1, pa2, pa3); FA_SBAR();
  pv_d0(o, vb0 + s2 * SHM_V, pa0, pa1, pa2, pa3); partialSM(pB0, pB1, m_reg, mnB, alB, SCALE);
  RESC(alB); asm volatile("s_waitcnt vmcnt(0) lgkmcnt(0)" ::: "memory"); __builtin_amdgcn_s_barrier(); asm volatile("" ::: "memory");
  finishSM(pB0, pB1, alB, l_reg, pa0, pa1, pa2, pa3); FA_SBAR();
  pv_d0(o, vb0 + s0 * SHM_V, pa0, pa1, pa2, pa3);
  if (hi == 0) li_l[r32] = l_reg; asm volatile("s_waitcnt lgkmcnt(0)" ::: "memory");
  bf16* Ow = O + (size_t)(qrow0 + wid * 32) * 2048 + h * 128 + r32;
#pragma unroll
  for (int r = 0; r < 16; ++r) { const int orow = crow(r, hi); const float rli = __builtin_amdgcn_rcpf(li_l[orow]);
#pragma unroll
    for (int d0 = 0; d0 < 4; ++d0) Ow[(size_t)orow * 2048 + d0 * 32] = (bf16)(cvtpk(o[d0][r] * rli, 0.f) & 0xffffu); }
  asm volatile("s_waitcnt vmcnt(0)" ::: "memory"); __syncthreads();
#undef DMA_STEP
#undef QKT
#undef QK1
#undef QP1
#undef RESC
#undef STEP_END
}
__device__ __forceinline__ void mla_attn_phase(LAS unsigned char* lds, const bf16* QH, const bf16* KV, const bf16* KPE, const float* cosT, const float* sinT, bf16* O) {
  const int G = gridDim.x, bx = blockIdx.x;
  const int nu = (G == 256) ? (bx < 32 ? 5 : 4) : (1056 - bx + G - 1) / G;
  for (int i = 0; i < nu; ++i) {
    int bh, q0; bool latq;
    if (G == 256) { if (i < 4) { bh = i * 8 + (bx & 7); q0 = (bh >> 4) * 8192 + (bx >> 3) * 256; latq = true; } else { bh = bx; q0 = MLAT + (bh >> 4) * 256; latq = false; } }
    else { const int u = bx + i * G; if (u < 1024) { bh = u >> 5; q0 = (bh >> 4) * 8192 + (u & 31) * 256; latq = true; } else { bh = u - 1024; q0 = MLAT + (bh >> 4) * 256; latq = false; } }
    mla_unit(lds, QH, KV, KPE, cosT, sinT, O, q0, latq, bh >> 4, bh & 15);
  }
}

__device__ __forceinline__ void na_unit(LAS unsigned char* lds, const bf16* __restrict__ QKV, const float* __restrict__ rpb_h, bf16* __restrict__ O, const int qrow0, const bool ctxq, const int b, const int h, const int r0) {
  constexpr float SCALE = 0.08838834764831845f, ISCALE = 11.313708498984761f;
  const int tid = threadIdx.x, wid = __builtin_amdgcn_readfirstlane(tid >> 6), lane = tid & 63, r32 = lane & 31, hi = lane >> 5;
  LAS char* V_lds = (LAS char*)lds + OFF_V; LAS char* K_lds = (LAS char*)lds + OFF_K;
  LAS float* ws = (LAS float*)(lds + OFF_WS) + wid * 64; LAS float* li_l = ws; LAS float* al_l = ws + 32;
  LAS float* rpbL = (LAS float*)(lds + OFF_QP + 1024);
  unsigned offK[2], offV[2];
#pragma unroll
  for (int i = 0; i < 2; ++i) { const int Lb = (2 * wid + i) * 1024 + 16 * lane;
    { const int row = Lb >> 8, colB = (Lb & 255) ^ ((row & 7) << 4); offK[i] = (unsigned)(row * 6144 + (colB >> 1)) * 2u; }
    { const int sub = Lb >> 9, w_ = Lb & 511, kk = (sub >> 2) * 8 + (w_ >> 6), c = (sub & 3) * 32 + ((w_ & 63) >> 1), k = (kk & ~0xC) | ((kk & 4) << 1) | ((kk & 8) >> 1); offV[i] = (unsigned)(k * 6144 + c) * 2u; } }
  const int R0 = min(max(r0 - 4, 0), 120), R1 = min(max(r0 + 3 - 4, 0), 120) + 7;
  const int nW = ctxq ? 0 : (R1 - R0 + 1), NT = nW + 4;
  const int wbase = b * 8192 + R0 * 64, cbase = MLAT + b * 256;
  const bf16* Kh = QKV + 2048 + h * 128; const bf16* Vh = QKV + 4096 + h * 128;
#define NA_KB(t) (((t) < nW) ? wbase + 64 * (t) : cbase + 64 * ((t) - nW))
#define DMA_K(t, bf) do { const int tt_ = (t) < NT ? (t) : NT - 1; const char* gk_ = (const char*)(Kh + (size_t)NA_KB(tt_) * 6144); FA_DMA(gk_ + offK[0], K_lds + (bf) * SHM_K + (2 * wid) * 1024); FA_DMA(gk_ + offK[1], K_lds + (bf) * SHM_K + (2 * wid + 1) * 1024); } while (0)
#define DMA_V(t, bf) do { const int tt_ = (t) < NT ? (t) : NT - 1; const char* gv_ = (const char*)(Vh + (size_t)NA_KB(tt_) * 6144); FA_DMA(gv_ + offV[0], V_lds + (bf) * SHM_V + (2 * wid) * 1024); FA_DMA(gv_ + offV[1], V_lds + (bf) * SHM_V + (2 * wid + 1) * 1024); } while (0)
  DMA_K(0, 0); DMA_V(0, 0); DMA_K(1, 1); DMA_V(1, 1);
  if (!ctxq) for (int i = tid; i < 15 * 31; i += NTHR) rpbL[i] = rpb_h[i] * ISCALE;
  float m_reg = -1e30f, l_reg = 0; f32x16 o[4] = {}; bf16x8 qr[8];
  const int qrow = qrow0 + wid * 32 + r32;
  const bf16* Qw = QKV + (size_t)qrow * 6144 + h * 128 + hi * 8;
#pragma unroll
  for (int d0 = 0; d0 < 8; ++d0) qr[d0] = *(const bf16x8*)(Qw + d0 * 16);
  const int vb0 = (int)(unsigned)(uintptr_t)V_lds + v_rd_base(lane);
  const int zsw = ((r32 & 7) ^ hi) << 4;
  const LAS char* kA0 = K_lds + r32 * 256 + (0 ^ zsw); const LAS char* kA1 = K_lds + r32 * 256 + (32 ^ zsw); const LAS char* kA2 = K_lds + r32 * 256 + (64 ^ zsw); const LAS char* kA3 = K_lds + r32 * 256 + (96 ^ zsw);
  const int rq = r0 + (wid >> 1), wa = ctxq ? 0 : (min(max(rq - 4, 0), 120) - R0), we = ctxq ? 0 : wa + 8;
  const int cq = 32 * (wid & 1) + r32, cs = min(max(cq - 8, 0), 48);
#define ACT(t) ((t) < NT && ((t) >= nW || ((t) >= wa && (t) < we)))
#define QK1(p0, p1, KA, OFF, QV) do { const bf16x8 b0 = *(const LAS bf16x8*)((KA) + (OFF)); const bf16x8 b1 = *(const LAS bf16x8*)((KA) + (OFF) + 8192); \
    p0 = __builtin_amdgcn_mfma_f32_32x32x16_bf16(b0, QV, p0, 0, 0, 0); p1 = __builtin_amdgcn_mfma_f32_32x32x16_bf16(b1, QV, p1, 0, 0, 0); } while (0)
#define QKT(p0, p1, t, bf) do { if ((t) < nW) { const int dr_ = R0 + (t) - rq + 7; const LAS float* bp_ = rpbL + dr_ * 31 + (15 - cq) + 4 * hi; \
      _Pragma("unroll") for (int i_ = 0; i_ < 16; ++i_) { const int kc_ = crow(i_, hi); const float v0_ = bp_[8 * (i_ >> 2) + (i_ & 3)], v1_ = bp_[32 + 8 * (i_ >> 2) + (i_ & 3)]; \
        p0[i_] = (kc_ >= cs && kc_ < cs + 16) ? v0_ : -INFINITY; p1[i_] = (kc_ + 32 >= cs && kc_ + 32 < cs + 16) ? v1_ : -INFINITY; } } else { p0 = f32x16{}; p1 = f32x16{}; } \
    QK1(p0, p1, kA0, (bf) * SHM_K, qr[0]); QK1(p0, p1, kA1, (bf) * SHM_K, qr[1]); QK1(p0, p1, kA2, (bf) * SHM_K, qr[2]); QK1(p0, p1, kA3, (bf) * SHM_K, qr[3]); \
    QK1(p0, p1, kA0, (bf) * SHM_K + 128, qr[4]); QK1(p0, p1, kA1, (bf) * SHM_K + 128, qr[5]); QK1(p0, p1, kA2, (bf) * SHM_K + 128, qr[6]); QK1(p0, p1, kA3, (bf) * SHM_K + 128, qr[7]); } while (0)
#define RESC(a) do { if (__any((a) < 1.f)) { if (hi == 0) al_l[r32] = (a); asm volatile("s_waitcnt lgkmcnt(0)" ::: "memory"); \
    _Pragma("unroll") for (int d = 0; d < 4; ++d) _Pragma("unroll") for (int r = 0; r < 16; ++r) o[d][r] *= al_l[crow(r, hi)]; } } while (0)
#define STEP_END() do { FA_SBAR(); asm volatile("s_waitcnt vmcnt(4) lgkmcnt(0)" ::: "memory"); __builtin_amdgcn_s_barrier(); asm volatile("" ::: "memory"); } while (0)
  f32x16 pA0, pA1; float mnA, alA = 1.f; bf16x8 pa0, pa1, pa2, pa3;
  STEP_END();
  int s0 = 0, s1 = 1, s2 = 2;
  for (int t = 0; t < NT; ++t) {
    DMA_K(t + 2, s2); DMA_V(t + 2, s2);
    FA_SBAR();
    if (ACT(t)) { QKT(pA0, pA1, t, s0); partialSM(pA0, pA1, m_reg, mnA, alA, SCALE); RESC(alA);
      finishSM(pA0, pA1, alA, l_reg, pa0, pa1, pa2, pa3); FA_SBAR(); pv_d0(o, vb0 + s0 * SHM_V, pa0, pa1, pa2, pa3); }
    STEP_END();
    { const int t_ = s0; s0 = s1; s1 = s2; s2 = t_; }
  }
  asm volatile("s_waitcnt vmcnt(0)" ::: "memory");
  if (hi == 0) li_l[r32] = l_reg; asm volatile("s_waitcnt lgkmcnt(0)" ::: "memory");
  bf16* Ow = O + (size_t)(qrow0 + wid * 32) * 2048 + h * 128 + r32;
#pragma unroll
  for (int r = 0; r < 16; ++r) { const int orow = crow(r, hi); const float rli = __builtin_amdgcn_rcpf(li_l[orow]);
#pragma unroll
    for (int d0 = 0; d0 < 4; ++d0) Ow[(size_t)orow * 2048 + d0 * 32] = (bf16)(cvtpk(o[d0][r] * rli, 0.f) & 0xffffu); }
  __syncthreads();
#undef NA_KB
#undef DMA_K
#undef DMA_V
#undef ACT
#undef QK1
#undef QKT
#undef RESC
#undef STEP_END
}
__device__ __forceinline__ void na_attn_phase(LAS unsigned char* lds, const bf16* QKV, const float* rpb, bf16* O, const bool need_ctx) {
  const int G = gridDim.x, bx = blockIdx.x; const int ntot = need_ctx ? 1056 : 1024;
  const int nu = (G == 256) ? ((need_ctx && bx < 32) ? 5 : 4) : (ntot - bx + G - 1) / G;
  for (int i = 0; i < nu; ++i) {
    int bh, q0, r0; bool ctxq;
    if (G == 256) { if (i < 4) { bh = i * 8 + (bx & 7); r0 = (bx >> 3) * 4; q0 = (bh >> 4) * 8192 + r0 * 64; ctxq = false; } else { bh = bx; r0 = 0; q0 = MLAT + (bh >> 4) * 256; ctxq = true; } }
    else { const int u = bx + i * G; if (u < 1024) { bh = u >> 5; r0 = (u & 31) * 4; q0 = (bh >> 4) * 8192 + r0 * 64; ctxq = false; } else { bh = u - 1024; r0 = 0; q0 = MLAT + (bh >> 4) * 256; ctxq = true; } }
    na_unit(lds, QKV, rpb + (size_t)(bh & 15) * 15 * 31, O, q0, ctxq, bh >> 4, bh & 15, r0);
  }
}
}

namespace m16 {
using fa::f32x16; using fa::cvtpk;
typedef float f32x4q __attribute__((ext_vector_type(4)));
typedef short v4i16q __attribute__((ext_vector_type(4)));
constexpr int VROW = 256, SHM_V = 64 * VROW, SHM_K = 16384, SHM_P = 8192, OFF_V = 0, OFF_K = 3 * SHM_V, OFF_P = OFF_K + 3 * SHM_K, OFF_WS = OFF_P + 3 * SHM_P;
static_assert(OFF_WS + 8 * 256 <= 131072, "MLA LDS map");
#define M16_DMA(gp, lp) __builtin_amdgcn_global_load_lds((const unsigned*)(gp), (LAS unsigned*)(lp), 16, 0, 0)
__device__ __forceinline__ float xor16(float v) { return __int_as_float(__builtin_amdgcn_ds_swizzle(__float_as_int(v), 0x401F)); }
__device__ __forceinline__ float xor32_max(float v) { auto rr = __builtin_amdgcn_permlane32_swap(__float_as_uint(v), __float_as_uint(v), false, false); return fmaxf(__uint_as_float(rr[0]), __uint_as_float(rr[1])); }
__device__ __forceinline__ float xor32_sum(float v) { auto rr = __builtin_amdgcn_permlane32_swap(__float_as_uint(v), __float_as_uint(v), false, false); return __uint_as_float(rr[0]) + __uint_as_float(rr[1]); }

__device__ __forceinline__ void mla_unit16(LAS unsigned char* lds, const bf16* __restrict__ QH, const bf16* __restrict__ KV, const bf16* __restrict__ KPE, const float* __restrict__ cosT, const float* __restrict__ sinT,
                                           bf16* __restrict__ O, const int qrow0, const bool latq, const int b, const int h) {
  constexpr float SCALE = 0.07216878364870322f, C = SCALE * 1.4426950408889634f, THR2 = 8.f * 1.4426950408889634f;
  int tid_ = threadIdx.x; asm volatile("" : "+v"(tid_));
  const int tid = tid_, wid = __builtin_amdgcn_readfirstlane(tid >> 6), lane = tid & 63, l15 = lane & 15, kg = lane >> 4;
  LAS char* V_lds = (LAS char*)lds + OFF_V; LAS char* K_lds = (LAS char*)lds + OFF_K; LAS char* P_lds = (LAS char*)lds + OFF_P;
  LAS float* ws = (LAS float*)(lds + OFF_WS) + wid * 64;
  unsigned offK[2], offV[2], offP;
#pragma unroll
  for (int i = 0; i < 2; ++i) { const int Lb = (2 * wid + i) * 1024 + 16 * lane, row = Lb >> 8, colB = (Lb & 255) ^ ((row & 15) << 4); offK[i] = (unsigned)(row * 4096 + (colB >> 1)) * 2u; }
  { const int Lb = wid * 1024 + 16 * lane, row = Lb >> 7, colB = (Lb & 127) ^ ((row & 7) << 4); offP = (unsigned)(row * 64 + (colB >> 1)) * 2u; }
#pragma unroll
  for (int i = 0; i < 2; ++i) { const int Lb = (2 * wid + i) * 1024 + 16 * lane, row = Lb >> 8, colB = (Lb & 255) ^ ((row & 7) << 5); offV[i] = (unsigned)(row * 4096 + 128 + (colB >> 1)) * 2u; }
  const int NT = latq ? 132 : 4;
  const int ctx0 = MLAT + b * 256, lat0 = b * 8192 - 256;
  const bf16* KVh = KV + h * 256;
  const __amdgpu_buffer_rsrc_t rsKV = __builtin_amdgcn_make_buffer_rsrc((void*)KVh, (short)0, 0x7fffffff, 0x00020000), rsPE = __builtin_amdgcn_make_buffer_rsrc((void*)KPE, (short)0, 0x7fffffff, 0x00020000);
#define M16_BDMA(rs, voff, soff, lp) __builtin_amdgcn_raw_ptr_buffer_load_lds(rs, (LAS void*)(lp), 16, (int)(voff), (int)(soff), 0, 0)
#define DMA_K(tk, sK) do { const int tk_ = (tk) < NT ? (tk) : NT - 1; const int kb_ = (tk_ < 4 ? ctx0 : lat0) + 64 * tk_; \
    M16_BDMA(rsKV, offK[0], kb_ * 8192, K_lds + (sK) * SHM_K + (2 * wid) * 1024); M16_BDMA(rsKV, offK[1], kb_ * 8192, K_lds + (sK) * SHM_K + (2 * wid + 1) * 1024); M16_BDMA(rsPE, offP, kb_ * 128, P_lds + (sK) * SHM_P + wid * 1024); } while (0)
#define DMA_V(tv, sV) do { const int tv_ = (tv) < NT ? (tv) : NT - 1; const int vb_ = (tv_ < 4 ? ctx0 : lat0) + 64 * tv_; \
    M16_BDMA(rsKV, offV[0], vb_ * 8192, V_lds + (sV) * SHM_V + (2 * wid) * 1024); M16_BDMA(rsKV, offV[1], vb_ * 8192, V_lds + (sV) * SHM_V + (2 * wid + 1) * 1024); } while (0)
  DMA_K(0, 0); DMA_K(1, 1); DMA_V(0, 0);
  bf16x8 qf[2][6];
#pragma unroll
  for (int qb = 0; qb < 2; ++qb) { const int qrow = qrow0 + wid * 32 + 16 * qb + l15; const bf16* Qw = QH + (size_t)qrow * 3072 + h * 192 + 8 * kg;
#pragma unroll
    for (int s = 0; s < 4; ++s) { float f[8]; unpack8(*(const v4u*)(Qw + 32 * s), f);
      const v4u w = {cvtpk(f[0] * C, f[1] * C), cvtpk(f[2] * C, f[3] * C), cvtpk(f[4] * C, f[5] * C), cvtpk(f[6] * C, f[7] * C)}; qf[qb][s] = __builtin_bit_cast(bf16x8, w); }
    const int sp = qrow & 8191;
#pragma unroll
    for (int ax = 0; ax < 2; ++ax) { const v4u own = *(const v4u*)(Qw + 128 + 32 * ax), oth = *(const v4u*)(Qw + 128 + 32 * ax + (kg < 2 ? 16 : -16));
      v4u res;
      if (!latq) { float f[8]; unpack8(own, f); res = (v4u){cvtpk(f[0] * C, f[1] * C), cvtpk(f[2] * C, f[3] * C), cvtpk(f[4] * C, f[5] * C), cvtpk(f[6] * C, f[7] * C)}; }
      else { const int pos = ax ? (sp & 63) : (sp >> 6); const float* ct = cosT + pos * 16 + 8 * (kg & 1); const float* st = sinT + pos * 16 + 8 * (kg & 1);
        float x1[8], x2[8], yv[8]; if (kg < 2) { unpack8(own, x1); unpack8(oth, x2); } else { unpack8(oth, x1); unpack8(own, x2); }
#pragma unroll
        for (int i = 0; i < 8; ++i) yv[i] = kg < 2 ? x1[i] * ct[i] - x2[i] * st[i] : x1[i] * st[i] + x2[i] * ct[i];
        res = (v4u){cvtpk(yv[0] * C, yv[1] * C), cvtpk(yv[2] * C, yv[3] * C), cvtpk(yv[4] * C, yv[5] * C), cvtpk(yv[6] * C, yv[7] * C)}; }
      qf[qb][4 + ax] = __builtin_bit_cast(bf16x8, res); } }
  const int zsw = (l15 & 7) << 4;
  const LAS char* kS0 = K_lds + l15 * 256 + ((16 * kg) ^ (l15 << 4)); const LAS char* kS1 = K_lds + l15 * 256 + ((64 + 16 * kg) ^ (l15 << 4));
  const LAS char* kS2 = K_lds + l15 * 256 + ((128 + 16 * kg) ^ (l15 << 4)); const LAS char* kS3 = K_lds + l15 * 256 + ((192 + 16 * kg) ^ (l15 << 4));
  const LAS char* pE = P_lds + l15 * 128 + ((16 * kg) ^ zsw); const LAS char* pO = P_lds + l15 * 128 + (((16 * kg) ^ zsw) ^ 64);
  unsigned vBc[8];
#pragma unroll
  for (int c = 0; c < 8; ++c) vBc[c] = (unsigned)(uintptr_t)V_lds + (unsigned)((4 * kg + (l15 >> 2)) * VROW + 8 * (l15 & 3) + 32 * (c ^ ((4 * (kg & 1) + (l15 >> 2)) & 7)));
  float m0 = 0.f, m1 = 0.f, lr0 = 0.f, lr1 = 0.f; f32x4q o[2][8];
  f32x4q nm0 = {0.f, 0.f, 0.f, 0.f}, nm1 = {0.f, 0.f, 0.f, 0.f};
#pragma unroll
  for (int qb = 0; qb < 2; ++qb)
#pragma unroll
    for (int c = 0; c < 8; ++c) o[qb][c] = (f32x4q){0.f, 0.f, 0.f, 0.f};
  struct Tile { f32x4q s[4][2]; };
#define M16_RD2(d0_, d1_, A_, O0_, O1_) do { asm volatile("ds_read_b128 %0, %1 offset:%2" : "=v"(d0_) : "v"(A_), "i"(O0_)); asm volatile("ds_read_b128 %0, %1 offset:%2" : "=v"(d1_) : "v"(A_), "i"(O1_)); } while (0)
#define M16_W2(x_, y_) asm volatile("s_waitcnt lgkmcnt(2)" : "+v"(x_), "+v"(y_))
#define M16_W0(x_, y_) asm volatile("s_waitcnt lgkmcnt(0)" : "+v"(x_), "+v"(y_))
#define M16_MM(T_, KB_, x_, y_, S_) do { T_.s[KB_][0] = __builtin_amdgcn_mfma_f32_16x16x32_bf16(x_, qf[0][S_], T_.s[KB_][0], 0, 0, 0); T_.s[KB_][1] = __builtin_amdgcn_mfma_f32_16x16x32_bf16(x_, qf[1][S_], T_.s[KB_][1], 0, 0, 0); \
    T_.s[KB_ + 1][0] = __builtin_amdgcn_mfma_f32_16x16x32_bf16(y_, qf[0][S_], T_.s[KB_ + 1][0], 0, 0, 0); T_.s[KB_ + 1][1] = __builtin_amdgcn_mfma_f32_16x16x32_bf16(y_, qf[1][S_], T_.s[KB_ + 1][1], 0, 0, 0); } while (0)
#define QK16(T_, sl) do { const unsigned ko_ = (unsigned)((sl) * SHM_K), po_ = (unsigned)((sl) * SHM_P); \
    const unsigned a0_ = (unsigned)(uintptr_t)kS0 + ko_, a1_ = (unsigned)(uintptr_t)kS1 + ko_, a2_ = (unsigned)(uintptr_t)kS2 + ko_, a3_ = (unsigned)(uintptr_t)kS3 + ko_, pe_ = (unsigned)(uintptr_t)pE + po_, pq_ = (unsigned)(uintptr_t)pO + po_; \
    _Pragma("unroll") for (int kb = 0; kb < 4; ++kb) { T_.s[kb][0] = nm0; T_.s[kb][1] = nm1; } \
    bf16x8 e0_, e1_, f0_, f1_; \
    M16_RD2(e0_, e1_, a0_, 0, 4096); \
    M16_RD2(f0_, f1_, a0_, 8192, 12288);          M16_W2(e0_, e1_); M16_MM(T_, 0, e0_, e1_, 0); \
    M16_RD2(e0_, e1_, a1_, 0, 4096);              M16_W2(f0_, f1_); M16_MM(T_, 2, f0_, f1_, 0); \
    M16_RD2(f0_, f1_, a1_, 8192, 12288);          M16_W2(e0_, e1_); M16_MM(T_, 0, e0_, e1_, 1); \
    M16_RD2(e0_, e1_, a2_, 0, 4096);              M16_W2(f0_, f1_); M16_MM(T_, 2, f0_, f1_, 1); \
    M16_RD2(f0_, f1_, a2_, 8192, 12288);          M16_W2(e0_, e1_); M16_MM(T_, 0, e0_, e1_, 2); \
    M16_RD2(e0_, e1_, a3_, 0, 4096);              M16_W2(f0_, f1_); M16_MM(T_, 2, f0_, f1_, 2); \
    M16_RD2(f0_, f1_, a3_, 8192, 12288);          M16_W2(e0_, e1_); M16_MM(T_, 0, e0_, e1_, 3); \
    M16_RD2(e0_, e1_, pe_, 0, 2048);              M16_W2(f0_, f1_); M16_MM(T_, 2, f0_, f1_, 3); \
    M16_RD2(f0_, f1_, pe_, 4096, 6144);           M16_W2(e0_, e1_); M16_MM(T_, 0, e0_, e1_, 4); \
    M16_RD2(e0_, e1_, pq_, 0, 2048);              M16_W2(f0_, f1_); M16_MM(T_, 2, f0_, f1_, 4); \
    M16_RD2(f0_, f1_, pq_, 4096, 6144);           M16_W2(e0_, e1_); M16_MM(T_, 0, e0_, e1_, 5); \
                                                  M16_W0(f0_, f1_); M16_MM(T_, 2, f0_, f1_, 5); } while (0)
#define SOFT16(T_, al0_, al1_, FIRST_) do { float x0 = T_.s[0][0][0], x1 = T_.s[0][1][0]; \
    _Pragma("unroll") for (int kb = 0; kb < 4; ++kb) _Pragma("unroll") for (int i = 0; i < 4; ++i) { x0 = fmaxf(x0, T_.s[kb][0][i]); x1 = fmaxf(x1, T_.s[kb][1][i]); } \
    al0_ = 1.f; al1_ = 1.f;                                                                    \
    if ((FIRST_) || !__builtin_expect(__all(x0 <= THR2 && x1 <= THR2), 1)) {                  \
      x0 = fmaxf(x0, xor16(x0)); x1 = fmaxf(x1, xor16(x1)); x0 = xor32_max(x0); x1 = xor32_max(x1); \
      const float d0 = (FIRST_) ? x0 : fmaxf(x0, 0.f), d1 = (FIRST_) ? x1 : fmaxf(x1, 0.f); \
      if (!(FIRST_)) { al0_ = __builtin_amdgcn_exp2f(-d0); al1_ = __builtin_amdgcn_exp2f(-d1); } \
      m0 += d0; m1 += d1; nm0 = (f32x4q){-m0, -m0, -m0, -m0}; nm1 = (f32x4q){-m1, -m1, -m1, -m1}; \
      _Pragma("unroll") for (int kb = 0; kb < 4; ++kb) _Pragma("unroll") for (int i = 0; i < 4; ++i) { T_.s[kb][0][i] -= d0; T_.s[kb][1][i] -= d1; } } \
    float y0 = 0.f, y1 = 0.f; \
    _Pragma("unroll") for (int kb = 0; kb < 4; ++kb) _Pragma("unroll") for (int i = 0; i < 4; ++i) { T_.s[kb][0][i] = __builtin_amdgcn_exp2f(T_.s[kb][0][i]); T_.s[kb][1][i] = __builtin_amdgcn_exp2f(T_.s[kb][1][i]); \
      y0 += T_.s[kb][0][i]; y1 += T_.s[kb][1][i]; } \
    lr0 = lr0 * al0_ + y0; lr1 = lr1 * al1_ + y1;                                             \
    _Pragma("unroll") for (int qb = 0; qb < 2; ++qb) _Pragma("unroll") for (int ks = 0; ks < 2; ++ks) { \
      const v4u w_ = {cvtpk(T_.s[2 * ks][qb][0], T_.s[2 * ks][qb][1]), cvtpk(T_.s[2 * ks][qb][2], T_.s[2 * ks][qb][3]), cvtpk(T_.s[2 * ks + 1][qb][0], T_.s[2 * ks + 1][qb][1]), cvtpk(T_.s[2 * ks + 1][qb][2], T_.s[2 * ks + 1][qb][3])}; \
      pa[qb][ks] = __builtin_bit_cast(bf16x8, w_); } } while (0)
#define RESC16(al0_, al1_) do { if (__any((al0_) < 1.f || (al1_) < 1.f)) { if (kg == 0) { ws[l15] = (al0_); ws[16 + l15] = (al1_); } asm volatile("s_waitcnt lgkmcnt(0)" ::: "memory"); \
    const f32x4q a0_ = *(const LAS f32x4q*)(ws + 4 * kg), a1_ = *(const LAS f32x4q*)(ws + 16 + 4 * kg); \
    _Pragma("unroll") for (int c = 0; c < 8; ++c) { o[0][c] *= a0_; o[1][c] *= a1_; } } } while (0)
#define M16_TR4(a_, b_, c_, d_, A_, C_) do { const unsigned ad_ = vBc[C_] + (A_); asm volatile("ds_read_b64_tr_b16 %0, %1 offset:%2" : "=v"(a_) : "v"(ad_), "i"(0)); asm volatile("ds_read_b64_tr_b16 %0, %1 offset:%2" : "=v"(b_) : "v"(ad_), "i"(16 * VROW)); \
    asm volatile("ds_read_b64_tr_b16 %0, %1 offset:%2" : "=v"(c_) : "v"(ad_), "i"(32 * VROW)); asm volatile("ds_read_b64_tr_b16 %0, %1 offset:%2" : "=v"(d_) : "v"(ad_), "i"(48 * VROW)); } while (0)
#define M16_WV4(a_, b_, c_, d_) asm volatile("s_waitcnt lgkmcnt(4)" : "+v"(a_), "+v"(b_), "+v"(c_), "+v"(d_))
#define M16_WV0(a_, b_, c_, d_) asm volatile("s_waitcnt lgkmcnt(0)" : "+v"(a_), "+v"(b_), "+v"(c_), "+v"(d_))
#define M16_PM(C_, a_, b_, c_, d_) do { const bf16x8 v0_ = __builtin_bit_cast(bf16x8, __builtin_shufflevector(a_, b_, 0, 1, 2, 3, 4, 5, 6, 7)), v1_ = __builtin_bit_cast(bf16x8, __builtin_shufflevector(c_, d_, 0, 1, 2, 3, 4, 5, 6, 7)); \
    o[0][C_] = __builtin_amdgcn_mfma_f32_16x16x32_bf16(pa[0][0], v0_, o[0][C_], 0, 0, 0); o[1][C_] = __builtin_amdgcn_mfma_f32_16x16x32_bf16(pa[1][0], v0_, o[1][C_], 0, 0, 0); \
    o[0][C_] = __builtin_amdgcn_mfma_f32_16x16x32_bf16(pa[0][1], v1_, o[0][C_], 0, 0, 0); o[1][C_] = __builtin_amdgcn_mfma_f32_16x16x32_bf16(pa[1][1], v1_, o[1][C_], 0, 0, 0); } while (0)
#define PV16(sl) do { const unsigned va_ = (unsigned)((sl) * SHM_V); v4i16q a_, b_, c_, d_, e_, f_, g_, h_; \
    M16_TR4(a_, b_, c_, d_, va_, 0); \
    M16_TR4(e_, f_, g_, h_, va_, 1); M16_WV4(a_, b_, c_, d_); M16_PM(0, a_, b_, c_, d_); \
    M16_TR4(a_, b_, c_, d_, va_, 2); M16_WV4(e_, f_, g_, h_); M16_PM(1, e_, f_, g_, h_); \
    M16_TR4(e_, f_, g_, h_, va_, 3); M16_WV4(a_, b_, c_, d_); M16_PM(2, a_, b_, c_, d_); \
    M16_TR4(a_, b_, c_, d_, va_, 4); M16_WV4(e_, f_, g_, h_); M16_PM(3, e_, f_, g_, h_); \
    M16_TR4(e_, f_, g_, h_, va_, 5); M16_WV4(a_, b_, c_, d_); M16_PM(4, a_, b_, c_, d_); \
    M16_TR4(a_, b_, c_, d_, va_, 6); M16_WV4(e_, f_, g_, h_); M16_PM(5, e_, f_, g_, h_); \
    M16_TR4(e_, f_, g_, h_, va_, 7); M16_WV4(a_, b_, c_, d_); M16_PM(6, a_, b_, c_, d_); \
                                     M16_WV0(e_, f_, g_, h_); M16_PM(7, e_, f_, g_, h_); } while (0)
#define M16_WK(n_, x_, y_) asm volatile("s_waitcnt lgkmcnt(" #n_ ")" : "+v"(x_), "+v"(y_))
#define M16_WV(n_, a_, b_, c_, d_) asm volatile("s_waitcnt lgkmcnt(" #n_ ")" : "+v"(a_), "+v"(b_), "+v"(c_), "+v"(d_))
#define MSEG16(T_, slK, slV) do { const unsigned ko_ = (unsigned)((slK) * SHM_K), po_ = (unsigned)((slK) * SHM_P), va_ = (unsigned)((slV) * SHM_V); \
    const unsigned a0_ = (unsigned)(uintptr_t)kS0 + ko_, a1_ = (unsigned)(uintptr_t)kS1 + ko_, a2_ = (unsigned)(uintptr_t)kS2 + ko_, a3_ = (unsigned)(uintptr_t)kS3 + ko_, pe_ = (unsigned)(uintptr_t)pE + po_, pq_ = (unsigned)(uintptr_t)pO + po_; \
    _Pragma("unroll") for (int kb = 0; kb < 4; ++kb) { T_.s[kb][0] = nm0; T_.s[kb][1] = nm1; } \
    bf16x8 e0_, e1_, f0_, f1_, g0_, g1_; v4i16q va0_, va1_, va2_, va3_, vb0_, vb1_, vb2_, vb3_, vc0_, vc1_, vc2_, vc3_; \
    M16_RD2(e0_, e1_, a0_, 0, 4096); M16_RD2(f0_, f1_, a0_, 8192, 12288); \
    M16_RD2(g0_, g1_, a1_, 0, 4096); M16_WK(4, e0_, e1_); M16_MM(T_, 0, e0_, e1_, 0); \
    M16_RD2(e0_, e1_, a1_, 8192, 12288); M16_WK(4, f0_, f1_); M16_MM(T_, 2, f0_, f1_, 0); \
    M16_RD2(f0_, f1_, a2_, 0, 4096); M16_WK(4, g0_, g1_); M16_MM(T_, 0, g0_, g1_, 1); \
    M16_RD2(g0_, g1_, a2_, 8192, 12288); M16_WK(4, e0_, e1_); M16_MM(T_, 2, e0_, e1_, 1); \
    M16_RD2(e0_, e1_, a3_, 0, 4096); M16_WK(4, f0_, f1_); M16_MM(T_, 0, f0_, f1_, 2); \
    M16_RD2(f0_, f1_, a3_, 8192, 12288); M16_WK(4, g0_, g1_); M16_MM(T_, 2, g0_, g1_, 2); \
    M16_RD2(g0_, g1_, pe_, 0, 2048); M16_WK(4, e0_, e1_); M16_MM(T_, 0, e0_, e1_, 3); \
    M16_RD2(e0_, e1_, pe_, 4096, 6144); M16_WK(4, f0_, f1_); M16_MM(T_, 2, f0_, f1_, 3); \
    M16_RD2(f0_, f1_, pq_, 0, 2048); M16_WK(4, g0_, g1_); M16_MM(T_, 0, g0_, g1_, 4); \
    M16_RD2(g0_, g1_, pq_, 4096, 6144); M16_WK(4, e0_, e1_); M16_MM(T_, 2, e0_, e1_, 4); \
    M16_TR4(va0_, va1_, va2_, va3_, va_, 0); M16_WK(6, f0_, f1_); M16_MM(T_, 0, f0_, f1_, 5); \
    M16_TR4(vb0_, vb1_, vb2_, vb3_, va_, 1); M16_WK(8, g0_, g1_); M16_MM(T_, 2, g0_, g1_, 5); \
    M16_TR4(vc0_, vc1_, vc2_, vc3_, va_, 2); M16_WV(8, va0_, va1_, va2_, va3_); M16_PM(0, va0_, va1_, va2_, va3_); \
    M16_TR4(va0_, va1_, va2_, va3_, va_, 3); M16_WV(8, vb0_, vb1_, vb2_, vb3_); M16_PM(1, vb0_, vb1_, vb2_, vb3_); \
    M16_TR4(vb0_, vb1_, vb2_, vb3_, va_, 4); M16_WV(8, vc0_, vc1_, vc2_, vc3_); M16_PM(2, vc0_, vc1_, vc2_, vc3_); \
    M16_TR4(vc0_, vc1_, vc2_, vc3_, va_, 5); M16_WV(8, va0_, va1_, va2_, va3_); M16_PM(3, va0_, va1_, va2_, va3_); \
    M16_TR4(va0_, va1_, va2_, va3_, va_, 6); M16_WV(8, vb0_, vb1_, vb2_, vb3_); M16_PM(4, vb0_, vb1_, vb2_, vb3_); \
    M16_TR4(vb0_, vb1_, vb2_, vb3_, va_, 7); M16_WV(8, vc0_, vc1_, vc2_, vc3_); M16_PM(5, vc0_, vc1_, vc2_, vc3_); \
    M16_WV(4, va0_, va1_, va2_, va3_); M16_PM(6, va0_, va1_, va2_, va3_); \
    M16_WV(0, vb0_, vb1_, vb2_, vb3_); M16_PM(7, vb0_, vb1_, vb2_, vb3_); } while (0)
#define SEG_END_M() do { FA_SBAR(); asm volatile("s_waitcnt vmcnt(0) lgkmcnt(0)" ::: "memory"); __builtin_amdgcn_s_barrier(); asm volatile("" ::: "memory"); FA_SBAR(); } while (0)
#define SEG_END_V() do { FA_SBAR(); asm volatile("s_waitcnt lgkmcnt(0)" ::: "memory"); __builtin_amdgcn_s_barrier(); asm volatile("" ::: "memory"); FA_SBAR(); } while (0)
  Tile tS; bf16x8 pa[2][2]; float al0, al1;
  SEG_END_M();
  if (wid >= 4) { __builtin_amdgcn_s_barrier(); asm volatile("" ::: "memory"); }
  FA_SBAR();
  QK16(tS, 0);
  SEG_END_M();
  DMA_K(2, 2); DMA_V(1, 1);
  SOFT16(tS, al0, al1, true);
  SEG_END_V();
  int s0 = 0, s1 = 1, s2 = 2;
  for (int k = 0; k + 1 < NT; ++k) {
    MSEG16(tS, s1, s0);
    SEG_END_M();
    DMA_K(k + 3, s0); DMA_V(k + 2, s2);
    SOFT16(tS, al0, al1, false);
    RESC16(al0, al1);
    SEG_END_V();
    { const int t_ = s0; s0 = s1; s1 = s2; s2 = t_; }
  }
  PV16(s0);
  SEG_END_M();
  if (wid < 4) { __builtin_amdgcn_s_barrier(); asm volatile("" ::: "memory"); }
  lr0 += xor16(lr0); lr1 += xor16(lr1); lr0 = xor32_sum(lr0); lr1 = xor32_sum(lr1);
  if (kg == 0) { ws[32 + l15] = lr0; ws[48 + l15] = lr1; } asm volatile("s_waitcnt lgkmcnt(0)" ::: "memory");
#pragma unroll
  for (int qb = 0; qb < 2; ++qb) { const f32x4q lv = *(const LAS f32x4q*)(ws + 32 + 16 * qb + 4 * kg);
    bf16* Ow = O + (size_t)(qrow0 + wid * 32 + 16 * qb + 4 * kg) * 2048 + h * 128 + l15;
#pragma unroll
    for (int i = 0; i < 4; ++i) { const float rl = __builtin_amdgcn_rcpf(lv[i]);
#pragma unroll
      for (int c = 0; c < 8; ++c) Ow[(size_t)i * 2048 + 16 * c] = (bf16)(cvtpk(o[qb][c][i] * rl, 0.f) & 0xffffu); } }
  asm volatile("s_waitcnt vmcnt(0)" ::: "memory"); __syncthreads();
#undef DMA_K
#undef M16_BDMA
#undef DMA_V
#undef QK16
#undef M16_RD2
#undef M16_W2
#undef M16_W0
#undef M16_MM
#undef SOFT16
#undef RESC16
#undef PV16
#undef MSEG16
#undef M16_WK
#undef M16_WV
#undef M16_TR4
#undef M16_WV4
#undef M16_WV0
#undef M16_PM
#undef SEG_END_M
#undef SEG_END_V
}
__device__ __forceinline__ void mla_attn_phase16(LAS unsigned char* lds, const bf16* QH, const bf16* KV, const bf16* KPE, const float* cosT, const float* sinT, bf16* O) {
  const int G = gridDim.x, bx = blockIdx.x;
  const int nu = (G == 256) ? (bx < 32 ? 5 : 4) : (1056 - bx + G - 1) / G;
  for (int i = 0; i < nu; ++i) {
    int bh, q0; bool latq;
    if (G == 256) { if (i < 4) { bh = i * 8 + (bx & 7); q0 = (bh >> 4) * 8192 + (bx >> 3) * 256; latq = true; } else { bh = bx; q0 = MLAT + (bh >> 4) * 256; latq = false; } }
    else { const int u = bx + i * G; if (u < 1024) { bh = u >> 5; q0 = (bh >> 4) * 8192 + (u & 31) * 256; latq = true; } else { bh = u - 1024; q0 = MLAT + (bh >> 4) * 256; latq = false; } }
    mla_unit16(lds, QH, KV, KPE, cosT, sinT, O, q0, latq, bh >> 4, bh & 15);
  }
}
}

namespace ml {
using fa::f32x16; using fa::s16x4; using fa::crow; using fa::cvtpk;
typedef float f32x4m __attribute__((ext_vector_type(4)));
constexpr int TQ = 17408, ROWB = 272, SPS = 144;
constexpr int OFF_Q = 0, OFF_K = 2 * TQ, OFF_V = 4 * TQ, OFF_KW = OFF_V + 32768, OFF_SP = OFF_KW + 16384, OFF_QN = OFF_SP + 64 * SPS, OFF_N32 = OFF_QN + 256, OFF_NB = OFF_N32 + 512, OFF_WV = OFF_NB + 256, ML_LDS_END = OFF_WV + 8 * 1280;
#define ML_DMA(gp, lp) __builtin_amdgcn_global_load_lds((const unsigned*)(gp), (LAS unsigned*)(lp), 16, 0, 0)
#define ML_TR(dst, vb, OFF) asm volatile("ds_read_b64_tr_b16 %0, %1 offset:%2" : "=&v"(dst) : "v"(vb), "i"(OFF) : "memory")
#define ML_PK(L, H) (bf16x8){L[0], L[1], L[2], L[3], H[0], H[1], H[2], H[3]}
__device__ __forceinline__ int chunk_base(int n, int dir, int b) { return dir == 0 ? (n < 4 ? MLAT + b * 256 + 64 * n : b * 8192 + 64 * (n - 4)) : (n < 4 ? MLAT + b * 256 + 64 * (3 - n) : b * 8192 + 64 * (131 - n)); }
template <int CTRL, int RM> __device__ __forceinline__ float dppf(float old, float src) { return __int_as_float(__builtin_amdgcn_update_dpp(__float_as_int(old), __float_as_int(src), CTRL, RM, 0xf, false)); }
__device__ __forceinline__ float scan_add(float v) {
  v += dppf<0x111, 0xf>(0.f, v); v += dppf<0x112, 0xf>(0.f, v); v += dppf<0x114, 0xf>(0.f, v); v += dppf<0x118, 0xf>(0.f, v);
  v += dppf<0x142, 0xa>(0.f, v); v += dppf<0x143, 0xc>(0.f, v); return v; }
__device__ __forceinline__ float scan_max(float v) {
  const float NI = -INFINITY;
  v = fmaxf(v, dppf<0x111, 0xf>(NI, v)); v = fmaxf(v, dppf<0x112, 0xf>(NI, v)); v = fmaxf(v, dppf<0x114, 0xf>(NI, v)); v = fmaxf(v, dppf<0x118, 0xf>(NI, v));
  v = fmaxf(v, dppf<0x142, 0xa>(NI, v)); v = fmaxf(v, dppf<0x143, 0xc>(NI, v)); return v; }

constexpr int NGRP = 8;
__host__ __device__ constexpr int grp_start(int g) { return g <= 4 ? 17 * g : 68 + 16 * (g - 4); }
constexpr int OFF_TAB = ML_LDS_END;
template <int MODE> __device__ __forceinline__ void scan_chain(LAS unsigned char* lds, const bf16* __restrict__ QK, const bf16* __restrict__ Z, const float* __restrict__ G, bf16* __restrict__ H, float* __restrict__ Ub, float* __restrict__ Nb, const int chain, const int grp) {
  const int dir = chain & 1, hd = (chain >> 1) & 7, b = chain >> 4; const int n0 = grp_start(grp), n1 = grp_start(grp + 1);
  int tid_ = threadIdx.x; asm volatile("" : "+v"(tid_)); const int tid = tid_, wid = __builtin_amdgcn_readfirstlane(tid >> 6), lane_ = tid & 63;
  LAS char* Lc = (LAS char*)lds;
  LAS float* QN = (LAS float*)(lds + OFF_QN); LAS float* N32 = (LAS float*)(lds + OFF_N32); LAS bf16* NB = (LAS bf16*)(lds + OFF_NB);
  const int lane = lane_;
  unsigned offQ[2], offQx, offV[4];
#pragma unroll
  for (int i = 0; i < 2; ++i) { const int Lb = (2 * wid + i) * 1024 + 16 * lane, row = Lb / ROWB, cB = Lb % ROWB, colB = cB < 256 ? cB : 0; const int srow = dir ? 63 - row : row; offQ[i] = (unsigned)((srow * 2048 + hd * 128) * 2 + colB); }
  { const int Lb = 16 * 1024 + 16 * lane, row = Lb / ROWB, cB = Lb % ROWB, colB = cB < 256 ? cB : 0; const int srow = dir ? 63 - row : row; offQx = (unsigned)((srow * 2048 + hd * 128) * 2 + colB); }
#pragma unroll
  for (int p = 0; p < 4; ++p) { const int Lb = p * 1024 + 16 * lane, sub = Lb >> 9, w_ = Lb & 511, kk = sub * 8 + (w_ >> 6), c = (w_ & 63) >> 1, k = (kk & ~0xC) | ((kk & 4) << 1) | ((kk & 8) >> 1); const int srow = dir ? 63 - k : k;
    offV[p] = (unsigned)((srow * 6400 + 2048 + hd * 256 + 32 * wid + c) * 2); }
  const int grow_off = dir ? 63 - lane : lane;
#define DMA_Q(n, slot) do { const char* g_ = (const char*)(QK + (size_t)chunk_base((n), dir, b) * 2048); LAS char* d_ = Lc + OFF_Q + (slot) * TQ; \
    ML_DMA(g_ + offQ[0], d_ + (2 * wid) * 1024); ML_DMA(g_ + offQ[1], d_ + (2 * wid + 1) * 1024); if (wid == 0) ML_DMA(g_ + offQx, d_ + 16 * 1024); } while (0)
#define DMA_K(n, slot) do { const char* g_ = (const char*)(QK + (size_t)chunk_base((n), dir, b) * 2048 + 1024); LAS char* d_ = Lc + OFF_K + (slot) * TQ; \
    ML_DMA(g_ + offQ[0], d_ + (2 * wid) * 1024); ML_DMA(g_ + offQ[1], d_ + (2 * wid + 1) * 1024); if (wid == 0) ML_DMA(g_ + offQx, d_ + 16 * 1024); } while (0)
#define DMA_VS(n) do { const char* g_ = (const char*)(Z + (size_t)chunk_base((n), dir, b) * 6400); LAS char* d_ = Lc + OFF_V + wid * 4096; \
    ML_DMA(g_ + offV[0], d_); ML_DMA(g_ + offV[1], d_ + 1024); ML_DMA(g_ + offV[2], d_ + 2048); ML_DMA(g_ + offV[3], d_ + 3072); } while (0)
#define LOAD_G(n, li_, lf_) do { const float* g_ = G + (size_t)(chunk_base((n), dir, b) + grow_off) * 32 + dir * 16 + hd; li_ = g_[0]; lf_ = g_[8]; } while (0)
#define BAR_LDS() do { asm volatile("s_waitcnt lgkmcnt(0)" ::: "memory"); __builtin_amdgcn_s_barrier(); asm volatile("" ::: "memory"); } while (0)
  LAS float* TB = (LAS float*)(lds + OFF_TAB); LAS float* TP = TB + 132; LAS float* TM = TB + 264; LAS float* TC = TB + 397;
  { float gl_[17], gf_[17];
#pragma unroll
    for (int i = 0; i < 17; ++i) { const int c = wid + 8 * i; gl_[i] = 0.f; gf_[i] = 0.f; if (c < 132) LOAD_G(c, gl_[i], gf_[i]); }
#pragma unroll
    for (int i = 0; i < 17; ++i) { const int c = wid + 8 * i; const float cb_ = scan_add(gf_[i]), pm_ = scan_max(gl_[i] - cb_); if (c < 132 && lane == 63) { TB[c] = cb_; TP[c] = pm_; } } }
  __syncthreads();
  if (tid == 0) { float m_ = 0.f, bc_ = 0.f;
#pragma unroll 12
    for (int c = 0; c < 132; ++c) { const float tb_ = TB[c], tp_ = TP[c]; TM[c] = m_; TC[c] = bc_; m_ = tb_ + fmaxf(m_, tp_); bc_ += tb_; }
    TM[132] = m_; TC[132] = bc_; }
  __syncthreads();
  if (MODE == 1) { DMA_Q(n0, 0); DMA_Q(n0 + 1, 1); }
  DMA_K(n0, 0); DMA_K(n0 + 1, 1); DMA_VS(n0);
  float li, lf; LOAD_G(n0, li, lf);
  f32x16 C[4];
#pragma unroll
  for (int i = 0; i < 4; ++i) C[i] = f32x16{};
  float nacc = 0.f;
  if (MODE == 1) {
#pragma unroll 1
    for (int j = 0; j < grp; ++j) { const int s1 = grp_start(j + 1); const float w = __expf(TC[n0] - TC[s1] + TM[s1] - TM[n0]);
      const float* up = Ub + ((size_t)(chain * NGRP + j) * 8 + wid) * 4096 + lane;
#pragma unroll
      for (int q = 0; q < 4; ++q) {
#pragma unroll
        for (int r = 0; r < 16; ++r) C[q][r] += w * up[(q * 16 + r) * 64];
        __builtin_amdgcn_sched_barrier(0); }
      if (tid < 128) nacc += w * Nb[(size_t)(chain * NGRP + j) * 128 + tid]; }
  }
  if (tid < 128) { N32[tid] = nacc; NB[tid] = (bf16)(cvtpk(nacc, 0.f) & 0xffffu); }
  float m_prev = TM[n0];
  asm volatile("s_waitcnt vmcnt(0)" ::: "memory"); BAR_LDS();
  float cumb = scan_add(lf), av = li - cumb, pm = scan_max(av);
  unsigned hp[16];
#pragma unroll
  for (int i = 0; i < 16; ++i) hp[i] = 0u;
  for (int n = n0; n < n1; ++n) {
    const int slot = (n - n0) & 1;
    const LAS char* Qs = Lc + OFF_Q + slot * TQ; const LAS char* Ks = Lc + OFF_K + slot * TQ;
    const float mx = fmaxf(m_prev, pm), wint = __expf(m_prev - mx), m_t = cumb + mx;
    const float mx63 = __int_as_float(__builtin_amdgcn_readlane(__float_as_int(mx), 63)), b_end = __int_as_float(__builtin_amdgcn_readlane(__float_as_int(cumb), 63)), m_new = b_end + mx63, decay = __expf(m_prev - mx63);
    { LAS float* WVt = (LAS float*)(lds + OFF_WV + wid * 1280); WVt[128 + lane] = -mx; WVt[192 + lane] = av; WVt[256 + lane] = __expf(av - mx63); }
    if (MODE == 1 && n > n0) {
      int lo_ = lane_; asm volatile("" : "+v"(lo_)); const int cbr = chunk_base(n - 1, dir, b); const int hi_ = lo_ >> 5;
      const unsigned loff = (unsigned)(2 * (lo_ & 31) + (dir ? 1 - hi_ : hi_) * 4 * 4096); char* const Hb = (char*)(H + hd * 256 + 32 * wid);
#pragma unroll
      for (int k = 0; k < 16; ++k) { const int i0 = 2 * (k & 7), tk = 32 * (k >> 3) + (i0 & 3) + 8 * (i0 >> 2); char* const r0 = Hb + (size_t)(cbr + (dir ? 63 - tk - 4 : tk)) * 4096; char* const r1 = dir ? r0 - 4096 : r0 + 4096;
        *(bf16*)(r0 + loff) = (bf16)(hp[k] & 0xffffu); *(bf16*)(r1 + loff) = (bf16)(hp[k] >> 16); }
    }
    __builtin_amdgcn_sched_barrier(0);
    {
      int lane = lane_; asm volatile("" : "+v"(lane));
      const int l15 = lane & 15, kg = lane >> 4;
      if (MODE == 1) {
      const int tb = wid >> 1;
      bf16x8 qa[4];
#pragma unroll
      for (int ks = 0; ks < 4; ++ks) qa[ks] = *(const LAS bf16x8*)(Qs + (16 * tb + l15) * ROWB + kg * 16 + ks * 64);
#pragma unroll
      for (int e = 0; e < 2; ++e) { const int sb = 2 * (wid & 1) + e; f32x4m acc = {0.f, 0.f, 0.f, 0.f};
        if (sb <= tb) {
#pragma unroll
          for (int ks = 0; ks < 4; ++ks) { const bf16x8 kb = *(const LAS bf16x8*)(Ks + (16 * sb + l15) * ROWB + kg * 16 + ks * 64); acc = __builtin_amdgcn_mfma_f32_16x16x32_bf16(qa[ks], kb, acc, 0, 0, 0); }
        }
        const int s = 16 * sb + l15; const LAS float* WVt = (const LAS float*)(lds + OFF_WV + wid * 1280); const float a_s = WVt[192 + s]; const f32x4m e1v = *(const LAS f32x4m*)(WVt + 128 + 16 * tb + 4 * kg);
#pragma unroll
        for (int i = 0; i < 4; ++i) { const int t = 16 * tb + 4 * kg + i; const float v = (s <= t) ? acc[i] * __expf(e1v[i] + a_s) : 0.f;
          *(LAS bf16*)(Lc + OFF_SP + t * SPS + s * 2) = (bf16)(cvtpk(v, 0.f) & 0xffffu); } }
      if (wid < 4) {
        f32x4m acc = {0.f, 0.f, 0.f, 0.f};
#pragma unroll
        for (int ks = 0; ks < 4; ++ks) { const bf16x8 qq = *(const LAS bf16x8*)(Qs + (16 * wid + l15) * ROWB + kg * 16 + ks * 64); const bf16x8 nn = *(const LAS bf16x8*)((const LAS char*)NB + kg * 16 + ks * 64);
          acc = __builtin_amdgcn_mfma_f32_16x16x32_bf16(qq, nn, acc, 0, 0, 0); }
        if (l15 == 0) { *(LAS f32x4m*)(QN + 16 * wid + 4 * kg) = acc; }
      }
      }
      {
        const int s = wid * 8 + (lane >> 3), part = lane & 7; const float es = ((const LAS float*)(lds + OFF_WV + wid * 1280))[256 + s];
        const v4u w0 = *(const LAS v4u*)(Ks + s * ROWB + part * 32), w1 = *(const LAS v4u*)(Ks + s * ROWB + part * 32 + 16);
        float f[16]; unpack8(w0, f); unpack8(w1, f + 8);
        v4u o0 = {cvtpk(f[0] * es, f[1] * es), cvtpk(f[2] * es, f[3] * es), cvtpk(f[4] * es, f[5] * es), cvtpk(f[6] * es, f[7] * es)};
        v4u o1 = {cvtpk(f[8] * es, f[9] * es), cvtpk(f[10] * es, f[11] * es), cvtpk(f[12] * es, f[13] * es), cvtpk(f[14] * es, f[15] * es)};
        *(LAS v4u*)(Lc + OFF_KW + fa::v_st(s, part * 16)) = o0; *(LAS v4u*)(Lc + OFF_KW + fa::v_st(s, part * 16 + 8)) = o1;
      }
    }
    BAR_LDS();
    int lane = lane_; asm volatile("" : "+v"(lane));
    const int r32 = lane & 31, hi = lane >> 5;
    const int vbV = (int)(unsigned)(uintptr_t)(Lc + OFF_V + wid * 4096) + fa::v_rd_base(lane);
    const int vbK = (int)(unsigned)(uintptr_t)(Lc + OFF_KW) + fa::v_rd_base(lane);
    LAS float* WV = (LAS float*)(lds + OFF_WV + wid * 1280);
    s16x4 vl0, vh0, vl1, vh1, vl2, vh2, vl3, vh3;
    ML_TR(vl0, vbV, 0); ML_TR(vh0, vbV, 512); ML_TR(vl1, vbV, 1024); ML_TR(vh1, vbV, 1536); ML_TR(vl2, vbV, 2048); ML_TR(vh2, vbV, 2560); ML_TR(vl3, vbV, 3072); ML_TR(vh3, vbV, 3584);
    asm volatile("s_waitcnt lgkmcnt(0)" ::: "memory"); __builtin_amdgcn_sched_barrier(0);
    const bf16x8 vf0 = ML_PK(vl0, vh0), vf1 = ML_PK(vl1, vh1), vf2 = ML_PK(vl2, vh2), vf3 = ML_PK(vl3, vh3);
    float li_n = 0.f, lf_n = 0.f;
    if (n + 1 < n1) { DMA_VS(n + 1); LOAD_G(n + 1, li_n, lf_n); }
    if (n + 2 < n1) DMA_K(n + 2, slot);
    if (MODE == 1) {
    {
      float rs = 0.f;
#pragma unroll
      for (int j = 0; j < 8; ++j) { float f[8]; unpack8(*(const LAS v4u*)(Lc + OFF_SP + lane * SPS + 16 * j), f);
#pragma unroll
        for (int i = 0; i < 8; ++i) rs += f[i]; }
      const float den = wint * QN[lane] + rs; const float rinv = 1.f / fmaxf(fabsf(den), __expf(-m_t));
      WV[lane] = wint; WV[64 + lane] = rinv;
    }
    __builtin_amdgcn_sched_barrier(0);
    f32x16 aI0 = f32x16{}, aI1 = f32x16{};
#pragma unroll
    for (int dkb = 0; dkb < 4; ++dkb) {
#pragma unroll
      for (int jj = 0; jj < 2; ++jj) {
        const v4u cw = {cvtpk(C[dkb][8 * jj + 0], C[dkb][8 * jj + 1]), cvtpk(C[dkb][8 * jj + 2], C[dkb][8 * jj + 3]), cvtpk(C[dkb][8 * jj + 4], C[dkb][8 * jj + 5]), cvtpk(C[dkb][8 * jj + 6], C[dkb][8 * jj + 7])};
        const bf16x8 cb = __builtin_bit_cast(bf16x8, cw);
        const LAS char* qp = Qs + r32 * ROWB + (32 * dkb + 16 * jj + 4 * hi) * 2;
        typedef unsigned u32x2m __attribute__((ext_vector_type(2)));
        const u32x2m a0 = *(const LAS u32x2m*)(qp), a1 = *(const LAS u32x2m*)(qp + 16), b0 = *(const LAS u32x2m*)(qp + 32 * ROWB), b1 = *(const LAS u32x2m*)(qp + 32 * ROWB + 16);
        const v4u qa0 = {a0.x, a0.y, a1.x, a1.y}, qa1 = {b0.x, b0.y, b1.x, b1.y};
        aI0 = __builtin_amdgcn_mfma_f32_32x32x16_bf16(__builtin_bit_cast(bf16x8, qa0), cb, aI0, 0, 0, 0);
        aI1 = __builtin_amdgcn_mfma_f32_32x32x16_bf16(__builtin_bit_cast(bf16x8, qa1), cb, aI1, 0, 0, 0);
      }
      __builtin_amdgcn_sched_barrier(0);
    }
#pragma unroll
    for (int g = 0; g < 4; ++g) { const f32x4m w0 = *(const LAS f32x4m*)(WV + 8 * g + 4 * hi), w1 = *(const LAS f32x4m*)(WV + 32 + 8 * g + 4 * hi);
#pragma unroll
      for (int i = 0; i < 4; ++i) { aI0[4 * g + i] *= w0[i]; aI1[4 * g + i] *= w1[i]; } }
    {
      const LAS char* sp = Lc + OFF_SP + r32 * SPS + hi * 16;
#define ML_INTRA(ks, vf) do { const bf16x8 s0 = *(const LAS bf16x8*)(sp + (ks) * 32), s1 = *(const LAS bf16x8*)(sp + 32 * SPS + (ks) * 32); \
      aI0 = __builtin_amdgcn_mfma_f32_32x32x16_bf16(s0, vf, aI0, 0, 0, 0); aI1 = __builtin_amdgcn_mfma_f32_32x32x16_bf16(s1, vf, aI1, 0, 0, 0); } while (0)
      ML_INTRA(0, vf0); ML_INTRA(1, vf1); ML_INTRA(2, vf2); ML_INTRA(3, vf3);
#undef ML_INTRA
    }
    __builtin_amdgcn_sched_barrier(0);
    {
#pragma unroll
      for (int tb = 0; tb < 2; ++tb)
#pragma unroll
        for (int g = 0; g < 4; ++g) { const int t0 = 32 * tb + 8 * g + 4 * hi; const f32x4m rv = *(const LAS f32x4m*)(WV + 64 + t0);
          const float h0 = (tb ? aI1[4 * g + 0] : aI0[4 * g + 0]) * rv[0], h1 = (tb ? aI1[4 * g + 1] : aI0[4 * g + 1]) * rv[1], h2 = (tb ? aI1[4 * g + 2] : aI0[4 * g + 2]) * rv[2], h3 = (tb ? aI1[4 * g + 3] : aI0[4 * g + 3]) * rv[3];
          hp[8 * tb + 2 * g] = cvtpk(h0, h1); hp[8 * tb + 2 * g + 1] = cvtpk(h2, h3); }
    }
    __builtin_amdgcn_sched_barrier(0);
    __builtin_amdgcn_sched_barrier(0);
    __builtin_amdgcn_sched_barrier(0);
    }
    {
      int tid_o = tid; asm volatile("" : "+v"(tid_o)); const int d = tid_o >> 2, q4 = tid_o & 3; float a = 0.f;
#pragma unroll
      for (int j = 0; j < 16; ++j) a += bf1(*(const LAS bf16*)(Lc + OFF_KW + fa::v_st(16 * q4 + j, d)));
      a += __shfl_xor(a, 1); a += __shfl_xor(a, 2);
      if (q4 == 0) { const float nn = decay * N32[d] + a; N32[d] = nn; NB[d] = (bf16)(cvtpk(nn, 0.f) & 0xffffu); }
    }
    __builtin_amdgcn_sched_barrier(0);
#pragma unroll
    for (int dkb = 0; dkb < 4; ++dkb) {
#pragma unroll
      for (int r = 0; r < 16; ++r) { float c_ = C[dkb][r]; asm("v_mul_f32 %0, %1, %2" : "=v"(c_) : "v"(c_), "v"(decay)); C[dkb][r] = c_; }
    }
#define ML_U(DKB) do { s16x4 kl0, kh0, kl1, kh1, kl2, kh2, kl3, kh3; \
      ML_TR(kl0, vbK, fa::v_rd_off(DKB, 0, 0)); ML_TR(kh0, vbK, fa::v_rd_off(DKB, 0, 1)); ML_TR(kl1, vbK, fa::v_rd_off(DKB, 1, 0)); ML_TR(kh1, vbK, fa::v_rd_off(DKB, 1, 1)); \
      ML_TR(kl2, vbK, fa::v_rd_off(DKB, 2, 0)); ML_TR(kh2, vbK, fa::v_rd_off(DKB, 2, 1)); ML_TR(kl3, vbK, fa::v_rd_off(DKB, 3, 0)); ML_TR(kh3, vbK, fa::v_rd_off(DKB, 3, 1)); \
      asm volatile("s_waitcnt lgkmcnt(0)" ::: "memory"); __builtin_amdgcn_sched_barrier(0); \
      C[DKB] = __builtin_amdgcn_mfma_f32_32x32x16_bf16(ML_PK(kl0, kh0), vf0, C[DKB], 0, 0, 0); C[DKB] = __builtin_amdgcn_mfma_f32_32x32x16_bf16(ML_PK(kl1, kh1), vf1, C[DKB], 0, 0, 0); \
      C[DKB] = __builtin_amdgcn_mfma_f32_32x32x16_bf16(ML_PK(kl2, kh2), vf2, C[DKB], 0, 0, 0); C[DKB] = __builtin_amdgcn_mfma_f32_32x32x16_bf16(ML_PK(kl3, kh3), vf3, C[DKB], 0, 0, 0); } while (0)
    ML_U(0); ML_U(1); ML_U(2); ML_U(3);
#undef ML_U
    m_prev = m_new;
    if (n + 1 < n1) { cumb = scan_add(lf_n); av = li_n - cumb; pm = scan_max(av); }
    asm volatile("s_waitcnt vmcnt(0)" ::: "memory"); BAR_LDS();
    if (MODE == 1 && n + 2 < n1) DMA_Q(n + 2, slot);
  }
  if (MODE == 1) { int lo_ = lane_; asm volatile("" : "+v"(lo_)); const int cbr = chunk_base(n1 - 1, dir, b); const int hi_ = lo_ >> 5;
    const unsigned loff = (unsigned)(2 * (lo_ & 31) + (dir ? 1 - hi_ : hi_) * 4 * 4096); char* const Hb = (char*)(H + hd * 256 + 32 * wid);
#pragma unroll
    for (int k = 0; k < 16; ++k) { const int i0 = 2 * (k & 7), tk = 32 * (k >> 3) + (i0 & 3) + 8 * (i0 >> 2); char* const r0 = Hb + (size_t)(cbr + (dir ? 63 - tk - 4 : tk)) * 4096; char* const r1 = dir ? r0 - 4096 : r0 + 4096;
      *(bf16*)(r0 + loff) = (bf16)(hp[k] & 0xffffu); *(bf16*)(r1 + loff) = (bf16)(hp[k] >> 16); } }
  if (MODE == 0) {
    float* up = Ub + ((size_t)(chain * NGRP + grp) * 8 + wid) * 4096 + lane;
#pragma unroll
    for (int q = 0; q < 4; ++q)
#pragma unroll
      for (int r = 0; r < 16; ++r) up[(q * 16 + r) * 64] = C[q][r];
    if (tid < 128) Nb[(size_t)(chain * NGRP + grp) * 128 + tid] = N32[tid];
  }
  asm volatile("s_waitcnt vmcnt(0)" ::: "memory"); __syncthreads();
#undef DMA_Q
#undef DMA_K
#undef DMA_VS
#undef LOAD_G
#undef BAR_LDS
}
__device__ __forceinline__ void scan_phase_a(LAS unsigned char* lds, const bf16* QK, const bf16* Z, const float* G, float* Ub, float* Nb) {
  for (int u = blockIdx.x; u < 32 * (NGRP - 1); u += gridDim.x) { const int chain = u / (NGRP - 1), grp = u % (NGRP - 1); scan_chain<0>(lds, QK, Z, G, nullptr, Ub, Nb, chain, grp); }
}
__device__ __forceinline__ void scan_phase_b(LAS unsigned char* lds, const bf16* QK, const bf16* Z, const float* G, bf16* HF, bf16* HB, float* Ub, float* Nb) {
  for (int u = blockIdx.x; u < 32 * NGRP; u += gridDim.x) { const int chain = u / NGRP, grp = u % NGRP; scan_chain<1>(lds, QK, Z, G, (chain & 1) ? HB : HF, Ub, Nb, chain, grp); }
}
}

#define TRD_BEGIN(tab_) int nm_ = 0, base_ = 0; LAS TrDesc* const tb_ = (tab_); for (int i_ = 0; i_ < TR_NMAT; ++i_) tb_[i_].base = 0x7fffffff
#define TRD(W_, K_, N_, NP_, WT_) do { tb_[nm_].W = (W_); tb_[nm_].WT = (WT_); tb_[nm_].K = (K_); tb_[nm_].N = (N_); tb_[nm_].Npad = (NP_); tb_[nm_].base = base_; base_ += ((K_) / 64) * ((NP_) / 256); ++nm_; } while (0)
#define TRD_END() (((LAS int*)(X.lds + TR_LDS_OFF + TR_NMAT * 32))[0] = base_)
#define TRD_TOTAL() (((const LAS int*)(X.lds + TR_LDS_OFF + TR_NMAT * 32))[0])
struct Args { const float* in[23]; float* out; unsigned char* ws; int ph_lo, ph_hi; };
constexpr int PH_LAYER0 = 3, PH_PER_LAYER = 10, NPHASES = PH_LAYER0 + DEPTH * PH_PER_LAYER;
__host__ __device__ constexpr bool phase_active(int p) { return p < PH_LAYER0 ? true : ((((p - PH_LAYER0) / PH_PER_LAYER) % 3 == 0) ? !(((p - PH_LAYER0) % PH_PER_LAYER) >= 2 && ((p - PH_LAYER0) % PH_PER_LAYER) <= 4) : ((((p - PH_LAYER0) / PH_PER_LAYER) % 3 == 1) ? ((p - PH_LAYER0) % PH_PER_LAYER) != 4 : true)); }

#define IN(k) (lo <= (k) && (k) < hi)
#define SEAM(k) do { if (single && (k) + 1 < hi) xcd_barrier(bar); } while (0)
template <int L> __device__ __forceinline__ void run_layer(const Ctx& X, const Args& args, const XcdBarrier& bar, const int lo, const int hi, const bool single) {
    unsigned char* ws = args.ws; const int G = gridDim.x;
    const float* norm_g = args.in[6];
    float* mod = (float*)(ws + WS_MOD); float* cosT = (float*)(ws + WS_ROPE); float* sinT = cosT + 2048;
    hfp* h = (hfp*)(ws + WS_H); bf16* a = (bf16*)(ws + WS_A); bf16* y = (bf16*)(ws + WS_Y); bf16* o = (bf16*)(ws + WS_O); unsigned char* big = ws + WS_BIG;
        constexpr int kind = L % 3, jj = L / 3, pb = PH_LAYER0 + L * PH_PER_LAYER;
        const bf16* wo_t;
        if constexpr (kind == 0) {
            bf16* QKV = (bf16*)(big + BIG_QKV); wo_t = (const bf16*)(ws + WS_NAWO) + (size_t)jj * D * D;
            if (IN(pb + 0)) { pg8::Gemm g{a, (const bf16*)(ws + WS_NAQKV) + (size_t)jj * D * 6144, M, 6144, D}; pg8::StaticOrder S; S.init(M, 6144, G, (int)blockIdx.x, WGM_IN); pg8::EpiBf16<0> E{QKV, 6144};
                REPEAT_REP_IN(pg8::gemm_phase<pg8::EpiBf16<0>, pg8::StaticOrder, true, true>(X.lds, g, S, E);)
                if (L == 0) { if (G == 256 && (int)blockIdx.x >= 48) { LAS TrDesc* tab = (LAS TrDesc*)(X.lds + TR_LDS_OFF); if (X.tid == 0) { TRD_BEGIN(tab); TRD(args.in[12], D, 1088, 1280, (bf16*)(ws + WS_MLAIN)); TRD(args.in[15], 512, 3072, 3072, (bf16*)(ws + WS_MLAUQ)); TRD(args.in[16], 512, 4096, 4096, (bf16*)(ws + WS_MLAUKV)); TRD(args.in[17], D, D, D, (bf16*)(ws + WS_MLAWO)); TRD_END(); } __syncthreads(); tr_all(X, tab, TRD_TOTAL(), (int)blockIdx.x - 48, 256 - 48); } } SEAM(pb + 0); }
            if (IN(pb + 1)) { REPEAT_REP_NA(fa::na_attn_phase(X.lds, QKV, args.in[10] + (size_t)jj * 16 * 15 * 31, o, L < DEPTH - 1);) SEAM(pb + 1); }
        } else if constexpr (kind == 1) {
            bf16* Z = (bf16*)(big + BIG_MZ); bf16* QH = (bf16*)(big + BIG_QH); bf16* KV = (bf16*)(big + BIG_KV); bf16* CQN = (bf16*)(big + BIG_CQN); bf16* CKVN = (bf16*)(big + BIG_CKVN); bf16* KPE = (bf16*)(big + BIG_KPE);
            wo_t = (const bf16*)(ws + WS_MLAWO);
            if (IN(pb + 0)) { pg8::Gemm g{a, (const bf16*)(ws + WS_MLAIN), M, 1280, D}; pg8::StaticOrder S; S.init(M, 1280, G, (int)blockIdx.x, WGM_IN); pg8::EpiBf16<0> E{Z, 1280};
                REPEAT_REP_IN(pg8::gemm_phase<pg8::EpiBf16<0>, pg8::StaticOrder, true, true>(X.lds, g, S, E);)
                if (G == 256 && (int)blockIdx.x >= 74) { LAS TrDesc* tab = (LAS TrDesc*)(X.lds + TR_LDS_OFF); if (X.tid == 0) { TRD_BEGIN(tab); TRD(args.in[18], D, 6176, 6400, (bf16*)(ws + WS_MLIN)); TRD(args.in[22], D, D, D, (bf16*)(ws + WS_MLWO)); TRD_END(); } __syncthreads(); tr_all(X, tab, TRD_TOTAL(), (int)blockIdx.x - 74, 256 - 74); } SEAM(pb + 0); }
            if (IN(pb + 1)) { mla_rows(X, Z, args.in[13], args.in[14], cosT, sinT, CQN, CKVN, KPE); SEAM(pb + 1); }
            if (IN(pb + 2)) {
                { pg8::Gemm g{CQN, (const bf16*)(ws + WS_MLAUQ), M, 3072, 512}; pg8::StaticOrder S; S.init(M, 3072, G, (int)blockIdx.x, WGM_UQ); pg8::EpiBf16<0> E{QH, 3072};
                  pg8::gemm_phase<pg8::EpiBf16<0>, pg8::StaticOrder, true, true>(X.lds, g, S, E); }
                { pg8::Gemm g{CKVN, (const bf16*)(ws + WS_MLAUKV), M, 4096, 512}; pg8::StaticOrder S; S.init(M, 4096, G, (int)blockIdx.x, WGM_UQ); pg8::EpiBf16<0> E{KV, 4096};
                  pg8::gemm_phase<pg8::EpiBf16<0>, pg8::StaticOrder, true, true>(X.lds, g, S, E); }
                SEAM(pb + 2); }
            if (IN(pb + 3)) { m16::mla_attn_phase16(X.lds, QH, KV, KPE, cosT, sinT, o); SEAM(pb + 3); }
        } else {
            bf16* Z = (bf16*)(big + BIG_LZ); bf16* QK = (bf16*)(big + BIG_LQK); float* GT = (float*)(big + BIG_LG);
            wo_t = (const bf16*)(ws + WS_MLWO);
            if (IN(pb + 0)) { pg8::Gemm g{a, (const bf16*)(ws + WS_MLIN), M, 6400, D}; pg8::StaticOrder S; S.init(M, 6400, G, (int)blockIdx.x, WGM_IN); pg8::EpiBf16<0> E{Z, 6400};
                REPEAT_REP_IN(pg8::gemm_phase<pg8::EpiBf16<0>, pg8::StaticOrder, true, true>(X.lds, g, S, E);)
                if (G == 256 && (int)blockIdx.x >= 114) { LAS TrDesc* tab = (LAS TrDesc*)(X.lds + TR_LDS_OFF); if (X.tid == 0) { TRD_BEGIN(tab); TRD(args.in[9] + (size_t)D * 6144, D, 6144, 6144, (bf16*)(ws + WS_NAQKV) + (size_t)D * 6144); TRD(args.in[11] + (size_t)D * D, D, D, D, (bf16*)(ws + WS_NAWO) + (size_t)D * D); TRD_END(); } __syncthreads(); tr_all(X, tab, TRD_TOTAL(), (int)blockIdx.x - 114, 256 - 114); } SEAM(pb + 0); }
            if (IN(pb + 1)) { ml_rows(X, Z, args.in[20], args.in[19], QK, GT); SEAM(pb + 1); }
            float* Ub = (float*)(ws + WS_SLAB); float* Nb = Ub + (size_t)32 * ml::NGRP * 8 * 4096;
            if (IN(pb + 2)) { ml::scan_phase_a(X.lds, QK, Z, GT, Ub, Nb); SEAM(pb + 2); }
            if (IN(pb + 3)) { ml::scan_phase_b(X.lds, QK, Z, GT, y, a, Ub, Nb); SEAM(pb + 3); }
            if (IN(pb + 4)) { ml_gate_rows(X, Z, y, a, args.in[21], o); SEAM(pb + 4); }
        }
        constexpr bool LASTL = (L == DEPTH - 1); float* slab = (float*)(ws + WS_SLAB);
        if (IN(pb + 5)) { { pg8::Gemm g{o, wo_t, MLAT, D, D}; pg8::StaticOrder S; S.init(MLAT, D, G, (int)blockIdx.x, WGM_WO); pg8::EpiBf16<0> E{y, D};
            REPEAT_REP_WO(pg8::gemm_phase<pg8::EpiBf16<0>, pg8::StaticOrder, true, true>(X.lds, g, S, E);) }
            if (!LASTL) { pg8::Gemm g{o + (size_t)MLAT * D, wo_t, MCTX, D, 256, D}; pg8::SplitKOrder S; S.init(MCTX, D, 8, G, (int)blockIdx.x); pg8::EpiF32Slab E{slab, D, (size_t)MCTX * D};
                pg8::gemm_phase<pg8::EpiF32Slab, pg8::SplitKOrder, true, true>(X.lds, g, S, E); }
            SEAM(pb + 5); }
        if (IN(pb + 6)) { vec_setup(X, mod, norm_g, true, L, 2, 1, true, L, 2, 3, 4); npost<0, false>(X, y, h, a, nullptr, slab, 0, 0, MLAT); if (!LASTL) npost<0, true>(X, y, h, a, nullptr, slab, 8, MLAT, M); __syncthreads(); SEAM(pb + 6); }
        bf16* HID = (bf16*)(big + BIG_HID);
        if (IN(pb + 7)) { constexpr int MR = LASTL ? MLAT : M; pg8::Gemm g{a, (const bf16*)(ws + WS_W1T) + (size_t)L * D * DFF, MR, DFF, D}; pg8::StaticOrder S; S.init(MR, DFF, G, (int)blockIdx.x, WGM_F1); pg8::EpiBf16<2> E{HID, DFF};
            const bool tailwg = !LASTL && G == 256 && blockIdx.x >= 64; const int r_ = (int)blockIdx.x - 64; const int npre = tailwg ? 2 * (((int)blockIdx.x & 7) >> 1) : 0; const bool pre = npre > 0;
            LAS TrDesc* tab = (LAS TrDesc*)(X.lds + TR_LDS_OFF);
            if (tailwg) {
                if (X.tid == 0) { for (int i = 0; i < TR_NMAT; ++i) tab[i].base = 0x7fffffff;
                    tab[0].W = args.in[7] + (size_t)(L + 1) * D * DFF; tab[0].WT = (bf16*)(ws + WS_W1T) + (size_t)(L + 1) * D * DFF; tab[0].K = D; tab[0].N = DFF; tab[0].Npad = DFF; tab[0].base = 0;
                    tab[1].W = args.in[8] + (size_t)(L + 1) * D * DFF; tab[1].WT = (bf16*)(ws + WS_W2T) + (size_t)(L + 1) * D * DFF; tab[1].K = DFF; tab[1].N = D; tab[1].Npad = D; tab[1].base = 1024; }
                __syncthreads();
                if (pre) tr_all(X, tab, min(2048, r_ + 192 * npre), r_, 192); }
            REPEAT_REP_FFN1(pg8::gemm_phase<pg8::EpiBf16<2>, pg8::StaticOrder, true, true>(X.lds, g, S, E);)
            if (tailwg) tr_all(X, tab, 2048, r_ + 192 * npre, 192);
            SEAM(pb + 7); }
        if (IN(pb + 8)) { { pg8::Gemm g{HID, (const bf16*)(ws + WS_W2T) + (size_t)L * D * DFF, MLAT, D, DFF}; pg8::StaticOrder S; S.init(MLAT, D, G, (int)blockIdx.x, WGM_F2); pg8::EpiBf16<0> E{y, D};
            REPEAT_REP_FFN2(pg8::gemm_phase<pg8::EpiBf16<0>, pg8::StaticOrder, true, true>(X.lds, g, S, E);) }
            if (!LASTL) { pg8::Gemm g{HID + (size_t)MLAT * DFF, (const bf16*)(ws + WS_W2T) + (size_t)L * D * DFF, MCTX, D, 512, DFF}; pg8::SplitKOrder S; S.init(MCTX, D, 16, G, (int)blockIdx.x); pg8::EpiF32Slab E{slab, D, (size_t)MCTX * D};
                pg8::gemm_phase<pg8::EpiF32Slab, pg8::SplitKOrder, true, true>(X.lds, g, S, E); }
            SEAM(pb + 8); }
        if (IN(pb + 9)) {
            if (L < DEPTH - 1) { vec_setup(X, mod, norm_g, true, L, 5, 3, true, L + 1, 0, 0, 1); npost<0, false>(X, y, h, a, nullptr, slab, 0, 0, MLAT); npost<0, true>(X, y, h, a, nullptr, slab, 16, MLAT, M); }
            else { vec_setup(X, mod, norm_g, true, L, 5, 3, false, 0, 0, 0, 0); npost<1, false>(X, y, h, nullptr, args.out, slab, 0, 0, MLAT); }
            __syncthreads(); SEAM(pb + 9); }
}
__global__ void __launch_bounds__(NTHR, 2) mega_fwd(Args args) {
    extern __shared__ __attribute__((aligned(16))) unsigned char lds_raw[];
    Ctx X; X.lds = (LAS unsigned char*)lds_raw; X.tid = threadIdx.x; X.lane = X.tid & 63; X.wave = __builtin_amdgcn_readfirstlane(X.tid >> 6);
    X.gw = blockIdx.x * NWAVES + X.wave; X.ngw = gridDim.x * NWAVES;
    volatile LAS unsigned* MISC = (volatile LAS unsigned*)(X.lds + MISC_OFF);
    for (int u = X.tid; u < (LDS_BYTES - RING_BYTES) / 4; u += NTHR) ((LAS unsigned*)(X.lds + RING_BYTES))[u] = 0u;
    __syncthreads();
    unsigned char* ws = args.ws;
    const int lo = args.ph_lo, hi = args.ph_hi; const bool single = (hi - lo) > 1;
    XcdBarrier bar; bar.bar = (unsigned*)(ws + WS_CTL) + CW_BAR; bar.x = 0; bar.st = nullptr;
    if (single) bar = xcd_barrier_post((unsigned*)(ws + WS_CTL) + CW_BAR, MISC + 8);
    const float* x = args.in[0]; const float* c = args.in[1]; const float* ctx = args.in[2]; const float* c_ctx = args.in[3]; const float* ada_w = args.in[4]; const float* ada_b = args.in[5]; const float* norm_g = args.in[6];
    float* mod = (float*)(ws + WS_MOD); float* cosT = (float*)(ws + WS_ROPE); float* sinT = cosT + 2048; float* part = (float*)(ws + WS_PART);
    hfp* h = (hfp*)(ws + WS_H); bf16* a = (bf16*)(ws + WS_A); bf16* y = (bf16*)(ws + WS_Y); bf16* o = (bf16*)(ws + WS_O); unsigned char* big = ws + WS_BIG;
    const int G = gridDim.x;

    if (IN(0)) { for (int rep_ = 0; rep_ < REP_P0; ++rep_) {
        ada_partials(X, c, c_ctx, ada_w, part);
        rope_table(X, cosT, sinT);
        { LAS TrDesc* tab = (LAS TrDesc*)(X.lds + TR_LDS_OFF);
          if (X.tid == 0) { TRD_BEGIN(tab); const bool all = gridDim.x != 256;
            for (int l = 0; l < (all ? 4 : 1); ++l) { TRD(args.in[7] + (size_t)l * D * DFF, D, DFF, DFF, (bf16*)(ws + WS_W1T) + (size_t)l * D * DFF); TRD(args.in[8] + (size_t)l * D * DFF, DFF, D, D, (bf16*)(ws + WS_W2T) + (size_t)l * D * DFF); }
            for (int j = 0; j < (all ? 2 : 1); ++j) { TRD(args.in[9] + (size_t)j * D * 6144, D, 6144, 6144, (bf16*)(ws + WS_NAQKV) + (size_t)j * D * 6144); TRD(args.in[11] + (size_t)j * D * D, D, D, D, (bf16*)(ws + WS_NAWO) + (size_t)j * D * D); }
            if (all) { TRD(args.in[12], D, 1088, 1280, (bf16*)(ws + WS_MLAIN)); TRD(args.in[15], 512, 3072, 3072, (bf16*)(ws + WS_MLAUQ)); TRD(args.in[16], 512, 4096, 4096, (bf16*)(ws + WS_MLAUKV)); TRD(args.in[17], D, D, D, (bf16*)(ws + WS_MLAWO));
                       TRD(args.in[18], D, 6176, 6400, (bf16*)(ws + WS_MLIN)); TRD(args.in[22], D, D, D, (bf16*)(ws + WS_MLWO)); }
            TRD_END(); }
          __syncthreads();
          tr_all(X, tab, TRD_TOTAL(), (int)blockIdx.x, (int)gridDim.x); }
        __syncthreads(); }
        SEAM(0);
    }
    if (IN(1)) {
        for (int i = blockIdx.x * NTHR + X.tid; i < 4 * 3 * NMOD; i += G * NTHR) { const int l = i / (3 * NMOD), rem = i % (3 * NMOD), j = rem % NMOD; float s = ada_b[l * NMOD + j];
            for (int sl = 0; sl < 16; ++sl) s += part[((size_t)(sl * 4 + l) * 3) * NMOD + rem];
            mod[i] = s; }
        SEAM(1);
    }
    if (IN(2)) {
        vec_setup(X, mod, norm_g, false, 0, 0, 0, true, 0, 0, 0, 1);
        first_norm(X, x, ctx, h, a);
        __syncthreads();
        SEAM(2);
    }
    run_layer<0>(X, args, bar, lo, hi, single); run_layer<1>(X, args, bar, lo, hi, single); run_layer<2>(X, args, bar, lo, hi, single); run_layer<3>(X, args, bar, lo, hi, single);
#undef IN
#undef SEAM
}

#ifndef MK_SINGLE
#define MK_SINGLE 1
#endif
extern "C" void kernel_launch(void* const* d_in, const int* in_sizes, int n_in, void* d_out, int out_size, void* d_ws, size_t ws_size, hipStream_t stream) {
    static int grid = 0;
    if (grid == 0) {
        if (n_in != 23 || in_sizes[0] != MLAT * D || out_size != MLAT * D || ws_size < WS_END) { fprintf(stderr, "kernel_launch: shape mismatch n_in %d in0 %d out %d ws %zu (need %zu)\n", n_in, n_in > 0 ? in_sizes[0] : -1, out_size, ws_size, (size_t)WS_END); grid = -1; return; }
        int dev = 0, cus = 0;
        if (hipGetDevice(&dev) != hipSuccess || hipDeviceGetAttribute(&cus, hipDeviceAttributeMultiprocessorCount, dev) != hipSuccess) { grid = -1; return; }
        if (hipFuncSetAttribute((const void*)mega_fwd, hipFuncAttributeMaxDynamicSharedMemorySize, LDS_BYTES) != hipSuccess) { fprintf(stderr, "kernel_launch: hipFuncSetAttribute failed\n"); grid = -1; return; }
        int per_cu = 0;
        if (hipOccupancyMaxActiveBlocksPerMultiprocessor(&per_cu, (const void*)mega_fwd, NTHR, LDS_BYTES) != hipSuccess || per_cu < 1) fprintf(stderr, "kernel_launch: occupancy query reports %d\n", per_cu);
        (void)hipGetLastError();
        grid = cus;
    }
    if (grid < 0) return;
    if (hipMemsetAsync((char*)d_ws + WS_CTL, 0, CTL_ZERO_BYTES, stream) != hipSuccess) return;
    Args a{};
    for (int i = 0; i < 23; ++i) a.in[i] = (const float*)d_in[i];
    a.out = (float*)d_out; a.ws = (unsigned char*)d_ws;
#if MK_SINGLE
    a.ph_lo = 0; a.ph_hi = NPHASES;
    hipLaunchKernelGGL(mega_fwd, dim3(grid), dim3(NTHR), LDS_BYTES, stream, a);
#else
    for (int p = 0; p < NPHASES; ++p) { if (!phase_active(p)) continue; a.ph_lo = p; a.ph_hi = p + 1; hipLaunchKernelGGL(mega_fwd, dim3(grid), dim3(NTHR), LDS_BYTES, stream, a); }
#endif
    const hipError_t le = hipPeekAtLastError();
    if (le != hipSuccess) fprintf(stderr, "kernel_launch: launch failed: %s\n", hipGetErrorName(le));
}
```

```cpp
#include <hip/hip_runtime.h>
#include <cstdio>
#include <cstdint>
#include <cmath>
namespace pg8 {
#define PG8_LAS __attribute__((address_space(3)))
typedef unsigned short bf16_t;
typedef short bf16x8 __attribute__((ext_vector_type(8)));
typedef float f32x4 __attribute__((ext_vector_type(4)));
typedef unsigned u32x4 __attribute__((ext_vector_type(4)));
constexpr int BM = 256, BK = 64, HALF = 128, HTB = HALF * BK * 2  , STAGE_BYTES = 8 * HTB, NXCD = 8, WGM = 8;

__host__ __device__ __forceinline__ int lds_byte(int r, int c) { const int st = (r >> 4) * 2 + (c >> 5), rr = r & 15, cc = c & 31, ob = rr * 64 + cc * 2; return st * 1024 + (ob ^ (((ob >> 9) & 1) << 5)); }
__host__ __device__ __forceinline__ void stage_rc(int b, int& R, int& C) { const int st = b / 1024, sb = b % 1024, swz = sb ^ (((sb >> 9) & 1) << 5); R = (st >> 1) * 16 + swz / 64; C = (st & 1) * 32 + (swz % 64) / 2; }
__host__ __device__ __forceinline__ int perm32(int rho) { const int n = rho >> 4, i = rho & 15; return 8 * (i >> 2) + 4 * n + (i & 3); }

struct Unit { int pm, pn, pk; };
struct Gemm { const bf16_t* A; const bf16_t* Bt; int M, N, K, ld; };

struct StaticOrder {
    int nM, nN, nwg, G, c, wgm;
    __host__ __device__ void init(int M, int N, int G_, int c_, int wgm_ = WGM) { nM = M / BM; nN = N / BM; nwg = nM * nN; G = G_; c = c_; wgm = wgm_; }
    __host__ __device__ bool next(int i, Unit& u) const {
        const long L = (long)i * G + c; if (L >= nwg) return false;
        int wgid = (int)L; { const int q = nwg / NXCD, r = nwg % NXCD, xcd = wgid % NXCD, off = wgid / NXCD; wgid = (xcd < r ? xcd * (q + 1) : r * (q + 1) + (xcd - r) * q) + off; }
        const int nig = wgm * nN, gid = wgid / nig, fm = gid * wgm, gsz = (nM - fm) < wgm ? (nM - fm) : wgm;
        u.pm = fm + ((wgid % nig) % gsz); u.pn = (wgid % nig) / gsz; u.pk = 0; return true;
    }
    __device__ __forceinline__ void a_ready(const Unit&) const {}
    __device__ __forceinline__ void done(const Unit&) const {}
};

struct SplitKOrder {
    int nN, KS, nitems, G, c;
    __host__ __device__ void init(int M, int N, int KS_, int G_, int c_) { nN = N / BM; KS = KS_; nitems = (M / BM) * nN * KS_; G = G_; c = c_; }
    __host__ __device__ bool next(int i, Unit& u) const { const long L = (long)i * G + c; if (L >= nitems) return false; const int l = (int)L; u.pk = l % KS; const int t = l / KS; u.pn = t % nN; u.pm = t / nN; return true; }
    __device__ __forceinline__ void a_ready(const Unit&) const {}
    __device__ __forceinline__ void done(const Unit&) const {}
};

__device__ __forceinline__ unsigned cvt_pk_bf16(float lo, float hi) { unsigned r; asm volatile("v_cvt_pk_bf16_f32 %0, %1, %2" : "=v"(r) : "v"(lo), "v"(hi)); return r; }
typedef float f32x2 __attribute__((ext_vector_type(2)));
template <int ACT> struct EpiBf16 {
    static constexpr bool PERM = true, AFTER_DRAIN = false;
    bf16_t* O; int ldc;
    __device__ __forceinline__ void operator()(const f32x4 (&acc)[2][2][4][2], const Unit& u, int wr, int wc, int fr, int fq) const {
        const int row0 = u.pm * BM + wr * 64 + fr; const int col0 = u.pn * BM + wc * 32 + 8 * fq;
#pragma unroll
        for (int ai = 0; ai < 2; ++ai)
#pragma unroll
            for (int m = 0; m < 4; ++m) { bf16_t* rowp = O + (size_t)(row0 + ai * HALF + m * 16) * ldc + col0;
#pragma unroll
                for (int bj = 0; bj < 2; ++bj) { f32x4 v0 = acc[ai][bj][m][0], v1 = acc[ai][bj][m][1];
                    if (ACT == 2) {
#pragma unroll
                        for (int e = 0; e < 4; ++e) { const float a = v0[e] > 0.f ? v0[e] : 0.f, b = v1[e] > 0.f ? v1[e] : 0.f; v0[e] = a * a; v1[e] = b * b; } }
                    u32x4 w; w.x = cvt_pk_bf16(v0[0], v0[1]); w.y = cvt_pk_bf16(v0[2], v0[3]); w.z = cvt_pk_bf16(v1[0], v1[1]); w.w = cvt_pk_bf16(v1[2], v1[3]);
                    *(u32x4*)(rowp + bj * HALF) = w; } }
    }
};

struct EpiF32Slab {
    static constexpr bool PERM = false, AFTER_DRAIN = false;
    float* O; int ldc; size_t slab;
    __device__ __forceinline__ void operator()(const f32x4 (&acc)[2][2][4][2], const Unit& u, int wr, int wc, int fr, int fq) const {
        const int row0 = u.pm * BM + wr * 64 + fr; const int col0 = u.pn * BM + wc * 32 + 4 * fq; float* base = O + (size_t)u.pk * slab;
#pragma unroll
        for (int ai = 0; ai < 2; ++ai)
#pragma unroll
            for (int m = 0; m < 4; ++m) { float* rowp = base + (size_t)(row0 + ai * HALF + m * 16) * ldc + col0;
#pragma unroll
                for (int bj = 0; bj < 2; ++bj)
#pragma unroll
                    for (int n = 0; n < 2; ++n) *(f32x4*)(rowp + bj * HALF + n * 16) = acc[ai][bj][m][n]; }
    }
};

template <class Epi, class Sched, bool ALIGN_EPI = false, bool SP2 = false>
__device__ __forceinline__ void gemm_phase(PG8_LAS unsigned char* lds, const Gemm g, const Sched& S, const Epi& E) {
    const int tid = threadIdx.x, wid = __builtin_amdgcn_readfirstlane(tid >> 6), lane = tid & 63, wr = wid >> 2, wc = wid & 3, fr = lane & 15, fq = lane >> 4;
    const int K = g.K, nt = K / BK, ld = g.ld ? g.ld : g.K;
    unsigned voffA[2], voffB[2];
#pragma unroll
    for (int i = 0; i < 2; ++i) { int R, C; stage_rc(tid * 16 + i * 8192, R, C); const int Rb = Epi::PERM ? ((R & ~31) + perm32(R & 31)) : R;
        voffA[i] = (unsigned)(R * ld + C) * 2u; voffB[i] = (unsigned)(Rb * ld + C) * 2u; }
    const size_t kstep = (size_t)(BK * 2);
    const size_t hstep = (size_t)HALF * ld * 2;
    const size_t tstep = 2 * hstep;
    const unsigned ldsw = (unsigned)wid * 1024u;
    const int aoff = lds_byte(wr * 64 + fr, fq * 8), boff = lds_byte(wc * 32 + fr, fq * 8);
#define PG8_SA(b, h) (((b) * 2 + (h)) * HTB)
#define PG8_SB(b, h) ((4 + (b) * 2 + (h)) * HTB)
#define PG8_STAGE(bufoff, gbase, voff) do { _Pragma("unroll") for (int _i = 0; _i < 2; ++_i) \
        __builtin_amdgcn_global_load_lds((const unsigned*)((const char*)(gbase) + (voff)[_i]), (PG8_LAS unsigned*)(lds + (bufoff) + ldsw + _i * 8192), 16, 0, 0); } while (0)
#define PG8_LDA(dst, b, h) do { _Pragma("unroll") for (int m = 0; m < 4; ++m) _Pragma("unroll") for (int k = 0; k < 2; ++k) dst[m][k] = *(const PG8_LAS bf16x8*)(lds + PG8_SA(b, h) + aoff + m * 2048 + k * 1024); } while (0)
#define PG8_LDB(dst, b, h) do { _Pragma("unroll") for (int n = 0; n < 2; ++n) _Pragma("unroll") for (int k = 0; k < 2; ++k) dst[n][k] = *(const PG8_LAS bf16x8*)(lds + PG8_SB(b, h) + boff + n * 2048 + k * 1024); } while (0)
#define PG8_MMA(ai, bj, At, Bt) do { __builtin_amdgcn_s_setprio(1); _Pragma("unroll") for (int m = 0; m < 4; ++m) _Pragma("unroll") for (int n = 0; n < 2; ++n) _Pragma("unroll") for (int k = 0; k < 2; ++k) \
        acc[ai][bj][m][n] = __builtin_amdgcn_mfma_f32_16x16x32_bf16(Bt[n][k], At[m][k], acc[ai][bj][m][n], 0, 0, 0); __builtin_amdgcn_s_setprio(0); } while (0)
#define PG8_WAIT_V(n) asm volatile("s_waitcnt vmcnt(" #n ")" ::: "memory")
#define PG8_WAIT_L(n) asm volatile("s_waitcnt lgkmcnt(" #n ")" ::: "memory")
#define PG8_BAR __builtin_amdgcn_s_barrier()
#define PG8_SCHED __builtin_amdgcn_sched_barrier(0)
    Unit cur, nxt; int ui = 0;
    if (!S.next(0, cur)) return;
    f32x4 acc[2][2][4][2];
#pragma unroll
    for (int a = 0; a < 2; ++a)
#pragma unroll
        for (int b = 0; b < 2; ++b)
#pragma unroll
            for (int m = 0; m < 4; ++m)
#pragma unroll
                for (int n = 0; n < 2; ++n) acc[a][b][m][n] = (f32x4){0.f, 0.f, 0.f, 0.f};
    bf16x8 At[4][2], B0[2][2], B1[2][2];
    const char* cA = (const char*)g.A + (size_t)cur.pm * tstep + (size_t)cur.pk * K * 2; const char* cB = (const char*)g.Bt + (size_t)cur.pn * tstep + (size_t)cur.pk * K * 2;
    S.a_ready(cur);
    if constexpr (SP2) {
        PG8_STAGE(PG8_SB(0, 0), cB, voffB); PG8_STAGE(PG8_SB(0, 1), cB + hstep, voffB); PG8_STAGE(PG8_SA(0, 0), cA, voffA); PG8_STAGE(PG8_SA(0, 1), cA + hstep, voffA);
        if (wr == 1) PG8_BAR;
        PG8_WAIT_V(2); PG8_BAR;
        PG8_STAGE(PG8_SB(1, 0), cB + kstep, voffB); PG8_STAGE(PG8_SA(1, 0), cA + kstep, voffA); PG8_STAGE(PG8_SB(1, 1), cB + hstep + kstep, voffB);
        PG8_WAIT_V(6); PG8_BAR;
    } else {
        PG8_STAGE(PG8_SB(0, 0), cB, voffB); PG8_STAGE(PG8_SA(0, 0), cA, voffA); PG8_STAGE(PG8_SB(0, 1), cB + hstep, voffB); PG8_STAGE(PG8_SA(0, 1), cA + hstep, voffA);
        if (wr == 1) PG8_BAR;
        PG8_WAIT_V(4); PG8_BAR;
        PG8_STAGE(PG8_SB(1, 0), cB + kstep, voffB); PG8_STAGE(PG8_SA(1, 0), cA + kstep, voffA); PG8_STAGE(PG8_SB(1, 1), cB + hstep + kstep, voffB);
        PG8_WAIT_V(6); PG8_BAR;
    }
    for (;;) {
        const bool has_next = S.next(ui + 1, nxt);
        const char* nA = has_next ? (const char*)g.A + (size_t)nxt.pm * tstep + (size_t)nxt.pk * K * 2 : cA; const char* nB = has_next ? (const char*)g.Bt + (size_t)nxt.pn * tstep + (size_t)nxt.pk * K * 2 : cB;
        for (int t = 0; t < nt; t += 2) {
            const bool last = (t == nt - 2);
            const char* a1 = cA + (size_t)(t + 1) * kstep;
            const char* a2 = last ? nA : cA + (size_t)(t + 2) * kstep; const char* b2 = last ? nB : cB + (size_t)(t + 2) * kstep;
            const char* a3 = a2 + kstep; const char* b3 = b2 + kstep;
            if (last && has_next) S.a_ready(nxt);
            if constexpr (SP2) {
            PG8_LDB(B0, 0, 0); PG8_LDB(B1, 0, 1); PG8_SCHED; PG8_LDA(At, 0, 0); PG8_STAGE(PG8_SA(1, 1), a1 + hstep, voffA);
            PG8_WAIT_V(8); PG8_WAIT_L(0); PG8_BAR; PG8_MMA(0, 0, At, B0); PG8_MMA(0, 1, At, B1); PG8_BAR; PG8_SCHED;
            PG8_LDA(At, 0, 1); PG8_STAGE(PG8_SB(0, 0), b2, voffB); PG8_STAGE(PG8_SB(0, 1), b2 + hstep, voffB); PG8_STAGE(PG8_SA(0, 0), a2, voffA);
            PG8_WAIT_V(8); PG8_WAIT_L(0); PG8_BAR; PG8_MMA(1, 0, At, B0); PG8_MMA(1, 1, At, B1); PG8_BAR; PG8_SCHED;
            PG8_LDB(B0, 1, 0); PG8_LDB(B1, 1, 1); PG8_SCHED; PG8_LDA(At, 1, 0); PG8_STAGE(PG8_SA(0, 1), a2 + hstep, voffA);
            PG8_WAIT_V(8); PG8_WAIT_L(0); PG8_BAR; PG8_MMA(0, 0, At, B0); PG8_MMA(0, 1, At, B1); PG8_BAR; PG8_SCHED;
            PG8_LDA(At, 1, 1); PG8_STAGE(PG8_SB(1, 0), b3, voffB); PG8_STAGE(PG8_SB(1, 1), b3 + hstep, voffB); PG8_STAGE(PG8_SA(1, 0), a3, voffA);
            PG8_WAIT_V(8); PG8_WAIT_L(0); PG8_BAR; PG8_MMA(1, 0, At, B0); PG8_MMA(1, 1, At, B1); PG8_BAR; PG8_SCHED;
            } else {
            PG8_LDB(B0, 0, 0); PG8_SCHED; PG8_LDA(At, 0, 0); PG8_STAGE(PG8_SA(1, 1), a1 + hstep, voffA);
            PG8_WAIT_L(8); PG8_BAR; PG8_WAIT_L(0); PG8_MMA(0, 0, At, B0); PG8_BAR; PG8_SCHED;
            PG8_LDB(B1, 0, 1); PG8_STAGE(PG8_SB(0, 0), b2, voffB);
            PG8_BAR; PG8_WAIT_L(0); PG8_MMA(0, 1, At, B1); PG8_BAR;
            PG8_LDA(At, 0, 1); PG8_STAGE(PG8_SA(0, 0), a2, voffA);
            PG8_BAR; PG8_WAIT_L(0); PG8_MMA(1, 0, At, B0); PG8_BAR; PG8_SCHED;
            PG8_STAGE(PG8_SB(0, 1), b2 + hstep, voffB);
            PG8_WAIT_V(6); PG8_BAR; PG8_MMA(1, 1, At, B1); PG8_BAR;
            PG8_LDB(B0, 1, 0); PG8_SCHED; PG8_LDA(At, 1, 0); PG8_STAGE(PG8_SA(0, 1), a2 + hstep, voffA);
            PG8_WAIT_L(8); PG8_BAR; PG8_WAIT_L(0); PG8_MMA(0, 0, At, B0); PG8_BAR; PG8_SCHED;
            PG8_LDB(B1, 1, 1); PG8_STAGE(PG8_SB(1, 0), b3, voffB);
            PG8_BAR; PG8_WAIT_L(0); PG8_MMA(0, 1, At, B1); PG8_BAR;
            PG8_LDA(At, 1, 1); PG8_STAGE(PG8_SA(1, 0), a3, voffA);
            PG8_BAR; PG8_WAIT_L(0); PG8_MMA(1, 0, At, B0); PG8_BAR; PG8_SCHED;
            PG8_STAGE(PG8_SB(1, 1), b3 + hstep, voffB);
            PG8_WAIT_V(6); PG8_BAR; PG8_MMA(1, 1, At, B1); PG8_BAR;
            }
        }
        if constexpr (ALIGN_EPI) { if (wr == 0) PG8_BAR; }
        if constexpr (!Epi::AFTER_DRAIN) { E(acc, cur, wr, wc, fr, fq); S.done(cur); }
        if (!has_next) break;
#pragma unroll
        for (int a = 0; a < 2; ++a)
#pragma unroll
            for (int b = 0; b < 2; ++b)
#pragma unroll
                for (int m = 0; m < 4; ++m)
#pragma unroll
                    for (int n = 0; n < 2; ++n) acc[a][b][m][n] = (f32x4){0.f, 0.f, 0.f, 0.f};
        cur = nxt; cA = nA; cB = nB; ++ui;
        if constexpr (ALIGN_EPI) { if (wr == 1) PG8_BAR; }
    }
    PG8_WAIT_V(0);
    if constexpr (!ALIGN_EPI) { if (wr == 0) PG8_BAR; }
    PG8_BAR;
    if constexpr (Epi::AFTER_DRAIN) { E.fused(acc, cur, wr, wc, fr, fq, lds, wid, lane); S.done(cur); }
#undef PG8_SA
#undef PG8_SB
#undef PG8_STAGE
#undef PG8_LDA
#undef PG8_LDB
#undef PG8_MMA
#undef PG8_WAIT_V
#undef PG8_WAIT_L
#undef PG8_BAR
#undef PG8_SCHED
}
}
#define GAS __attribute__((address_space(1)))
#define LAS __attribute__((address_space(3)))
typedef unsigned short bf16;
typedef unsigned v4u __attribute__((ext_vector_type(4)));
typedef float f32x4 __attribute__((ext_vector_type(4)));
typedef short bf16x8 __attribute__((ext_vector_type(8)));
typedef GAS unsigned gu32;
typedef GAS unsigned long long gu64;
#define RLX_AGENT __ATOMIC_RELAXED, __HIP_MEMORY_SCOPE_AGENT
#define LDS_WAIT() asm volatile("s_waitcnt lgkmcnt(0)" ::: "memory")
#define VM_WAIT() asm volatile("s_waitcnt vmcnt(0)" ::: "memory")
__device__ __forceinline__ unsigned long long rt() { return __builtin_amdgcn_s_memrealtime(); }
__device__ __forceinline__ unsigned f2bf(float f) { unsigned u = __builtin_bit_cast(unsigned, f); return (u + 0x7fffu + ((u >> 16) & 1u)) >> 16; }
__device__ __forceinline__ unsigned pk2(float lo, float hi) { return f2bf(lo) | (f2bf(hi) << 16); }

#define XB_TMO      128
#define XB_XCNT(j)  (256  + 64 * (j))
#define XB_XSUB(j)  (1280 + 64 * (j))
#define XB_XGEN(j)  (2304 + 64 * (j))
#define XB_TOP      3328
#define XB_TOPGEN   3392
#define XCD_BAR_WORDS 3456
#define XB_SPIN_CAP (1u << 18)

__device__ __forceinline__ unsigned xb_ld(unsigned* p)              { return __hip_atomic_load(p, __ATOMIC_RELAXED, __HIP_MEMORY_SCOPE_AGENT); }
__device__ __forceinline__ unsigned xb_add(unsigned* p, unsigned v) { return __hip_atomic_fetch_add(p, v, __ATOMIC_RELAXED, __HIP_MEMORY_SCOPE_AGENT); }
__device__ __forceinline__ unsigned xb_xcc_id() { return (unsigned)__builtin_amdgcn_s_getreg((3 << 11) | 20) & 0xFu; }
#define XB_SPIN(cond, bar) do { unsigned _sp = 0; while (cond) { __builtin_amdgcn_s_sleep(1); \
    if ((++_sp & 255u) == 0u) { if (xb_ld(&(bar)[XB_TMO])) break; if (_sp > XB_SPIN_CAP) { atomicAdd(&(bar)[XB_TMO], 1u); break; } } } } while (0)

struct XcdBarrier {
    unsigned* bar; unsigned x;
    volatile LAS unsigned* st;
};

__device__ __forceinline__ XcdBarrier xcd_barrier_post(unsigned* bar, volatile LAS unsigned* st) {
    XcdBarrier b; b.bar = bar; b.x = xb_xcc_id(); b.st = st;
    if (threadIdx.x == 0) (void)xb_add(&bar[XB_XCNT(b.x)], 1u);
    return b;
}
__device__ __forceinline__ void xcd_barrier_complete(unsigned* bar, unsigned x, unsigned& nloc, unsigned& nx) {
    const unsigned G = gridDim.x * gridDim.y * gridDim.z;
    unsigned sum, cnt, mine, sp = 0u;
    for (;;) {
        sum = 0u; cnt = 0u; mine = 0u;
#pragma unroll
        for (unsigned j = 0; j < 16; ++j) { const unsigned c = xb_ld(&bar[XB_XCNT(j)]); sum += c; cnt += (c > 0u) ? 1u : 0u; mine = (j == x) ? c : mine; }
        if (sum == G) break;
        __builtin_amdgcn_s_sleep(1);
        if ((++sp & 255u) == 0u) { if (xb_ld(&bar[XB_TMO])) break; if (sp > XB_SPIN_CAP) { atomicAdd(&bar[XB_TMO], 1u); break; } }
    }
    nloc = mine > 0u ? mine : 1u; nx = cnt > 0u ? cnt : 1u;
}

__device__ __forceinline__ void xcd_barrier(const XcdBarrier& b) {
    asm volatile("s_waitcnt vmcnt(0)" ::: "memory");
    __syncthreads();
    if (threadIdx.x == 0) {
        unsigned* bar = b.bar;
        __builtin_amdgcn_s_waitcnt(0);
        unsigned nloc = b.st[0], nx = b.st[1];
        if (nloc == 0u) { xcd_barrier_complete(bar, b.x, nloc, nx); b.st[0] = nloc; b.st[1] = nx; }
        const unsigned old = xb_add(&bar[XB_XSUB(b.x)], 1u);
        const unsigned gen = old / nloc;
        if (old + 1u == (gen + 1u) * nloc) {
            __builtin_amdgcn_fence(__ATOMIC_RELEASE, "agent");
            asm volatile("s_waitcnt vmcnt(0)" ::: "memory");
            const unsigned og = xb_add(&bar[XB_TOP], 1u);
            const unsigned tg = og / nx;
            if (og + 1u == (tg + 1u) * nx) xb_add(&bar[XB_TOPGEN], 1u);
            else XB_SPIN(xb_ld(&bar[XB_TOPGEN]) == tg, bar);
            __builtin_amdgcn_fence(__ATOMIC_ACQUIRE, "agent");
            xb_add(&bar[XB_XGEN(b.x)], 1u);
            asm volatile("s_waitcnt vmcnt(0)" ::: "memory");
        } else {
            XB_SPIN(xb_ld(&bar[XB_XGEN(b.x)]) == gen, bar);
            __builtin_amdgcn_fence(__ATOMIC_ACQUIRE, "agent");
            asm volatile("s_waitcnt vmcnt(0)" ::: "memory");
        }
    }
    __syncthreads();
}
__device__ __forceinline__ float wave_sum(float v) {
#pragma unroll
    for (int o = 1; o < 64; o <<= 1) v += __shfl_xor(v, o);
    return v;
}
__device__ __forceinline__ void p0_transpose_item(const float* W, int K, int N, bf16* WT, int row_off, LAS float* scr, int item, int lane) {
    const int nblk = N / 32, kb = item / nblk, nb = item % nblk, k0 = 64 * kb, n0 = 32 * nb;
#pragma unroll 8
    for (int i = 0; i < 32; ++i) { const int kk = 2 * i + (lane >> 5); scr[kk * 33 + (lane & 31)] = W[(size_t)(k0 + kk) * N + n0 + (lane & 31)]; }
    LDS_WAIT(); asm volatile("" ::: "memory");
    const int c = lane & 7;
#pragma unroll
    for (int j = 0; j < 4; ++j) { const int n = (lane >> 3) + 8 * j; const LAS float* s = scr + (8 * c) * 33 + n;
        v4u o; o.x = pk2(s[0 * 33], s[1 * 33]); o.y = pk2(s[2 * 33], s[3 * 33]); o.z = pk2(s[4 * 33], s[5 * 33]); o.w = pk2(s[6 * 33], s[7 * 33]);
        *(GAS v4u*)(WT + (size_t)(row_off + n0 + n) * K + k0 + 8 * c) = o; }
    LDS_WAIT(); asm volatile("" ::: "memory");
}
#ifndef WGM_IN
#define WGM_IN 4
#endif
#ifndef WGM_UQ
#define WGM_UQ 4
#endif
#ifndef WGM_WO
#define WGM_WO 4
#endif
#ifndef WGM_F1
#define WGM_F1 4
#endif
#ifndef WGM_F2
#define WGM_F2 4
#endif
#ifndef REP_IN
#define REP_IN 1
#endif
#ifndef REP_NA
#define REP_NA 1
#endif
#ifndef REP_MLA
#define REP_MLA 1
#endif
#ifndef REP_SCAN
#define REP_SCAN 1
#endif
#ifndef REP_WO
#define REP_WO 1
#endif
#ifndef REP_FFN1
#define REP_FFN1 1
#endif
#ifndef REP_FFN2
#define REP_FFN2 1
#endif
#ifndef REP_P0
#define REP_P0 1
#endif

#if REP_IN == 2
#define REPEAT_REP_IN(...) __VA_ARGS__ __VA_ARGS__
#else
#define REPEAT_REP_IN(...) __VA_ARGS__
#endif
#if REP_NA == 2
#define REPEAT_REP_NA(...) __VA_ARGS__ __VA_ARGS__
#else
#define REPEAT_REP_NA(...) __VA_ARGS__
#endif
#if REP_MLA == 2
#define REPEAT_REP_MLA(...) __VA_ARGS__ __VA_ARGS__
#else
#define REPEAT_REP_MLA(...) __VA_ARGS__
#endif
#if REP_SCAN == 2
#define REPEAT_REP_SCAN(...) __VA_ARGS__ __VA_ARGS__
#else
#define REPEAT_REP_SCAN(...) __VA_ARGS__
#endif
#if REP_WO == 2
#define REPEAT_REP_WO(...) __VA_ARGS__ __VA_ARGS__
#else
#define REPEAT_REP_WO(...) __VA_ARGS__
#endif
#if REP_FFN1 == 2
#define REPEAT_REP_FFN1(...) __VA_ARGS__ __VA_ARGS__
#else
#define REPEAT_REP_FFN1(...) __VA_ARGS__
#endif
#if REP_FFN2 == 2
#define REPEAT_REP_FFN2(...) __VA_ARGS__ __VA_ARGS__
#else
#define REPEAT_REP_FFN2(...) __VA_ARGS__
#endif

constexpr int NWAVES = 8, NTHR = 512;
constexpr int D = 2048, NB = 2, SEQ = 8192, CTXL = 256, DFF = 8192, DEPTH = 4;
constexpr int MLAT = NB * SEQ, MCTX = NB * CTXL, M = MLAT + MCTX;
constexpr float EPS = 1e-6f;
constexpr int NMOD = 6 * D;
constexpr size_t MiB = 1u << 20;
constexpr size_t WS_CTL = 0, CTL_ZERO_BYTES = 1 * MiB;
constexpr size_t WS_MOD = 1 * MiB, WS_ROPE = 2 * MiB, WS_PART = 3 * MiB;
constexpr size_t WS_W1T = 12 * MiB, WS_W2T = WS_W1T + 128 * MiB, WS_NAQKV = WS_W2T + 128 * MiB, WS_NAWO = WS_NAQKV + 48 * MiB;
constexpr size_t WS_MLAIN = WS_NAWO + 16 * MiB, WS_MLAUQ = WS_MLAIN + 5 * MiB, WS_MLAUKV = WS_MLAUQ + 3 * MiB, WS_MLAWO = WS_MLAUKV + 4 * MiB;
constexpr size_t WS_MLIN = WS_MLAWO + 8 * MiB, WS_MLWO = WS_MLIN + 25 * MiB;
constexpr size_t WS_H = WS_MLWO + 8 * MiB, WS_A = WS_H + 132 * MiB, WS_Y = WS_A + 66 * MiB, WS_O = WS_Y + 66 * MiB, WS_BIG = WS_O + 66 * MiB, WS_SLAB = WS_BIG + 276 * MiB, WS_END = WS_SLAB + 64 * MiB;
constexpr size_t BIG_QKV = 0;
constexpr size_t BIG_QH = 0, BIG_MZ = 0, BIG_KV = 99 * MiB, BIG_CQN = 231 * MiB, BIG_CKVN = BIG_CQN + (size_t)M * 512 * 2, BIG_KPE = 264 * MiB;
constexpr size_t BIG_LZ = 0, BIG_LQK = 207 * MiB, BIG_LG = 273 * MiB;
constexpr size_t BIG_HID = 0;
constexpr int CW_BAR = 4096;
constexpr int RING_BYTES = 131072, LDS_BYTES = 147456, MISC_OFF = LDS_BYTES - 256;

__device__ __forceinline__ float bf_lo(unsigned w) { return __uint_as_float(w << 16); }
__device__ __forceinline__ float bf_hi(unsigned w) { return __uint_as_float(w & 0xffff0000u); }
__device__ __forceinline__ float bf1(bf16 b) { return __uint_as_float(((unsigned)b) << 16); }
__device__ __forceinline__ unsigned pkbf(float lo, float hi) { return pg8::cvt_pk_bf16(lo, hi); }
__device__ __forceinline__ void unpack8(const v4u w, float* f) { f[0] = bf_lo(w.x); f[1] = bf_hi(w.x); f[2] = bf_lo(w.y); f[3] = bf_hi(w.y); f[4] = bf_lo(w.z); f[5] = bf_hi(w.z); f[6] = bf_lo(w.w); f[7] = bf_hi(w.w); }
__device__ __forceinline__ float sigmoidf_(float x) { return 1.f / (1.f + expf(-x)); }

typedef _Float16 hfp;
typedef _Float16 hfp4 __attribute__((ext_vector_type(4)));
struct Ctx { LAS unsigned char* lds; int tid, lane, wave, gw, ngw; };

__device__ __forceinline__ void tr_matrix(const Ctx& X, const float* W, int K, int N, bf16* WT) {
    LAS float* scr = (LAS float*)(X.lds + X.wave * 8448);
    const int nitems = (K / 64) * (N / 32);
    for (int it = X.gw; it < nitems; it += X.ngw) p0_transpose_item(W, K, N, WT, 0, scr, it, X.lane);
}
struct TrDesc { const float* W; bf16* WT; int K, N, Npad, base; };
constexpr int TR_NMAT = 18, TR_LDS_OFF = 132096;
__device__ __forceinline__ void tr_decode(const LAS TrDesc* tab, int g, const float*& W, bf16*& WT, int& K, int& N, int& k0, int& n0) {
    int mi = 0;
#pragma unroll 1
    for (int i = 1; i < TR_NMAT; ++i) if (g >= tab[i].base) mi = i;
    const LAS TrDesc* d = tab + mi; const int it = g - d->base, nb = d->Npad >> 8; W = d->W; WT = d->WT; K = d->K; N = d->N; k0 = (it / nb) * 64; n0 = (it % nb) * 256;
}
struct TrItem { const float* W; bf16* WT; int K, N, k0, n0; };
__device__ __forceinline__ void tr_all(const Ctx& X, const LAS TrDesc* tab, int total, const int first, const int G) {
    LAS float* T = (LAS float*)X.lds; const int q = X.tid & 63, rr = X.tid >> 6, c = X.tid & 7;
    if (first >= total) return;
#define TR_LOAD(v_, I_) do { _Pragma("unroll") for (int i = 0; i < 8; ++i) { const int n = (I_).n0 + 4 * q; v_[i] = n < (I_).N ? *(const f32x4*)((I_).W + (size_t)((I_).k0 + rr + 8 * i) * (I_).N + n) : (f32x4){0.f, 0.f, 0.f, 0.f}; } } while (0)
#define TR_PUT(v_) do { _Pragma("unroll") for (int i = 0; i < 8; ++i) *(LAS f32x4*)(T + (rr + 8 * i) * 256 + 4 * (q ^ i)) = v_[i]; } while (0)
#define TR_STORE(I_) do { _Pragma("unroll") for (int j = 0; j < 4; ++j) { const int nn = (X.tid >> 3) + 64 * j; const LAS float* s = T + (8 * c) * 256 + (nn ^ (4 * c)); \
        v4u o; o.x = pk2(s[0 * 256], s[1 * 256]); o.y = pk2(s[2 * 256], s[3 * 256]); o.z = pk2(s[4 * 256], s[5 * 256]); o.w = pk2(s[6 * 256], s[7 * 256]); \
        *(GAS v4u*)((I_).WT + (size_t)((I_).n0 + nn) * (I_).K + (I_).k0 + 8 * c) = o; } } while (0)
    TrItem A, B, Cn; f32x4 va[8], vb[8];
    int g = first;
    tr_decode(tab, g, A.W, A.WT, A.K, A.N, A.k0, A.n0); TR_LOAD(va, A);
    bool hasB = g + G < total; B = A; if (hasB) { tr_decode(tab, g + G, B.W, B.WT, B.K, B.N, B.k0, B.n0); TR_LOAD(vb, B); }
    for (;;) {
        const bool hasC = g + 2 * G < total; Cn = A; if (hasC) tr_decode(tab, g + 2 * G, Cn.W, Cn.WT, Cn.K, Cn.N, Cn.k0, Cn.n0);
        TR_PUT(va); __syncthreads();
        const TrItem cur = A;
        if (hasC) { A = Cn; TR_LOAD(va, A); }
        TR_STORE(cur); __syncthreads();
        if (!hasB) break;
        const bool hasD = g + 3 * G < total; Cn = B; if (hasD) tr_decode(tab, g + 3 * G, Cn.W, Cn.WT, Cn.K, Cn.N, Cn.k0, Cn.n0);
        TR_PUT(vb); __syncthreads();
        const TrItem cur2 = B;
        if (hasD) { B = Cn; TR_LOAD(vb, B); }
        TR_STORE(cur2); __syncthreads();
        if (!hasC) break;
        hasB = hasD; g += 2 * G;
    }
#undef TR_LOAD
#undef TR_PUT
#undef TR_STORE
}
__device__ __forceinline__ void zero_bf16(const Ctx& X, bf16* p, size_t n8) {
    for (size_t i = (size_t)blockIdx.x * NTHR + X.tid; i < n8; i += (size_t)gridDim.x * NTHR) ((v4u*)p)[i] = (v4u){0u, 0u, 0u, 0u};
}
__device__ __forceinline__ void ada_partials(const Ctx& X, const float* c, const float* c_ctx, const float* ada_w, float* part) {
    LAS float* S = (LAS float*)(X.lds + 69632);
    for (int i = X.tid; i < 3 * D; i += NTHR) { const int cls = i / D, k = i % D; const float v = cls < 2 ? c[cls * D + k] : c_ctx[k]; S[i] = v / (1.f + expf(-v)); }
    __syncthreads();
    for (int it = X.gw; it < 4 * 48 * 16; it += X.ngw) {
        const int sl = it & 15, cb = (it >> 4) % 48, l = it / (16 * 48);
        const float* W = ada_w + ((size_t)l * D + sl * 128) * NMOD + cb * 256 + X.lane * 4;
        f32x4 a0 = {0.f, 0.f, 0.f, 0.f}, a1 = a0, a2 = a0;
#pragma unroll 8
        for (int kk = 0; kk < 128; ++kk) { const f32x4 w = *(const f32x4*)(W + (size_t)kk * NMOD); const int k = sl * 128 + kk; a0 += w * S[k]; a1 += w * S[D + k]; a2 += w * S[2 * D + k]; }
        float* P = part + ((size_t)(sl * 4 + l) * 3) * NMOD + cb * 256 + X.lane * 4;
        *(f32x4*)(P) = a0; *(f32x4*)(P + NMOD) = a1; *(f32x4*)(P + 2 * NMOD) = a2;
    }
}
__device__ __forceinline__ void rope_table(const Ctx& X, float* cosT, float* sinT) {
    for (int i = blockIdx.x * NTHR + X.tid; i < 2048; i += gridDim.x * NTHR) {
        const int pos = i >> 4, p = i & 15;
        const double f = exp(-(double)p * (9.210340371976184 / 16.0)); const double ang = (double)pos * f;
        const double k = rint(ang * 0.15915494309189535); const double r = ang - k * 6.283185307179586;
        cosT[i] = (float)cos(r); sinT[i] = (float)sin(r);
    }
}
__device__ __forceinline__ const float* modv(const float* mod, int l, int cls, int chunk) { return mod + ((size_t)(l * 3 + cls) * 6 + chunk) * D; }
__device__ __forceinline__ void vec_setup(const Ctx& X, const float* mod, const float* norm_g, bool has_gate, int l_gate, int chunk_gate, int gi_post, bool has_next, int l_next, int gi_pre, int chunk_sh, int chunk_sc) {
    LAS float* G = (LAS float*)(X.lds); LAS float* A = (LAS float*)(X.lds + 24576); LAS float* S = (LAS float*)(X.lds + 49152);
    for (int i = X.tid; i < 3 * D; i += NTHR) { const int cls = i / D, k = i % D;
        if (has_gate) G[i] = modv(mod, l_gate, cls, chunk_gate)[k] * norm_g[(l_gate * 4 + gi_post) * D + k];
        if (has_next) { A[i] = norm_g[(l_next * 4 + gi_pre) * D + k] * (1.f + modv(mod, l_next, cls, chunk_sc)[k]); S[i] = modv(mod, l_next, cls, chunk_sh)[k]; } }
    __syncthreads();
}
__device__ __forceinline__ void first_norm(const Ctx& X, const float* x, const float* ctx, hfp* h, bf16* a) {
    const LAS f32x4* A = (const LAS f32x4*)(X.lds + 24576); const LAS f32x4* S = (const LAS f32x4*)(X.lds + 49152);
    for (int row = X.gw; row < M; row += X.ngw) {
        const int cls = row < MLAT ? (row >> 13) : 2;
        const f32x4* src = (const f32x4*)(row < MLAT ? x + (size_t)row * D : ctx + (size_t)(row - MLAT) * D) + X.lane;
        f32x4 v[8]; float ss = 0.f;
#pragma unroll
        for (int j = 0; j < 8; ++j) { v[j] = src[64 * j]; ss += (v[j].x * v[j].x + v[j].y * v[j].y) + (v[j].z * v[j].z + v[j].w * v[j].w); }
        const float rstd = 1.f / sqrtf(wave_sum(ss) * (1.f / D) + EPS);
        hfp4* hp = (hfp4*)(h + (size_t)row * D) + X.lane; unsigned long long* ap = (unsigned long long*)(a + (size_t)row * D) + X.lane;
#pragma unroll
        for (int j = 0; j < 8; ++j) { hp[64 * j] = __builtin_convertvector(v[j], hfp4); const f32x4 av = A[cls * 512 + 64 * j + X.lane], sv = S[cls * 512 + 64 * j + X.lane]; const f32x4 o = v[j] * rstd * av + sv;
            ap[64 * j] = (unsigned long long)pkbf(o.x, o.y) | ((unsigned long long)pkbf(o.z, o.w) << 32); }
    }
}
template <int MODE, bool SLAB> __device__ __forceinline__ void npost(const Ctx& X, const bf16* y, hfp* h, bf16* a, float* out, const float* slab, const int KS, const int row_lo, const int row_hi) {
    const LAS f32x4* G = (const LAS f32x4*)(X.lds); const LAS f32x4* A = (const LAS f32x4*)(X.lds + 24576); const LAS f32x4* S = (const LAS f32x4*)(X.lds + 49152);
    for (int row = row_lo + X.gw; row < row_hi; row += X.ngw) {
        const int cls = row < MLAT ? (row >> 13) : 2;
        hfp4* hp = (hfp4*)(h + (size_t)row * D) + X.lane;
        f32x4 hv[8], yv[8]; float ssy = 0.f;
        if (!SLAB) {
            const unsigned long long* yp = (const unsigned long long*)(y + (size_t)row * D) + X.lane;
#pragma unroll
            for (int j = 0; j < 8; ++j) { const unsigned long long w = yp[64 * j]; const unsigned lo = (unsigned)w, hi = (unsigned)(w >> 32); yv[j] = (f32x4){bf_lo(lo), bf_hi(lo), bf_lo(hi), bf_hi(hi)}; }
        } else {
            const f32x4* sp = (const f32x4*)(slab + (size_t)(row - MLAT) * D) + X.lane;
#pragma unroll
            for (int j = 0; j < 8; ++j) yv[j] = sp[64 * j];
#pragma unroll 1
            for (int k = 1; k < KS; ++k) { sp += (MCTX * D / 4);
#pragma unroll
                for (int j = 0; j < 8; ++j) yv[j] += sp[64 * j]; }
        }
#pragma unroll
        for (int j = 0; j < 8; ++j) { hv[j] = __builtin_convertvector(hp[64 * j], f32x4); ssy += (yv[j].x * yv[j].x + yv[j].y * yv[j].y) + (yv[j].z * yv[j].z + yv[j].w * yv[j].w); }
        const float rstd_y = 1.f / sqrtf(wave_sum(ssy) * (1.f / D) + EPS); float ssh = 0.f;
#pragma unroll
        for (int j = 0; j < 8; ++j) { const f32x4 g = G[cls * 512 + 64 * j + X.lane]; hv[j] = hv[j] + g * (yv[j] * rstd_y); ssh += (hv[j].x * hv[j].x + hv[j].y * hv[j].y) + (hv[j].z * hv[j].z + hv[j].w * hv[j].w); }
        if (MODE == 0) {
            const float rstd_h = 1.f / sqrtf(wave_sum(ssh) * (1.f / D) + EPS);
            unsigned long long* ap = (unsigned long long*)(a + (size_t)row * D) + X.lane;
#pragma unroll
            for (int j = 0; j < 8; ++j) { hp[64 * j] = __builtin_convertvector(hv[j], hfp4); const f32x4 av = A[cls * 512 + 64 * j + X.lane], sv = S[cls * 512 + 64 * j + X.lane]; const f32x4 o = hv[j] * rstd_h * av + sv;
                ap[64 * j] = (unsigned long long)pkbf(o.x, o.y) | ((unsigned long long)pkbf(o.z, o.w) << 32); }
        } else {
            f32x4* op = (f32x4*)(out + (size_t)row * D) + X.lane;
#pragma unroll
            for (int j = 0; j < 8; ++j) op[64 * j] = hv[j];
        }
    }
}
__device__ __forceinline__ void mla_rows(const Ctx& X, const bf16* Z, const float* g_q, const float* g_kv, const float* cosT, const float* sinT, bf16* CQN, bf16* CKVN, bf16* KPE) {
    for (int row = X.gw; row < M; row += X.ngw) {
        const bf16* z = Z + (size_t)row * 1280;
#pragma unroll
        for (int part = 0; part < 2; ++part) {
            const v4u w = *(const v4u*)(z + part * 512 + 8 * X.lane); float f[8]; unpack8(w, f); float ss = 0.f;
#pragma unroll
            for (int i = 0; i < 8; ++i) ss += f[i] * f[i];
            const float rstd = 1.f / sqrtf(wave_sum(ss) * (1.f / 512.f) + EPS); const float* g = (part ? g_kv : g_q) + 8 * X.lane;
            v4u o; o.x = pkbf(f[0] * rstd * g[0], f[1] * rstd * g[1]); o.y = pkbf(f[2] * rstd * g[2], f[3] * rstd * g[3]); o.z = pkbf(f[4] * rstd * g[4], f[5] * rstd * g[5]); o.w = pkbf(f[6] * rstd * g[6], f[7] * rstd * g[7]);
            *(v4u*)((part ? CKVN : CQN) + (size_t)row * 512 + 8 * X.lane) = o;
        }
        const float xv = bf1(z[1024 + X.lane]); float ov = xv;
        const float x1 = __shfl(xv, X.lane & ~16), x2 = __shfl(xv, X.lane | 16);
        if (row < MLAT) { const int s = row & 8191, pos = (X.lane >> 5) ? (s & 63) : (s >> 6), p = X.lane & 15; const float cs = cosT[pos * 16 + p], sn = sinT[pos * 16 + p];
            ov = (X.lane & 16) ? (x1 * sn + x2 * cs) : (x1 * cs - x2 * sn); }
        KPE[(size_t)row * 64 + X.lane] = (bf16)(pkbf(ov, 0.f) & 0xffffu);
    }
}
__device__ __forceinline__ void ml_rows(const Ctx& X, const bf16* Z, const float* conv_w, const float* b_gate, bf16* QK, float* G) {
    for (int row = X.gw; row < M; row += X.ngw) {
        bool hp, hn; if (row < MLAT) { const int s = row & 8191; hp = s > 0; hn = s < 8191; } else { const int n = (row - MLAT) & 255; hp = n > 0; hn = n < 255; }
        const bf16* z = Z + (size_t)row * 6400;
#pragma unroll
        for (int j = 0; j < 4; ++j) { const int col = 8 * X.lane + 512 * j;
            float x0[8], x1[8], x2[8]; const v4u zero = {0u, 0u, 0u, 0u};
            unpack8(hp ? *(const v4u*)(z - 6400 + col) : zero, x0); unpack8(*(const v4u*)(z + col), x1); unpack8(hn ? *(const v4u*)(z + 6400 + col) : zero, x2);
            float o[8];
#pragma unroll
            for (int i = 0; i < 8; ++i) { float v = conv_w[col + i] * x0[i] + conv_w[2048 + col + i] * x1[i] + conv_w[4096 + col + i] * x2[i]; v = v / (1.f + expf(-v)); o[i] = col < 1024 ? v * 0.08838834764831845f : v; }
            v4u w; w.x = pkbf(o[0], o[1]); w.y = pkbf(o[2], o[3]); w.z = pkbf(o[4], o[5]); w.w = pkbf(o[6], o[7]);
            *(v4u*)(QK + (size_t)row * 2048 + col) = w; }
        if (X.lane < 32) { float v = bf1(z[6144 + X.lane]) + b_gate[X.lane]; if ((X.lane >> 3) & 1) v = fminf(v, 0.f) - log1pf(expf(-fabsf(v))); G[(size_t)row * 32 + X.lane] = v; }
    }
}
__device__ __forceinline__ void ml_gate_rows(const Ctx& X, const bf16* Z, const bf16* HF, const bf16* HB, const float* g_head, bf16* O) {
    for (int row = X.gw; row < M; row += X.ngw) {
#pragma unroll
        for (int j = 0; j < 4; ++j) { const int col = 8 * X.lane + 512 * j;
            float a[8], b[8], g[8]; unpack8(*(const v4u*)(HF + (size_t)row * 2048 + col), a); unpack8(*(const v4u*)(HB + (size_t)row * 2048 + col), b); unpack8(*(const v4u*)(Z + (size_t)row * 6400 + 4096 + col), g);
            float ss = 0.f;
#pragma unroll
            for (int i = 0; i < 8; ++i) { a[i] += b[i]; ss += a[i] * a[i]; }
#pragma unroll
            for (int o = 1; o < 32; o <<= 1) ss += __shfl_xor(ss, o);
            const float rstd = 1.f / sqrtf(ss * (1.f / 256.f) + EPS); float o[8];
#pragma unroll
            for (int i = 0; i < 8; ++i) o[i] = a[i] * rstd * g_head[col + i] * sigmoidf_(g[i]);
            v4u w; w.x = pkbf(o[0], o[1]); w.y = pkbf(o[2], o[3]); w.z = pkbf(o[4], o[5]); w.w = pkbf(o[6], o[7]);
            *(v4u*)(O + (size_t)row * 2048 + col) = w; }
    }
}
#define ATT_UPDATE(sc, vptr) do { const float s_ = (sc); const float mn_ = fmaxf(m_run, s_); const float corr_ = __expf(m_run - mn_), p_ = __expf(s_ - mn_); l_run = l_run * corr_ + p_; m_run = mn_; \
    _Pragma("unroll") for (int c_ = 0; c_ < 4; ++c_) { float vf_[8]; unpack8(*(const v4u*)((vptr) + 8 * c_), vf_); _Pragma("unroll") for (int i_ = 0; i_ < 8; ++i_) o[8 * c_ + i_] = o[8 * c_ + i_] * corr_ + p_ * vf_[i_]; } } while (0)
__device__ __forceinline__ float dot32(const bf16* kp, const float* q) { float s = 0.f;
#pragma unroll
    for (int c = 0; c < 4; ++c) { float kf[8]; unpack8(*(const v4u*)(kp + 8 * c), kf);
#pragma unroll
        for (int i = 0; i < 8; ++i) s += q[8 * c + i] * kf[i]; }
    return s; }
__device__ __forceinline__ float quad_sum(float s) { s += __shfl_xor(s, 1); s += __shfl_xor(s, 2); return s; }
__device__ __forceinline__ void store_o32(bf16* op, const float* o, float inv) {
#pragma unroll
    for (int c = 0; c < 4; ++c) { v4u w; w.x = pkbf(o[8 * c] * inv, o[8 * c + 1] * inv); w.y = pkbf(o[8 * c + 2] * inv, o[8 * c + 3] * inv); w.z = pkbf(o[8 * c + 4] * inv, o[8 * c + 5] * inv); w.w = pkbf(o[8 * c + 6] * inv, o[8 * c + 7] * inv); *(v4u*)(op + 8 * c) = w; } }

__device__ __forceinline__ void na_attn_naive(const Ctx& X, const bf16* QKV, const float* rpb, bf16* O, int nrows) {
    const int hd = X.lane >> 2, j = X.lane & 3; const float scale = 0.08838834764831845f;
    for (int row = X.gw; row < nrows; row += X.ngw) {
        float q[32], o[32]; float m_run = -INFINITY, l_run = 0.f;
#pragma unroll
        for (int c = 0; c < 4; ++c) unpack8(*(const v4u*)(QKV + (size_t)row * 6144 + hd * 128 + 32 * j + 8 * c), q + 8 * c);
#pragma unroll
        for (int i = 0; i < 32; ++i) o[i] = 0.f;
        int b;
        if (row < MLAT) {
            b = row >> 13; const int s = row & 8191, r = s >> 6, c = s & 63;
            const int rs = min(max(r - 4, 0), 120), cs = min(max(c - 8, 0), 48);
            for (int jr = 0; jr < 8; ++jr) for (int jc = 0; jc < 16; ++jc) {
                const int kr = rs + jr, kc = cs + jc; const size_t key = (size_t)b * 8192 + kr * 64 + kc;
                const float bias = rpb[(hd * 15 + (kr - r + 7)) * 31 + (kc - c + 15)];
                const bf16* kp = QKV + key * 6144 + 2048 + hd * 128 + 32 * j;
                const float sc = quad_sum(dot32(kp, q)) * scale + bias;
                ATT_UPDATE(sc, kp + 2048);
            }
        } else b = (row - MLAT) >> 8;
        for (int n = 0; n < 256; ++n) {
            const size_t key = (size_t)MLAT + b * 256 + n; const bf16* kp = QKV + key * 6144 + 2048 + hd * 128 + 32 * j;
            const float sc = quad_sum(dot32(kp, q)) * scale;
            ATT_UPDATE(sc, kp + 2048);
        }
        store_o32(O + (size_t)row * 2048 + hd * 128 + 32 * j, o, 1.f / l_run);
    }
}
__device__ __forceinline__ void mla_attn_naive(const Ctx& X, const bf16* QH, const bf16* KV, const bf16* KPE, const float* cosT, const float* sinT, bf16* O) {
    const int hd = X.lane >> 2, j = X.lane & 3; const float scale = 0.07216878364870322f;
    for (int row = X.gw; row < M; row += X.ngw) {
        float q[32], qp[16], o[32]; float m_run = -INFINITY, l_run = 0.f;
        const bf16* qrow = QH + (size_t)row * 3072 + hd * 192;
#pragma unroll
        for (int c = 0; c < 4; ++c) unpack8(*(const v4u*)(qrow + 32 * j + 8 * c), q + 8 * c);
        {
            const int axis = j >> 1; float x1[16], x2[16];
            unpack8(*(const v4u*)(qrow + 128 + axis * 32), x1); unpack8(*(const v4u*)(qrow + 128 + axis * 32 + 8), x1 + 8);
            unpack8(*(const v4u*)(qrow + 128 + axis * 32 + 16), x2); unpack8(*(const v4u*)(qrow + 128 + axis * 32 + 24), x2 + 8);
            if (row < MLAT) { const int s = row & 8191, pos = axis ? (s & 63) : (s >> 6);
#pragma unroll
                for (int p = 0; p < 16; ++p) { const float cs = cosT[pos * 16 + p], sn = sinT[pos * 16 + p]; qp[p] = (j & 1) ? (x1[p] * sn + x2[p] * cs) : (x1[p] * cs - x2[p] * sn); }
            } else {
#pragma unroll
                for (int p = 0; p < 16; ++p) qp[p] = (j & 1) ? x2[p] : x1[p];
            }
        }
#pragma unroll
        for (int i = 0; i < 32; ++i) o[i] = 0.f;
        const int b = row < MLAT ? (row >> 13) : ((row - MLAT) >> 8);
        const int nkeys = row < MLAT ? (256 + 8192) : 256;
        for (int n = 0; n < nkeys; ++n) {
            const size_t key = n < 256 ? (size_t)MLAT + b * 256 + n : (size_t)b * 8192 + (n - 256);
            const bf16* kp = KV + key * 4096 + hd * 256 + 32 * j; const bf16* pp = KPE + key * 64 + 16 * j;
            float s = dot32(kp, q); float kf[16]; unpack8(*(const v4u*)(pp), kf); unpack8(*(const v4u*)(pp + 8), kf + 8);
#pragma unroll
            for (int p = 0; p < 16; ++p) s += qp[p] * kf[p];
            const float sc = quad_sum(s) * scale;
            ATT_UPDATE(sc, kp + 128);
        }
        store_o32(O + (size_t)row * 2048 + hd * 128 + 32 * j, o, 1.f / l_run);
    }
}
__device__ __forceinline__ void ml_scan_naive(const Ctx& X, const bf16* QK, const bf16* Z, const float* G, bf16* HF, bf16* HB) {
    LAS float* L = (LAS float*)X.lds;
    LAS float* q = L; LAS float* k = L + 8256; LAS float* v = L + 16512; LAS float* S = L + 18624; LAS float* C = L + 22784; LAS float* nv = L + 27008;
    LAS float* li = L + 27136; LAS float* lf = L + 27200; LAS float* bc = L + 27264; LAS float* mt = L + 27328; LAS float* ex = L + 27392; LAS float* misc = L + 27456;
    const int tid = X.tid, t = tid >> 3, part = tid & 7;
    for (int u = blockIdx.x; u < 256; u += gridDim.x) {
        const int slice = u & 7, dir = (u >> 3) & 1, hd = (u >> 4) & 7, b = u >> 7;
        for (int i = tid; i < 128 * 33; i += NTHR) C[i] = 0.f;
        if (tid < 128) nv[tid] = 0.f;
        float m_run = 0.f;
        bf16* H = dir ? HB : HF;
        __syncthreads();
        for (int n = 0; n < 132; ++n) {
            int base;
            if (dir == 0) base = n < 4 ? MLAT + b * 256 + 64 * n : b * 8192 + 64 * (n - 4);
            else base = n < 4 ? MLAT + b * 256 + 64 * (3 - n) : b * 8192 + 64 * (131 - n);
            const int row = base + (dir ? 63 - t : t);
            {
                float f[16];
                unpack8(*(const v4u*)(QK + (size_t)row * 2048 + hd * 128 + part * 16), f); unpack8(*(const v4u*)(QK + (size_t)row * 2048 + hd * 128 + part * 16 + 8), f + 8);
#pragma unroll
                for (int i = 0; i < 16; ++i) q[t * 129 + part * 16 + i] = f[i];
                unpack8(*(const v4u*)(QK + (size_t)row * 2048 + 1024 + hd * 128 + part * 16), f); unpack8(*(const v4u*)(QK + (size_t)row * 2048 + 1024 + hd * 128 + part * 16 + 8), f + 8);
#pragma unroll
                for (int i = 0; i < 16; ++i) k[t * 129 + part * 16 + i] = f[i];
                const unsigned long long w = *(const unsigned long long*)(Z + (size_t)row * 6400 + 2048 + hd * 256 + slice * 32 + part * 4); const unsigned lo = (unsigned)w, hi = (unsigned)(w >> 32);
                v[t * 33 + part * 4 + 0] = bf_lo(lo); v[t * 33 + part * 4 + 1] = bf_hi(lo); v[t * 33 + part * 4 + 2] = bf_lo(hi); v[t * 33 + part * 4 + 3] = bf_hi(hi);
                if (tid < 64) { const int row2 = base + (dir ? 63 - tid : tid); li[tid] = G[(size_t)row2 * 32 + dir * 16 + hd]; lf[tid] = G[(size_t)row2 * 32 + dir * 16 + 8 + hd]; }
            }
            __syncthreads();
            if (tid == 0) {
                float bsum = 0.f, pm = -INFINITY;
                for (int s = 0; s < 64; ++s) { bsum += lf[s]; bc[s] = bsum; pm = fmaxf(pm, li[s] - bsum); mt[s] = bsum + fmaxf(m_run, pm); }
                const float m_new = bsum + fmaxf(m_run, pm); misc[0] = m_new; misc[1] = expf(bsum + m_run - m_new);
                for (int s = 0; s < 64; ++s) ex[s] = expf(bsum - bc[s] + li[s] - m_new);
            }
            __syncthreads();
            {
                const float bt = bc[t], mtt = mt[t];
                for (int i = 0; i < 8; ++i) { const int s = part + 8 * i; float r = 0.f;
                    if (s <= t) { float dsum = 0.f; for (int d = 0; d < 128; ++d) dsum += q[t * 129 + d] * k[s * 129 + d]; r = dsum * expf(bt - bc[s] + li[s] - mtt); }
                    S[t * 65 + s] = r; }
            }
            __syncthreads();
            {
                const float mtt = mt[t], winter = expf(bc[t] + m_run - mtt);
                float den = 0.f; for (int d = 0; d < 128; ++d) den += q[t * 129 + d] * nv[d];
                den *= winter; for (int s = 0; s < 64; ++s) den += S[t * 65 + s];
                const float dn = fmaxf(fabsf(den), expf(-mtt)); float hv[4];
#pragma unroll
                for (int i = 0; i < 4; ++i) { const int e = part * 4 + i; float a = 0.f; for (int d = 0; d < 128; ++d) a += q[t * 129 + d] * C[d * 33 + e];
                    a *= winter; for (int s = 0; s < 64; ++s) a += S[t * 65 + s] * v[s * 33 + e]; hv[i] = a / dn; }
                *(unsigned long long*)(H + (size_t)row * 2048 + hd * 256 + slice * 32 + part * 4) = (unsigned long long)pkbf(hv[0], hv[1]) | ((unsigned long long)pkbf(hv[2], hv[3]) << 32);
            }
            __syncthreads();
            { const float e = ex[t];
#pragma unroll
              for (int i = 0; i < 16; ++i) k[t * 129 + part * 16 + i] *= e; }
            __syncthreads();
            {
                const int d = tid >> 2, eg = (tid & 3) * 8; const float decay = misc[1];
#pragma unroll
                for (int i = 0; i < 8; ++i) { const int e = eg + i; float a = 0.f; for (int s = 0; s < 64; ++s) a += k[s * 129 + d] * v[s * 33 + e]; C[d * 33 + e] = decay * C[d * 33 + e] + a; }
                if ((tid & 3) == 0) { float a = 0.f; for (int s = 0; s < 64; ++s) a += k[s * 129 + d]; nv[d] = decay * nv[d] + a; }
                m_run = misc[0];
            }
            __syncthreads();
        }
    }
}

namespace fa {
using f32x16 = __attribute__((ext_vector_type(16))) float;
using s16x4  = __attribute__((ext_vector_type(4))) short;
#define FA_KSWZ(row, colB) ((row) * 256 + ((colB) ^ (((row) & 7) << 4)))
#define FA_PSWZ(row, colB) ((row) * 128 + ((colB) ^ (((row) & 7) << 4)))
#define FA_SBAR() __builtin_amdgcn_sched_barrier(0)
__device__ __forceinline__ int crow(int r, int hi) { return (r & 3) + 8 * (r >> 2) + 4 * hi; }
__device__ __forceinline__ unsigned cvtpk(float lo, float hi) { return pg8::cvt_pk_bf16(lo, hi); }
constexpr float THR = 8.f;
__device__ __forceinline__ void partialSM(f32x16& p0, f32x16& p1, float& m_reg, float& mn, float& alpha, const float SCALE) {
  const float C = SCALE * 1.4426950408889634f;
  float pmax = p0[0];
#pragma unroll
  for (int r = 1; r < 16; ++r) pmax = fmaxf(pmax, p0[r]);
#pragma unroll
  for (int r = 0; r < 16; ++r) pmax = fmaxf(pmax, p1[r]);
  { auto rr = __builtin_amdgcn_permlane32_swap(__float_as_uint(pmax), __float_as_uint(pmax), false, false);
    pmax = fmaxf(__uint_as_float(rr[0]), __uint_as_float(rr[1])); }
  if (__builtin_expect(__all(pmax - m_reg <= THR / SCALE), 1)) { mn = m_reg; alpha = 1.f; }
  else { mn = fmaxf(m_reg, pmax); alpha = __builtin_amdgcn_exp2f((m_reg - mn) * C); m_reg = mn; }
  const float mnC = -mn * C;
#pragma unroll
  for (int r = 0; r < 16; ++r) p0[r] = fmaf(p0[r], C, mnC);
#pragma unroll
  for (int r = 0; r < 16; ++r) p1[r] = fmaf(p1[r], C, mnC);
#pragma unroll
  for (int r = 0; r < 16; ++r) p0[r] = __builtin_amdgcn_exp2f(p0[r]);
}
__device__ __forceinline__ void finishSM(f32x16& p0, f32x16& p1, float alpha, float& l_reg, bf16x8& pa0, bf16x8& pa1, bf16x8& pa2, bf16x8& pa3) {
#pragma unroll
  for (int r = 0; r < 16; ++r) p1[r] = __builtin_amdgcn_exp2f(p1[r]);
  float ps = 0;
#pragma unroll
  for (int r = 0; r < 16; ++r) ps += p0[r];
#pragma unroll
  for (int r = 0; r < 16; ++r) ps += p1[r];
  { auto rr = __builtin_amdgcn_permlane32_swap(__float_as_uint(ps), __float_as_uint(ps), false, false);
    ps = __uint_as_float(rr[0]) + __uint_as_float(rr[1]); }
  l_reg = l_reg * alpha + ps;
#define FA_PK4(P, BASE, OUT) do { unsigned a0 = cvtpk(P[BASE + 0], P[BASE + 1]), a1 = cvtpk(P[BASE + 2], P[BASE + 3]);   \
    unsigned b0 = cvtpk(P[BASE + 4], P[BASE + 5]), b1 = cvtpk(P[BASE + 6], P[BASE + 7]);                              \
    auto r0 = __builtin_amdgcn_permlane32_swap(a0, b0, false, false); auto r1 = __builtin_amdgcn_permlane32_swap(a1, b1, false, false); \
    v4u w = {r0[0], r1[0], r0[1], r1[1]}; OUT = __builtin_bit_cast(bf16x8, w); } while (0)
  FA_PK4(p0, 0, pa0); FA_PK4(p0, 8, pa1); FA_PK4(p1, 0, pa2); FA_PK4(p1, 8, pa3);
#undef FA_PK4
}
__device__ __forceinline__ int v_st(int k, int c) { const int kk = (k & ~0xC) | ((k & 4) << 1) | ((k & 8) >> 1); return ((kk >> 3) * 4 + (c >> 5)) * 512 + ((kk & 7) * 32 + (c & 31)) * 2; }
__device__ __forceinline__ int v_rd_base(int lane) { return ((lane & 3) << 3) | (((lane >> 2) & 3) << 6) | (((lane >> 4) & 1) << 5) | (((lane >> 5) & 1) << 8); }
constexpr int v_rd_off(int d0, int ks, int half) { return d0 * 512 + ks * 4096 + half * 2048; }
template <int OFF> __device__ __forceinline__ s16x4 tr_read(int vb) {
  s16x4 r; asm volatile("ds_read_b64_tr_b16 %0, %1 offset:%2" : "=&v"(r) : "v"(vb), "i"(OFF) : "memory"); return r;
}
template <int D0> __device__ __forceinline__ void pv_one(f32x16& od, int vb, bf16x8 pa0, bf16x8 pa1, bf16x8 pa2, bf16x8 pa3) {
  const s16x4 l0 = tr_read<v_rd_off(D0, 0, 0)>(vb), h0 = tr_read<v_rd_off(D0, 0, 1)>(vb), l1 = tr_read<v_rd_off(D0, 1, 0)>(vb), h1 = tr_read<v_rd_off(D0, 1, 1)>(vb);
  const s16x4 l2 = tr_read<v_rd_off(D0, 2, 0)>(vb), h2 = tr_read<v_rd_off(D0, 2, 1)>(vb), l3 = tr_read<v_rd_off(D0, 3, 0)>(vb), h3 = tr_read<v_rd_off(D0, 3, 1)>(vb);
  asm volatile("s_waitcnt lgkmcnt(0)" ::: "memory"); FA_SBAR();
#define FA_PK(L, H) (bf16x8){L[0], L[1], L[2], L[3], H[0], H[1], H[2], H[3]}
  od = __builtin_amdgcn_mfma_f32_32x32x16_bf16(pa0, FA_PK(l0, h0), od, 0, 0, 0);
  od = __builtin_amdgcn_mfma_f32_32x32x16_bf16(pa1, FA_PK(l1, h1), od, 0, 0, 0);
  od = __builtin_amdgcn_mfma_f32_32x32x16_bf16(pa2, FA_PK(l2, h2), od, 0, 0, 0);
  od = __builtin_amdgcn_mfma_f32_32x32x16_bf16(pa3, FA_PK(l3, h3), od, 0, 0, 0);
#undef FA_PK
}
__device__ __forceinline__ void pv_d0(f32x16* o, int vb, bf16x8 pa0, bf16x8 pa1, bf16x8 pa2, bf16x8 pa3) {
  pv_one<0>(o[0], vb, pa0, pa1, pa2, pa3); pv_one<1>(o[1], vb, pa0, pa1, pa2, pa3); pv_one<2>(o[2], vb, pa0, pa1, pa2, pa3); pv_one<3>(o[3], vb, pa0, pa1, pa2, pa3);
}
constexpr int SHM_V = 16384, SHM_K = 16384, SHM_P = 8192, OFF_V = 0, OFF_K = 49152, OFF_P = 98304, OFF_WS = 122880, OFF_QP = 124928;
#define FA_DMA(gp, lp) __builtin_amdgcn_global_load_lds((const unsigned*)(gp), (LAS unsigned*)(lp), 16, 0, 0)

__device__ __forceinline__ void mla_unit(LAS unsigned char* lds, const bf16* __restrict__ QH, const bf16* __restrict__ KV, const bf16* __restrict__ KPE, const float* __restrict__ cosT, const float* __restrict__ sinT,
                                         bf16* __restrict__ O, const int qrow0, const bool latq, const int b, const int h) {
  constexpr float SCALE = 0.07216878364870322f;
  int tid_ = threadIdx.x; asm volatile("" : "+v"(tid_));
  const int tid = tid_, wid = __builtin_amdgcn_readfirstlane(tid >> 6), lane = tid & 63, r32 = lane & 31, hi = lane >> 5;
  LAS char* V_lds = (LAS char*)lds + OFF_V; LAS char* K_lds = (LAS char*)lds + OFF_K; LAS char* P_lds = (LAS char*)lds + OFF_P;
  LAS float* ws = (LAS float*)(lds + OFF_WS) + wid * 64; LAS float* li_l = ws; LAS float* al_l = ws + 32;
  unsigned offK[2], offV[2], offP;
#pragma unroll
  for (int i = 0; i < 2; ++i) { const int Lb = (2 * wid + i) * 1024 + 16 * lane;
    { const int row = Lb >> 8, colB = (Lb & 255) ^ ((row & 7) << 4); offK[i] = (unsigned)(row * 4096 + (colB >> 1)) * 2u; }
    { const int sub = Lb >> 9, w_ = Lb & 511, kk = (sub >> 2) * 8 + (w_ >> 6), c = (sub & 3) * 32 + ((w_ & 63) >> 1), k = (kk & ~0xC) | ((kk & 4) << 1) | ((kk & 8) >> 1); offV[i] = (unsigned)(k * 4096 + 128 + c) * 2u; } }
  { const int Lb = wid * 1024 + 16 * lane, row = Lb >> 7, colB = (Lb & 127) ^ ((row & 7) << 4); offP = (unsigned)(row * 64 + (colB >> 1)) * 2u; }
  const int NT = latq ? 132 : 4;
  const int ctx0 = MLAT + b * 256, lat0 = b * 8192 - 256;
  const bf16* KVh = KV + h * 256;
#define DMA_STEP(tk, tv, sK, sV) do { const int tk_ = (tk) < NT ? (tk) : NT - 1, tv_ = (tv) < NT ? (tv) : NT - 1; const int kb_ = (tk_ < 4 ? ctx0 : lat0) + 64 * tk_, vb_ = (tv_ < 4 ? ctx0 : lat0) + 64 * tv_; \
    const char* gk_ = (const char*)(KVh + (size_t)kb_ * 4096); const char* gp_ = (const char*)(KPE + (size_t)kb_ * 64); const char* gv_ = (const char*)(KVh + (size_t)vb_ * 4096); \
    FA_DMA(gk_ + offK[0], K_lds + (sK) * SHM_K + (2 * wid) * 1024); FA_DMA(gk_ + offK[1], K_lds + (sK) * SHM_K + (2 * wid + 1) * 1024); FA_DMA(gp_ + offP, P_lds + (sK) * SHM_P + wid * 1024); \
    FA_DMA(gv_ + offV[0], V_lds + (sV) * SHM_V + (2 * wid) * 1024); FA_DMA(gv_ + offV[1], V_lds + (sV) * SHM_V + (2 * wid + 1) * 1024); } while (0)
  DMA_STEP(0, 0, 0, 0); DMA_STEP(1, 0, 1, 2);
  float m_reg = -1e30f, l_reg = 0; f32x16 o[4] = {}; bf16x8 qr[12];
  const int qrow = qrow0 + wid * 32 + r32;
  const bf16* Qw = QH + (size_t)qrow * 3072 + h * 192 + hi * 8;
#pragma unroll
  for (int d0 = 0; d0 < 12; ++d0) qr[d0] = *(const bf16x8*)(Qw + d0 * 16);
  if (latq) {
    const int s = qrow & 8191;
#pragma unroll
    for (int ax = 0; ax < 2; ++ax) { const int pos = ax ? (s & 63) : (s >> 6); const float* ct = cosT + pos * 16 + 8 * hi; const float* st = sinT + pos * 16 + 8 * hi;
      float x1[8], x2[8]; unpack8(__builtin_bit_cast(v4u, qr[8 + 2 * ax]), x1); unpack8(__builtin_bit_cast(v4u, qr[9 + 2 * ax]), x2); float y1[8], y2[8];
#pragma unroll
      for (int i = 0; i < 8; ++i) { const float cs = ct[i], sn = st[i]; y1[i] = x1[i] * cs - x2[i] * sn; y2[i] = x1[i] * sn + x2[i] * cs; }
      const v4u w1 = {cvtpk(y1[0], y1[1]), cvtpk(y1[2], y1[3]), cvtpk(y1[4], y1[5]), cvtpk(y1[6], y1[7])}, w2 = {cvtpk(y2[0], y2[1]), cvtpk(y2[2], y2[3]), cvtpk(y2[4], y2[5]), cvtpk(y2[6], y2[7])};
      qr[8 + 2 * ax] = __builtin_bit_cast(bf16x8, w1); qr[9 + 2 * ax] = __builtin_bit_cast(bf16x8, w2); }
  }
  const int zsw = ((r32 & 7) ^ hi) << 4;
  const LAS char* kA0 = K_lds + r32 * 256 + (0 ^ zsw); const LAS char* kA1 = K_lds + r32 * 256 + (32 ^ zsw); const LAS char* kA2 = K_lds + r32 * 256 + (64 ^ zsw); const LAS char* kA3 = K_lds + r32 * 256 + (96 ^ zsw);
  const LAS char* pA0_ = P_lds + r32 * 128 + (0 ^ zsw); const LAS char* pA1_ = P_lds + r32 * 128 + (32 ^ zsw); const LAS char* pA2_ = P_lds + r32 * 128 + (64 ^ zsw); const LAS char* pA3_ = P_lds + r32 * 128 + (96 ^ zsw);
  const int vb0 = (int)(unsigned)(uintptr_t)V_lds + v_rd_base(lane);
#define QK1(p0, p1, KA, OFF, QV) do { const bf16x8 b0 = *(const LAS bf16x8*)((KA) + (OFF)); const bf16x8 b1 = *(const LAS bf16x8*)((KA) + (OFF) + 8192); \
    p0 = __builtin_amdgcn_mfma_f32_32x32x16_bf16(b0, QV, p0, 0, 0, 0); p1 = __builtin_amdgcn_mfma_f32_32x32x16_bf16(b1, QV, p1, 0, 0, 0); } while (0)
#define QP1(p0, p1, PA, OFF, QV) do { const bf16x8 b0 = *(const LAS bf16x8*)((PA) + (OFF)); const bf16x8 b1 = *(const LAS bf16x8*)((PA) + (OFF) + 4096); \
    p0 = __builtin_amdgcn_mfma_f32_32x32x16_bf16(b0, QV, p0, 0, 0, 0); p1 = __builtin_amdgcn_mfma_f32_32x32x16_bf16(b1, QV, p1, 0, 0, 0); } while (0)
#define QKT(p0, p1, s) do { p0 = f32x16{}; p1 = f32x16{}; const int ko_ = (s) * SHM_K, po_ = (s) * SHM_P; \
    QK1(p0, p1, kA0, ko_, qr[0]); QK1(p0, p1, kA1, ko_, qr[1]); QK1(p0, p1, kA2, ko_, qr[2]); QK1(p0, p1, kA3, ko_, qr[3]); \
    QK1(p0, p1, kA0, ko_ + 128, qr[4]); QK1(p0, p1, kA1, ko_ + 128, qr[5]); QK1(p0, p1, kA2, ko_ + 128, qr[6]); QK1(p0, p1, kA3, ko_ + 128, qr[7]); \
    QP1(p0, p1, pA0_, po_, qr[8]); QP1(p0, p1, pA1_, po_, qr[9]); QP1(p0, p1, pA2_, po_, qr[10]); QP1(p0, p1, pA3_, po_, qr[11]); } while (0)
#define RESC(a) do { if (__any((a) < 1.f)) { if (hi == 0) al_l[r32] = (a); asm volatile("s_waitcnt lgkmcnt(0)" ::: "memory"); \
    _Pragma("unroll") for (int d = 0; d < 4; ++d) _Pragma("unroll") for (int r = 0; r < 16; ++r) o[d][r] *= al_l[crow(r, hi)]; } } while (0)
#define STEP_END() do { asm volatile("s_waitcnt vmcnt(5) lgkmcnt(0)" ::: "memory"); __builtin_amdgcn_s_barrier(); asm volatile("" ::: "memory"); } while (0)
  f32x16 pA0, pA1, pB0, pB1; float mnA, mnB, alA, alB; bf16x8 pa0, pa1, pa2, pa3;
  STEP_END();
  int s0 = 0, s1 = 1, s2 = 2;
  DMA_STEP(2, 1, s2, s1);
  QKT(pA0, pA1, s0); partialSM(pA0, pA1, m_reg, mnA, alA, SCALE);
  STEP_END();
  for (int j = 1; j + 1 < NT; j += 2) {
    { const int t_ = s0; s0 = s1; s1 = s2; s2 = t_; }
    DMA_STEP(j + 2, j + 1, s2, s1);
    FA_SBAR(); QKT(pB0, pB1, s0);
    finishSM(pA0, pA1, alA, l_reg, pa0, pa1, pa2, pa3); FA_SBAR();
    pv_d0(o, vb0 + s2 * SHM_V, pa0, pa1, pa2, pa3); partialSM(pB0, pB1, m_reg, mnB, alB, SCALE);
    RESC(alB); STEP_END();
    { const int t_ = s0; s0 = s1; s1 = s2; s2 = t_; }
    DMA_STEP(j + 3, j + 2, s2, s1);
    FA_SBAR(); QKT(pA0, pA1, s0);
    finishSM(pB0, pB1, alB, l_reg, pa0, pa1, pa2, pa3); FA_SBAR();
    pv_d0(o, vb0 + s2 * SHM_V, pa0, pa1, pa2, pa3); partialSM(pA0, pA1, m_reg, mnA, alA, SCALE);
    RESC(alA); STEP_END();
  }
  { const int t_ = s0; s0 = s1; s1 = s2; s2 = t_; }
  DMA_STEP(NT, NT, s2, s1);
  FA_SBAR(); QKT(pB0, pB1, s0);
  finishSM(pA0, pA1, alA, l_reg, pa0, pa1, pa2, pa3); FA_SBAR();
  pv_d0(o, vb0 + s2 * SHM_V, pa0, pa1, pa2, pa3); partialSM(pB0, pB1, m_reg, mnB, alB, SCALE);
  RESC(alB); asm volatile("s_waitcnt vmcnt(0) lgkmcnt(0)" ::: "memory"); __builtin_amdgcn_s_barrier(); asm volatile("" ::: "memory");
  finishSM(pB0, pB1, alB, l_reg, pa0, pa1, pa2, pa3); FA_SBAR();
  pv_d0(o, vb0 + s0 * SHM_V, pa0, pa1, pa2, pa3);
  if (hi == 0) li_l[r32] = l_reg; asm volatile("s_waitcnt lgkmcnt(0)" ::: "memory");
  bf16* Ow = O + (size_t)(qrow0 + wid * 32) * 2048 + h * 128 + r32;
#pragma unroll
  for (int r = 0; r < 16; ++r) { const int orow = crow(r, hi); const float rli = __builtin_amdgcn_rcpf(li_l[orow]);
#pragma unroll
    for (int d0 = 0; d0 < 4; ++d0) Ow[(size_t)orow * 2048 + d0 * 32] = (bf16)(cvtpk(o[d0][r] * rli, 0.f) & 0xffffu); }
  asm volatile("s_waitcnt vmcnt(0)" ::: "memory"); __syncthreads();
#undef DMA_STEP
#undef QKT
#undef NA_BODY
#undef QK1
#undef QP1
#undef RESC
#undef STEP_END
}
__device__ __forceinline__ void mla_attn_phase(LAS unsigned char* lds, const bf16* QH, const bf16* KV, const bf16* KPE, const float* cosT, const float* sinT, bf16* O) {
  const int G = gridDim.x, bx = blockIdx.x;
  const int nu = (G == 256) ? (bx < 32 ? 5 : 4) : (1056 - bx + G - 1) / G;
  for (int i = 0; i < nu; ++i) {
    int bh, q0; bool latq;
    if (G == 256) { if (i < 4) { bh = i * 8 + (bx & 7); q0 = (bh >> 4) * 8192 + (bx >> 3) * 256; latq = true; } else { bh = bx; q0 = MLAT + (bh >> 4) * 256; latq = false; } }
    else { const int u = bx + i * G; if (u < 1024) { bh = u >> 5; q0 = (bh >> 4) * 8192 + (u & 31) * 256; latq = true; } else { bh = u - 1024; q0 = MLAT + (bh >> 4) * 256; latq = false; } }
    mla_unit(lds, QH, KV, KPE, cosT, sinT, O, q0, latq, bh >> 4, bh & 15);
  }
}

template <int MODE> __device__ __forceinline__ void partialSM_t(f32x16& p0, f32x16& p1, float& m_reg, float& mn, float& alpha, const float SCALE) {
  const float C = SCALE * 1.4426950408889634f;
  constexpr int A0 = (MODE == 2) ? 12 : 0, B1 = (MODE == 1) ? 4 : 16;
  float pmax = p0[A0];
#pragma unroll
  for (int r = A0 + 1; r < 16; ++r) pmax = fmaxf(pmax, p0[r]);
#pragma unroll
  for (int r = 0; r < B1; ++r) pmax = fmaxf(pmax, p1[r]);
  { auto rr = __builtin_amdgcn_permlane32_swap(__float_as_uint(pmax), __float_as_uint(pmax), false, false);
    pmax = fmaxf(__uint_as_float(rr[0]), __uint_as_float(rr[1])); }
  if (__builtin_expect(__all(pmax - m_reg <= THR / SCALE), 1)) { mn = m_reg; alpha = 1.f; }
  else { mn = fmaxf(m_reg, pmax); alpha = __builtin_amdgcn_exp2f((m_reg - mn) * C); m_reg = mn; }
  const float mnC = -mn * C;
#pragma unroll
  for (int r = A0; r < 16; ++r) p0[r] = fmaf(p0[r], C, mnC);
#pragma unroll
  for (int r = 0; r < B1; ++r) p1[r] = fmaf(p1[r], C, mnC);
#pragma unroll
  for (int r = A0; r < 16; ++r) p0[r] = __builtin_amdgcn_exp2f(p0[r]);
}
template <int MODE> __device__ __forceinline__ void finishSM_t(f32x16& p0, f32x16& p1, float alpha, float& l_reg, bf16x8& pa0, bf16x8& pa1, bf16x8& pa2, bf16x8& pa3) {
  constexpr int A0 = (MODE == 2) ? 12 : 0, B1 = (MODE == 1) ? 4 : 16;
#pragma unroll
  for (int r = 0; r < B1; ++r) p1[r] = __builtin_amdgcn_exp2f(p1[r]);
  float ps = 0;
#pragma unroll
  for (int r = A0; r < 16; ++r) ps += p0[r];
#pragma unroll
  for (int r = 0; r < B1; ++r) ps += p1[r];
  { auto rr = __builtin_amdgcn_permlane32_swap(__float_as_uint(ps), __float_as_uint(ps), false, false);
    ps = __uint_as_float(rr[0]) + __uint_as_float(rr[1]); }
  l_reg = l_reg * alpha + ps;
  if (MODE == 2) {
#pragma unroll
    for (int r = 8; r < 12; ++r) p0[r] = 0.f; }
  if (MODE == 1) {
#pragma unroll
    for (int r = 4; r < 8; ++r) p1[r] = 0.f; }
#define FA_PK4(P, BASE, OUT) do { unsigned a0 = cvtpk(P[BASE + 0], P[BASE + 1]), a1 = cvtpk(P[BASE + 2], P[BASE + 3]);   \
    unsigned b0 = cvtpk(P[BASE + 4], P[BASE + 5]), b1 = cvtpk(P[BASE + 6], P[BASE + 7]);                              \
    auto r0 = __builtin_amdgcn_permlane32_swap(a0, b0, false, false); auto r1 = __builtin_amdgcn_permlane32_swap(a1, b1, false, false); \
    v4u w = {r0[0], r1[0], r0[1], r1[1]}; OUT = __builtin_bit_cast(bf16x8, w); } while (0)
  if (MODE != 2) FA_PK4(p0, 0, pa0);
  FA_PK4(p0, 8, pa1); FA_PK4(p1, 0, pa2);
  if (MODE != 1) FA_PK4(p1, 8, pa3);
#undef FA_PK4
}
template <int D0, int MODE> __device__ __forceinline__ void pv_one_t(f32x16& od, int vb, bf16x8 pa0, bf16x8 pa1, bf16x8 pa2, bf16x8 pa3) {
#define FA_PK(L, H) (bf16x8){L[0], L[1], L[2], L[3], H[0], H[1], H[2], H[3]}
  if (MODE == 1) {
    const s16x4 l0 = tr_read<v_rd_off(D0, 0, 0)>(vb), h0 = tr_read<v_rd_off(D0, 0, 1)>(vb), l1 = tr_read<v_rd_off(D0, 1, 0)>(vb), h1 = tr_read<v_rd_off(D0, 1, 1)>(vb), l2 = tr_read<v_rd_off(D0, 2, 0)>(vb), h2 = tr_read<v_rd_off(D0, 2, 1)>(vb);
    asm volatile("s_waitcnt lgkmcnt(0)" ::: "memory"); FA_SBAR();
    od = __builtin_amdgcn_mfma_f32_32x32x16_bf16(pa0, FA_PK(l0, h0), od, 0, 0, 0); od = __builtin_amdgcn_mfma_f32_32x32x16_bf16(pa1, FA_PK(l1, h1), od, 0, 0, 0); od = __builtin_amdgcn_mfma_f32_32x32x16_bf16(pa2, FA_PK(l2, h2), od, 0, 0, 0);
  } else if (MODE == 2) {
    const s16x4 l1 = tr_read<v_rd_off(D0, 1, 0)>(vb), h1 = tr_read<v_rd_off(D0, 1, 1)>(vb), l2 = tr_read<v_rd_off(D0, 2, 0)>(vb), h2 = tr_read<v_rd_off(D0, 2, 1)>(vb), l3 = tr_read<v_rd_off(D0, 3, 0)>(vb), h3 = tr_read<v_rd_off(D0, 3, 1)>(vb);
    asm volatile("s_waitcnt lgkmcnt(0)" ::: "memory"); FA_SBAR();
    od = __builtin_amdgcn_mfma_f32_32x32x16_bf16(pa1, FA_PK(l1, h1), od, 0, 0, 0); od = __builtin_amdgcn_mfma_f32_32x32x16_bf16(pa2, FA_PK(l2, h2), od, 0, 0, 0); od = __builtin_amdgcn_mfma_f32_32x32x16_bf16(pa3, FA_PK(l3, h3), od, 0, 0, 0);
  } else pv_one<D0>(od, vb, pa0, pa1, pa2, pa3);
#undef FA_PK
}
template <int MODE> __device__ __forceinline__ void pv_d0_t(f32x16* o, int vb, bf16x8 pa0, bf16x8 pa1, bf16x8 pa2, bf16x8 pa3) {
  pv_one_t<0, MODE>(o[0], vb, pa0, pa1, pa2, pa3); pv_one_t<1, MODE>(o[1], vb, pa0, pa1, pa2, pa3); pv_one_t<2, MODE>(o[2], vb, pa0, pa1, pa2, pa3); pv_one_t<3, MODE>(o[3], vb, pa0, pa1, pa2, pa3);
}
__device__ __forceinline__ void na_unit(LAS unsigned char* lds, const bf16* __restrict__ QKV, const float* __restrict__ rpb_h, bf16* __restrict__ O, const int qrow0, const bool ctxq, const int b, const int h, const int r0) {
  constexpr float SCALE = 0.08838834764831845f, ISCALE = 11.313708498984761f;
  const int tid = threadIdx.x, wid = __builtin_amdgcn_readfirstlane(tid >> 6), lane = tid & 63, r32 = lane & 31, hi = lane >> 5;
  LAS char* V_lds = (LAS char*)lds + OFF_V; LAS char* K_lds = (LAS char*)lds + OFF_K;
  LAS float* ws = (LAS float*)(lds + OFF_WS) + wid * 64; LAS float* li_l = ws; LAS float* al_l = ws + 32;
  LAS float* rpbL = (LAS float*)(lds + OFF_QP + 1024);
  unsigned offK[2], offV[2];
#pragma unroll
  for (int i = 0; i < 2; ++i) { const int Lb = (2 * wid + i) * 1024 + 16 * lane;
    { const int row = Lb >> 8, colB = (Lb & 255) ^ ((row & 7) << 4); offK[i] = (unsigned)(row * 6144 + (colB >> 1)) * 2u; }
    { const int sub = Lb >> 9, w_ = Lb & 511, kk = (sub >> 2) * 8 + (w_ >> 6), c = (sub & 3) * 32 + ((w_ & 63) >> 1), k = (kk & ~0xC) | ((kk & 4) << 1) | ((kk & 8) >> 1); offV[i] = (unsigned)(k * 6144 + c) * 2u; } }
  const int R0 = min(max(r0 - 4, 0), 120), R1 = min(max(r0 + 3 - 4, 0), 120) + 7;
  const int nW = ctxq ? 0 : (R1 - R0 + 1), NT = nW + 4;
  const int wbase = b * 8192 + R0 * 64, cbase = MLAT + b * 256;
  const bf16* Kh = QKV + 2048 + h * 128; const bf16* Vh = QKV + 4096 + h * 128;
#define NA_KB(t) (((t) < nW) ? wbase + 64 * (t) : cbase + 64 * ((t) - nW))
#define DMA_K(t, bf) do { const int tt_ = (t) < NT ? (t) : NT - 1; const char* gk_ = (const char*)(Kh + (size_t)NA_KB(tt_) * 6144); FA_DMA(gk_ + offK[0], K_lds + (bf) * SHM_K + (2 * wid) * 1024); FA_DMA(gk_ + offK[1], K_lds + (bf) * SHM_K + (2 * wid + 1) * 1024); } while (0)
#define DMA_V(t, bf) do { const int tt_ = (t) < NT ? (t) : NT - 1; const char* gv_ = (const char*)(Vh + (size_t)NA_KB(tt_) * 6144); FA_DMA(gv_ + offV[0], V_lds + (bf) * SHM_V + (2 * wid) * 1024); FA_DMA(gv_ + offV[1], V_lds + (bf) * SHM_V + (2 * wid + 1) * 1024); } while (0)
  DMA_K(0, 0); DMA_V(0, 0); DMA_K(1, 1); DMA_V(1, 1);
  if (!ctxq) for (int i = tid; i < 15 * 31; i += NTHR) rpbL[i] = rpb_h[i] * ISCALE;
  float m_reg = -1e30f, l_reg = 0; f32x16 o[4] = {}; bf16x8 qr[8];
  const int qrow = qrow0 + wid * 32 + r32;
  const bf16* Qw = QKV + (size_t)qrow * 6144 + h * 128 + hi * 8;
#pragma unroll
  for (int d0 = 0; d0 < 8; ++d0) qr[d0] = *(const bf16x8*)(Qw + d0 * 16);
  const int vb0 = (int)(unsigned)(uintptr_t)V_lds + v_rd_base(lane);
  const int zsw = ((r32 & 7) ^ hi) << 4;
  const LAS char* kA0 = K_lds + r32 * 256 + (0 ^ zsw); const LAS char* kA1 = K_lds + r32 * 256 + (32 ^ zsw); const LAS char* kA2 = K_lds + r32 * 256 + (64 ^ zsw); const LAS char* kA3 = K_lds + r32 * 256 + (96 ^ zsw);
  const int rq = r0 + (wid >> 1), wa = ctxq ? 0 : (min(max(rq - 4, 0), 120) - R0), we = ctxq ? 0 : wa + 8;
  const int cq = 32 * (wid & 1) + r32, cs = min(max(cq - 8, 0), 48);
  const bool wodd = (wid & 1) != 0;
#define ACT(t) ((t) < NT && ((t) >= nW || ((t) >= wa && (t) < we)))
#define QK1(p0, p1, KA, OFF, QV) do { const bf16x8 b0 = *(const LAS bf16x8*)((KA) + (OFF)); const bf16x8 b1 = *(const LAS bf16x8*)((KA) + (OFF) + 8192); \
    p0 = __builtin_amdgcn_mfma_f32_32x32x16_bf16(b0, QV, p0, 0, 0, 0); p1 = __builtin_amdgcn_mfma_f32_32x32x16_bf16(b1, QV, p1, 0, 0, 0); } while (0)
#define QKT(p0, p1, t, bf, MODE_) do { if ((MODE_) != 0) { const int dr_ = R0 + (t) - rq + 7; const LAS float* bp_ = rpbL + dr_ * 31 + (15 - cq) + 4 * hi; \
      _Pragma("unroll") for (int i_ = ((MODE_) == 2 ? 12 : 0); i_ < 16; ++i_) { const int kc_ = crow(i_, hi); const float v0_ = bp_[8 * (i_ >> 2) + (i_ & 3)]; p0[i_] = (kc_ >= cs && kc_ < cs + 16) ? v0_ : -INFINITY; } \
      _Pragma("unroll") for (int i_ = 0; i_ < ((MODE_) == 1 ? 4 : 16); ++i_) { const int kc_ = crow(i_, hi); const float v1_ = bp_[32 + 8 * (i_ >> 2) + (i_ & 3)]; p1[i_] = (kc_ + 32 >= cs && kc_ + 32 < cs + 16) ? v1_ : -INFINITY; } \
      } else { p0 = f32x16{}; p1 = f32x16{}; } \
    QK1(p0, p1, kA0, (bf) * SHM_K, qr[0]); QK1(p0, p1, kA1, (bf) * SHM_K, qr[1]); QK1(p0, p1, kA2, (bf) * SHM_K, qr[2]); QK1(p0, p1, kA3, (bf) * SHM_K, qr[3]); \
    QK1(p0, p1, kA0, (bf) * SHM_K + 128, qr[4]); QK1(p0, p1, kA1, (bf) * SHM_K + 128, qr[5]); QK1(p0, p1, kA2, (bf) * SHM_K + 128, qr[6]); QK1(p0, p1, kA3, (bf) * SHM_K + 128, qr[7]); } while (0)
#define RESC(a) do { if (__any((a) < 1.f)) { if (hi == 0) al_l[r32] = (a); asm volatile("s_waitcnt lgkmcnt(0)" ::: "memory"); \
    _Pragma("unroll") for (int d = 0; d < 4; ++d) _Pragma("unroll") for (int r = 0; r < 16; ++r) o[d][r] *= al_l[crow(r, hi)]; } } while (0)
#define STEP_END() do { FA_SBAR(); asm volatile("s_waitcnt vmcnt(4) lgkmcnt(0)" ::: "memory"); __builtin_amdgcn_s_barrier(); asm volatile("" ::: "memory"); } while (0)
  f32x16 pA0 = {}, pA1 = {}; float mnA, alA = 1.f; bf16x8 pa0 = {}, pa1 = {}, pa2 = {}, pa3 = {};
  STEP_END();
  int s0 = 0, s1 = 1, s2 = 2;
#define NA_BODY(MODE_) do { QKT(pA0, pA1, t, s0, MODE_); partialSM_t<MODE_>(pA0, pA1, m_reg, mnA, alA, SCALE); RESC(alA); \
      finishSM_t<MODE_>(pA0, pA1, alA, l_reg, pa0, pa1, pa2, pa3); FA_SBAR(); pv_d0_t<MODE_>(o, vb0 + s0 * SHM_V, pa0, pa1, pa2, pa3); } while (0)
#define NA_STEP(MODE_, COND_) do { DMA_K(t + 2, s2); DMA_V(t + 2, s2); FA_SBAR(); if (COND_) NA_BODY(MODE_); STEP_END(); { const int t_ = s0; s0 = s1; s1 = s2; s2 = t_; } } while (0)
  int t = 0;
  if (wodd) { for (; t < nW; ++t) NA_STEP(2, t >= wa && t < we); }
  else      { for (; t < nW; ++t) NA_STEP(1, t >= wa && t < we); }
  for (; t < NT; ++t) NA_STEP(0, true);
#undef NA_STEP
  asm volatile("s_waitcnt vmcnt(0)" ::: "memory");
  if (hi == 0) li_l[r32] = l_reg; asm volatile("s_waitcnt lgkmcnt(0)" ::: "memory");
  bf16* Ow = O + (size_t)(qrow0 + wid * 32) * 2048 + h * 128 + r32;
#pragma unroll
  for (int r = 0; r < 16; ++r) { const int orow = crow(r, hi); const float rli = __builtin_amdgcn_rcpf(li_l[orow]);
#pragma unroll
    for (int d0 = 0; d0 < 4; ++d0) Ow[(size_t)orow * 2048 + d0 * 32] = (bf16)(cvtpk(o[d0][r] * rli, 0.f) & 0xffffu); }
  __syncthreads();
#undef NA_KB
#undef DMA_K
#undef DMA_V
#undef ACT
#undef QK1
#undef QKT
#undef NA_BODY
#undef RESC
#undef STEP_END
}
__device__ __forceinline__ void na_attn_phase(LAS unsigned char* lds, const bf16* QKV, const float* rpb, bf16* O, const bool need_ctx) {
  const int G = gridDim.x, bx = blockIdx.x; const int ntot = need_ctx ? 1056 : 1024;
  const int nu = (G == 256) ? ((need_ctx && bx < 32) ? 5 : 4) : (ntot - bx + G - 1) / G;
  for (int i = 0; i < nu; ++i) {
    int bh, q0, r0; bool ctxq;
    if (G == 256) { if (i < 4) { bh = i * 8 + (bx & 7); r0 = (bx >> 3) * 4; q0 = (bh >> 4) * 8192 + r0 * 64; ctxq = false; } else { bh = bx; r0 = 0; q0 = MLAT + (bh >> 4) * 256; ctxq = true; } }
    else { const int u = bx + i * G; if (u < 1024) { bh = u >> 5; r0 = (u & 31) * 4; q0 = (bh >> 4) * 8192 + r0 * 64; ctxq = false; } else { bh = u - 1024; r0 = 0; q0 = MLAT + (bh >> 4) * 256; ctxq = true; } }
    na_unit(lds, QKV, rpb + (size_t)(bh & 15) * 15 * 31, O, q0, ctxq, bh >> 4, bh & 15, r0);
  }
}
}

namespace m16 {
using fa::f32x16; using fa::cvtpk;
typedef float f32x4q __attribute__((ext_vector_type(4)));
typedef short v4i16q __attribute__((ext_vector_type(4)));
constexpr int VROW = 256, SHM_V = 64 * VROW, SHM_K = 16384, SHM_P = 8192, OFF_V = 0, OFF_K = 3 * SHM_V, OFF_P = OFF_K + 3 * SHM_K, OFF_WS = OFF_P + 3 * SHM_P;
static_assert(OFF_WS + 8 * 256 <= 131072, "MLA LDS map");
#define M16_DMA(gp, lp) __builtin_amdgcn_global_load_lds((const unsigned*)(gp), (LAS unsigned*)(lp), 16, 0, 0)
__device__ __forceinline__ float xor16(float v) { return __int_as_float(__builtin_amdgcn_ds_swizzle(__float_as_int(v), 0x401F)); }
__device__ __forceinline__ float xor32_max(float v) { auto rr = __builtin_amdgcn_permlane32_swap(__float_as_uint(v), __float_as_uint(v), false, false); return fmaxf(__uint_as_float(rr[0]), __uint_as_float(rr[1])); }
__device__ __forceinline__ float xor32_sum(float v) { auto rr = __builtin_amdgcn_permlane32_swap(__float_as_uint(v), __float_as_uint(v), false, false); return __uint_as_float(rr[0]) + __uint_as_float(rr[1]); }

__device__ __forceinline__ void mla_unit16(LAS unsigned char* lds, const bf16* __restrict__ QH, const bf16* __restrict__ KV, const bf16* __restrict__ KPE, const float* __restrict__ cosT, const float* __restrict__ sinT,
                                           bf16* __restrict__ O, const int qrow0, const bool latq, const int b, const int h) {
  constexpr float SCALE = 0.07216878364870322f, C = SCALE * 1.4426950408889634f, THR2 = 8.f * 1.4426950408889634f;
  int tid_ = threadIdx.x; asm volatile("" : "+v"(tid_));
  const int tid = tid_, wid = __builtin_amdgcn_readfirstlane(tid >> 6), lane = tid & 63, l15 = lane & 15, kg = lane >> 4;
  LAS char* V_lds = (LAS char*)lds + OFF_V; LAS char* K_lds = (LAS char*)lds + OFF_K; LAS char* P_lds = (LAS char*)lds + OFF_P;
  LAS float* ws = (LAS float*)(lds + OFF_WS) + wid * 64;
  unsigned offK[2], offV[2], offP;
#pragma unroll
  for (int i = 0; i < 2; ++i) { const int Lb = (2 * wid + i) * 1024 + 16 * lane, row = Lb >> 8, colB = (Lb & 255) ^ ((row & 15) << 4); offK[i] = (unsigned)(row * 4096 + (colB >> 1)) * 2u; }
  { const int Lb = wid * 1024 + 16 * lane, row = Lb >> 7, colB = (Lb & 127) ^ ((row & 7) << 4); offP = (unsigned)(row * 64 + (colB >> 1)) * 2u; }
#pragma unroll
  for (int i = 0; i < 2; ++i) { const int Lb = (2 * wid + i) * 1024 + 16 * lane, row = Lb >> 8, colB = (Lb & 255) ^ ((row & 7) << 5); offV[i] = (unsigned)(row * 4096 + 128 + (colB >> 1)) * 2u; }
  const int NT = latq ? 132 : 4;
  const int ctx0 = MLAT + b * 256, lat0 = b * 8192 - 256;
  const bf16* KVh = KV + h * 256;
#define DMA_K(tk, sK) do { const int tk_ = (tk) < NT ? (tk) : NT - 1; const int kb_ = (tk_ < 4 ? ctx0 : lat0) + 64 * tk_; \
    const char* gk_ = (const char*)(KVh + (size_t)kb_ * 4096); const char* gp_ = (const char*)(KPE + (size_t)kb_ * 64); \
    M16_DMA(gk_ + offK[0], K_lds + (sK) * SHM_K + (2 * wid) * 1024); M16_DMA(gk_ + offK[1], K_lds + (sK) * SHM_K + (2 * wid + 1) * 1024); M16_DMA(gp_ + offP, P_lds + (sK) * SHM_P + wid * 1024); } while (0)
#define DMA_V(tv, sV) do { const int tv_ = (tv) < NT ? (tv) : NT - 1; const int vb_ = (tv_ < 4 ? ctx0 : lat0) + 64 * tv_; const char* gv_ = (const char*)(KVh + (size_t)vb_ * 4096); \
    M16_DMA(gv_ + offV[0], V_lds + (sV) * SHM_V + (2 * wid) * 1024); M16_DMA(gv_ + offV[1], V_lds + (sV) * SHM_V + (2 * wid + 1) * 1024); } while (0)
  DMA_K(0, 0); DMA_K(1, 1); DMA_V(0, 0);
  bf16x8 qf[2][6];
#pragma unroll
  for (int qb = 0; qb < 2; ++qb) { const int qrow = qrow0 + wid * 32 + 16 * qb + l15; const bf16* Qw = QH + (size_t)qrow * 3072 + h * 192 + 8 * kg;
#pragma unroll
    for (int s = 0; s < 4; ++s) { float f[8]; unpack8(*(const v4u*)(Qw + 32 * s), f);
      const v4u w = {cvtpk(f[0] * C, f[1] * C), cvtpk(f[2] * C, f[3] * C), cvtpk(f[4] * C, f[5] * C), cvtpk(f[6] * C, f[7] * C)}; qf[qb][s] = __builtin_bit_cast(bf16x8, w); }
    const int sp = qrow & 8191;
#pragma unroll
    for (int ax = 0; ax < 2; ++ax) { const v4u own = *(const v4u*)(Qw + 128 + 32 * ax), oth = *(const v4u*)(Qw + 128 + 32 * ax + (kg < 2 ? 16 : -16));
      v4u res;
      if (!latq) { float f[8]; unpack8(own, f); res = (v4u){cvtpk(f[0] * C, f[1] * C), cvtpk(f[2] * C, f[3] * C), cvtpk(f[4] * C, f[5] * C), cvtpk(f[6] * C, f[7] * C)}; }
      else { const int pos = ax ? (sp & 63) : (sp >> 6); const float* ct = cosT + pos * 16 + 8 * (kg & 1); const float* st = sinT + pos * 16 + 8 * (kg & 1);
        float x1[8], x2[8], yv[8]; if (kg < 2) { unpack8(own, x1); unpack8(oth, x2); } else { unpack8(oth, x1); unpack8(own, x2); }
#pragma unroll
        for (int i = 0; i < 8; ++i) yv[i] = kg < 2 ? x1[i] * ct[i] - x2[i] * st[i] : x1[i] * st[i] + x2[i] * ct[i];
        res = (v4u){cvtpk(yv[0] * C, yv[1] * C), cvtpk(yv[2] * C, yv[3] * C), cvtpk(yv[4] * C, yv[5] * C), cvtpk(yv[6] * C, yv[7] * C)}; }
      qf[qb][4 + ax] = __builtin_bit_cast(bf16x8, res); } }
  const int zsw = (l15 & 7) << 4;
  const LAS char* kS0 = K_lds + l15 * 256 + ((16 * kg) ^ (l15 << 4)); const LAS char* kS1 = K_lds + l15 * 256 + ((64 + 16 * kg) ^ (l15 << 4));
  const LAS char* kS2 = K_lds + l15 * 256 + ((128 + 16 * kg) ^ (l15 << 4)); const LAS char* kS3 = K_lds + l15 * 256 + ((192 + 16 * kg) ^ (l15 << 4));
  const LAS char* pE = P_lds + l15 * 128 + ((16 * kg) ^ zsw); const LAS char* pO = P_lds + l15 * 128 + (((16 * kg) ^ zsw) ^ 64);
  unsigned vBc[8];
#pragma unroll
  for (int c = 0; c < 8; ++c) vBc[c] = (unsigned)(uintptr_t)V_lds + (unsigned)((4 * kg + (l15 >> 2)) * VROW + 8 * (l15 & 3) + 32 * (c ^ ((4 * (kg & 1) + (l15 >> 2)) & 7)));
  float m0 = 0.f, m1 = 0.f, lr0 = 0.f, lr1 = 0.f; f32x4q o[2][8];
  f32x4q nm0 = {0.f, 0.f, 0.f, 0.f}, nm1 = {0.f, 0.f, 0.f, 0.f};
#pragma unroll
  for (int qb = 0; qb < 2; ++qb)
#pragma unroll
    for (int c = 0; c < 8; ++c) o[qb][c] = (f32x4q){0.f, 0.f, 0.f, 0.f};
  struct Tile { f32x4q s[4][2]; };
#define M16_RD2(d0_, d1_, A_, O0_, O1_) do { asm volatile("ds_read_b128 %0, %1 offset:%2" : "=v"(d0_) : "v"(A_), "i"(O0_)); asm volatile("ds_read_b128 %0, %1 offset:%2" : "=v"(d1_) : "v"(A_), "i"(O1_)); } while (0)
#define M16_W2(x_, y_) asm volatile("s_waitcnt lgkmcnt(2)" : "+v"(x_), "+v"(y_))
#define M16_W0(x_, y_) asm volatile("s_waitcnt lgkmcnt(0)" : "+v"(x_), "+v"(y_))
#define M16_MM(T_, KB_, x_, y_, S_) do { T_.s[KB_][0] = __builtin_amdgcn_mfma_f32_16x16x32_bf16(x_, qf[0][S_], T_.s[KB_][0], 0, 0, 0); T_.s[KB_][1] = __builtin_amdgcn_mfma_f32_16x16x32_bf16(x_, qf[1][S_], T_.s[KB_][1], 0, 0, 0); \
    T_.s[KB_ + 1][0] = __builtin_amdgcn_mfma_f32_16x16x32_bf16(y_, qf[0][S_], T_.s[KB_ + 1][0], 0, 0, 0); T_.s[KB_ + 1][1] = __builtin_amdgcn_mfma_f32_16x16x32_bf16(y_, qf[1][S_], T_.s[KB_ + 1][1], 0, 0, 0); } while (0)
#define QK16(T_, sl) do { const unsigned ko_ = (unsigned)((sl) * SHM_K), po_ = (unsigned)((sl) * SHM_P); \
    const unsigned a0_ = (unsigned)(uintptr_t)kS0 + ko_, a1_ = (unsigned)(uintptr_t)kS1 + ko_, a2_ = (unsigned)(uintptr_t)kS2 + ko_, a3_ = (unsigned)(uintptr_t)kS3 + ko_, pe_ = (unsigned)(uintptr_t)pE + po_, pq_ = (unsigned)(uintptr_t)pO + po_; \
    _Pragma("unroll") for (int kb = 0; kb < 4; ++kb) { T_.s[kb][0] = nm0; T_.s[kb][1] = nm1; } \
    bf16x8 e0_, e1_, f0_, f1_; \
    M16_RD2(e0_, e1_, a0_, 0, 4096); \
    M16_RD2(f0_, f1_, a0_, 8192, 12288);          M16_W2(e0_, e1_); M16_MM(T_, 0, e0_, e1_, 0); \
    M16_RD2(e0_, e1_, a1_, 0, 4096);              M16_W2(f0_, f1_); M16_MM(T_, 2, f0_, f1_, 0); \
    M16_RD2(f0_, f1_, a1_, 8192, 12288);          M16_W2(e0_, e1_); M16_MM(T_, 0, e0_, e1_, 1); \
    M16_RD2(e0_, e1_, a2_, 0, 4096);              M16_W2(f0_, f1_); M16_MM(T_, 2, f0_, f1_, 1); \
    M16_RD2(f0_, f1_, a2_, 8192, 12288);          M16_W2(e0_, e1_); M16_MM(T_, 0, e0_, e1_, 2); \
    M16_RD2(e0_, e1_, a3_, 0, 4096);              M16_W2(f0_, f1_); M16_MM(T_, 2, f0_, f1_, 2); \
    M16_RD2(f0_, f1_, a3_, 8192, 12288);          M16_W2(e0_, e1_); M16_MM(T_, 0, e0_, e1_, 3); \
    M16_RD2(e0_, e1_, pe_, 0, 2048);              M16_W2(f0_, f1_); M16_MM(T_, 2, f0_, f1_, 3); \
    M16_RD2(f0_, f1_, pe_, 4096, 6144);           M16_W2(e0_, e1_); M16_MM(T_, 0, e0_, e1_, 4); \
    M16_RD2(e0_, e1_, pq_, 0, 2048);              M16_W2(f0_, f1_); M16_MM(T_, 2, f0_, f1_, 4); \
    M16_RD2(f0_, f1_, pq_, 4096, 6144);           M16_W2(e0_, e1_); M16_MM(T_, 0, e0_, e1_, 5); \
                                                  M16_W0(f0_, f1_); M16_MM(T_, 2, f0_, f1_, 5); } while (0)
#define SOFT16(T_, al0_, al1_, FIRST_) do { float x0 = T_.s[0][0][0], x1 = T_.s[0][1][0]; \
    _Pragma("unroll") for (int kb = 0; kb < 4; ++kb) _Pragma("unroll") for (int i = 0; i < 4; ++i) { x0 = fmaxf(x0, T_.s[kb][0][i]); x1 = fmaxf(x1, T_.s[kb][1][i]); } \
    al0_ = 1.f; al1_ = 1.f;                                                                    \
    if ((FIRST_) || !__builtin_expect(__all(x0 <= THR2 && x1 <= THR2), 1)) {                  \
      x0 = fmaxf(x0, xor16(x0)); x1 = fmaxf(x1, xor16(x1)); x0 = xor32_max(x0); x1 = xor32_max(x1); \
      const float d0 = (FIRST_) ? x0 : fmaxf(x0, 0.f), d1 = (FIRST_) ? x1 : fmaxf(x1, 0.f); \
      if (!(FIRST_)) { al0_ = __builtin_amdgcn_exp2f(-d0); al1_ = __builtin_amdgcn_exp2f(-d1); } \
      m0 += d0; m1 += d1; nm0 = (f32x4q){-m0, -m0, -m0, -m0}; nm1 = (f32x4q){-m1, -m1, -m1, -m1}; \
      _Pragma("unroll") for (int kb = 0; kb < 4; ++kb) _Pragma("unroll") for (int i = 0; i < 4; ++i) { T_.s[kb][0][i] -= d0; T_.s[kb][1][i] -= d1; } } \
    float y0 = 0.f, y1 = 0.f; \
    _Pragma("unroll") for (int kb = 0; kb < 4; ++kb) _Pragma("unroll") for (int i = 0; i < 4; ++i) { T_.s[kb][0][i] = __builtin_amdgcn_exp2f(T_.s[kb][0][i]); T_.s[kb][1][i] = __builtin_amdgcn_exp2f(T_.s[kb][1][i]); \
      y0 += T_.s[kb][0][i]; y1 += T_.s[kb][1][i]; } \
    lr0 = lr0 * al0_ + y0; lr1 = lr1 * al1_ + y1;                                             \
    _Pragma("unroll") for (int qb = 0; qb < 2; ++qb) _Pragma("unroll") for (int ks = 0; ks < 2; ++ks) { \
      const v4u w_ = {cvtpk(T_.s[2 * ks][qb][0], T_.s[2 * ks][qb][1]), cvtpk(T_.s[2 * ks][qb][2], T_.s[2 * ks][qb][3]), cvtpk(T_.s[2 * ks + 1][qb][0], T_.s[2 * ks + 1][qb][1]), cvtpk(T_.s[2 * ks + 1][qb][2], T_.s[2 * ks + 1][qb][3])}; \
      pa[qb][ks] = __builtin_bit_cast(bf16x8, w_); } } while (0)
#define RESC16(al0_, al1_) do { if (__any((al0_) < 1.f || (al1_) < 1.f)) { if (kg == 0) { ws[l15] = (al0_); ws[16 + l15] = (al1_); } asm volatile("s_waitcnt lgkmcnt(0)" ::: "memory"); \
    const f32x4q a0_ = *(const LAS f32x4q*)(ws + 4 * kg), a1_ = *(const LAS f32x4q*)(ws + 16 + 4 * kg); \
    _Pragma("unroll") for (int c = 0; c < 8; ++c) { o[0][c] *= a0_; o[1][c] *= a1_; } } } while (0)
#define M16_TR4(a_, b_, c_, d_, A_, C_) do { const unsigned ad_ = vBc[C_] + (A_); asm volatile("ds_read_b64_tr_b16 %0, %1 offset:%2" : "=v"(a_) : "v"(ad_), "i"(0)); asm volatile("ds_read_b64_tr_b16 %0, %1 offset:%2" : "=v"(b_) : "v"(ad_), "i"(16 * VROW)); \
    asm volatile("ds_read_b64_tr_b16 %0, %1 offset:%2" : "=v"(c_) : "v"(ad_), "i"(32 * VROW)); asm volatile("ds_read_b64_tr_b16 %0, %1 offset:%2" : "=v"(d_) : "v"(ad_), "i"(48 * VROW)); } while (0)
#define M16_WV4(a_, b_, c_, d_) asm volatile("s_waitcnt lgkmcnt(4)" : "+v"(a_), "+v"(b_), "+v"(c_), "+v"(d_))
#define M16_WV0(a_, b_, c_, d_) asm volatile("s_waitcnt lgkmcnt(0)" : "+v"(a_), "+v"(b_), "+v"(c_), "+v"(d_))
#define M16_PM(C_, a_, b_, c_, d_) do { const bf16x8 v0_ = __builtin_bit_cast(bf16x8, __builtin_shufflevector(a_, b_, 0, 1, 2, 3, 4, 5, 6, 7)), v1_ = __builtin_bit_cast(bf16x8, __builtin_shufflevector(c_, d_, 0, 1, 2, 3, 4, 5, 6, 7)); \
    o[0][C_] = __builtin_amdgcn_mfma_f32_16x16x32_bf16(pa[0][0], v0_, o[0][C_], 0, 0, 0); o[1][C_] = __builtin_amdgcn_mfma_f32_16x16x32_bf16(pa[1][0], v0_, o[1][C_], 0, 0, 0); \
    o[0][C_] = __builtin_amdgcn_mfma_f32_16x16x32_bf16(pa[0][1], v1_, o[0][C_], 0, 0, 0); o[1][C_] = __builtin_amdgcn_mfma_f32_16x16x32_bf16(pa[1][1], v1_, o[1][C_], 0, 0, 0); } while (0)
#define PV16(sl) do { const unsigned va_ = (unsigned)((sl) * SHM_V); v4i16q a_, b_, c_, d_, e_, f_, g_, h_; \
    M16_TR4(a_, b_, c_, d_, va_, 0); \
    M16_TR4(e_, f_, g_, h_, va_, 1); M16_WV4(a_, b_, c_, d_); M16_PM(0, a_, b_, c_, d_); \
    M16_TR4(a_, b_, c_, d_, va_, 2); M16_WV4(e_, f_, g_, h_); M16_PM(1, e_, f_, g_, h_); \
    M16_TR4(e_, f_, g_, h_, va_, 3); M16_WV4(a_, b_, c_, d_); M16_PM(2, a_, b_, c_, d_); \
    M16_TR4(a_, b_, c_, d_, va_, 4); M16_WV4(e_, f_, g_, h_); M16_PM(3, e_, f_, g_, h_); \
    M16_TR4(e_, f_, g_, h_, va_, 5); M16_WV4(a_, b_, c_, d_); M16_PM(4, a_, b_, c_, d_); \
    M16_TR4(a_, b_, c_, d_, va_, 6); M16_WV4(e_, f_, g_, h_); M16_PM(5, e_, f_, g_, h_); \
    M16_TR4(e_, f_, g_, h_, va_, 7); M16_WV4(a_, b_, c_, d_); M16_PM(6, a_, b_, c_, d_); \
                                     M16_WV0(e_, f_, g_, h_); M16_PM(7, e_, f_, g_, h_); } while (0)
#define M16_WK(n_, x_, y_) asm volatile("s_waitcnt lgkmcnt(" #n_ ")" : "+v"(x_), "+v"(y_))
#define M16_WV(n_, a_, b_, c_, d_) asm volatile("s_waitcnt lgkmcnt(" #n_ ")" : "+v"(a_), "+v"(b_), "+v"(c_), "+v"(d_))
#define MSEG16(T_, slK, slV) do { const unsigned ko_ = (unsigned)((slK) * SHM_K), po_ = (unsigned)((slK) * SHM_P), va_ = (unsigned)((slV) * SHM_V); \
    const unsigned a0_ = (unsigned)(uintptr_t)kS0 + ko_, a1_ = (unsigned)(uintptr_t)kS1 + ko_, a2_ = (unsigned)(uintptr_t)kS2 + ko_, a3_ = (unsigned)(uintptr_t)kS3 + ko_, pe_ = (unsigned)(uintptr_t)pE + po_, pq_ = (unsigned)(uintptr_t)pO + po_; \
    _Pragma("unroll") for (int kb = 0; kb < 4; ++kb) { T_.s[kb][0] = nm0; T_.s[kb][1] = nm1; } \
    bf16x8 e0_, e1_, f0_, f1_, g0_, g1_; v4i16q va0_, va1_, va2_, va3_, vb0_, vb1_, vb2_, vb3_, vc0_, vc1_, vc2_, vc3_; \
    M16_RD2(e0_, e1_, a0_, 0, 4096); M16_RD2(f0_, f1_, a0_, 8192, 12288); \
    M16_RD2(g0_, g1_, a1_, 0, 4096); M16_WK(4, e0_, e1_); M16_MM(T_, 0, e0_, e1_, 0); \
    M16_RD2(e0_, e1_, a1_, 8192, 12288); M16_WK(4, f0_, f1_); M16_MM(T_, 2, f0_, f1_, 0); \
    M16_RD2(f0_, f1_, a2_, 0, 4096); M16_WK(4, g0_, g1_); M16_MM(T_, 0, g0_, g1_, 1); \
    M16_RD2(g0_, g1_, a2_, 8192, 12288); M16_WK(4, e0_, e1_); M16_MM(T_, 2, e0_, e1_, 1); \
    M16_RD2(e0_, e1_, a3_, 0, 4096); M16_WK(4, f0_, f1_); M16_MM(T_, 0, f0_, f1_, 2); \
    M16_RD2(f0_, f1_, a3_, 8192, 12288); M16_WK(4, g0_, g1_); M16_MM(T_, 2, g0_, g1_, 2); \
    M16_RD2(g0_, g1_, pe_, 0, 2048); M16_WK(4, e0_, e1_); M16_MM(T_, 0, e0_, e1_, 3); \
    M16_RD2(e0_, e1_, pe_, 4096, 6144); M16_WK(4, f0_, f1_); M16_MM(T_, 2, f0_, f1_, 3); \
    M16_RD2(f0_, f1_, pq_, 0, 2048); M16_WK(4, g0_, g1_); M16_MM(T_, 0, g0_, g1_, 4); \
    M16_RD2(g0_, g1_, pq_, 4096, 6144); M16_WK(4, e0_, e1_); M16_MM(T_, 2, e0_, e1_, 4); \
    M16_TR4(va0_, va1_, va2_, va3_, va_, 0); M16_WK(6, f0_, f1_); M16_MM(T_, 0, f0_, f1_, 5); \
    M16_TR4(vb0_, vb1_, vb2_, vb3_, va_, 1); M16_WK(8, g0_, g1_); M16_MM(T_, 2, g0_, g1_, 5); \
    M16_TR4(vc0_, vc1_, vc2_, vc3_, va_, 2); M16_WV(8, va0_, va1_, va2_, va3_); M16_PM(0, va0_, va1_, va2_, va3_); \
    M16_TR4(va0_, va1_, va2_, va3_, va_, 3); M16_WV(8, vb0_, vb1_, vb2_, vb3_); M16_PM(1, vb0_, vb1_, vb2_, vb3_); \
    M16_TR4(vb0_, vb1_, vb2_, vb3_, va_, 4); M16_WV(8, vc0_, vc1_, vc2_, vc3_); M16_PM(2, vc0_, vc1_, vc2_, vc3_); \
    M16_TR4(vc0_, vc1_, vc2_, vc3_, va_, 5); M16_WV(8, va0_, va1_, va2_, va3_); M16_PM(3, va0_, va1_, va2_, va3_); \
    M16_TR4(va0_, va1_, va2_, va3_, va_, 6); M16_WV(8, vb0_, vb1_, vb2_, vb3_); M16_PM(4, vb0_, vb1_, vb2_, vb3_); \
    M16_TR4(vb0_, vb1_, vb2_, vb3_, va_, 7); M16_WV(8, vc0_, vc1_, vc2_, vc3_); M16_PM(5, vc0_, vc1_, vc2_, vc3_); \
    M16_WV(4, va0_, va1_, va2_, va3_); M16_PM(6, va0_, va1_, va2_, va3_); \
    M16_WV(0, vb0_, vb1_, vb2_, vb3_); M16_PM(7, vb0_, vb1_, vb2_, vb3_); } while (0)
#define SEG_END_M() do { FA_SBAR(); asm volatile("s_waitcnt vmcnt(0) lgkmcnt(0)" ::: "memory"); __builtin_amdgcn_s_barrier(); asm volatile("" ::: "memory"); FA_SBAR(); } while (0)
#define SEG_END_V() do { FA_SBAR(); asm volatile("s_waitcnt lgkmcnt(0)" ::: "memory"); __builtin_amdgcn_s_barrier(); asm volatile("" ::: "memory"); FA_SBAR(); } while (0)
  Tile tS; bf16x8 pa[2][2]; float al0, al1;
  SEG_END_M();
  if (wid >= 4) { __builtin_amdgcn_s_barrier(); asm volatile("" ::: "memory"); }
  FA_SBAR();
  QK16(tS, 0);
  SEG_END_M();
  DMA_K(2, 2); DMA_V(1, 1);
  SOFT16(tS, al0, al1, true);
  SEG_END_V();
  int s0 = 0, s1 = 1, s2 = 2;
  for (int k = 0; k + 1 < NT; ++k) {
    MSEG16(tS, s1, s0);
    SEG_END_M();
    DMA_K(k + 3, s0); DMA_V(k + 2, s2);
    SOFT16(tS, al0, al1, false);
    RESC16(al0, al1);
    SEG_END_V();
    { const int t_ = s0; s0 = s1; s1 = s2; s2 = t_; }
  }
  PV16(s0);
  SEG_END_M();
  if (wid < 4) { __builtin_amdgcn_s_barrier(); asm volatile("" ::: "memory"); }
  lr0 += xor16(lr0); lr1 += xor16(lr1); lr0 = xor32_sum(lr0); lr1 = xor32_sum(lr1);
  if (kg == 0) { ws[32 + l15] = lr0; ws[48 + l15] = lr1; } asm volatile("s_waitcnt lgkmcnt(0)" ::: "memory");
#pragma unroll
  for (int qb = 0; qb < 2; ++qb) { const f32x4q lv = *(const LAS f32x4q*)(ws + 32 + 16 * qb + 4 * kg);
    bf16* Ow = O + (size_t)(qrow0 + wid * 32 + 16 * qb + 4 * kg) * 2048 + h * 128 + l15;
#pragma unroll
    for (int i = 0; i < 4; ++i) { const float rl = __builtin_amdgcn_rcpf(lv[i]);
#pragma unroll
      for (int c = 0; c < 8; ++c) Ow[(size_t)i * 2048 + 16 * c] = (bf16)(cvtpk(o[qb][c][i] * rl, 0.f) & 0xffffu); } }
  asm volatile("s_waitcnt vmcnt(0)" ::: "memory"); __syncthreads();
#undef DMA_K
#undef DMA_V
#undef QK16
#undef M16_RD2
#undef M16_W2
#undef M16_W0
#undef M16_MM
#undef SOFT16
#undef RESC16
#undef PV16
#undef MSEG16
#undef M16_WK
#undef M16_WV
#undef M16_TR4
#undef M16_WV4
#undef M16_WV0
#undef M16_PM
#undef SEG_END_M
#undef SEG_END_V
}
__device__ __forceinline__ void mla_attn_phase16(LAS unsigned char* lds, const bf16* QH, const bf16* KV, const bf16* KPE, const float* cosT, const float* sinT, bf16* O) {
  const int G = gridDim.x, bx = blockIdx.x;
  const int nu = (G == 256) ? (bx < 32 ? 5 : 4) : (1056 - bx + G - 1) / G;
  for (int i = 0; i < nu; ++i) {
    int bh, q0; bool latq;
    if (G == 256) { if (i < 4) { bh = i * 8 + (bx & 7); q0 = (bh >> 4) * 8192 + (bx >> 3) * 256; latq = true; } else { bh = bx; q0 = MLAT + (bh >> 4) * 256; latq = false; } }
    else { const int u = bx + i * G; if (u < 1024) { bh = u >> 5; q0 = (bh >> 4) * 8192 + (u & 31) * 256; latq = true; } else { bh = u - 1024; q0 = MLAT + (bh >> 4) * 256; latq = false; } }
    mla_unit16(lds, QH, KV, KPE, cosT, sinT, O, q0, latq, bh >> 4, bh & 15);
  }
}
}

namespace ml {
using fa::f32x16; using fa::s16x4; using fa::crow; using fa::cvtpk;
typedef float f32x4m __attribute__((ext_vector_type(4)));
constexpr int TQ = 17408, ROWB = 272, SPS = 144;
constexpr int OFF_Q = 0, OFF_K = 2 * TQ, OFF_V = 4 * TQ, OFF_KW = OFF_V + 32768, OFF_SP = OFF_KW + 16384, OFF_QN = OFF_SP + 64 * SPS, OFF_N32 = OFF_QN + 256, OFF_NB = OFF_N32 + 512, OFF_WV = OFF_NB + 256, ML_LDS_END = OFF_WV + 8 * 1280;
#define ML_DMA(gp, lp) __builtin_amdgcn_global_load_lds((const unsigned*)(gp), (LAS unsigned*)(lp), 16, 0, 0)
#define ML_TR(dst, vb, OFF) asm volatile("ds_read_b64_tr_b16 %0, %1 offset:%2" : "=&v"(dst) : "v"(vb), "i"(OFF) : "memory")
#define ML_PK(L, H) (bf16x8){L[0], L[1], L[2], L[3], H[0], H[1], H[2], H[3]}
__device__ __forceinline__ int chunk_base(int n, int dir, int b) { return dir == 0 ? (n < 4 ? MLAT + b * 256 + 64 * n : b * 8192 + 64 * (n - 4)) : (n < 4 ? MLAT + b * 256 + 64 * (3 - n) : b * 8192 + 64 * (131 - n)); }
template <int CTRL, int RM> __device__ __forceinline__ float dppf(float old, float src) { return __int_as_float(__builtin_amdgcn_update_dpp(__float_as_int(old), __float_as_int(src), CTRL, RM, 0xf, false)); }
__device__ __forceinline__ float scan_add(float v) {
  v += dppf<0x111, 0xf>(0.f, v); v += dppf<0x112, 0xf>(0.f, v); v += dppf<0x114, 0xf>(0.f, v); v += dppf<0x118, 0xf>(0.f, v);
  v += dppf<0x142, 0xa>(0.f, v); v += dppf<0x143, 0xc>(0.f, v); return v; }
__device__ __forceinline__ float scan_max(float v) {
  const float NI = -INFINITY;
  v = fmaxf(v, dppf<0x111, 0xf>(NI, v)); v = fmaxf(v, dppf<0x112, 0xf>(NI, v)); v = fmaxf(v, dppf<0x114, 0xf>(NI, v)); v = fmaxf(v, dppf<0x118, 0xf>(NI, v));
  v = fmaxf(v, dppf<0x142, 0xa>(NI, v)); v = fmaxf(v, dppf<0x143, 0xc>(NI, v)); return v; }

constexpr int NGRP = 8;
__host__ __device__ constexpr int grp_start(int g) { return g <= 4 ? 17 * g : 68 + 16 * (g - 4); }
constexpr int OFF_TAB = ML_LDS_END;
template <int MODE> __device__ __forceinline__ void scan_chain(LAS unsigned char* lds, const bf16* __restrict__ QK, const bf16* __restrict__ Z, const float* __restrict__ G, bf16* __restrict__ H, float* __restrict__ Ub, float* __restrict__ Nb, const int chain, const int grp) {
  const int dir = chain & 1, hd = (chain >> 1) & 7, b = chain >> 4; const int n0 = grp_start(grp), n1 = grp_start(grp + 1);
  int tid_ = threadIdx.x; asm volatile("" : "+v"(tid_)); const int tid = tid_, wid = __builtin_amdgcn_readfirstlane(tid >> 6), lane_ = tid & 63;
  LAS char* Lc = (LAS char*)lds;
  LAS float* QN = (LAS float*)(lds + OFF_QN); LAS float* N32 = (LAS float*)(lds + OFF_N32); LAS bf16* NB = (LAS bf16*)(lds + OFF_NB);
  const int lane = lane_;
  unsigned offQ[2], offQx, offV[4];
#pragma unroll
  for (int i = 0; i < 2; ++i) { const int Lb = (2 * wid + i) * 1024 + 16 * lane, row = Lb / ROWB, cB = Lb % ROWB, colB = cB < 256 ? cB : 0; const int srow = dir ? 63 - row : row; offQ[i] = (unsigned)((srow * 2048 + hd * 128) * 2 + colB); }
  { const int Lb = 16 * 1024 + 16 * lane, row = Lb / ROWB, cB = Lb % ROWB, colB = cB < 256 ? cB : 0; const int srow = dir ? 63 - row : row; offQx = (unsigned)((srow * 2048 + hd * 128) * 2 + colB); }
#pragma unroll
  for (int p = 0; p < 4; ++p) { const int Lb = p * 1024 + 16 * lane, sub = Lb >> 9, w_ = Lb & 511, kk = sub * 8 + (w_ >> 6), c = (w_ & 63) >> 1, k = (kk & ~0xC) | ((kk & 4) << 1) | ((kk & 8) >> 1); const int srow = dir ? 63 - k : k;
    offV[p] = (unsigned)((srow * 6400 + 2048 + hd * 256 + 32 * wid + c) * 2); }
  const int grow_off = dir ? 63 - lane : lane;
#define DMA_Q(n, slot) do { const char* g_ = (const char*)(QK + (size_t)chunk_base((n), dir, b) * 2048); LAS char* d_ = Lc + OFF_Q + (slot) * TQ; \
    ML_DMA(g_ + offQ[0], d_ + (2 * wid) * 1024); ML_DMA(g_ + offQ[1], d_ + (2 * wid + 1) * 1024); if (wid == 0) ML_DMA(g_ + offQx, d_ + 16 * 1024); } while (0)
#define DMA_K(n, slot) do { const char* g_ = (const char*)(QK + (size_t)chunk_base((n), dir, b) * 2048 + 1024); LAS char* d_ = Lc + OFF_K + (slot) * TQ; \
    ML_DMA(g_ + offQ[0], d_ + (2 * wid) * 1024); ML_DMA(g_ + offQ[1], d_ + (2 * wid + 1) * 1024); if (wid == 0) ML_DMA(g_ + offQx, d_ + 16 * 1024); } while (0)
#define DMA_VS(n) do { const char* g_ = (const char*)(Z + (size_t)chunk_base((n), dir, b) * 6400); LAS char* d_ = Lc + OFF_V + wid * 4096; \
    ML_DMA(g_ + offV[0], d_); ML_DMA(g_ + offV[1], d_ + 1024); ML_DMA(g_ + offV[2], d_ + 2048); ML_DMA(g_ + offV[3], d_ + 3072); } while (0)
#define LOAD_G(n, li_, lf_) do { const float* g_ = G + (size_t)(chunk_base((n), dir, b) + grow_off) * 32 + dir * 16 + hd; li_ = g_[0]; lf_ = g_[8]; } while (0)
#define BAR_LDS() do { asm volatile("s_waitcnt lgkmcnt(0)" ::: "memory"); __builtin_amdgcn_s_barrier(); asm volatile("" ::: "memory"); } while (0)
  LAS float* TB = (LAS float*)(lds + OFF_TAB); LAS float* TP = TB + 132; LAS float* TM = TB + 264; LAS float* TC = TB + 397;
  { float gl_[17], gf_[17];
#pragma unroll
    for (int i = 0; i < 17; ++i) { const int c = wid + 8 * i; gl_[i] = 0.f; gf_[i] = 0.f; if (c < 132) LOAD_G(c, gl_[i], gf_[i]); }
#pragma unroll
    for (int i = 0; i < 17; ++i) { const int c = wid + 8 * i; const float cb_ = scan_add(gf_[i]), pm_ = scan_max(gl_[i] - cb_); if (c < 132 && lane == 63) { TB[c] = cb_; TP[c] = pm_; } } }
  __syncthreads();
  if (tid == 0) { float m_ = 0.f, bc_ = 0.f;
#pragma unroll 12
    for (int c = 0; c < 132; ++c) { const float tb_ = TB[c], tp_ = TP[c]; TM[c] = m_; TC[c] = bc_; m_ = tb_ + fmaxf(m_, tp_); bc_ += tb_; }
    TM[132] = m_; TC[132] = bc_; }
  __syncthreads();
  if (MODE == 1) { DMA_Q(n0, 0); DMA_Q(n0 + 1, 1); }
  DMA_K(n0, 0); DMA_K(n0 + 1, 1); DMA_VS(n0);
  float li, lf; LOAD_G(n0, li, lf);
  f32x16 C[4];
#pragma unroll
  for (int i = 0; i < 4; ++i) C[i] = f32x16{};
  float nacc = 0.f;
  if (MODE == 1) {
#pragma unroll 1
    for (int j = 0; j < grp; ++j) { const int s1 = grp_start(j + 1); const float w = __expf(TC[n0] - TC[s1] + TM[s1] - TM[n0]);
      const float* up = Ub + ((size_t)(chain * NGRP + j) * 8 + wid) * 4096 + lane;
#pragma unroll
      for (int q = 0; q < 4; ++q) {
#pragma unroll
        for (int r = 0; r < 16; ++r) C[q][r] += w * up[(q * 16 + r) * 64];
        __builtin_amdgcn_sched_barrier(0); }
      if (tid < 128) nacc += w * Nb[(size_t)(chain * NGRP + j) * 128 + tid]; }
  }
  if (tid < 128) { N32[tid] = nacc; NB[tid] = (bf16)(cvtpk(nacc, 0.f) & 0xffffu); }
  float m_prev = TM[n0];
  asm volatile("s_waitcnt vmcnt(0)" ::: "memory"); BAR_LDS();
  float cumb = scan_add(lf), av = li - cumb, pm = scan_max(av);
  unsigned hp[16];
#pragma unroll
  for (int i = 0; i < 16; ++i) hp[i] = 0u;
  for (int n = n0; n < n1; ++n) {
    const int slot = (n - n0) & 1;
    const LAS char* Qs = Lc + OFF_Q + slot * TQ; const LAS char* Ks = Lc + OFF_K + slot * TQ;
    const float mx = fmaxf(m_prev, pm), wint = __expf(m_prev - mx), m_t = cumb + mx;
    const float mx63 = __int_as_float(__builtin_amdgcn_readlane(__float_as_int(mx), 63)), b_end = __int_as_float(__builtin_amdgcn_readlane(__float_as_int(cumb), 63)), m_new = b_end + mx63, decay = __expf(m_prev - mx63);
    { LAS float* WVt = (LAS float*)(lds + OFF_WV + wid * 1280); WVt[128 + lane] = -mx; WVt[192 + lane] = av; WVt[256 + lane] = __expf(av - mx63); }
    if (MODE == 1 && n > n0) {
      int lo_ = lane_; asm volatile("" : "+v"(lo_)); const int cbr = chunk_base(n - 1, dir, b); const int hi_ = lo_ >> 5;
      const unsigned loff = (unsigned)(2 * (lo_ & 31) + (dir ? 1 - hi_ : hi_) * 4 * 4096); char* const Hb = (char*)(H + hd * 256 + 32 * wid);
#pragma unroll
      for (int k = 0; k < 16; ++k) { const int i0 = 2 * (k & 7), tk = 32 * (k >> 3) + (i0 & 3) + 8 * (i0 >> 2); char* const r0 = Hb + (size_t)(cbr + (dir ? 63 - tk - 4 : tk)) * 4096; char* const r1 = dir ? r0 - 4096 : r0 + 4096;
        *(bf16*)(r0 + loff) = (bf16)(hp[k] & 0xffffu); *(bf16*)(r1 + loff) = (bf16)(hp[k] >> 16); }
    }
    __builtin_amdgcn_sched_barrier(0);
    {
      int lane = lane_; asm volatile("" : "+v"(lane));
      const int l15 = lane & 15, kg = lane >> 4;
      if (MODE == 1) {
      const int tb = wid >> 1;
      bf16x8 qa[4];
#pragma unroll
      for (int ks = 0; ks < 4; ++ks) qa[ks] = *(const LAS bf16x8*)(Qs + (16 * tb + l15) * ROWB + kg * 16 + ks * 64);
#pragma unroll
      for (int e = 0; e < 2; ++e) { const int sb = 2 * (wid & 1) + e; f32x4m acc = {0.f, 0.f, 0.f, 0.f};
        if (sb <= tb) {
#pragma unroll
          for (int ks = 0; ks < 4; ++ks) { const bf16x8 kb = *(const LAS bf16x8*)(Ks + (16 * sb + l15) * ROWB + kg * 16 + ks * 64); acc = __builtin_amdgcn_mfma_f32_16x16x32_bf16(qa[ks], kb, acc, 0, 0, 0); }
        }
        const int s = 16 * sb + l15; const LAS float* WVt = (const LAS float*)(lds + OFF_WV + wid * 1280); const float a_s = WVt[192 + s]; const f32x4m e1v = *(const LAS f32x4m*)(WVt + 128 + 16 * tb + 4 * kg);
#pragma unroll
        for (int i = 0; i < 4; ++i) { const int t = 16 * tb + 4 * kg + i; const float v = (s <= t) ? acc[i] * __expf(e1v[i] + a_s) : 0.f;
          *(LAS bf16*)(Lc + OFF_SP + t * SPS + s * 2) = (bf16)(cvtpk(v, 0.f) & 0xffffu); } }
      if (wid < 4) {
        f32x4m acc = {0.f, 0.f, 0.f, 0.f};
#pragma unroll
        for (int ks = 0; ks < 4; ++ks) { const bf16x8 qq = *(const LAS bf16x8*)(Qs + (16 * wid + l15) * ROWB + kg * 16 + ks * 64); const bf16x8 nn = *(const LAS bf16x8*)((const LAS char*)NB + kg * 16 + ks * 64);
          acc = __builtin_amdgcn_mfma_f32_16x16x32_bf16(qq, nn, acc, 0, 0, 0); }
        if (l15 == 0) { *(LAS f32x4m*)(QN + 16 * wid + 4 * kg) = acc; }
      }
      }
      {
        const int s = wid * 8 + (lane >> 3), part = lane & 7; const float es = ((const LAS float*)(lds + OFF_WV + wid * 1280))[256 + s];
        const v4u w0 = *(const LAS v4u*)(Ks + s * ROWB + part * 32), w1 = *(const LAS v4u*)(Ks + s * ROWB + part * 32 + 16);
        float f[16]; unpack8(w0, f); unpack8(w1, f + 8);
        v4u o0 = {cvtpk(f[0] * es, f[1] * es), cvtpk(f[2] * es, f[3] * es), cvtpk(f[4] * es, f[5] * es), cvtpk(f[6] * es, f[7] * es)};
        v4u o1 = {cvtpk(f[8] * es, f[9] * es), cvtpk(f[10] * es, f[11] * es), cvtpk(f[12] * es, f[13] * es), cvtpk(f[14] * es, f[15] * es)};
        *(LAS v4u*)(Lc + OFF_KW + fa::v_st(s, part * 16)) = o0; *(LAS v4u*)(Lc + OFF_KW + fa::v_st(s, part * 16 + 8)) = o1;
      }
    }
    BAR_LDS();
    int lane = lane_; asm volatile("" : "+v"(lane));
    const int r32 = lane & 31, hi = lane >> 5;
    const int vbV = (int)(unsigned)(uintptr_t)(Lc + OFF_V + wid * 4096) + fa::v_rd_base(lane);
    const int vbK = (int)(unsigned)(uintptr_t)(Lc + OFF_KW) + fa::v_rd_base(lane);
    LAS float* WV = (LAS float*)(lds + OFF_WV + wid * 1280);
    s16x4 vl0, vh0, vl1, vh1, vl2, vh2, vl3, vh3;
    ML_TR(vl0, vbV, 0); ML_TR(vh0, vbV, 512); ML_TR(vl1, vbV, 1024); ML_TR(vh1, vbV, 1536); ML_TR(vl2, vbV, 2048); ML_TR(vh2, vbV, 2560); ML_TR(vl3, vbV, 3072); ML_TR(vh3, vbV, 3584);
    asm volatile("s_waitcnt lgkmcnt(0)" ::: "memory"); __builtin_amdgcn_sched_barrier(0);
    const bf16x8 vf0 = ML_PK(vl0, vh0), vf1 = ML_PK(vl1, vh1), vf2 = ML_PK(vl2, vh2), vf3 = ML_PK(vl3, vh3);
    float li_n = 0.f, lf_n = 0.f;
    if (n + 1 < n1) { DMA_VS(n + 1); LOAD_G(n + 1, li_n, lf_n); }
    if (n + 2 < n1) DMA_K(n + 2, slot);
    if (MODE == 1) {
    {
      float rs = 0.f;
#pragma unroll
      for (int j = 0; j < 8; ++j) { float f[8]; unpack8(*(const LAS v4u*)(Lc + OFF_SP + lane * SPS + 16 * j), f);
#pragma unroll
        for (int i = 0; i < 8; ++i) rs += f[i]; }
      const float den = wint * QN[lane] + rs; const float rinv = 1.f / fmaxf(fabsf(den), __expf(-m_t));
      WV[lane] = wint; WV[64 + lane] = rinv;
    }
    __builtin_amdgcn_sched_barrier(0);
    f32x16 aI0 = f32x16{}, aI1 = f32x16{};
#pragma unroll
    for (int dkb = 0; dkb < 4; ++dkb) {
#pragma unroll
      for (int jj = 0; jj < 2; ++jj) {
        const v4u cw = {cvtpk(C[dkb][8 * jj + 0], C[dkb][8 * jj + 1]), cvtpk(C[dkb][8 * jj + 2], C[dkb][8 * jj + 3]), cvtpk(C[dkb][8 * jj + 4], C[dkb][8 * jj + 5]), cvtpk(C[dkb][8 * jj + 6], C[dkb][8 * jj + 7])};
        const bf16x8 cb = __builtin_bit_cast(bf16x8, cw);
        const LAS char* qp = Qs + r32 * ROWB + (32 * dkb + 16 * jj + 4 * hi) * 2;
        typedef unsigned u32x2m __attribute__((ext_vector_type(2)));
        const u32x2m a0 = *(const LAS u32x2m*)(qp), a1 = *(const LAS u32x2m*)(qp + 16), b0 = *(const LAS u32x2m*)(qp + 32 * ROWB), b1 = *(const LAS u32x2m*)(qp + 32 * ROWB + 16);
        const v4u qa0 = {a0.x, a0.y, a1.x, a1.y}, qa1 = {b0.x, b0.y, b1.x, b1.y};
        aI0 = __builtin_amdgcn_mfma_f32_32x32x16_bf16(__builtin_bit_cast(bf16x8, qa0), cb, aI0, 0, 0, 0);
        aI1 = __builtin_amdgcn_mfma_f32_32x32x16_bf16(__builtin_bit_cast(bf16x8, qa1), cb, aI1, 0, 0, 0);
      }
      __builtin_amdgcn_sched_barrier(0);
    }
#pragma unroll
    for (int g = 0; g < 4; ++g) { const f32x4m w0 = *(const LAS f32x4m*)(WV + 8 * g + 4 * hi), w1 = *(const LAS f32x4m*)(WV + 32 + 8 * g + 4 * hi);
#pragma unroll
      for (int i = 0; i < 4; ++i) { aI0[4 * g + i] *= w0[i]; aI1[4 * g + i] *= w1[i]; } }
    {
      const LAS char* sp = Lc + OFF_SP + r32 * SPS + hi * 16;
#define ML_INTRA(ks, vf) do { const bf16x8 s0 = *(const LAS bf16x8*)(sp + (ks) * 32), s1 = *(const LAS bf16x8*)(sp + 32 * SPS + (ks) * 32); \
      aI0 = __builtin_amdgcn_mfma_f32_32x32x16_bf16(s0, vf, aI0, 0, 0, 0); aI1 = __builtin_amdgcn_mfma_f32_32x32x16_bf16(s1, vf, aI1, 0, 0, 0); } while (0)
      ML_INTRA(0, vf0); ML_INTRA(1, vf1); ML_INTRA(2, vf2); ML_INTRA(3, vf3);
#undef ML_INTRA
    }
    __builtin_amdgcn_sched_barrier(0);
    {
#pragma unroll
      for (int tb = 0; tb < 2; ++tb)
#pragma unroll
        for (int g = 0; g < 4; ++g) { const int t0 = 32 * tb + 8 * g + 4 * hi; const f32x4m rv = *(const LAS f32x4m*)(WV + 64 + t0);
          const float h0 = (tb ? aI1[4 * g + 0] : aI0[4 * g + 0]) * rv[0], h1 = (tb ? aI1[4 * g + 1] : aI0[4 * g + 1]) * rv[1], h2 = (tb ? aI1[4 * g + 2] : aI0[4 * g + 2]) * rv[2], h3 = (tb ? aI1[4 * g + 3] : aI0[4 * g + 3]) * rv[3];
          hp[8 * tb + 2 * g] = cvtpk(h0, h1); hp[8 * tb + 2 * g + 1] = cvtpk(h2, h3); }
    }
    __builtin_amdgcn_sched_barrier(0);
    __builtin_amdgcn_sched_barrier(0);
    __builtin_amdgcn_sched_barrier(0);
    }
    {
      int tid_o = tid; asm volatile("" : "+v"(tid_o)); const int d = tid_o >> 2, q4 = tid_o & 3; float a = 0.f;
#pragma unroll
      for (int j = 0; j < 16; ++j) a += bf1(*(const LAS bf16*)(Lc + OFF_KW + fa::v_st(16 * q4 + j, d)));
      a += __shfl_xor(a, 1); a += __shfl_xor(a, 2);
      if (q4 == 0) { const float nn = decay * N32[d] + a; N32[d] = nn; NB[d] = (bf16)(cvtpk(nn, 0.f) & 0xffffu); }
    }
    __builtin_amdgcn_sched_barrier(0);
#pragma unroll
    for (int dkb = 0; dkb < 4; ++dkb) {
#pragma unroll
      for (int r = 0; r < 16; ++r) { float c_ = C[dkb][r]; asm("v_mul_f32 %0, %1, %2" : "=v"(c_) : "v"(c_), "v"(decay)); C[dkb][r] = c_; }
    }
#define ML_U(DKB) do { s16x4 kl0, kh0, kl1, kh1, kl2, kh2, kl3, kh3; \
      ML_TR(kl0, vbK, fa::v_rd_off(DKB, 0, 0)); ML_TR(kh0, vbK, fa::v_rd_off(DKB, 0, 1)); ML_TR(kl1, vbK, fa::v_rd_off(DKB, 1, 0)); ML_TR(kh1, vbK, fa::v_rd_off(DKB, 1, 1)); \
      ML_TR(kl2, vbK, fa::v_rd_off(DKB, 2, 0)); ML_TR(kh2, vbK, fa::v_rd_off(DKB, 2, 1)); ML_TR(kl3, vbK, fa::v_rd_off(DKB, 3, 0)); ML_TR(kh3, vbK, fa::v_rd_off(DKB, 3, 1)); \
      asm volatile("s_waitcnt lgkmcnt(0)" ::: "memory"); __builtin_amdgcn_sched_barrier(0); \
      C[DKB] = __builtin_amdgcn_mfma_f32_32x32x16_bf16(ML_PK(kl0, kh0), vf0, C[DKB], 0, 0, 0); C[DKB] = __builtin_amdgcn_mfma_f32_32x32x16_bf16(ML_PK(kl1, kh1), vf1, C[DKB], 0, 0, 0); \
      C[DKB] = __builtin_amdgcn_mfma_f32_32x32x16_bf16(ML_PK(kl2, kh2), vf2, C[DKB], 0, 0, 0); C[DKB] = __builtin_amdgcn_mfma_f32_32x32x16_bf16(ML_PK(kl3, kh3), vf3, C[DKB], 0, 0, 0); } while (0)
    ML_U(0); ML_U(1); ML_U(2); ML_U(3);
#undef ML_U
    m_prev = m_new;
    if (n + 1 < n1) { cumb = scan_add(lf_n); av = li_n - cumb; pm = scan_max(av); }
    asm volatile("s_waitcnt vmcnt(0)" ::: "memory"); BAR_LDS();
    if (MODE == 1 && n + 2 < n1) DMA_Q(n + 2, slot);
  }
  if (MODE == 1) { int lo_ = lane_; asm volatile("" : "+v"(lo_)); const int cbr = chunk_base(n1 - 1, dir, b); const int hi_ = lo_ >> 5;
    const unsigned loff = (unsigned)(2 * (lo_ & 31) + (dir ? 1 - hi_ : hi_) * 4 * 4096); char* const Hb = (char*)(H + hd * 256 + 32 * wid);
#pragma unroll
    for (int k = 0; k < 16; ++k) { const int i0 = 2 * (k & 7), tk = 32 * (k >> 3) + (i0 & 3) + 8 * (i0 >> 2); char* const r0 = Hb + (size_t)(cbr + (dir ? 63 - tk - 4 : tk)) * 4096; char* const r1 = dir ? r0 - 4096 : r0 + 4096;
      *(bf16*)(r0 + loff) = (bf16)(hp[k] & 0xffffu); *(bf16*)(r1 + loff) = (bf16)(hp[k] >> 16); } }
  if (MODE == 0) {
    float* up = Ub + ((size_t)(chain * NGRP + grp) * 8 + wid) * 4096 + lane;
#pragma unroll
    for (int q = 0; q < 4; ++q)
#pragma unroll
      for (int r = 0; r < 16; ++r) up[(q * 16 + r) * 64] = C[q][r];
    if (tid < 128) Nb[(size_t)(chain * NGRP + grp) * 128 + tid] = N32[tid];
  }
  asm volatile("s_waitcnt vmcnt(0)" ::: "memory"); __syncthreads();
#undef DMA_Q
#undef DMA_K
#undef DMA_VS
#undef LOAD_G
#undef BAR_LDS
}
__device__ __forceinline__ void scan_phase_a(LAS unsigned char* lds, const bf16* QK, const bf16* Z, const float* G, float* Ub, float* Nb) {
  for (int u = blockIdx.x; u < 32 * (NGRP - 1); u += gridDim.x) { const int chain = u / (NGRP - 1), grp = u % (NGRP - 1); scan_chain<0>(lds, QK, Z, G, nullptr, Ub, Nb, chain, grp); }
}
__device__ __forceinline__ void scan_phase_b(LAS unsigned char* lds, const bf16* QK, const bf16* Z, const float* G, bf16* HF, bf16* HB, float* Ub, float* Nb) {
  for (int u = blockIdx.x; u < 32 * NGRP; u += gridDim.x) { const int chain = u / NGRP, grp = u % NGRP; scan_chain<1>(lds, QK, Z, G, (chain & 1) ? HB : HF, Ub, Nb, chain, grp); }
}
}

#define TRD_BEGIN(tab_) int nm_ = 0, base_ = 0; LAS TrDesc* const tb_ = (tab_); for (int i_ = 0; i_ < TR_NMAT; ++i_) tb_[i_].base = 0x7fffffff
#define TRD(W_, K_, N_, NP_, WT_) do { tb_[nm_].W = (W_); tb_[nm_].WT = (WT_); tb_[nm_].K = (K_); tb_[nm_].N = (N_); tb_[nm_].Npad = (NP_); tb_[nm_].base = base_; base_ += ((K_) / 64) * ((NP_) / 256); ++nm_; } while (0)
#define TRD_END() (((LAS int*)(X.lds + TR_LDS_OFF + TR_NMAT * 32))[0] = base_)
#define TRD_TOTAL() (((const LAS int*)(X.lds + TR_LDS_OFF + TR_NMAT * 32))[0])
struct Args { const float* in[23]; float* out; unsigned char* ws; int ph_lo, ph_hi; };
constexpr int PH_LAYER0 = 3, PH_PER_LAYER = 10, NPHASES = PH_LAYER0 + DEPTH * PH_PER_LAYER;
__host__ __device__ constexpr bool phase_active(int p) { return p < PH_LAYER0 ? true : ((((p - PH_LAYER0) / PH_PER_LAYER) % 3 == 0) ? !(((p - PH_LAYER0) % PH_PER_LAYER) >= 2 && ((p - PH_LAYER0) % PH_PER_LAYER) <= 4) : ((((p - PH_LAYER0) / PH_PER_LAYER) % 3 == 1) ? ((p - PH_LAYER0) % PH_PER_LAYER) != 4 : true)); }

#define IN(k) (lo <= (k) && (k) < hi)
#define SEAM(k) do { if (single && (k) + 1 < hi) xcd_barrier(bar); } while (0)
template <int L> __device__ __forceinline__ void run_layer(const Ctx& X, const Args& args, const XcdBarrier& bar, const int lo, const int hi, const bool single) {
    unsigned char* ws = args.ws; const int G = gridDim.x;
    const float* norm_g = args.in[6];
    float* mod = (float*)(ws + WS_MOD); float* cosT = (float*)(ws + WS_ROPE); float* sinT = cosT + 2048;
    hfp* h = (hfp*)(ws + WS_H); bf16* a = (bf16*)(ws + WS_A); bf16* y = (bf16*)(ws + WS_Y); bf16* o = (bf16*)(ws + WS_O); unsigned char* big = ws + WS_BIG;
        constexpr int kind = L % 3, jj = L / 3, pb = PH_LAYER0 + L * PH_PER_LAYER;
        const bf16* wo_t;
        if constexpr (kind == 0) {
            bf16* QKV = (bf16*)(big + BIG_QKV); wo_t = (const bf16*)(ws + WS_NAWO) + (size_t)jj * D * D;
            if (IN(pb + 0)) { pg8::Gemm g{a, (const bf16*)(ws + WS_NAQKV) + (size_t)jj * D * 6144, M, 6144, D}; pg8::StaticOrder S; S.init(M, 6144, G, (int)blockIdx.x, WGM_IN); pg8::EpiBf16<0> E{QKV, 6144};
                REPEAT_REP_IN(pg8::gemm_phase<pg8::EpiBf16<0>, pg8::StaticOrder, true, true>(X.lds, g, S, E);)
                if (L == 0) { if (G == 256 && (int)blockIdx.x >= 48) { LAS TrDesc* tab = (LAS TrDesc*)(X.lds + TR_LDS_OFF); if (X.tid == 0) { TRD_BEGIN(tab); TRD(args.in[12], D, 1088, 1280, (bf16*)(ws + WS_MLAIN)); TRD(args.in[15], 512, 3072, 3072, (bf16*)(ws + WS_MLAUQ)); TRD(args.in[16], 512, 4096, 4096, (bf16*)(ws + WS_MLAUKV)); TRD(args.in[17], D, D, D, (bf16*)(ws + WS_MLAWO)); TRD_END(); } __syncthreads(); tr_all(X, tab, TRD_TOTAL(), (int)blockIdx.x - 48, 256 - 48); } } SEAM(pb + 0); }
            if (IN(pb + 1)) { REPEAT_REP_NA(fa::na_attn_phase(X.lds, QKV, args.in[10] + (size_t)jj * 16 * 15 * 31, o, L < DEPTH - 1);) SEAM(pb + 1); }
        } else if constexpr (kind == 1) {
            bf16* Z = (bf16*)(big + BIG_MZ); bf16* QH = (bf16*)(big + BIG_QH); bf16* KV = (bf16*)(big + BIG_KV); bf16* CQN = (bf16*)(big + BIG_CQN); bf16* CKVN = (bf16*)(big + BIG_CKVN); bf16* KPE = (bf16*)(big + BIG_KPE);
            wo_t = (const bf16*)(ws + WS_MLAWO);
            if (IN(pb + 0)) { pg8::Gemm g{a, (const bf16*)(ws + WS_MLAIN), M, 1280, D}; pg8::StaticOrder S; S.init(M, 1280, G, (int)blockIdx.x, WGM_IN); pg8::EpiBf16<0> E{Z, 1280};
                REPEAT_REP_IN(pg8::gemm_phase<pg8::EpiBf16<0>, pg8::StaticOrder, true, true>(X.lds, g, S, E);)
                if (G == 256 && (int)blockIdx.x >= 74) { LAS TrDesc* tab = (LAS TrDesc*)(X.lds + TR_LDS_OFF); if (X.tid == 0) { TRD_BEGIN(tab); TRD(args.in[18], D, 6176, 6400, (bf16*)(ws + WS_MLIN)); TRD(args.in[22], D, D, D, (bf16*)(ws + WS_MLWO)); TRD_END(); } __syncthreads(); tr_all(X, tab, TRD_TOTAL(), (int)blockIdx.x - 74, 256 - 74); } SEAM(pb + 0); }
            if (IN(pb + 1)) { mla_rows(X, Z, args.in[13], args.in[14], cosT, sinT, CQN, CKVN, KPE); SEAM(pb + 1); }
            if (IN(pb + 2)) {
                { pg8::Gemm g{CQN, (const bf16*)(ws + WS_MLAUQ), M, 3072, 512}; pg8::StaticOrder S; S.init(M, 3072, G, (int)blockIdx.x, WGM_UQ); pg8::EpiBf16<0> E{QH, 3072};
                  pg8::gemm_phase<pg8::EpiBf16<0>, pg8::StaticOrder, true, true>(X.lds, g, S, E); }
                { pg8::Gemm g{CKVN, (const bf16*)(ws + WS_MLAUKV), M, 4096, 512}; pg8::StaticOrder S; S.init(M, 4096, G, (int)blockIdx.x, WGM_UQ); pg8::EpiBf16<0> E{KV, 4096};
                  pg8::gemm_phase<pg8::EpiBf16<0>, pg8::StaticOrder, true, true>(X.lds, g, S, E); }
                SEAM(pb + 2); }
            if (IN(pb + 3)) { m16::mla_attn_phase16(X.lds, QH, KV, KPE, cosT, sinT, o); SEAM(pb + 3); }
        } else {
            bf16* Z = (bf16*)(big + BIG_LZ); bf16* QK = (bf16*)(big + BIG_LQK); float* GT = (float*)(big + BIG_LG);
            wo_t = (const bf16*)(ws + WS_MLWO);
            if (IN(pb + 0)) { pg8::Gemm g{a, (const bf16*)(ws + WS_MLIN), M, 6400, D}; pg8::StaticOrder S; S.init(M, 6400, G, (int)blockIdx.x, WGM_IN); pg8::EpiBf16<0> E{Z, 6400};
                REPEAT_REP_IN(pg8::gemm_phase<pg8::EpiBf16<0>, pg8::StaticOrder, true, true>(X.lds, g, S, E);)
                if (G == 256 && (int)blockIdx.x >= 114) { LAS TrDesc* tab = (LAS TrDesc*)(X.lds + TR_LDS_OFF); if (X.tid == 0) { TRD_BEGIN(tab); TRD(args.in[9] + (size_t)D * 6144, D, 6144, 6144, (bf16*)(ws + WS_NAQKV) + (size_t)D * 6144); TRD(args.in[11] + (size_t)D * D, D, D, D, (bf16*)(ws + WS_NAWO) + (size_t)D * D); TRD_END(); } __syncthreads(); tr_all(X, tab, TRD_TOTAL(), (int)blockIdx.x - 114, 256 - 114); } SEAM(pb + 0); }
            if (IN(pb + 1)) { ml_rows(X, Z, args.in[20], args.in[19], QK, GT); SEAM(pb + 1); }
            float* Ub = (float*)(ws + WS_SLAB); float* Nb = Ub + (size_t)32 * ml::NGRP * 8 * 4096;
            if (IN(pb + 2)) { ml::scan_phase_a(X.lds, QK, Z, GT, Ub, Nb); SEAM(pb + 2); }
            if (IN(pb + 3)) { ml::scan_phase_b(X.lds, QK, Z, GT, y, a, Ub, Nb); SEAM(pb + 3); }
            if (IN(pb + 4)) { ml_gate_rows(X, Z, y, a, args.in[21], o); SEAM(pb + 4); }
        }
        constexpr bool LASTL = (L == DEPTH - 1); float* slab = (float*)(ws + WS_SLAB);
        if (IN(pb + 5)) { { pg8::Gemm g{o, wo_t, MLAT, D, D}; pg8::StaticOrder S; S.init(MLAT, D, G, (int)blockIdx.x, WGM_WO); pg8::EpiBf16<0> E{y, D};
            REPEAT_REP_WO(pg8::gemm_phase<pg8::EpiBf16<0>, pg8::StaticOrder, true, true>(X.lds, g, S, E);) }
            if (!LASTL) { pg8::Gemm g{o + (size_t)MLAT * D, wo_t, MCTX, D, 256, D}; pg8::SplitKOrder S; S.init(MCTX, D, 8, G, (int)blockIdx.x); pg8::EpiF32Slab E{slab, D, (size_t)MCTX * D};
                pg8::gemm_phase<pg8::EpiF32Slab, pg8::SplitKOrder, true, true>(X.lds, g, S, E); }
            SEAM(pb + 5); }
        if (IN(pb + 6)) { vec_setup(X, mod, norm_g, true, L, 2, 1, true, L, 2, 3, 4); npost<0, false>(X, y, h, a, nullptr, slab, 0, 0, MLAT); if (!LASTL) npost<0, true>(X, y, h, a, nullptr, slab, 8, MLAT, M); __syncthreads(); SEAM(pb + 6); }
        bf16* HID = (bf16*)(big + BIG_HID);
        if (IN(pb + 7)) { constexpr int MR = LASTL ? MLAT : M; pg8::Gemm g{a, (const bf16*)(ws + WS_W1T) + (size_t)L * D * DFF, MR, DFF, D}; pg8::StaticOrder S; S.init(MR, DFF, G, (int)blockIdx.x, WGM_F1); pg8::EpiBf16<2> E{HID, DFF};
            const bool tailwg = !LASTL && G == 256 && blockIdx.x >= 64; const int r_ = (int)blockIdx.x - 64; const int npre = tailwg ? 2 * (((int)blockIdx.x & 7) >> 1) : 0; const bool pre = npre > 0;
            LAS TrDesc* tab = (LAS TrDesc*)(X.lds + TR_LDS_OFF);
            if (tailwg) {
                if (X.tid == 0) { for (int i = 0; i < TR_NMAT; ++i) tab[i].base = 0x7fffffff;
                    tab[0].W = args.in[7] + (size_t)(L + 1) * D * DFF; tab[0].WT = (bf16*)(ws + WS_W1T) + (size_t)(L + 1) * D * DFF; tab[0].K = D; tab[0].N = DFF; tab[0].Npad = DFF; tab[0].base = 0;
                    tab[1].W = args.in[8] + (size_t)(L + 1) * D * DFF; tab[1].WT = (bf16*)(ws + WS_W2T) + (size_t)(L + 1) * D * DFF; tab[1].K = DFF; tab[1].N = D; tab[1].Npad = D; tab[1].base = 1024; }
                __syncthreads();
                if (pre) tr_all(X, tab, min(2048, r_ + 192 * npre), r_, 192); }
            REPEAT_REP_FFN1(pg8::gemm_phase<pg8::EpiBf16<2>, pg8::StaticOrder, true, true>(X.lds, g, S, E);)
            if (tailwg) tr_all(X, tab, 2048, r_ + 192 * npre, 192);
            SEAM(pb + 7); }
        if (IN(pb + 8)) { { pg8::Gemm g{HID, (const bf16*)(ws + WS_W2T) + (size_t)L * D * DFF, MLAT, D, DFF}; pg8::StaticOrder S; S.init(MLAT, D, G, (int)blockIdx.x, WGM_F2); pg8::EpiBf16<0> E{y, D};
            REPEAT_REP_FFN2(pg8::gemm_phase<pg8::EpiBf16<0>, pg8::StaticOrder, true, true>(X.lds, g, S, E);) }
            if (!LASTL) { pg8::Gemm g{HID + (size_t)MLAT * DFF, (const bf16*)(ws + WS_W2T) + (size_t)L * D * DFF, MCTX, D, 512, DFF}; pg8::SplitKOrder S; S.init(MCTX, D, 16, G, (int)blockIdx.x); pg8::EpiF32Slab E{slab, D, (size_t)MCTX * D};
                pg8::gemm_phase<pg8::EpiF32Slab, pg8::SplitKOrder, true, true>(X.lds, g, S, E); }
            SEAM(pb + 8); }
        if (IN(pb + 9)) {
            if (L < DEPTH - 1) { vec_setup(X, mod, norm_g, true, L, 5, 3, true, L + 1, 0, 0, 1); npost<0, false>(X, y, h, a, nullptr, slab, 0, 0, MLAT); npost<0, true>(X, y, h, a, nullptr, slab, 16, MLAT, M); }
            else { vec_setup(X, mod, norm_g, true, L, 5, 3, false, 0, 0, 0, 0); npost<1, false>(X, y, h, nullptr, args.out, slab, 0, 0, MLAT); }
            __syncthreads(); SEAM(pb + 9); }
}
__global__ void __launch_bounds__(NTHR, 2) mega_fwd(Args args) {
    extern __shared__ __attribute__((aligned(16))) unsigned char lds_raw[];
    Ctx X; X.lds = (LAS unsigned char*)lds_raw; X.tid = threadIdx.x; X.lane = X.tid & 63; X.wave = __builtin_amdgcn_readfirstlane(X.tid >> 6);
    X.gw = blockIdx.x * NWAVES + X.wave; X.ngw = gridDim.x * NWAVES;
    volatile LAS unsigned* MISC = (volatile LAS unsigned*)(X.lds + MISC_OFF);
    for (int u = X.tid; u < (LDS_BYTES - RING_BYTES) / 4; u += NTHR) ((LAS unsigned*)(X.lds + RING_BYTES))[u] = 0u;
    __syncthreads();
    unsigned char* ws = args.ws;
    const int lo = args.ph_lo, hi = args.ph_hi; const bool single = (hi - lo) > 1;
    XcdBarrier bar; bar.bar = (unsigned*)(ws + WS_CTL) + CW_BAR; bar.x = 0; bar.st = nullptr;
    if (single) bar = xcd_barrier_post((unsigned*)(ws + WS_CTL) + CW_BAR, MISC + 8);
    const float* x = args.in[0]; const float* c = args.in[1]; const float* ctx = args.in[2]; const float* c_ctx = args.in[3]; const float* ada_w = args.in[4]; const float* ada_b = args.in[5]; const float* norm_g = args.in[6];
    float* mod = (float*)(ws + WS_MOD); float* cosT = (float*)(ws + WS_ROPE); float* sinT = cosT + 2048; float* part = (float*)(ws + WS_PART);
    hfp* h = (hfp*)(ws + WS_H); bf16* a = (bf16*)(ws + WS_A); bf16* y = (bf16*)(ws + WS_Y); bf16* o = (bf16*)(ws + WS_O); unsigned char* big = ws + WS_BIG;
    const int G = gridDim.x;

    if (IN(0)) { for (int rep_ = 0; rep_ < REP_P0; ++rep_) {
        ada_partials(X, c, c_ctx, ada_w, part);
        rope_table(X, cosT, sinT);
        { LAS TrDesc* tab = (LAS TrDesc*)(X.lds + TR_LDS_OFF);
          if (X.tid == 0) { TRD_BEGIN(tab); const bool all = gridDim.x != 256;
            for (int l = 0; l < (all ? 4 : 1); ++l) { TRD(args.in[7] + (size_t)l * D * DFF, D, DFF, DFF, (bf16*)(ws + WS_W1T) + (size_t)l * D * DFF); TRD(args.in[8] + (size_t)l * D * DFF, DFF, D, D, (bf16*)(ws + WS_W2T) + (size_t)l * D * DFF); }
            for (int j = 0; j < (all ? 2 : 1); ++j) { TRD(args.in[9] + (size_t)j * D * 6144, D, 6144, 6144, (bf16*)(ws + WS_NAQKV) + (size_t)j * D * 6144); TRD(args.in[11] + (size_t)j * D * D, D, D, D, (bf16*)(ws + WS_NAWO) + (size_t)j * D * D); }
            if (all) { TRD(args.in[12], D, 1088, 1280, (bf16*)(ws + WS_MLAIN)); TRD(args.in[15], 512, 3072, 3072, (bf16*)(ws + WS_MLAUQ)); TRD(args.in[16], 512, 4096, 4096, (bf16*)(ws + WS_MLAUKV)); TRD(args.in[17], D, D, D, (bf16*)(ws + WS_MLAWO));
                       TRD(args.in[18], D, 6176, 6400, (bf16*)(ws + WS_MLIN)); TRD(args.in[22], D, D, D, (bf16*)(ws + WS_MLWO)); }
            TRD_END(); }
          __syncthreads();
          tr_all(X, tab, TRD_TOTAL(), (int)blockIdx.x, (int)gridDim.x); }
        __syncthreads(); }
        SEAM(0);
    }
    if (IN(1)) {
        for (int i = blockIdx.x * NTHR + X.tid; i < 4 * 3 * NMOD; i += G * NTHR) { const int l = i / (3 * NMOD), rem = i % (3 * NMOD), j = rem % NMOD; float s = ada_b[l * NMOD + j];
            for (int sl = 0; sl < 16; ++sl) s += part[((size_t)(sl * 4 + l) * 3) * NMOD + rem];
            mod[i] = s; }
        SEAM(1);
    }
    if (IN(2)) {
        vec_setup(X, mod, norm_g, false, 0, 0, 0, true, 0, 0, 0, 1);
        first_norm(X, x, ctx, h, a);
        __syncthreads();
        SEAM(2);
    }
    run_layer<0>(X, args, bar, lo, hi, single); run_layer<1>(X, args, bar, lo, hi, single); run_layer<2>(X, args, bar, lo, hi, single); run_layer<3>(X, args, bar, lo, hi, single);
#undef IN
#undef SEAM
}

#ifndef MK_SINGLE
#define MK_SINGLE 1
#endif
extern "C" void kernel_launch(void* const* d_in, const int* in_sizes, int n_in, void* d_out, int out_size, void* d_ws, size_t ws_size, hipStream_t stream) {
    static int grid = 0;
    if (grid == 0) {
        if (n_in != 23 || in_sizes[0] != MLAT * D || out_size != MLAT * D || ws_size < WS_END) { fprintf(stderr, "kernel_launch: shape mismatch n_in %d in0 %d out %d ws %zu (need %zu)\n", n_in, n_in > 0 ? in_sizes[0] : -1, out_size, ws_size, (size_t)WS_END); grid = -1; return; }
        int dev = 0, cus = 0;
        if (hipGetDevice(&dev) != hipSuccess || hipDeviceGetAttribute(&cus, hipDeviceAttributeMultiprocessorCount, dev) != hipSuccess) { grid = -1; return; }
        if (hipFuncSetAttribute((const void*)mega_fwd, hipFuncAttributeMaxDynamicSharedMemorySize, LDS_BYTES) != hipSuccess) { fprintf(stderr, "kernel_launch: hipFuncSetAttribute failed\n"); grid = -1; return; }
        int per_cu = 0;
        if (hipOccupancyMaxActiveBlocksPerMultiprocessor(&per_cu, (const void*)mega_fwd, NTHR, LDS_BYTES) != hipSuccess || per_cu < 1) fprintf(stderr, "kernel_launch: occupancy query reports %d\n", per_cu);
        (void)hipGetLastError();
        grid = cus;
    }
    if (grid < 0) return;
    if (hipMemsetAsync((char*)d_ws + WS_CTL, 0, CTL_ZERO_BYTES, stream) != hipSuccess) return;
    Args a{};
    for (int i = 0; i < 23; ++i) a.in[i] = (const float*)d_in[i];
    a.out = (float*)d_out; a.ws = (unsigned char*)d_ws;
#if MK_SINGLE
    a.ph_lo = 0; a.ph_hi = NPHASES;
    hipLaunchKernelGGL(mega_fwd, dim3(grid), dim3(NTHR), LDS_BYTES, stream, a);
#else
    for (int p = 0; p < NPHASES; ++p) { if (!phase_active(p)) continue; a.ph_lo = p; a.ph_hi = p + 1; hipLaunchKernelGGL(mega_fwd, dim3(grid), dim3(NTHR), LDS_BYTES, stream, a); }
#endif
    const hipError_t le = hipPeekAtLastError();
    if (le != hipSuccess) fprintf(stderr, "kernel_launch: launch failed: %s\n", hipGetErrorName(le));
}
```

```cpp
#include <hip/hip_runtime.h>
#include <cstdio>
#include <cstdint>
#include <cmath>
namespace pg8 {
#define PG8_LAS __attribute__((address_space(3)))
typedef unsigned short bf16_t;
typedef short bf16x8 __attribute__((ext_vector_type(8)));
typedef float f32x4 __attribute__((ext_vector_type(4)));
typedef unsigned u32x4 __attribute__((ext_vector_type(4)));
constexpr int BM = 256, BK = 64, HALF = 128, HTB = HALF * BK * 2  , STAGE_BYTES = 8 * HTB, NXCD = 8, WGM = 8;

__host__ __device__ __forceinline__ int lds_byte(int r, int c) { const int st = (r >> 4) * 2 + (c >> 5), rr = r & 15, cc = c & 31, ob = rr * 64 + cc * 2; return st * 1024 + (ob ^ (((ob >> 9) & 1) << 5)); }
__host__ __device__ __forceinline__ void stage_rc(int b, int& R, int& C) { const int st = b / 1024, sb = b % 1024, swz = sb ^ (((sb >> 9) & 1) << 5); R = (st >> 1) * 16 + swz / 64; C = (st & 1) * 32 + (swz % 64) / 2; }
__host__ __device__ __forceinline__ int perm32(int rho) { const int n = rho >> 4, i = rho & 15; return 8 * (i >> 2) + 4 * n + (i & 3); }

struct Unit { int pm, pn, pk; };
struct Gemm { const bf16_t* A; const bf16_t* Bt; int M, N, K, ld; };

struct StaticOrder {
    int nM, nN, nwg, G, c, wgm;
    __host__ __device__ void init(int M, int N, int G_, int c_, int wgm_ = WGM) { nM = M / BM; nN = N / BM; nwg = nM * nN; G = G_; c = c_; wgm = wgm_; }
    __host__ __device__ bool next(int i, Unit& u) const {
        const long L = (long)i * G + c; if (L >= nwg) return false;
        int wgid = (int)L; { const int q = nwg / NXCD, r = nwg % NXCD, xcd = wgid % NXCD, off = wgid / NXCD; wgid = (xcd < r ? xcd * (q + 1) : r * (q + 1) + (xcd - r) * q) + off; }
        const int nig = wgm * nN, gid = wgid / nig, fm = gid * wgm, gsz = (nM - fm) < wgm ? (nM - fm) : wgm;
        u.pm = fm + ((wgid % nig) % gsz); u.pn = (wgid % nig) / gsz; u.pk = 0; return true;
    }
    __device__ __forceinline__ void a_ready(const Unit&) const {}
    __device__ __forceinline__ void done(const Unit&) const {}
};

struct SplitKOrder {
    int nN, KS, nitems, G, c;
    __host__ __device__ void init(int M, int N, int KS_, int G_, int c_) { nN = N / BM; KS = KS_; nitems = (M / BM) * nN * KS_; G = G_; c = c_; }
    __host__ __device__ bool next(int i, Unit& u) const { const long L = (long)i * G + c; if (L >= nitems) return false; const int l = (int)L; u.pk = l % KS; const int t = l / KS; u.pn = t % nN; u.pm = t / nN; return true; }
    __device__ __forceinline__ void a_ready(const Unit&) const {}
    __device__ __forceinline__ void done(const Unit&) const {}
};

__device__ __forceinline__ unsigned cvt_pk_bf16(float lo, float hi) { unsigned r; asm volatile("v_cvt_pk_bf16_f32 %0, %1, %2" : "=v"(r) : "v"(lo), "v"(hi)); return r; }
typedef float f32x2 __attribute__((ext_vector_type(2)));
template <int ACT> struct EpiBf16 {
    static constexpr bool PERM = true, AFTER_DRAIN = false;
    bf16_t* O; int ldc;
    __device__ __forceinline__ void operator()(const f32x4 (&acc)[2][2][4][2], const Unit& u, int wr, int wc, int fr, int fq) const {
        const int row0 = u.pm * BM + wr * 64 + fr; const int col0 = u.pn * BM + wc * 32 + 8 * fq;
#pragma unroll
        for (int ai = 0; ai < 2; ++ai)
#pragma unroll
            for (int m = 0; m < 4; ++m) { bf16_t* rowp = O + (size_t)(row0 + ai * HALF + m * 16) * ldc + col0;
#pragma unroll
                for (int bj = 0; bj < 2; ++bj) { f32x4 v0 = acc[ai][bj][m][0], v1 = acc[ai][bj][m][1];
                    if (ACT == 2) {
#pragma unroll
                        for (int e = 0; e < 4; ++e) { const float a = v0[e] > 0.f ? v0[e] : 0.f, b = v1[e] > 0.f ? v1[e] : 0.f; v0[e] = a * a; v1[e] = b * b; } }
                    u32x4 w; w.x = cvt_pk_bf16(v0[0], v0[1]); w.y = cvt_pk_bf16(v0[2], v0[3]); w.z = cvt_pk_bf16(v1[0], v1[1]); w.w = cvt_pk_bf16(v1[2], v1[3]);
                    *(u32x4*)(rowp + bj * HALF) = w; } }
    }
};

struct EpiF32Slab {
    static constexpr bool PERM = false, AFTER_DRAIN = false;
    float* O; int ldc; size_t slab;
    __device__ __forceinline__ void operator()(const f32x4 (&acc)[2][2][4][2], const Unit& u, int wr, int wc, int fr, int fq) const {
        const int row0 = u.pm * BM + wr * 64 + fr; const int col0 = u.pn * BM + wc * 32 + 4 * fq; float* base = O + (size_t)u.pk * slab;
#pragma unroll
        for (int ai = 0; ai < 2; ++ai)
#pragma unroll
            for (int m = 0; m < 4; ++m) { float* rowp = base + (size_t)(row0 + ai * HALF + m * 16) * ldc + col0;
#pragma unroll
                for (int bj = 0; bj < 2; ++bj)
#pragma unroll
                    for (int n = 0; n < 2; ++n) *(f32x4*)(rowp + bj * HALF + n * 16) = acc[ai][bj][m][n]; }
    }
};

template <class Epi, class Sched, bool ALIGN_EPI = false, bool SP2 = false>
__device__ __forceinline__ void gemm_phase(PG8_LAS unsigned char* lds, const Gemm g, const Sched& S, const Epi& E) {
    const int tid = threadIdx.x, wid = __builtin_amdgcn_readfirstlane(tid >> 6), lane = tid & 63, wr = wid >> 2, wc = wid & 3, fr = lane & 15, fq = lane >> 4;
    const int K = g.K, nt = K / BK, ld = g.ld ? g.ld : g.K;
    unsigned voffA[2], voffB[2];
#pragma unroll
    for (int i = 0; i < 2; ++i) { int R, C; stage_rc(tid * 16 + i * 8192, R, C); const int Rb = Epi::PERM ? ((R & ~31) + perm32(R & 31)) : R;
        voffA[i] = (unsigned)(R * ld + C) * 2u; voffB[i] = (unsigned)(Rb * ld + C) * 2u; }
    const __amdgpu_buffer_rsrc_t rsA = __builtin_amdgcn_make_buffer_rsrc((void*)g.A, (short)0, 0x7fffffff, 0x00020000), rsB = __builtin_amdgcn_make_buffer_rsrc((void*)g.Bt, (short)0, 0x7fffffff, 0x00020000);
    const size_t kstep = (size_t)(BK * 2);
    const size_t hstep = (size_t)HALF * ld * 2;
    const size_t tstep = 2 * hstep;
    const unsigned ldsw = (unsigned)wid * 1024u;
    const int aoff = lds_byte(wr * 64 + fr, fq * 8), boff = lds_byte(wc * 32 + fr, fq * 8);
#define PG8_SA(b, h) (((b) * 2 + (h)) * HTB)
#define PG8_SB(b, h) ((4 + (b) * 2 + (h)) * HTB)
#define PG8_STAGE_X(rs, base, bufoff, gbase, voff) do { const int so_ = (int)((const char*)(gbase) - (const char*)(base)); _Pragma("unroll") for (int _i = 0; _i < 2; ++_i) \
        __builtin_amdgcn_raw_ptr_buffer_load_lds(rs, (PG8_LAS void*)(lds + (bufoff) + ldsw + _i * 8192), 16, (int)(voff)[_i], so_, 0, 0); } while (0)
#define PG8_STAGE_voffA(bufoff, gbase) PG8_STAGE_X(rsA, g.A, bufoff, gbase, voffA)
#define PG8_STAGE_voffB(bufoff, gbase) PG8_STAGE_X(rsB, g.Bt, bufoff, gbase, voffB)
#define PG8_STAGE(bufoff, gbase, voff) PG8_STAGE_##voff(bufoff, gbase)
#define PG8_LDA(dst, b, h) do { _Pragma("unroll") for (int m = 0; m < 4; ++m) _Pragma("unroll") for (int k = 0; k < 2; ++k) dst[m][k] = *(const PG8_LAS bf16x8*)(lds + PG8_SA(b, h) + aoff + m * 2048 + k * 1024); } while (0)
#define PG8_LDB(dst, b, h) do { _Pragma("unroll") for (int n = 0; n < 2; ++n) _Pragma("unroll") for (int k = 0; k < 2; ++k) dst[n][k] = *(const PG8_LAS bf16x8*)(lds + PG8_SB(b, h) + boff + n * 2048 + k * 1024); } while (0)
#define PG8_MMA(ai, bj, At, Bt) do { __builtin_amdgcn_s_setprio(1); _Pragma("unroll") for (int m = 0; m < 4; ++m) _Pragma("unroll") for (int n = 0; n < 2; ++n) _Pragma("unroll") for (int k = 0; k < 2; ++k) \
        acc[ai][bj][m][n] = __builtin_amdgcn_mfma_f32_16x16x32_bf16(Bt[n][k], At[m][k], acc[ai][bj][m][n], 0, 0, 0); __builtin_amdgcn_s_setprio(0); } while (0)
#define PG8_WAIT_V(n) asm volatile("s_waitcnt vmcnt(" #n ")" ::: "memory")
#define PG8_WAIT_L(n) asm volatile("s_waitcnt lgkmcnt(" #n ")" ::: "memory")
#define PG8_BAR __builtin_amdgcn_s_barrier()
#define PG8_SCHED __builtin_amdgcn_sched_barrier(0)
    Unit cur, nxt; int ui = 0;
    if (!S.next(0, cur)) return;
    f32x4 acc[2][2][4][2];
#pragma unroll
    for (int a = 0; a < 2; ++a)
#pragma unroll
        for (int b = 0; b < 2; ++b)
#pragma unroll
            for (int m = 0; m < 4; ++m)
#pragma unroll
                for (int n = 0; n < 2; ++n) acc[a][b][m][n] = (f32x4){0.f, 0.f, 0.f, 0.f};
    bf16x8 At[4][2], B0[2][2], B1[2][2];
    const char* cA = (const char*)g.A + (size_t)cur.pm * tstep + (size_t)cur.pk * K * 2; const char* cB = (const char*)g.Bt + (size_t)cur.pn * tstep + (size_t)cur.pk * K * 2;
    S.a_ready(cur);
    if constexpr (SP2) {
        PG8_STAGE(PG8_SB(0, 0), cB, voffB); PG8_STAGE(PG8_SB(0, 1), cB + hstep, voffB); PG8_STAGE(PG8_SA(0, 0), cA, voffA); PG8_STAGE(PG8_SA(0, 1), cA + hstep, voffA);
        if (wr == 1) PG8_BAR;
        PG8_WAIT_V(2); PG8_BAR;
        PG8_STAGE(PG8_SB(1, 0), cB + kstep, voffB); PG8_STAGE(PG8_SA(1, 0), cA + kstep, voffA); PG8_STAGE(PG8_SB(1, 1), cB + hstep + kstep, voffB);
        PG8_WAIT_V(6); PG8_BAR;
    } else {
        PG8_STAGE(PG8_SB(0, 0), cB, voffB); PG8_STAGE(PG8_SA(0, 0), cA, voffA); PG8_STAGE(PG8_SB(0, 1), cB + hstep, voffB); PG8_STAGE(PG8_SA(0, 1), cA + hstep, voffA);
        if (wr == 1) PG8_BAR;
        PG8_WAIT_V(4); PG8_BAR;
        PG8_STAGE(PG8_SB(1, 0), cB + kstep, voffB); PG8_STAGE(PG8_SA(1, 0), cA + kstep, voffA); PG8_STAGE(PG8_SB(1, 1), cB + hstep + kstep, voffB);
        PG8_WAIT_V(6); PG8_BAR;
    }
    for (;;) {
        const bool has_next = S.next(ui + 1, nxt);
        const char* nA = has_next ? (const char*)g.A + (size_t)nxt.pm * tstep + (size_t)nxt.pk * K * 2 : cA; const char* nB = has_next ? (const char*)g.Bt + (size_t)nxt.pn * tstep + (size_t)nxt.pk * K * 2 : cB;
        for (int t = 0; t < nt; t += 2) {
            const bool last = (t == nt - 2);
            const char* a1 = cA + (size_t)(t + 1) * kstep;
            const char* a2 = last ? nA : cA + (size_t)(t + 2) * kstep; const char* b2 = last ? nB : cB + (size_t)(t + 2) * kstep;
            const char* a3 = a2 + kstep; const char* b3 = b2 + kstep;
            if (last && has_next) S.a_ready(nxt);
            if constexpr (SP2) {
            PG8_LDB(B0, 0, 0); PG8_LDB(B1, 0, 1); PG8_SCHED; PG8_LDA(At, 0, 0); PG8_STAGE(PG8_SA(1, 1), a1 + hstep, voffA);
            PG8_WAIT_V(8); PG8_WAIT_L(0); PG8_BAR; PG8_MMA(0, 0, At, B0); PG8_MMA(0, 1, At, B1); PG8_BAR; PG8_SCHED;
            PG8_LDA(At, 0, 1); PG8_STAGE(PG8_SB(0, 0), b2, voffB); PG8_STAGE(PG8_SB(0, 1), b2 + hstep, voffB); PG8_STAGE(PG8_SA(0, 0), a2, voffA);
            PG8_WAIT_V(8); PG8_WAIT_L(0); PG8_BAR; PG8_MMA(1, 0, At, B0); PG8_MMA(1, 1, At, B1); PG8_BAR; PG8_SCHED;
            PG8_LDB(B0, 1, 0); PG8_LDB(B1, 1, 1); PG8_SCHED; PG8_LDA(At, 1, 0); PG8_STAGE(PG8_SA(0, 1), a2 + hstep, voffA);
            PG8_WAIT_V(8); PG8_WAIT_L(0); PG8_BAR; PG8_MMA(0, 0, At, B0); PG8_MMA(0, 1, At, B1); PG8_BAR; PG8_SCHED;
            PG8_LDA(At, 1, 1); PG8_STAGE(PG8_SB(1, 0), b3, voffB); PG8_STAGE(PG8_SB(1, 1), b3 + hstep, voffB); PG8_STAGE(PG8_SA(1, 0), a3, voffA);
            PG8_WAIT_V(8); PG8_WAIT_L(0); PG8_BAR; PG8_MMA(1, 0, At, B0); PG8_MMA(1, 1, At, B1); PG8_BAR; PG8_SCHED;
            } else {
            PG8_LDB(B0, 0, 0); PG8_SCHED; PG8_LDA(At, 0, 0); PG8_STAGE(PG8_SA(1, 1), a1 + hstep, voffA);
            PG8_WAIT_L(8); PG8_BAR; PG8_WAIT_L(0); PG8_MMA(0, 0, At, B0); PG8_BAR; PG8_SCHED;
            PG8_LDB(B1, 0, 1); PG8_STAGE(PG8_SB(0, 0), b2, voffB);
            PG8_BAR; PG8_WAIT_L(0); PG8_MMA(0, 1, At, B1); PG8_BAR;
            PG8_LDA(At, 0, 1); PG8_STAGE(PG8_SA(0, 0), a2, voffA);
            PG8_BAR; PG8_WAIT_L(0); PG8_MMA(1, 0, At, B0); PG8_BAR; PG8_SCHED;
            PG8_STAGE(PG8_SB(0, 1), b2 + hstep, voffB);
            PG8_WAIT_V(6); PG8_BAR; PG8_MMA(1, 1, At, B1); PG8_BAR;
            PG8_LDB(B0, 1, 0); PG8_SCHED; PG8_LDA(At, 1, 0); PG8_STAGE(PG8_SA(0, 1), a2 + hstep, voffA);
            PG8_WAIT_L(8); PG8_BAR; PG8_WAIT_L(0); PG8_MMA(0, 0, At, B0); PG8_BAR; PG8_SCHED;
            PG8_LDB(B1, 1, 1); PG8_STAGE(PG8_SB(1, 0), b3, voffB);
            PG8_BAR; PG8_WAIT_L(0); PG8_MMA(0, 1, At, B1); PG8_BAR;
            PG8_LDA(At, 1, 1); PG8_STAGE(PG8_SA(1, 0), a3, voffA);
            PG8_BAR; PG8_WAIT_L(0); PG8_MMA(1, 0, At, B0); PG8_BAR; PG8_SCHED;
            PG8_STAGE(PG8_SB(1, 1), b3 + hstep, voffB);
            PG8_WAIT_V(6); PG8_BAR; PG8_MMA(1, 1, At, B1); PG8_BAR;
            }
        }
        if constexpr (ALIGN_EPI) { if (wr == 0) PG8_BAR; }
        if constexpr (!Epi::AFTER_DRAIN) { E(acc, cur, wr, wc, fr, fq); S.done(cur); }
        if (!has_next) break;
#pragma unroll
        for (int a = 0; a < 2; ++a)
#pragma unroll
            for (int b = 0; b < 2; ++b)
#pragma unroll
                for (int m = 0; m < 4; ++m)
#pragma unroll
                    for (int n = 0; n < 2; ++n) acc[a][b][m][n] = (f32x4){0.f, 0.f, 0.f, 0.f};
        cur = nxt; cA = nA; cB = nB; ++ui;
        if constexpr (ALIGN_EPI) { if (wr == 1) PG8_BAR; }
    }
    PG8_WAIT_V(0);
    if constexpr (!ALIGN_EPI) { if (wr == 0) PG8_BAR; }
    PG8_BAR;
    if constexpr (Epi::AFTER_DRAIN) { E.fused(acc, cur, wr, wc, fr, fq, lds, wid, lane); S.done(cur); }
#undef PG8_SA
#undef PG8_SB
#undef PG8_STAGE
#undef PG8_STAGE_X
#undef PG8_STAGE_voffA
#undef PG8_STAGE_voffB
#undef PG8_LDA
#undef PG8_LDB
#undef PG8_MMA
#undef PG8_WAIT_V
#undef PG8_WAIT_L
#undef PG8_BAR
#undef PG8_SCHED
}
}
#define GAS __attribute__((address_space(1)))
#define LAS __attribute__((address_space(3)))
typedef unsigned short bf16;
typedef unsigned v4u __attribute__((ext_vector_type(4)));
typedef float f32x4 __attribute__((ext_vector_type(4)));
typedef short bf16x8 __attribute__((ext_vector_type(8)));
typedef GAS unsigned gu32;
typedef GAS unsigned long long gu64;
#define RLX_AGENT __ATOMIC_RELAXED, __HIP_MEMORY_SCOPE_AGENT
#define LDS_WAIT() asm volatile("s_waitcnt lgkmcnt(0)" ::: "memory")
#define VM_WAIT() asm volatile("s_waitcnt vmcnt(0)" ::: "memory")
__device__ __forceinline__ unsigned long long rt() { return __builtin_amdgcn_s_memrealtime(); }
__device__ __forceinline__ unsigned f2bf(float f) { unsigned u = __builtin_bit_cast(unsigned, f); return (u + 0x7fffu + ((u >> 16) & 1u)) >> 16; }
__device__ __forceinline__ unsigned pk2(float lo, float hi) { return f2bf(lo) | (f2bf(hi) << 16); }

#define XB_TMO      128
#define XB_XCNT(j)  (256  + 64 * (j))
#define XB_XSUB(j)  (1280 + 64 * (j))
#define XB_XGEN(j)  (2304 + 64 * (j))
#define XB_TOP      3328
#define XB_TOPGEN   3392
#define XCD_BAR_WORDS 3456
#define XB_SPIN_CAP (1u << 18)

__device__ __forceinline__ unsigned xb_ld(unsigned* p)              { return __hip_atomic_load(p, __ATOMIC_RELAXED, __HIP_MEMORY_SCOPE_AGENT); }
__device__ __forceinline__ unsigned xb_add(unsigned* p, unsigned v) { return __hip_atomic_fetch_add(p, v, __ATOMIC_RELAXED, __HIP_MEMORY_SCOPE_AGENT); }
__device__ __forceinline__ unsigned xb_xcc_id() { return (unsigned)__builtin_amdgcn_s_getreg((3 << 11) | 20) & 0xFu; }
#define XB_SPIN(cond, bar) do { unsigned _sp = 0; while (cond) { __builtin_amdgcn_s_sleep(1); \
    if ((++_sp & 255u) == 0u) { if (xb_ld(&(bar)[XB_TMO])) break; if (_sp > XB_SPIN_CAP) { atomicAdd(&(bar)[XB_TMO], 1u); break; } } } } while (0)

struct XcdBarrier {
    unsigned* bar; unsigned x;
    volatile LAS unsigned* st;
};

__device__ __forceinline__ XcdBarrier xcd_barrier_post(unsigned* bar, volatile LAS unsigned* st) {
    XcdBarrier b; b.bar = bar; b.x = xb_xcc_id(); b.st = st;
    if (threadIdx.x == 0) (void)xb_add(&bar[XB_XCNT(b.x)], 1u);
    return b;
}
__device__ __forceinline__ void xcd_barrier_complete(unsigned* bar, unsigned x, unsigned& nloc, unsigned& nx) {
    const unsigned G = gridDim.x * gridDim.y * gridDim.z;
    unsigned sum, cnt, mine, sp = 0u;
    for (;;) {
        sum = 0u; cnt = 0u; mine = 0u;
#pragma unroll
        for (unsigned j = 0; j < 16; ++j) { const unsigned c = xb_ld(&bar[XB_XCNT(j)]); sum += c; cnt += (c > 0u) ? 1u : 0u; mine = (j == x) ? c : mine; }
        if (sum == G) break;
        __builtin_amdgcn_s_sleep(1);
        if ((++sp & 255u) == 0u) { if (xb_ld(&bar[XB_TMO])) break; if (sp > XB_SPIN_CAP) { atomicAdd(&bar[XB_TMO], 1u); break; } }
    }
    nloc = mine > 0u ? mine : 1u; nx = cnt > 0u ? cnt : 1u;
}

__device__ __forceinline__ void xcd_barrier(const XcdBarrier& b) {
    asm volatile("s_waitcnt vmcnt(0)" ::: "memory");
    __syncthreads();
    if (threadIdx.x == 0) {
        unsigned* bar = b.bar;
        __builtin_amdgcn_s_waitcnt(0);
        unsigned nloc = b.st[0], nx = b.st[1];
        if (nloc == 0u) { xcd_barrier_complete(bar, b.x, nloc, nx); b.st[0] = nloc; b.st[1] = nx; }
        const unsigned old = xb_add(&bar[XB_XSUB(b.x)], 1u);
        const unsigned gen = old / nloc;
        if (old + 1u == (gen + 1u) * nloc) {
            __builtin_amdgcn_fence(__ATOMIC_RELEASE, "agent");
            asm volatile("s_waitcnt vmcnt(0)" ::: "memory");
            const unsigned og = xb_add(&bar[XB_TOP], 1u);
            const unsigned tg = og / nx;
            if (og + 1u == (tg + 1u) * nx) xb_add(&bar[XB_TOPGEN], 1u);
            else XB_SPIN(xb_ld(&bar[XB_TOPGEN]) == tg, bar);
            __builtin_amdgcn_fence(__ATOMIC_ACQUIRE, "agent");
            xb_add(&bar[XB_XGEN(b.x)], 1u);
            asm volatile("s_waitcnt vmcnt(0)" ::: "memory");
        } else {
            XB_SPIN(xb_ld(&bar[XB_XGEN(b.x)]) == gen, bar);
            __builtin_amdgcn_fence(__ATOMIC_ACQUIRE, "agent");
            asm volatile("s_waitcnt vmcnt(0)" ::: "memory");
        }
    }
    __syncthreads();
}
__device__ __forceinline__ float wave_sum(float v) {
#pragma unroll
    for (int o = 1; o < 64; o <<= 1) v += __shfl_xor(v, o);
    return v;
}
__device__ __forceinline__ void p0_transpose_item(const float* W, int K, int N, bf16* WT, int row_off, LAS float* scr, int item, int lane) {
    const int nblk = N / 32, kb = item / nblk, nb = item % nblk, k0 = 64 * kb, n0 = 32 * nb;
#pragma unroll 8
    for (int i = 0; i < 32; ++i) { const int kk = 2 * i + (lane >> 5); scr[kk * 33 + (lane & 31)] = W[(size_t)(k0 + kk) * N + n0 + (lane & 31)]; }
    LDS_WAIT(); asm volatile("" ::: "memory");
    const int c = lane & 7;
#pragma unroll
    for (int j = 0; j < 4; ++j) { const int n = (lane >> 3) + 8 * j; const LAS float* s = scr + (8 * c) * 33 + n;
        v4u o; o.x = pk2(s[0 * 33], s[1 * 33]); o.y = pk2(s[2 * 33], s[3 * 33]); o.z = pk2(s[4 * 33], s[5 * 33]); o.w = pk2(s[6 * 33], s[7 * 33]);
        *(GAS v4u*)(WT + (size_t)(row_off + n0 + n) * K + k0 + 8 * c) = o; }
    LDS_WAIT(); asm volatile("" ::: "memory");
}
#ifndef WGM_IN
#define WGM_IN 4
#endif
#ifndef WGM_UQ
#define WGM_UQ 4
#endif
#ifndef WGM_WO
#define WGM_WO 4
#endif
#ifndef WGM_F1
#define WGM_F1 4
#endif
#ifndef WGM_F2
#define WGM_F2 4
#endif
#ifndef REP_IN
#define REP_IN 1
#endif
#ifndef REP_NA
#define REP_NA 1
#endif
#ifndef REP_MLA
#define REP_MLA 1
#endif
#ifndef REP_SCAN
#define REP_SCAN 1
#endif
#ifndef REP_WO
#define REP_WO 1
#endif
#ifndef REP_FFN1
#define REP_FFN1 1
#endif
#ifndef REP_FFN2
#define REP_FFN2 1
#endif
#ifndef REP_P0
#define REP_P0 1
#endif

#if REP_IN == 2
#define REPEAT_REP_IN(...) __VA_ARGS__ __VA_ARGS__
#else
#define REPEAT_REP_IN(...) __VA_ARGS__
#endif
#if REP_NA == 2
#define REPEAT_REP_NA(...) __VA_ARGS__ __VA_ARGS__
#else
#define REPEAT_REP_NA(...) __VA_ARGS__
#endif
#if REP_MLA == 2
#define REPEAT_REP_MLA(...) __VA_ARGS__ __VA_ARGS__
#else
#define REPEAT_REP_MLA(...) __VA_ARGS__
#endif
#if REP_SCAN == 2
#define REPEAT_REP_SCAN(...) __VA_ARGS__ __VA_ARGS__
#else
#define REPEAT_REP_SCAN(...) __VA_ARGS__
#endif
#if REP_WO == 2
#define REPEAT_REP_WO(...) __VA_ARGS__ __VA_ARGS__
#else
#define REPEAT_REP_WO(...) __VA_ARGS__
#endif
#if REP_FFN1 == 2
#define REPEAT_REP_FFN1(...) __VA_ARGS__ __VA_ARGS__
#else
#define REPEAT_REP_FFN1(...) __VA_ARGS__
#endif
#if REP_FFN2 == 2
#define REPEAT_REP_FFN2(...) __VA_ARGS__ __VA_ARGS__
#else
#define REPEAT_REP_FFN2(...) __VA_ARGS__
#endif

constexpr int NWAVES = 8, NTHR = 512;
constexpr int D = 2048, NB = 2, SEQ = 8192, CTXL = 256, DFF = 8192, DEPTH = 4;
constexpr int MLAT = NB * SEQ, MCTX = NB * CTXL, M = MLAT + MCTX;
constexpr float EPS = 1e-6f;
constexpr int NMOD = 6 * D;
constexpr size_t MiB = 1u << 20;
constexpr size_t WS_CTL = 0, CTL_ZERO_BYTES = 1 * MiB;
constexpr size_t WS_MOD = 1 * MiB, WS_ROPE = 2 * MiB, WS_PART = 3 * MiB;
constexpr size_t WS_W1T = 12 * MiB, WS_W2T = WS_W1T + 128 * MiB, WS_NAQKV = WS_W2T + 128 * MiB, WS_NAWO = WS_NAQKV + 48 * MiB;
constexpr size_t WS_MLAIN = WS_NAWO + 16 * MiB, WS_MLAUQ = WS_MLAIN + 5 * MiB, WS_MLAUKV = WS_MLAUQ + 3 * MiB, WS_MLAWO = WS_MLAUKV + 4 * MiB;
constexpr size_t WS_MLIN = WS_MLAWO + 8 * MiB, WS_MLWO = WS_MLIN + 25 * MiB;
constexpr size_t WS_H = WS_MLWO + 8 * MiB, WS_A = WS_H + 132 * MiB, WS_Y = WS_A + 66 * MiB, WS_O = WS_Y + 66 * MiB, WS_BIG = WS_O + 66 * MiB, WS_SLAB = WS_BIG + 276 * MiB, WS_END = WS_SLAB + 64 * MiB;
constexpr size_t BIG_QKV = 0;
constexpr size_t BIG_QH = 0, BIG_MZ = 0, BIG_KV = 99 * MiB, BIG_CQN = 231 * MiB, BIG_CKVN = BIG_CQN + (size_t)M * 512 * 2, BIG_KPE = 264 * MiB;
constexpr size_t BIG_LZ = 0, BIG_LQK = 207 * MiB, BIG_LG = 273 * MiB;
constexpr size_t BIG_HID = 0;
constexpr int CW_BAR = 4096;
constexpr int RING_BYTES = 131072, LDS_BYTES = 147456, MISC_OFF = LDS_BYTES - 256;

__device__ __forceinline__ float bf_lo(unsigned w) { return __uint_as_float(w << 16); }
__device__ __forceinline__ float bf_hi(unsigned w) { return __uint_as_float(w & 0xffff0000u); }
__device__ __forceinline__ float bf1(bf16 b) { return __uint_as_float(((unsigned)b) << 16); }
__device__ __forceinline__ unsigned pkbf(float lo, float hi) { return pg8::cvt_pk_bf16(lo, hi); }
__device__ __forceinline__ void unpack8(const v4u w, float* f) { f[0] = bf_lo(w.x); f[1] = bf_hi(w.x); f[2] = bf_lo(w.y); f[3] = bf_hi(w.y); f[4] = bf_lo(w.z); f[5] = bf_hi(w.z); f[6] = bf_lo(w.w); f[7] = bf_hi(w.w); }
__device__ __forceinline__ float sigmoidf_(float x) { return 1.f / (1.f + expf(-x)); }

typedef _Float16 hfp;
typedef _Float16 hfp4 __attribute__((ext_vector_type(4)));
struct Ctx { LAS unsigned char* lds; int tid, lane, wave, gw, ngw; };

__device__ __forceinline__ void tr_matrix(const Ctx& X, const float* W, int K, int N, bf16* WT) {
    LAS float* scr = (LAS float*)(X.lds + X.wave * 8448);
    const int nitems = (K / 64) * (N / 32);
    for (int it = X.gw; it < nitems; it += X.ngw) p0_transpose_item(W, K, N, WT, 0, scr, it, X.lane);
}
struct TrDesc { const float* W; bf16* WT; int K, N, Npad, base; };
constexpr int TR_NMAT = 18, TR_LDS_OFF = 132096;
__device__ __forceinline__ void tr_decode(const LAS TrDesc* tab, int g, const float*& W, bf16*& WT, int& K, int& N, int& k0, int& n0) {
    int mi = 0;
#pragma unroll 1
    for (int i = 1; i < TR_NMAT; ++i) if (g >= tab[i].base) mi = i;
    const LAS TrDesc* d = tab + mi; const int it = g - d->base, nb = d->Npad >> 8; W = d->W; WT = d->WT; K = d->K; N = d->N; k0 = (it / nb) * 64; n0 = (it % nb) * 256;
}
struct TrItem { const float* W; bf16* WT; int K, N, k0, n0; };
__device__ __forceinline__ void tr_all(const Ctx& X, const LAS TrDesc* tab, int total, const int first, const int G) {
    LAS float* T = (LAS float*)X.lds; const int q = X.tid & 63, rr = X.tid >> 6, c = X.tid & 7;
    if (first >= total) return;
#define TR_LOAD(v_, I_) do { _Pragma("unroll") for (int i = 0; i < 8; ++i) { const int n = (I_).n0 + 4 * q; v_[i] = n < (I_).N ? *(const f32x4*)((I_).W + (size_t)((I_).k0 + rr + 8 * i) * (I_).N + n) : (f32x4){0.f, 0.f, 0.f, 0.f}; } } while (0)
#define TR_PUT(v_) do { _Pragma("unroll") for (int i = 0; i < 8; ++i) *(LAS f32x4*)(T + (rr + 8 * i) * 256 + 4 * (q ^ i)) = v_[i]; } while (0)
#define TR_STORE(I_) do { _Pragma("unroll") for (int j = 0; j < 4; ++j) { const int nn = (X.tid >> 3) + 64 * j; const LAS float* s = T + (8 * c) * 256 + (nn ^ (4 * c)); \
        v4u o; o.x = pk2(s[0 * 256], s[1 * 256]); o.y = pk2(s[2 * 256], s[3 * 256]); o.z = pk2(s[4 * 256], s[5 * 256]); o.w = pk2(s[6 * 256], s[7 * 256]); \
        *(GAS v4u*)((I_).WT + (size_t)((I_).n0 + nn) * (I_).K + (I_).k0 + 8 * c) = o; } } while (0)
    TrItem A, B, Cn; f32x4 va[8], vb[8];
    int g = first;
    tr_decode(tab, g, A.W, A.WT, A.K, A.N, A.k0, A.n0); TR_LOAD(va, A);
    bool hasB = g + G < total; B = A; if (hasB) { tr_decode(tab, g + G, B.W, B.WT, B.K, B.N, B.k0, B.n0); TR_LOAD(vb, B); }
    for (;;) {
        const bool hasC = g + 2 * G < total; Cn = A; if (hasC) tr_decode(tab, g + 2 * G, Cn.W, Cn.WT, Cn.K, Cn.N, Cn.k0, Cn.n0);
        TR_PUT(va); __syncthreads();
        const TrItem cur = A;
        if (hasC) { A = Cn; TR_LOAD(va, A); }
        TR_STORE(cur); __syncthreads();
        if (!hasB) break;
        const bool hasD = g + 3 * G < total; Cn = B; if (hasD) tr_decode(tab, g + 3 * G, Cn.W, Cn.WT, Cn.K, Cn.N, Cn.k0, Cn.n0);
        TR_PUT(vb); __syncthreads();
        const TrItem cur2 = B;
        if (hasD) { B = Cn; TR_LOAD(vb, B); }
        TR_STORE(cur2); __syncthreads();
        if (!hasC) break;
        hasB = hasD; g += 2 * G;
    }
#undef TR_LOAD
#undef TR_PUT
#undef TR_STORE
}
__device__ __forceinline__ void zero_bf16(const Ctx& X, bf16* p, size_t n8) {
    for (size_t i = (size_t)blockIdx.x * NTHR + X.tid; i < n8; i += (size_t)gridDim.x * NTHR) ((v4u*)p)[i] = (v4u){0u, 0u, 0u, 0u};
}
__device__ __forceinline__ void ada_partials(const Ctx& X, const float* c, const float* c_ctx, const float* ada_w, float* part) {
    LAS float* S = (LAS float*)(X.lds + 69632);
    for (int i = X.tid; i < 3 * D; i += NTHR) { const int cls = i / D, k = i % D; const float v = cls < 2 ? c[cls * D + k] : c_ctx[k]; S[i] = v / (1.f + expf(-v)); }
    __syncthreads();
    for (int it = X.gw; it < 4 * 48 * 16; it += X.ngw) {
        const int sl = it & 15, cb = (it >> 4) % 48, l = it / (16 * 48);
        const float* W = ada_w + ((size_t)l * D + sl * 128) * NMOD + cb * 256 + X.lane * 4;
        f32x4 a0 = {0.f, 0.f, 0.f, 0.f}, a1 = a0, a2 = a0;
#pragma unroll 8
        for (int kk = 0; kk < 128; ++kk) { const f32x4 w = *(const f32x4*)(W + (size_t)kk * NMOD); const int k = sl * 128 + kk; a0 += w * S[k]; a1 += w * S[D + k]; a2 += w * S[2 * D + k]; }
        float* P = part + ((size_t)(sl * 4 + l) * 3) * NMOD + cb * 256 + X.lane * 4;
        *(f32x4*)(P) = a0; *(f32x4*)(P + NMOD) = a1; *(f32x4*)(P + 2 * NMOD) = a2;
    }
}
__device__ __forceinline__ void rope_table(const Ctx& X, float* cosT, float* sinT) {
    for (int i = blockIdx.x * NTHR + X.tid; i < 2048; i += gridDim.x * NTHR) {
        const int pos = i >> 4, p = i & 15;
        const double f = exp(-(double)p * (9.210340371976184 / 16.0)); const double ang = (double)pos * f;
        const double k = rint(ang * 0.15915494309189535); const double r = ang - k * 6.283185307179586;
        cosT[i] = (float)cos(r); sinT[i] = (float)sin(r);
    }
}
__device__ __forceinline__ const float* modv(const float* mod, int l, int cls, int chunk) { return mod + ((size_t)(l * 3 + cls) * 6 + chunk) * D; }
__device__ __forceinline__ void vec_setup(const Ctx& X, const float* mod, const float* norm_g, bool has_gate, int l_gate, int chunk_gate, int gi_post, bool has_next, int l_next, int gi_pre, int chunk_sh, int chunk_sc) {
    LAS float* G = (LAS float*)(X.lds); LAS float* A = (LAS float*)(X.lds + 24576); LAS float* S = (LAS float*)(X.lds + 49152);
    for (int i = X.tid; i < 3 * D; i += NTHR) { const int cls = i / D, k = i % D;
        if (has_gate) G[i] = modv(mod, l_gate, cls, chunk_gate)[k] * norm_g[(l_gate * 4 + gi_post) * D + k];
        if (has_next) { A[i] = norm_g[(l_next * 4 + gi_pre) * D + k] * (1.f + modv(mod, l_next, cls, chunk_sc)[k]); S[i] = modv(mod, l_next, cls, chunk_sh)[k]; } }
    __syncthreads();
}
__device__ __forceinline__ void first_norm(const Ctx& X, const float* x, const float* ctx, hfp* h, bf16* a) {
    const LAS f32x4* A = (const LAS f32x4*)(X.lds + 24576); const LAS f32x4* S = (const LAS f32x4*)(X.lds + 49152);
    for (int row = X.gw; row < M; row += X.ngw) {
        const int cls = row < MLAT ? (row >> 13) : 2;
        const f32x4* src = (const f32x4*)(row < MLAT ? x + (size_t)row * D : ctx + (size_t)(row - MLAT) * D) + X.lane;
        f32x4 v[8]; float ss = 0.f;
#pragma unroll
        for (int j = 0; j < 8; ++j) { v[j] = src[64 * j]; ss += (v[j].x * v[j].x + v[j].y * v[j].y) + (v[j].z * v[j].z + v[j].w * v[j].w); }
        const float rstd = 1.f / sqrtf(wave_sum(ss) * (1.f / D) + EPS);
        hfp4* hp = (hfp4*)(h + (size_t)row * D) + X.lane; unsigned long long* ap = (unsigned long long*)(a + (size_t)row * D) + X.lane;
#pragma unroll
        for (int j = 0; j < 8; ++j) { hp[64 * j] = __builtin_convertvector(v[j], hfp4); const f32x4 av = A[cls * 512 + 64 * j + X.lane], sv = S[cls * 512 + 64 * j + X.lane]; const f32x4 o = v[j] * rstd * av + sv;
            ap[64 * j] = (unsigned long long)pkbf(o.x, o.y) | ((unsigned long long)pkbf(o.z, o.w) << 32); }
    }
}
template <int MODE, bool SLAB> __device__ __forceinline__ void npost(const Ctx& X, const bf16* y, hfp* h, bf16* a, float* out, const float* slab, const int KS, const int row_lo, const int row_hi) {
    const LAS f32x4* G = (const LAS f32x4*)(X.lds); const LAS f32x4* A = (const LAS f32x4*)(X.lds + 24576); const LAS f32x4* S = (const LAS f32x4*)(X.lds + 49152);
    for (int row = row_lo + X.gw; row < row_hi; row += X.ngw) {
        const int cls = row < MLAT ? (row >> 13) : 2;
        hfp4* hp = (hfp4*)(h + (size_t)row * D) + X.lane;
        f32x4 hv[8], yv[8]; float ssy = 0.f;
        if (!SLAB) {
            const unsigned long long* yp = (const unsigned long long*)(y + (size_t)row * D) + X.lane;
#pragma unroll
            for (int j = 0; j < 8; ++j) { const unsigned long long w = yp[64 * j]; const unsigned lo = (unsigned)w, hi = (unsigned)(w >> 32); yv[j] = (f32x4){bf_lo(lo), bf_hi(lo), bf_lo(hi), bf_hi(hi)}; }
        } else {
            const f32x4* sp = (const f32x4*)(slab + (size_t)(row - MLAT) * D) + X.lane;
#pragma unroll
            for (int j = 0; j < 8; ++j) yv[j] = sp[64 * j];
#pragma unroll 1
            for (int k = 1; k < KS; ++k) { sp += (MCTX * D / 4);
#pragma unroll
                for (int j = 0; j < 8; ++j) yv[j] += sp[64 * j]; }
        }
#pragma unroll
        for (int j = 0; j < 8; ++j) { hv[j] = __builtin_convertvector(hp[64 * j], f32x4); ssy += (yv[j].x * yv[j].x + yv[j].y * yv[j].y) + (yv[j].z * yv[j].z + yv[j].w * yv[j].w); }
        const float rstd_y = 1.f / sqrtf(wave_sum(ssy) * (1.f / D) + EPS); float ssh = 0.f;
#pragma unroll
        for (int j = 0; j < 8; ++j) { const f32x4 g = G[cls * 512 + 64 * j + X.lane]; hv[j] = hv[j] + g * (yv[j] * rstd_y); ssh += (hv[j].x * hv[j].x + hv[j].y * hv[j].y) + (hv[j].z * hv[j].z + hv[j].w * hv[j].w); }
        if (MODE == 0) {
            const float rstd_h = 1.f / sqrtf(wave_sum(ssh) * (1.f / D) + EPS);
            unsigned long long* ap = (unsigned long long*)(a + (size_t)row * D) + X.lane;
#pragma unroll
            for (int j = 0; j < 8; ++j) { hp[64 * j] = __builtin_convertvector(hv[j], hfp4); const f32x4 av = A[cls * 512 + 64 * j + X.lane], sv = S[cls * 512 + 64 * j + X.lane]; const f32x4 o = hv[j] * rstd_h * av + sv;
                ap[64 * j] = (unsigned long long)pkbf(o.x, o.y) | ((unsigned long long)pkbf(o.z, o.w) << 32); }
        } else {
            f32x4* op = (f32x4*)(out + (size_t)row * D) + X.lane;
#pragma unroll
            for (int j = 0; j < 8; ++j) op[64 * j] = hv[j];
        }
    }
}
__device__ __forceinline__ void mla_rows(const Ctx& X, const bf16* Z, const float* g_q, const float* g_kv, const float* cosT, const float* sinT, bf16* CQN, bf16* CKVN, bf16* KPE) {
    for (int row = X.gw; row < M; row += X.ngw) {
        const bf16* z = Z + (size_t)row * 1280;
#pragma unroll
        for (int part = 0; part < 2; ++part) {
            const v4u w = *(const v4u*)(z + part * 512 + 8 * X.lane); float f[8]; unpack8(w, f); float ss = 0.f;
#pragma unroll
            for (int i = 0; i < 8; ++i) ss += f[i] * f[i];
            const float rstd = 1.f / sqrtf(wave_sum(ss) * (1.f / 512.f) + EPS); const float* g = (part ? g_kv : g_q) + 8 * X.lane;
            v4u o; o.x = pkbf(f[0] * rstd * g[0], f[1] * rstd * g[1]); o.y = pkbf(f[2] * rstd * g[2], f[3] * rstd * g[3]); o.z = pkbf(f[4] * rstd * g[4], f[5] * rstd * g[5]); o.w = pkbf(f[6] * rstd * g[6], f[7] * rstd * g[7]);
            *(v4u*)((part ? CKVN : CQN) + (size_t)row * 512 + 8 * X.lane) = o;
        }
        const float xv = bf1(z[1024 + X.lane]); float ov = xv;
        const float x1 = __shfl(xv, X.lane & ~16), x2 = __shfl(xv, X.lane | 16);
        if (row < MLAT) { const int s = row & 8191, pos = (X.lane >> 5) ? (s & 63) : (s >> 6), p = X.lane & 15; const float cs = cosT[pos * 16 + p], sn = sinT[pos * 16 + p];
            ov = (X.lane & 16) ? (x1 * sn + x2 * cs) : (x1 * cs - x2 * sn); }
        KPE[(size_t)row * 64 + X.lane] = (bf16)(pkbf(ov, 0.f) & 0xffffu);
    }
}
__device__ __forceinline__ void ml_rows(const Ctx& X, const bf16* Z, const float* conv_w, const float* b_gate, bf16* QK, float* G) {
    for (int row = X.gw; row < M; row += X.ngw) {
        bool hp, hn; if (row < MLAT) { const int s = row & 8191; hp = s > 0; hn = s < 8191; } else { const int n = (row - MLAT) & 255; hp = n > 0; hn = n < 255; }
        const bf16* z = Z + (size_t)row * 6400;
#pragma unroll
        for (int j = 0; j < 4; ++j) { const int col = 8 * X.lane + 512 * j;
            float x0[8], x1[8], x2[8]; const v4u zero = {0u, 0u, 0u, 0u};
            unpack8(hp ? *(const v4u*)(z - 6400 + col) : zero, x0); unpack8(*(const v4u*)(z + col), x1); unpack8(hn ? *(const v4u*)(z + 6400 + col) : zero, x2);
            float o[8];
#pragma unroll
            for (int i = 0; i < 8; ++i) { float v = conv_w[col + i] * x0[i] + conv_w[2048 + col + i] * x1[i] + conv_w[4096 + col + i] * x2[i]; v = v / (1.f + expf(-v)); o[i] = col < 1024 ? v * 0.08838834764831845f : v; }
            v4u w; w.x = pkbf(o[0], o[1]); w.y = pkbf(o[2], o[3]); w.z = pkbf(o[4], o[5]); w.w = pkbf(o[6], o[7]);
            *(v4u*)(QK + (size_t)row * 2048 + col) = w; }
        if (X.lane < 32) { float v = bf1(z[6144 + X.lane]) + b_gate[X.lane]; if ((X.lane >> 3) & 1) v = fminf(v, 0.f) - log1pf(expf(-fabsf(v))); G[(size_t)row * 32 + X.lane] = v; }
    }
}
__device__ __forceinline__ void ml_gate_rows(const Ctx& X, const bf16* Z, const bf16* HF, const bf16* HB, const float* g_head, bf16* O) {
    for (int row = X.gw; row < M; row += X.ngw) {
#pragma unroll
        for (int j = 0; j < 4; ++j) { const int col = 8 * X.lane + 512 * j;
            float a[8], b[8], g[8]; unpack8(*(const v4u*)(HF + (size_t)row * 2048 + col), a); unpack8(*(const v4u*)(HB + (size_t)row * 2048 + col), b); unpack8(*(const v4u*)(Z + (size_t)row * 6400 + 4096 + col), g);
            float ss = 0.f;
#pragma unroll
            for (int i = 0; i < 8; ++i) { a[i] += b[i]; ss += a[i] * a[i]; }
#pragma unroll
            for (int o = 1; o < 32; o <<= 1) ss += __shfl_xor(ss, o);
            const float rstd = 1.f / sqrtf(ss * (1.f / 256.f) + EPS); float o[8];
#pragma unroll
            for (int i = 0; i < 8; ++i) o[i] = a[i] * rstd * g_head[col + i] * sigmoidf_(g[i]);
            v4u w; w.x = pkbf(o[0], o[1]); w.y = pkbf(o[2], o[3]); w.z = pkbf(o[4], o[5]); w.w = pkbf(o[6], o[7]);
            *(v4u*)(O + (size_t)row * 2048 + col) = w; }
    }
}
#define ATT_UPDATE(sc, vptr) do { const float s_ = (sc); const float mn_ = fmaxf(m_run, s_); const float corr_ = __expf(m_run - mn_), p_ = __expf(s_ - mn_); l_run = l_run * corr_ + p_; m_run = mn_; \
    _Pragma("unroll") for (int c_ = 0; c_ < 4; ++c_) { float vf_[8]; unpack8(*(const v4u*)((vptr) + 8 * c_), vf_); _Pragma("unroll") for (int i_ = 0; i_ < 8; ++i_) o[8 * c_ + i_] = o[8 * c_ + i_] * corr_ + p_ * vf_[i_]; } } while (0)
__device__ __forceinline__ float dot32(const bf16* kp, const float* q) { float s = 0.f;
#pragma unroll
    for (int c = 0; c < 4; ++c) { float kf[8]; unpack8(*(const v4u*)(kp + 8 * c), kf);
#pragma unroll
        for (int i = 0; i < 8; ++i) s += q[8 * c + i] * kf[i]; }
    return s; }
__device__ __forceinline__ float quad_sum(float s) { s += __shfl_xor(s, 1); s += __shfl_xor(s, 2); return s; }
__device__ __forceinline__ void store_o32(bf16* op, const float* o, float inv) {
#pragma unroll
    for (int c = 0; c < 4; ++c) { v4u w; w.x = pkbf(o[8 * c] * inv, o[8 * c + 1] * inv); w.y = pkbf(o[8 * c + 2] * inv, o[8 * c + 3] * inv); w.z = pkbf(o[8 * c + 4] * inv, o[8 * c + 5] * inv); w.w = pkbf(o[8 * c + 6] * inv, o[8 * c + 7] * inv); *(v4u*)(op + 8 * c) = w; } }

__device__ __forceinline__ void na_attn_naive(const Ctx& X, const bf16* QKV, const float* rpb, bf16* O, int nrows) {
    const int hd = X.lane >> 2, j = X.lane & 3; const float scale = 0.08838834764831845f;
    for (int row = X.gw; row < nrows; row += X.ngw) {
        float q[32], o[32]; float m_run = -INFINITY, l_run = 0.f;
#pragma unroll
        for (int c = 0; c < 4; ++c) unpack8(*(const v4u*)(QKV + (size_t)row * 6144 + hd * 128 + 32 * j + 8 * c), q + 8 * c);
#pragma unroll
        for (int i = 0; i < 32; ++i) o[i] = 0.f;
        int b;
        if (row < MLAT) {
            b = row >> 13; const int s = row & 8191, r = s >> 6, c = s & 63;
            const int rs = min(max(r - 4, 0), 120), cs = min(max(c - 8, 0), 48);
            for (int jr = 0; jr < 8; ++jr) for (int jc = 0; jc < 16; ++jc) {
                const int kr = rs + jr, kc = cs + jc; const size_t key = (size_t)b * 8192 + kr * 64 + kc;
                const float bias = rpb[(hd * 15 + (kr - r + 7)) * 31 + (kc - c + 15)];
                const bf16* kp = QKV + key * 6144 + 2048 + hd * 128 + 32 * j;
                const float sc = quad_sum(dot32(kp, q)) * scale + bias;
                ATT_UPDATE(sc, kp + 2048);
            }
        } else b = (row - MLAT) >> 8;
        for (int n = 0; n < 256; ++n) {
            const size_t key = (size_t)MLAT + b * 256 + n; const bf16* kp = QKV + key * 6144 + 2048 + hd * 128 + 32 * j;
            const float sc = quad_sum(dot32(kp, q)) * scale;
            ATT_UPDATE(sc, kp + 2048);
        }
        store_o32(O + (size_t)row * 2048 + hd * 128 + 32 * j, o, 1.f / l_run);
    }
}
__device__ __forceinline__ void mla_attn_naive(const Ctx& X, const bf16* QH, const bf16* KV, const bf16* KPE, const float* cosT, const float* sinT, bf16* O) {
    const int hd = X.lane >> 2, j = X.lane & 3; const float scale = 0.07216878364870322f;
    for (int row = X.gw; row < M; row += X.ngw) {
        float q[32], qp[16], o[32]; float m_run = -INFINITY, l_run = 0.f;
        const bf16* qrow = QH + (size_t)row * 3072 + hd * 192;
#pragma unroll
        for (int c = 0; c < 4; ++c) unpack8(*(const v4u*)(qrow + 32 * j + 8 * c), q + 8 * c);
        {
            const int axis = j >> 1; float x1[16], x2[16];
            unpack8(*(const v4u*)(qrow + 128 + axis * 32), x1); unpack8(*(const v4u*)(qrow + 128 + axis * 32 + 8), x1 + 8);
            unpack8(*(const v4u*)(qrow + 128 + axis * 32 + 16), x2); unpack8(*(const v4u*)(qrow + 128 + axis * 32 + 24), x2 + 8);
            if (row < MLAT) { const int s = row & 8191, pos = axis ? (s & 63) : (s >> 6);
#pragma unroll
                for (int p = 0; p < 16; ++p) { const float cs = cosT[pos * 16 + p], sn = sinT[pos * 16 + p]; qp[p] = (j & 1) ? (x1[p] * sn + x2[p] * cs) : (x1[p] * cs - x2[p] * sn); }
            } else {
#pragma unroll
                for (int p = 0; p < 16; ++p) qp[p] = (j & 1) ? x2[p] : x1[p];
            }
        }
#pragma unroll
        for (int i = 0; i < 32; ++i) o[i] = 0.f;
        const int b = row < MLAT ? (row >> 13) : ((row - MLAT) >> 8);
        const int nkeys = row < MLAT ? (256 + 8192) : 256;
        for (int n = 0; n < nkeys; ++n) {
            const size_t key = n < 256 ? (size_t)MLAT + b * 256 + n : (size_t)b * 8192 + (n - 256);
            const bf16* kp = KV + key * 4096 + hd * 256 + 32 * j; const bf16* pp = KPE + key * 64 + 16 * j;
            float s = dot32(kp, q); float kf[16]; unpack8(*(const v4u*)(pp), kf); unpack8(*(const v4u*)(pp + 8), kf + 8);
#pragma unroll
            for (int p = 0; p < 16; ++p) s += qp[p] * kf[p];
            const float sc = quad_sum(s) * scale;
            ATT_UPDATE(sc, kp + 128);
        }
        store_o32(O + (size_t)row * 2048 + hd * 128 + 32 * j, o, 1.f / l_run);
    }
}
__device__ __forceinline__ void ml_scan_naive(const Ctx& X, const bf16* QK, const bf16* Z, const float* G, bf16* HF, bf16* HB) {
    LAS float* L = (LAS float*)X.lds;
    LAS float* q = L; LAS float* k = L + 8256; LAS float* v = L + 16512; LAS float* S = L + 18624; LAS float* C = L + 22784; LAS float* nv = L + 27008;
    LAS float* li = L + 27136; LAS float* lf = L + 27200; LAS float* bc = L + 27264; LAS float* mt = L + 27328; LAS float* ex = L + 27392; LAS float* misc = L + 27456;
    const int tid = X.tid, t = tid >> 3, part = tid & 7;
    for (int u = blockIdx.x; u < 256; u += gridDim.x) {
        const int slice = u & 7, dir = (u >> 3) & 1, hd = (u >> 4) & 7, b = u >> 7;
        for (int i = tid; i < 128 * 33; i += NTHR) C[i] = 0.f;
        if (tid < 128) nv[tid] = 0.f;
        float m_run = 0.f;
        bf16* H = dir ? HB : HF;
        __syncthreads();
        for (int n = 0; n < 132; ++n) {
            int base;
            if (dir == 0) base = n < 4 ? MLAT + b * 256 + 64 * n : b * 8192 + 64 * (n - 4);
            else base = n < 4 ? MLAT + b * 256 + 64 * (3 - n) : b * 8192 + 64 * (131 - n);
            const int row = base + (dir ? 63 - t : t);
            {
                float f[16];
                unpack8(*(const v4u*)(QK + (size_t)row * 2048 + hd * 128 + part * 16), f); unpack8(*(const v4u*)(QK + (size_t)row * 2048 + hd * 128 + part * 16 + 8), f + 8);
#pragma unroll
                for (int i = 0; i < 16; ++i) q[t * 129 + part * 16 + i] = f[i];
                unpack8(*(const v4u*)(QK + (size_t)row * 2048 + 1024 + hd * 128 + part * 16), f); unpack8(*(const v4u*)(QK + (size_t)row * 2048 + 1024 + hd * 128 + part * 16 + 8), f + 8);
#pragma unroll
                for (int i = 0; i < 16; ++i) k[t * 129 + part * 16 + i] = f[i];
                const unsigned long long w = *(const unsigned long long*)(Z + (size_t)row * 6400 + 2048 + hd * 256 + slice * 32 + part * 4); const unsigned lo = (unsigned)w, hi = (unsigned)(w >> 32);
                v[t * 33 + part * 4 + 0] = bf_lo(lo); v[t * 33 + part * 4 + 1] = bf_hi(lo); v[t * 33 + part * 4 + 2] = bf_lo(hi); v[t * 33 + part * 4 + 3] = bf_hi(hi);
                if (tid < 64) { const int row2 = base + (dir ? 63 - tid : tid); li[tid] = G[(size_t)row2 * 32 + dir * 16 + hd]; lf[tid] = G[(size_t)row2 * 32 + dir * 16 + 8 + hd]; }
            }
            __syncthreads();
            if (tid == 0) {
                float bsum = 0.f, pm = -INFINITY;
                for (int s = 0; s < 64; ++s) { bsum += lf[s]; bc[s] = bsum; pm = fmaxf(pm, li[s] - bsum); mt[s] = bsum + fmaxf(m_run, pm); }
                const float m_new = bsum + fmaxf(m_run, pm); misc[0] = m_new; misc[1] = expf(bsum + m_run - m_new);
                for (int s = 0; s < 64; ++s) ex[s] = expf(bsum - bc[s] + li[s] - m_new);
            }
            __syncthreads();
            {
                const float bt = bc[t], mtt = mt[t];
                for (int i = 0; i < 8; ++i) { const int s = part + 8 * i; float r = 0.f;
                    if (s <= t) { float dsum = 0.f; for (int d = 0; d < 128; ++d) dsum += q[t * 129 + d] * k[s * 129 + d]; r = dsum * expf(bt - bc[s] + li[s] - mtt); }
                    S[t * 65 + s] = r; }
            }
            __syncthreads();
            {
                const float mtt = mt[t], winter = expf(bc[t] + m_run - mtt);
                float den = 0.f; for (int d = 0; d < 128; ++d) den += q[t * 129 + d] * nv[d];
                den *= winter; for (int s = 0; s < 64; ++s) den += S[t * 65 + s];
                const float dn = fmaxf(fabsf(den), expf(-mtt)); float hv[4];
#pragma unroll
                for (int i = 0; i < 4; ++i) { const int e = part * 4 + i; float a = 0.f; for (int d = 0; d < 128; ++d) a += q[t * 129 + d] * C[d * 33 + e];
                    a *= winter; for (int s = 0; s < 64; ++s) a += S[t * 65 + s] * v[s * 33 + e]; hv[i] = a / dn; }
                *(unsigned long long*)(H + (size_t)row * 2048 + hd * 256 + slice * 32 + part * 4) = (unsigned long long)pkbf(hv[0], hv[1]) | ((unsigned long long)pkbf(hv[2], hv[3]) << 32);
            }
            __syncthreads();
            { const float e = ex[t];
#pragma unroll
              for (int i = 0; i < 16; ++i) k[t * 129 + part * 16 + i] *= e; }
            __syncthreads();
            {
                const int d = tid >> 2, eg = (tid & 3) * 8; const float decay = misc[1];
#pragma unroll
                for (int i = 0; i < 8; ++i) { const int e = eg + i; float a = 0.f; for (int s = 0; s < 64; ++s) a += k[s * 129 + d] * v[s * 33 + e]; C[d * 33 + e] = decay * C[d * 33 + e] + a; }
                if ((tid & 3) == 0) { float a = 0.f; for (int s = 0; s < 64; ++s) a += k[s * 129 + d]; nv[d] = decay * nv[d] + a; }
                m_run = misc[0];
            }
            __syncthreads();
        }
    }
}

namespace fa {
using f32x16 = __attribute__((ext_vector_type(16))) float;
using s16x4  = __attribute__((ext_vector_type(4))) short;
#define FA_KSWZ(row, colB) ((row) * 256 + ((colB) ^ (((row) & 7) << 4)))
#define FA_PSWZ(row, colB) ((row) * 128 + ((colB) ^ (((row) & 7) << 4)))
#define FA_SBAR() __builtin_amdgcn_sched_barrier(0)
__device__ __forceinline__ int crow(int r, int hi) { return (r & 3) + 8 * (r >> 2) + 4 * hi; }
__device__ __forceinline__ unsigned cvtpk(float lo, float hi) { return pg8::cvt_pk_bf16(lo, hi); }
constexpr float THR = 8.f;
__device__ __forceinline__ void partialSM(f32x16& p0, f32x16& p1, float& m_reg, float& mn, float& alpha, const float SCALE) {
  const float C = SCALE * 1.4426950408889634f;
  float pmax = p0[0];
#pragma unroll
  for (int r = 1; r < 16; ++r) pmax = fmaxf(pmax, p0[r]);
#pragma unroll
  for (int r = 0; r < 16; ++r) pmax = fmaxf(pmax, p1[r]);
  { auto rr = __builtin_amdgcn_permlane32_swap(__float_as_uint(pmax), __float_as_uint(pmax), false, false);
    pmax = fmaxf(__uint_as_float(rr[0]), __uint_as_float(rr[1])); }
  if (__builtin_expect(__all(pmax - m_reg <= THR / SCALE), 1)) { mn = m_reg; alpha = 1.f; }
  else { mn = fmaxf(m_reg, pmax); alpha = __builtin_amdgcn_exp2f((m_reg - mn) * C); m_reg = mn; }
  const float mnC = -mn * C;
#pragma unroll
  for (int r = 0; r < 16; ++r) p0[r] = fmaf(p0[r], C, mnC);
#pragma unroll
  for (int r = 0; r < 16; ++r) p1[r] = fmaf(p1[r], C, mnC);
#pragma unroll
  for (int r = 0; r < 16; ++r) p0[r] = __builtin_amdgcn_exp2f(p0[r]);
}
__device__ __forceinline__ void finishSM(f32x16& p0, f32x16& p1, float alpha, float& l_reg, bf16x8& pa0, bf16x8& pa1, bf16x8& pa2, bf16x8& pa3) {
#pragma unroll
  for (int r = 0; r < 16; ++r) p1[r] = __builtin_amdgcn_exp2f(p1[r]);
  float ps = 0;
#pragma unroll
  for (int r = 0; r < 16; ++r) ps += p0[r];
#pragma unroll
  for (int r = 0; r < 16; ++r) ps += p1[r];
  { auto rr = __builtin_amdgcn_permlane32_swap(__float_as_uint(ps), __float_as_uint(ps), false, false);
    ps = __uint_as_float(rr[0]) + __uint_as_float(rr[1]); }
  l_reg = l_reg * alpha + ps;
#define FA_PK4(P, BASE, OUT) do { unsigned a0 = cvtpk(P[BASE + 0], P[BASE + 1]), a1 = cvtpk(P[BASE + 2], P[BASE + 3]);   \
    unsigned b0 = cvtpk(P[BASE + 4], P[BASE + 5]), b1 = cvtpk(P[BASE + 6], P[BASE + 7]);                              \
    auto r0 = __builtin_amdgcn_permlane32_swap(a0, b0, false, false); auto r1 = __builtin_amdgcn_permlane32_swap(a1, b1, false, false); \
    v4u w = {r0[0], r1[0], r0[1], r1[1]}; OUT = __builtin_bit_cast(bf16x8, w); } while (0)
  FA_PK4(p0, 0, pa0); FA_PK4(p0, 8, pa1); FA_PK4(p1, 0, pa2); FA_PK4(p1, 8, pa3);
#undef FA_PK4
}
__device__ __forceinline__ int v_st(int k, int c) { const int kk = (k & ~0xC) | ((k & 4) << 1) | ((k & 8) >> 1); return ((kk >> 3) * 4 + (c >> 5)) * 512 + ((kk & 7) * 32 + (c & 31)) * 2; }
__device__ __forceinline__ int v_rd_base(int lane) { return ((lane & 3) << 3) | (((lane >> 2) & 3) << 6) | (((lane >> 4) & 1) << 5) | (((lane >> 5) & 1) << 8); }
constexpr int v_rd_off(int d0, int ks, int half) { return d0 * 512 + ks * 4096 + half * 2048; }
template <int OFF> __device__ __forceinline__ s16x4 tr_read(int vb) {
  s16x4 r; asm volatile("ds_read_b64_tr_b16 %0, %1 offset:%2" : "=&v"(r) : "v"(vb), "i"(OFF) : "memory"); return r;
}
template <int D0> __device__ __forceinline__ void pv_one(f32x16& od, int vb, bf16x8 pa0, bf16x8 pa1, bf16x8 pa2, bf16x8 pa3) {
  const s16x4 l0 = tr_read<v_rd_off(D0, 0, 0)>(vb), h0 = tr_read<v_rd_off(D0, 0, 1)>(vb), l1 = tr_read<v_rd_off(D0, 1, 0)>(vb), h1 = tr_read<v_rd_off(D0, 1, 1)>(vb);
  const s16x4 l2 = tr_read<v_rd_off(D0, 2, 0)>(vb), h2 = tr_read<v_rd_off(D0, 2, 1)>(vb), l3 = tr_read<v_rd_off(D0, 3, 0)>(vb), h3 = tr_read<v_rd_off(D0, 3, 1)>(vb);
  asm volatile("s_waitcnt lgkmcnt(0)" ::: "memory"); FA_SBAR();
#define FA_PK(L, H) (bf16x8){L[0], L[1], L[2], L[3], H[0], H[1], H[2], H[3]}
  od = __builtin_amdgcn_mfma_f32_32x32x16_bf16(pa0, FA_PK(l0, h0), od, 0, 0, 0);
  od = __builtin_amdgcn_mfma_f32_32x32x16_bf16(pa1, FA_PK(l1, h1), od, 0, 0, 0);
  od = __builtin_amdgcn_mfma_f32_32x32x16_bf16(pa2, FA_PK(l2, h2), od, 0, 0, 0);
  od = __builtin_amdgcn_mfma_f32_32x32x16_bf16(pa3, FA_PK(l3, h3), od, 0, 0, 0);
#undef FA_PK
}
__device__ __forceinline__ void pv_d0(f32x16* o, int vb, bf16x8 pa0, bf16x8 pa1, bf16x8 pa2, bf16x8 pa3) {
  pv_one<0>(o[0], vb, pa0, pa1, pa2, pa3); pv_one<1>(o[1], vb, pa0, pa1, pa2, pa3); pv_one<2>(o[2], vb, pa0, pa1, pa2, pa3); pv_one<3>(o[3], vb, pa0, pa1, pa2, pa3);
}
constexpr int SHM_V = 16384, SHM_K = 16384, SHM_P = 8192, OFF_V = 0, OFF_K = 49152, OFF_P = 98304, OFF_WS = 122880, OFF_QP = 124928;
#define FA_DMA(gp, lp) __builtin_amdgcn_global_load_lds((const unsigned*)(gp), (LAS unsigned*)(lp), 16, 0, 0)

__device__ __forceinline__ void mla_unit(LAS unsigned char* lds, const bf16* __restrict__ QH, const bf16* __restrict__ KV, const bf16* __restrict__ KPE, const float* __restrict__ cosT, const float* __restrict__ sinT,
                                         bf16* __restrict__ O, const int qrow0, const bool latq, const int b, const int h) {
  constexpr float SCALE = 0.07216878364870322f;
  int tid_ = threadIdx.x; asm volatile("" : "+v"(tid_));
  const int tid = tid_, wid = __builtin_amdgcn_readfirstlane(tid >> 6), lane = tid & 63, r32 = lane & 31, hi = lane >> 5;
  LAS char* V_lds = (LAS char*)lds + OFF_V; LAS char* K_lds = (LAS char*)lds + OFF_K; LAS char* P_lds = (LAS char*)lds + OFF_P;
  LAS float* ws = (LAS float*)(lds + OFF_WS) + wid * 64; LAS float* li_l = ws; LAS float* al_l = ws + 32;
  unsigned offK[2], offV[2], offP;
#pragma unroll
  for (int i = 0; i < 2; ++i) { const int Lb = (2 * wid + i) * 1024 + 16 * lane;
    { const int row = Lb >> 8, colB = (Lb & 255) ^ ((row & 7) << 4); offK[i] = (unsigned)(row * 4096 + (colB >> 1)) * 2u; }
    { const int sub = Lb >> 9, w_ = Lb & 511, kk = (sub >> 2) * 8 + (w_ >> 6), c = (sub & 3) * 32 + ((w_ & 63) >> 1), k = (kk & ~0xC) | ((kk & 4) << 1) | ((kk & 8) >> 1); offV[i] = (unsigned)(k * 4096 + 128 + c) * 2u; } }
  { const int Lb = wid * 1024 + 16 * lane, row = Lb >> 7, colB = (Lb & 127) ^ ((row & 7) << 4); offP = (unsigned)(row * 64 + (colB >> 1)) * 2u; }
  const int NT = latq ? 132 : 4;
  const int ctx0 = MLAT + b * 256, lat0 = b * 8192 - 256;
  const bf16* KVh = KV + h * 256;
#define DMA_STEP(tk, tv, sK, sV) do { const int tk_ = (tk) < NT ? (tk) : NT - 1, tv_ = (tv) < NT ? (tv) : NT - 1; const int kb_ = (tk_ < 4 ? ctx0 : lat0) + 64 * tk_, vb_ = (tv_ < 4 ? ctx0 : lat0) + 64 * tv_; \
    const char* gk_ = (const char*)(KVh + (size_t)kb_ * 4096); const char* gp_ = (const char*)(KPE + (size_t)kb_ * 64); const char* gv_ = (const char*)(KVh + (size_t)vb_ * 4096); \
    FA_DMA(gk_ + offK[0], K_lds + (sK) * SHM_K + (2 * wid) * 1024); FA_DMA(gk_ + offK[1], K_lds + (sK) * SHM_K + (2 * wid + 1) * 1024); FA_DMA(gp_ + offP, P_lds + (sK) * SHM_P + wid * 1024); \
    FA_DMA(gv_ + offV[0], V_lds + (sV) * SHM_V + (2 * wid) * 1024); FA_DMA(gv_ + offV[1], V_lds + (sV) * SHM_V + (2 * wid + 1) * 1024); } while (0)
  DMA_STEP(0, 0, 0, 0); DMA_STEP(1, 0, 1, 2);
  float m_reg = -1e30f, l_reg = 0; f32x16 o[4] = {}; bf16x8 qr[12];
  const int qrow = qrow0 + wid * 32 + r32;
  const bf16* Qw = QH + (size_t)qrow * 3072 + h * 192 + hi * 8;
#pragma unroll
  for (int d0 = 0; d0 < 12; ++d0) qr[d0] = *(const bf16x8*)(Qw + d0 * 16);
  if (latq) {
    const int s = qrow & 8191;
#pragma unroll
    for (int ax = 0; ax < 2; ++ax) { const int pos = ax ? (s & 63) : (s >> 6); const float* ct = cosT + pos * 16 + 8 * hi; const float* st = sinT + pos * 16 + 8 * hi;
      float x1[8], x2[8]; unpack8(__builtin_bit_cast(v4u, qr[8 + 2 * ax]), x1); unpack8(__builtin_bit_cast(v4u, qr[9 + 2 * ax]), x2); float y1[8], y2[8];
#pragma unroll
      for (int i = 0; i < 8; ++i) { const float cs = ct[i], sn = st[i]; y1[i] = x1[i] * cs - x2[i] * sn; y2[i] = x1[i] * sn + x2[i] * cs; }
      const v4u w1 = {cvtpk(y1[0], y1[1]), cvtpk(y1[2], y1[3]), cvtpk(y1[4], y1[5]), cvtpk(y1[6], y1[7])}, w2 = {cvtpk(y2[0], y2[1]), cvtpk(y2[2], y2[3]), cvtpk(y2[4], y2[5]), cvtpk(y2[6], y2[7])};
      qr[8 + 2 * ax] = __builtin_bit_cast(bf16x8, w1); qr[9 + 2 * ax] = __builtin_bit_cast(bf16x8, w2); }
  }
  const int zsw = ((r32 & 7) ^ hi) << 4;
  const LAS char* kA0 = K_lds + r32 * 256 + (0 ^ zsw); const LAS char* kA1 = K_lds + r32 * 256 + (32 ^ zsw); const LAS char* kA2 = K_lds + r32 * 256 + (64 ^ zsw); const LAS char* kA3 = K_lds + r32 * 256 + (96 ^ zsw);
  const LAS char* pA0_ = P_lds + r32 * 128 + (0 ^ zsw); const LAS char* pA1_ = P_lds + r32 * 128 + (32 ^ zsw); const LAS char* pA2_ = P_lds + r32 * 128 + (64 ^ zsw); const LAS char* pA3_ = P_lds + r32 * 128 + (96 ^ zsw);
  const int vb0 = (int)(unsigned)(uintptr_t)V_lds + v_rd_base(lane);
#define QK1(p0, p1, KA, OFF, QV) do { const bf16x8 b0 = *(const LAS bf16x8*)((KA) + (OFF)); const bf16x8 b1 = *(const LAS bf16x8*)((KA) + (OFF) + 8192); \
    p0 = __builtin_amdgcn_mfma_f32_32x32x16_bf16(b0, QV, p0, 0, 0, 0); p1 = __builtin_amdgcn_mfma_f32_32x32x16_bf16(b1, QV, p1, 0, 0, 0); } while (0)
#define QP1(p0, p1, PA, OFF, QV) do { const bf16x8 b0 = *(const LAS bf16x8*)((PA) + (OFF)); const bf16x8 b1 = *(const LAS bf16x8*)((PA) + (OFF) + 4096); \
    p0 = __builtin_amdgcn_mfma_f32_32x32x16_bf16(b0, QV, p0, 0, 0, 0); p1 = __builtin_amdgcn_mfma_f32_32x32x16_bf16(b1, QV, p1, 0, 0, 0); } while (0)
#define QKT(p0, p1, s) do { p0 = f32x16{}; p1 = f32x16{}; const int ko_ = (s) * SHM_K, po_ = (s) * SHM_P; \
    QK1(p0, p1, kA0, ko_, qr[0]); QK1(p0, p1, kA1, ko_, qr[1]); QK1(p0, p1, kA2, ko_, qr[2]); QK1(p0, p1, kA3, ko_, qr[3]); \
    QK1(p0, p1, kA0, ko_ + 128, qr[4]); QK1(p0, p1, kA1, ko_ + 128, qr[5]); QK1(p0, p1, kA2, ko_ + 128, qr[6]); QK1(p0, p1, kA3, ko_ + 128, qr[7]); \
    QP1(p0, p1, pA0_, po_, qr[8]); QP1(p0, p1, pA1_, po_, qr[9]); QP1(p0, p1, pA2_, po_, qr[10]); QP1(p0, p1, pA3_, po_, qr[11]); } while (0)
#define RESC(a) do { if (__any((a) < 1.f)) { if (hi == 0) al_l[r32] = (a); asm volatile("s_waitcnt lgkmcnt(0)" ::: "memory"); \
    _Pragma("unroll") for (int d = 0; d < 4; ++d) _Pragma("unroll") for (int r = 0; r < 16; ++r) o[d][r] *= al_l[crow(r, hi)]; } } while (0)
#define STEP_END() do { asm volatile("s_waitcnt vmcnt(5) lgkmcnt(0)" ::: "memory"); __builtin_amdgcn_s_barrier(); asm volatile("" ::: "memory"); } while (0)
  f32x16 pA0, pA1, pB0, pB1; float mnA, mnB, alA, alB; bf16x8 pa0, pa1, pa2, pa3;
  STEP_END();
  int s0 = 0, s1 = 1, s2 = 2;
  DMA_STEP(2, 1, s2, s1);
  QKT(pA0, pA1, s0); partialSM(pA0, pA1, m_reg, mnA, alA, SCALE);
  STEP_END();
  for (int j = 1; j + 1 < NT; j += 2) {
    { const int t_ = s0; s0 = s1; s1 = s2; s2 = t_; }
    DMA_STEP(j + 2, j + 1, s2, s1);
    FA_SBAR(); QKT(pB0, pB1, s0);
    finishSM(pA0, pA1, alA, l_reg, pa0, pa1, pa2, pa3); FA_SBAR();
    pv_d0(o, vb0 + s2 * SHM_V, pa0, pa1, pa2, pa3); partialSM(pB0, pB1, m_reg, mnB, alB, SCALE);
    RESC(alB); STEP_END();
    { const int t_ = s0; s0 = s1; s1 = s2; s2 = t_; }
    DMA_STEP(j + 3, j + 2, s2, s1);
    FA_SBAR(); QKT(pA0, pA1, s0);
    finishSM(pB0, pB1, alB, l_reg, pa0, pa1, pa2, pa3); FA_SBAR();
    pv_d0(o, vb0 + s2 * SHM_V, pa0, pa1, pa2, pa3); partialSM(pA0, pA1, m_reg, mnA, alA, SCALE);
    RESC(alA); STEP_END();
  }
  { const int t_ = s0; s0 = s1; s1 = s2; s2 = t_; }
  DMA_STEP(NT, NT, s2, s1);
  FA_SBAR(); QKT(pB0, pB1, s0);
  finishSM(pA0, pA1, alA, l_reg, pa0, pa1, pa2, pa3); FA_SBAR();
  pv_d0(o, vb0 + s2 * SHM_V, pa0, pa1, pa2, pa3); partialSM(pB0, pB1, m_reg, mnB, alB, SCALE);
  RESC(alB); asm volatile("s_waitcnt vmcnt(0) lgkmcnt(0)" ::: "memory"); __builtin_amdgcn_s_barrier(); asm volatile("" ::: "memory");
  finishSM(pB0, pB1, alB, l_reg, pa0, pa1, pa2, pa3); FA_SBAR();
  pv_d0(o, vb0 + s0 * SHM_V, pa0, pa1, pa2, pa3);
  if (hi == 0) li_l[r32] = l_reg; asm volatile("s_waitcnt lgkmcnt(0)" ::: "memory");
  bf16* Ow = O + (size_t)(qrow0 + wid * 32) * 2048 + h * 128 + r32;
#pragma unroll
  for (int r = 0; r < 16; ++r) { const int orow = crow(r, hi); const float rli = __builtin_amdgcn_rcpf(li_l[orow]);
#pragma unroll
    for (int d0 = 0; d0 < 4; ++d0) Ow[(size_t)orow * 2048 + d0 * 32] = (bf16)(cvtpk(o[d0][r] * rli, 0.f) & 0xffffu); }
  asm volatile("s_waitcnt vmcnt(0)" ::: "memory"); __syncthreads();
#undef DMA_STEP
#undef QKT
#undef NA_BODY
#undef QK1
#undef QP1
#undef RESC
#undef STEP_END
}
__device__ __forceinline__ void mla_attn_phase(LAS unsigned char* lds, const bf16* QH, const bf16* KV, const bf16* KPE, const float* cosT, const float* sinT, bf16* O) {
  const int G = gridDim.x, bx = blockIdx.x;
  const int nu = (G == 256) ? (bx < 32 ? 5 : 4) : (1056 - bx + G - 1) / G;
  for (int i = 0; i < nu; ++i) {
    int bh, q0; bool latq;
    if (G == 256) { if (i < 4) { bh = i * 8 + (bx & 7); q0 = (bh >> 4) * 8192 + (bx >> 3) * 256; latq = true; } else { bh = bx; q0 = MLAT + (bh >> 4) * 256; latq = false; } }
    else { const int u = bx + i * G; if (u < 1024) { bh = u >> 5; q0 = (bh >> 4) * 8192 + (u & 31) * 256; latq = true; } else { bh = u - 1024; q0 = MLAT + (bh >> 4) * 256; latq = false; } }
    mla_unit(lds, QH, KV, KPE, cosT, sinT, O, q0, latq, bh >> 4, bh & 15);
  }
}

template <int MODE> __device__ __forceinline__ void partialSM_t(f32x16& p0, f32x16& p1, float& m_reg, float& mn, float& alpha, const float SCALE) {
  const float C = SCALE * 1.4426950408889634f;
  constexpr int A0 = (MODE == 2) ? 12 : 0, B1 = (MODE == 1) ? 4 : 16;
  float pmax = p0[A0];
#pragma unroll
  for (int r = A0 + 1; r < 16; ++r) pmax = fmaxf(pmax, p0[r]);
#pragma unroll
  for (int r = 0; r < B1; ++r) pmax = fmaxf(pmax, p1[r]);
  { auto rr = __builtin_amdgcn_permlane32_swap(__float_as_uint(pmax), __float_as_uint(pmax), false, false);
    pmax = fmaxf(__uint_as_float(rr[0]), __uint_as_float(rr[1])); }
  if (__builtin_expect(__all(pmax - m_reg <= THR / SCALE), 1)) { mn = m_reg; alpha = 1.f; }
  else { mn = fmaxf(m_reg, pmax); alpha = __builtin_amdgcn_exp2f((m_reg - mn) * C); m_reg = mn; }
  const float mnC = -mn * C;
#pragma unroll
  for (int r = A0; r < 16; ++r) p0[r] = fmaf(p0[r], C, mnC);
#pragma unroll
  for (int r = 0; r < B1; ++r) p1[r] = fmaf(p1[r], C, mnC);
#pragma unroll
  for (int r = A0; r < 16; ++r) p0[r] = __builtin_amdgcn_exp2f(p0[r]);
}
template <int MODE> __device__ __forceinline__ void finishSM_t(f32x16& p0, f32x16& p1, float alpha, float& l_reg, bf16x8& pa0, bf16x8& pa1, bf16x8& pa2, bf16x8& pa3) {
  constexpr int A0 = (MODE == 2) ? 12 : 0, B1 = (MODE == 1) ? 4 : 16;
#pragma unroll
  for (int r = 0; r < B1; ++r) p1[r] = __builtin_amdgcn_exp2f(p1[r]);
  float ps = 0;
#pragma unroll
  for (int r = A0; r < 16; ++r) ps += p0[r];
#pragma unroll
  for (int r = 0; r < B1; ++r) ps += p1[r];
  { auto rr = __builtin_amdgcn_permlane32_swap(__float_as_uint(ps), __float_as_uint(ps), false, false);
    ps = __uint_as_float(rr[0]) + __uint_as_float(rr[1]); }
  l_reg = l_reg * alpha + ps;
  if (MODE == 2) {
#pragma unroll
    for (int r = 8; r < 12; ++r) p0[r] = 0.f; }
  if (MODE == 1) {
#pragma unroll
    for (int r = 4; r < 8; ++r) p1[r] = 0.f; }
#define FA_PK4(P, BASE, OUT) do { unsigned a0 = cvtpk(P[BASE + 0], P[BASE + 1]), a1 = cvtpk(P[BASE + 2], P[BASE + 3]);   \
    unsigned b0 = cvtpk(P[BASE + 4], P[BASE + 5]), b1 = cvtpk(P[BASE + 6], P[BASE + 7]);                              \
    auto r0 = __builtin_amdgcn_permlane32_swap(a0, b0, false, false); auto r1 = __builtin_amdgcn_permlane32_swap(a1, b1, false, false); \
    v4u w = {r0[0], r1[0], r0[1], r1[1]}; OUT = __builtin_bit_cast(bf16x8, w); } while (0)
  if (MODE != 2) FA_PK4(p0, 0, pa0);
  FA_PK4(p0, 8, pa1); FA_PK4(p1, 0, pa2);
  if (MODE != 1) FA_PK4(p1, 8, pa3);
#undef FA_PK4
}
template <int D0, int MODE> __device__ __forceinline__ void pv_one_t(f32x16& od, int vb, bf16x8 pa0, bf16x8 pa1, bf16x8 pa2, bf16x8 pa3) {
#define FA_PK(L, H) (bf16x8){L[0], L[1], L[2], L[3], H[0], H[1], H[2], H[3]}
  if (MODE == 1) {
    const s16x4 l0 = tr_read<v_rd_off(D0, 0, 0)>(vb), h0 = tr_read<v_rd_off(D0, 0, 1)>(vb), l1 = tr_read<v_rd_off(D0, 1, 0)>(vb), h1 = tr_read<v_rd_off(D0, 1, 1)>(vb), l2 = tr_read<v_rd_off(D0, 2, 0)>(vb), h2 = tr_read<v_rd_off(D0, 2, 1)>(vb);
    asm volatile("s_waitcnt lgkmcnt(0)" ::: "memory"); FA_SBAR();
    od = __builtin_amdgcn_mfma_f32_32x32x16_bf16(pa0, FA_PK(l0, h0), od, 0, 0, 0); od = __builtin_amdgcn_mfma_f32_32x32x16_bf16(pa1, FA_PK(l1, h1), od, 0, 0, 0); od = __builtin_amdgcn_mfma_f32_32x32x16_bf16(pa2, FA_PK(l2, h2), od, 0, 0, 0);
  } else if (MODE == 2) {
    const s16x4 l1 = tr_read<v_rd_off(D0, 1, 0)>(vb), h1 = tr_read<v_rd_off(D0, 1, 1)>(vb), l2 = tr_read<v_rd_off(D0, 2, 0)>(vb), h2 = tr_read<v_rd_off(D0, 2, 1)>(vb), l3 = tr_read<v_rd_off(D0, 3, 0)>(vb), h3 = tr_read<v_rd_off(D0, 3, 1)>(vb);
    asm volatile("s_waitcnt lgkmcnt(0)" ::: "memory"); FA_SBAR();
    od = __builtin_amdgcn_mfma_f32_32x32x16_bf16(pa1, FA_PK(l1, h1), od, 0, 0, 0); od = __builtin_amdgcn_mfma_f32_32x32x16_bf16(pa2, FA_PK(l2, h2), od, 0, 0, 0); od = __builtin_amdgcn_mfma_f32_32x32x16_bf16(pa3, FA_PK(l3, h3), od, 0, 0, 0);
  } else pv_one<D0>(od, vb, pa0, pa1, pa2, pa3);
#undef FA_PK
}
template <int MODE> __device__ __forceinline__ void pv_d0_t(f32x16* o, int vb, bf16x8 pa0, bf16x8 pa1, bf16x8 pa2, bf16x8 pa3) {
  pv_one_t<0, MODE>(o[0], vb, pa0, pa1, pa2, pa3); pv_one_t<1, MODE>(o[1], vb, pa0, pa1, pa2, pa3); pv_one_t<2, MODE>(o[2], vb, pa0, pa1, pa2, pa3); pv_one_t<3, MODE>(o[3], vb, pa0, pa1, pa2, pa3);
}
__device__ __forceinline__ void na_unit(LAS unsigned char* lds, const bf16* __restrict__ QKV, const float* __restrict__ rpb_h, bf16* __restrict__ O, const int qrow0, const bool ctxq, const int b, const int h, const int r0) {
  constexpr float SCALE = 0.08838834764831845f, ISCALE = 11.313708498984761f;
  const int tid = threadIdx.x, wid = __builtin_amdgcn_readfirstlane(tid >> 6), lane = tid & 63, r32 = lane & 31, hi = lane >> 5;
  LAS char* V_lds = (LAS char*)lds + OFF_V; LAS char* K_lds = (LAS char*)lds + OFF_K;
  LAS float* ws = (LAS float*)(lds + OFF_WS) + wid * 64; LAS float* li_l = ws; LAS float* al_l = ws + 32;
  LAS float* rpbL = (LAS float*)(lds + OFF_QP + 1024);
  unsigned offK[2], offV[2];
#pragma unroll
  for (int i = 0; i < 2; ++i) { const int Lb = (2 * wid + i) * 1024 + 16 * lane;
    { const int row = Lb >> 8, colB = (Lb & 255) ^ ((row & 7) << 4); offK[i] = (unsigned)(row * 6144 + (colB >> 1)) * 2u; }
    { const int sub = Lb >> 9, w_ = Lb & 511, kk = (sub >> 2) * 8 + (w_ >> 6), c = (sub & 3) * 32 + ((w_ & 63) >> 1), k = (kk & ~0xC) | ((kk & 4) << 1) | ((kk & 8) >> 1); offV[i] = (unsigned)(k * 6144 + c) * 2u; } }
  const int R0 = min(max(r0 - 4, 0), 120), R1 = min(max(r0 + 3 - 4, 0), 120) + 7;
  const int nW = ctxq ? 0 : (R1 - R0 + 1), NT = nW + 4;
  const int wbase = b * 8192 + R0 * 64, cbase = MLAT + b * 256;
  const bf16* Kh = QKV + 2048 + h * 128; const bf16* Vh = QKV + 4096 + h * 128;
#define NA_KB(t) (((t) < nW) ? wbase + 64 * (t) : cbase + 64 * ((t) - nW))
#define DMA_K(t, bf) do { const int tt_ = (t) < NT ? (t) : NT - 1; const char* gk_ = (const char*)(Kh + (size_t)NA_KB(tt_) * 6144); FA_DMA(gk_ + offK[0], K_lds + (bf) * SHM_K + (2 * wid) * 1024); FA_DMA(gk_ + offK[1], K_lds + (bf) * SHM_K + (2 * wid + 1) * 1024); } while (0)
#define DMA_V(t, bf) do { const int tt_ = (t) < NT ? (t) : NT - 1; const char* gv_ = (const char*)(Vh + (size_t)NA_KB(tt_) * 6144); FA_DMA(gv_ + offV[0], V_lds + (bf) * SHM_V + (2 * wid) * 1024); FA_DMA(gv_ + offV[1], V_lds + (bf) * SHM_V + (2 * wid + 1) * 1024); } while (0)
  DMA_K(0, 0); DMA_V(0, 0); DMA_K(1, 1); DMA_V(1, 1);
  if (!ctxq) for (int i = tid; i < 15 * 31; i += NTHR) rpbL[i] = rpb_h[i] * ISCALE;
  float m_reg = -1e30f, l_reg = 0; f32x16 o[4] = {}; bf16x8 qr[8];
  const int qrow = qrow0 + wid * 32 + r32;
  const bf16* Qw = QKV + (size_t)qrow * 6144 + h * 128 + hi * 8;
#pragma unroll
  for (int d0 = 0; d0 < 8; ++d0) qr[d0] = *(const bf16x8*)(Qw + d0 * 16);
  const int vb0 = (int)(unsigned)(uintptr_t)V_lds + v_rd_base(lane);
  const int zsw = ((r32 & 7) ^ hi) << 4;
  const LAS char* kA0 = K_lds + r32 * 256 + (0 ^ zsw); const LAS char* kA1 = K_lds + r32 * 256 + (32 ^ zsw); const LAS char* kA2 = K_lds + r32 * 256 + (64 ^ zsw); const LAS char* kA3 = K_lds + r32 * 256 + (96 ^ zsw);
  const int rq = r0 + (wid >> 1), wa = ctxq ? 0 : (min(max(rq - 4, 0), 120) - R0), we = ctxq ? 0 : wa + 8;
  const int cq = 32 * (wid & 1) + r32, cs = min(max(cq - 8, 0), 48);
  const bool wodd = (wid & 1) != 0;
#define ACT(t) ((t) < NT && ((t) >= nW || ((t) >= wa && (t) < we)))
#define QK1(p0, p1, KA, OFF, QV) do { const bf16x8 b0 = *(const LAS bf16x8*)((KA) + (OFF)); const bf16x8 b1 = *(const LAS bf16x8*)((KA) + (OFF) + 8192); \
    p0 = __builtin_amdgcn_mfma_f32_32x32x16_bf16(b0, QV, p0, 0, 0, 0); p1 = __builtin_amdgcn_mfma_f32_32x32x16_bf16(b1, QV, p1, 0, 0, 0); } while (0)
#define QKT(p0, p1, t, bf, MODE_) do { if ((MODE_) != 0) { const int dr_ = R0 + (t) - rq + 7; const LAS float* bp_ = rpbL + dr_ * 31 + (15 - cq) + 4 * hi; \
      _Pragma("unroll") for (int i_ = ((MODE_) == 2 ? 12 : 0); i_ < 16; ++i_) { const int kc_ = crow(i_, hi); const float v0_ = bp_[8 * (i_ >> 2) + (i_ & 3)]; p0[i_] = (kc_ >= cs && kc_ < cs + 16) ? v0_ : -INFINITY; } \
      _Pragma("unroll") for (int i_ = 0; i_ < ((MODE_) == 1 ? 4 : 16); ++i_) { const int kc_ = crow(i_, hi); const float v1_ = bp_[32 + 8 * (i_ >> 2) + (i_ & 3)]; p1[i_] = (kc_ + 32 >= cs && kc_ + 32 < cs + 16) ? v1_ : -INFINITY; } \
      } else { p0 = f32x16{}; p1 = f32x16{}; } \
    QK1(p0, p1, kA0, (bf) * SHM_K, qr[0]); QK1(p0, p1, kA1, (bf) * SHM_K, qr[1]); QK1(p0, p1, kA2, (bf) * SHM_K, qr[2]); QK1(p0, p1, kA3, (bf) * SHM_K, qr[3]); \
    QK1(p0, p1, kA0, (bf) * SHM_K + 128, qr[4]); QK1(p0, p1, kA1, (bf) * SHM_K + 128, qr[5]); QK1(p0, p1, kA2, (bf) * SHM_K + 128, qr[6]); QK1(p0, p1, kA3, (bf) * SHM_K + 128, qr[7]); } while (0)
#define RESC(a) do { if (__any((a) < 1.f)) { if (hi == 0) al_l[r32] = (a); asm volatile("s_waitcnt lgkmcnt(0)" ::: "memory"); \
    _Pragma("unroll") for (int d = 0; d < 4; ++d) _Pragma("unroll") for (int r = 0; r < 16; ++r) o[d][r] *= al_l[crow(r, hi)]; } } while (0)
#define STEP_END() do { FA_SBAR(); asm volatile("s_waitcnt vmcnt(4) lgkmcnt(0)" ::: "memory"); __builtin_amdgcn_s_barrier(); asm volatile("" ::: "memory"); } while (0)
  f32x16 pA0 = {}, pA1 = {}; float mnA, alA = 1.f; bf16x8 pa0 = {}, pa1 = {}, pa2 = {}, pa3 = {};
  STEP_END();
  int s0 = 0, s1 = 1, s2 = 2;
#define NA_BODY(MODE_) do { QKT(pA0, pA1, t, s0, MODE_); partialSM_t<MODE_>(pA0, pA1, m_reg, mnA, alA, SCALE); RESC(alA); \
      finishSM_t<MODE_>(pA0, pA1, alA, l_reg, pa0, pa1, pa2, pa3); FA_SBAR(); pv_d0_t<MODE_>(o, vb0 + s0 * SHM_V, pa0, pa1, pa2, pa3); } while (0)
#define NA_STEP(MODE_, COND_) do { DMA_K(t + 2, s2); DMA_V(t + 2, s2); FA_SBAR(); if (COND_) NA_BODY(MODE_); STEP_END(); { const int t_ = s0; s0 = s1; s1 = s2; s2 = t_; } } while (0)
  int t = 0;
  if (wodd) { for (; t < nW; ++t) NA_STEP(2, t >= wa && t < we); }
  else      { for (; t < nW; ++t) NA_STEP(1, t >= wa && t < we); }
  for (; t < NT; ++t) NA_STEP(0, true);
#undef NA_STEP
  asm volatile("s_waitcnt vmcnt(0)" ::: "memory");
  if (hi == 0) li_l[r32] = l_reg; asm volatile("s_waitcnt lgkmcnt(0)" ::: "memory");
  bf16* Ow = O + (size_t)(qrow0 + wid * 32) * 2048 + h * 128 + r32;
#pragma unroll
  for (int r = 0; r < 16; ++r) { const int orow = crow(r, hi); const float rli = __builtin_amdgcn_rcpf(li_l[orow]);
#pragma unroll
    for (int d0 = 0; d0 < 4; ++d0) Ow[(size_t)orow * 2048 + d0 * 32] = (bf16)(cvtpk(o[d0][r] * rli, 0.f) & 0xffffu); }
  __syncthreads();
#undef NA_KB
#undef DMA_K
#undef DMA_V
#undef ACT
#undef QK1
#undef QKT
#undef NA_BODY
#undef RESC
#undef STEP_END
}
__device__ __forceinline__ void na_attn_phase(LAS unsigned char* lds, const bf16* QKV, const float* rpb, bf16* O, const bool need_ctx) {
  const int G = gridDim.x, bx = blockIdx.x; const int ntot = need_ctx ? 1056 : 1024;
  const int nu = (G == 256) ? ((need_ctx && bx < 32) ? 5 : 4) : (ntot - bx + G - 1) / G;
  for (int i = 0; i < nu; ++i) {
    int bh, q0, r0; bool ctxq;
    if (G == 256) { if (i < 4) { bh = i * 8 + (bx & 7); r0 = (bx >> 3) * 4; q0 = (bh >> 4) * 8192 + r0 * 64; ctxq = false; } else { bh = bx; r0 = 0; q0 = MLAT + (bh >> 4) * 256; ctxq = true; } }
    else { const int u = bx + i * G; if (u < 1024) { bh = u >> 5; r0 = (u & 31) * 4; q0 = (bh >> 4) * 8192 + r0 * 64; ctxq = false; } else { bh = u - 1024; r0 = 0; q0 = MLAT + (bh >> 4) * 256; ctxq = true; } }
    na_unit(lds, QKV, rpb + (size_t)(bh & 15) * 15 * 31, O, q0, ctxq, bh >> 4, bh & 15, r0);
  }
}
}

namespace m16 {
using fa::f32x16; using fa::cvtpk;
typedef float f32x4q __attribute__((ext_vector_type(4)));
typedef short v4i16q __attribute__((ext_vector_type(4)));
constexpr int VROW = 256, SHM_V = 64 * VROW, SHM_K = 16384, SHM_P = 8192, OFF_V = 0, OFF_K = 3 * SHM_V, OFF_P = OFF_K + 3 * SHM_K, OFF_WS = OFF_P + 3 * SHM_P;
static_assert(OFF_WS + 8 * 256 <= 131072, "MLA LDS map");
#define M16_DMA(gp, lp) __builtin_amdgcn_global_load_lds((const unsigned*)(gp), (LAS unsigned*)(lp), 16, 0, 0)
__device__ __forceinline__ float xor16(float v) { return __int_as_float(__builtin_amdgcn_ds_swizzle(__float_as_int(v), 0x401F)); }
__device__ __forceinline__ float xor32_max(float v) { auto rr = __builtin_amdgcn_permlane32_swap(__float_as_uint(v), __float_as_uint(v), false, false); return fmaxf(__uint_as_float(rr[0]), __uint_as_float(rr[1])); }
__device__ __forceinline__ float xor32_sum(float v) { auto rr = __builtin_amdgcn_permlane32_swap(__float_as_uint(v), __float_as_uint(v), false, false); return __uint_as_float(rr[0]) + __uint_as_float(rr[1]); }

__device__ __forceinline__ void mla_unit16(LAS unsigned char* lds, const bf16* __restrict__ QH, const bf16* __restrict__ KV, const bf16* __restrict__ KPE, const float* __restrict__ cosT, const float* __restrict__ sinT,
                                           bf16* __restrict__ O, const int qrow0, const bool latq, const int b, const int h) {
  constexpr float SCALE = 0.07216878364870322f, C = SCALE * 1.4426950408889634f, THR2 = 8.f * 1.4426950408889634f;
  int tid_ = threadIdx.x; asm volatile("" : "+v"(tid_));
  const int tid = tid_, wid = __builtin_amdgcn_readfirstlane(tid >> 6), lane = tid & 63, l15 = lane & 15, kg = lane >> 4;
  LAS char* V_lds = (LAS char*)lds + OFF_V; LAS char* K_lds = (LAS char*)lds + OFF_K; LAS char* P_lds = (LAS char*)lds + OFF_P;
  LAS float* ws = (LAS float*)(lds + OFF_WS) + wid * 64;
  unsigned offK[2], offV[2], offP;
#pragma unroll
  for (int i = 0; i < 2; ++i) { const int Lb = (2 * wid + i) * 1024 + 16 * lane, row = Lb >> 8, colB = (Lb & 255) ^ ((row & 15) << 4); offK[i] = (unsigned)(row * 4096 + (colB >> 1)) * 2u; }
  { const int Lb = wid * 1024 + 16 * lane, row = Lb >> 7, colB = (Lb & 127) ^ ((row & 7) << 4); offP = (unsigned)(row * 64 + (colB >> 1)) * 2u; }
#pragma unroll
  for (int i = 0; i < 2; ++i) { const int Lb = (2 * wid + i) * 1024 + 16 * lane, row = Lb >> 8, colB = (Lb & 255) ^ ((row & 7) << 5); offV[i] = (unsigned)(row * 4096 + 128 + (colB >> 1)) * 2u; }
  const int NT = latq ? 132 : 4;
  const int ctx0 = MLAT + b * 256, lat0 = b * 8192 - 256;
  const bf16* KVh = KV + h * 256;
  const __amdgpu_buffer_rsrc_t rsKV = __builtin_amdgcn_make_buffer_rsrc((void*)KVh, (short)0, 0x7fffffff, 0x00020000), rsPE = __builtin_amdgcn_make_buffer_rsrc((void*)KPE, (short)0, 0x7fffffff, 0x00020000);
#define M16_BDMA(rs, voff, soff, lp) __builtin_amdgcn_raw_ptr_buffer_load_lds(rs, (LAS void*)(lp), 16, (int)(voff), (int)(soff), 0, 0)
#define DMA_K(tk, sK) do { const int tk_ = (tk) < NT ? (tk) : NT - 1; const int kb_ = (tk_ < 4 ? ctx0 : lat0) + 64 * tk_; \
    M16_BDMA(rsKV, offK[0], kb_ * 8192, K_lds + (sK) * SHM_K + (2 * wid) * 1024); M16_BDMA(rsKV, offK[1], kb_ * 8192, K_lds + (sK) * SHM_K + (2 * wid + 1) * 1024); M16_BDMA(rsPE, offP, kb_ * 128, P_lds + (sK) * SHM_P + wid * 1024); } while (0)
#define DMA_V(tv, sV) do { const int tv_ = (tv) < NT ? (tv) : NT - 1; const int vb_ = (tv_ < 4 ? ctx0 : lat0) + 64 * tv_; \
    M16_BDMA(rsKV, offV[0], vb_ * 8192, V_lds + (sV) * SHM_V + (2 * wid) * 1024); M16_BDMA(rsKV, offV[1], vb_ * 8192, V_lds + (sV) * SHM_V + (2 * wid + 1) * 1024); } while (0)
  DMA_K(0, 0); DMA_K(1, 1); DMA_V(0, 0);
  bf16x8 qf[2][6];
#pragma unroll
  for (int qb = 0; qb < 2; ++qb) { const int qrow = qrow0 + wid * 32 + 16 * qb + l15; const bf16* Qw = QH + (size_t)qrow * 3072 + h * 192 + 8 * kg;
#pragma unroll
    for (int s = 0; s < 4; ++s) { float f[8]; unpack8(*(const v4u*)(Qw + 32 * s), f);
      const v4u w = {cvtpk(f[0] * C, f[1] * C), cvtpk(f[2] * C, f[3] * C), cvtpk(f[4] * C, f[5] * C), cvtpk(f[6] * C, f[7] * C)}; qf[qb][s] = __builtin_bit_cast(bf16x8, w); }
    const int sp = qrow & 8191;
#pragma unroll
    for (int ax = 0; ax < 2; ++ax) { const v4u own = *(const v4u*)(Qw + 128 + 32 * ax), oth = *(const v4u*)(Qw + 128 + 32 * ax + (kg < 2 ? 16 : -16));
      v4u res;
      if (!latq) { float f[8]; unpack8(own, f); res = (v4u){cvtpk(f[0] * C, f[1] * C), cvtpk(f[2] * C, f[3] * C), cvtpk(f[4] * C, f[5] * C), cvtpk(f[6] * C, f[7] * C)}; }
      else { const int pos = ax ? (sp & 63) : (sp >> 6); const float* ct = cosT + pos * 16 + 8 * (kg & 1); const float* st = sinT + pos * 16 + 8 * (kg & 1);
        float x1[8], x2[8], yv[8]; if (kg < 2) { unpack8(own, x1); unpack8(oth, x2); } else { unpack8(oth, x1); unpack8(own, x2); }
#pragma unroll
        for (int i = 0; i < 8; ++i) yv[i] = kg < 2 ? x1[i] * ct[i] - x2[i] * st[i] : x1[i] * st[i] + x2[i] * ct[i];
        res = (v4u){cvtpk(yv[0] * C, yv[1] * C), cvtpk(yv[2] * C, yv[3] * C), cvtpk(yv[4] * C, yv[5] * C), cvtpk(yv[6] * C, yv[7] * C)}; }
      qf[qb][4 + ax] = __builtin_bit_cast(bf16x8, res); } }
  const int zsw = (l15 & 7) << 4;
  const LAS char* kS0 = K_lds + l15 * 256 + ((16 * kg) ^ (l15 << 4)); const LAS char* kS1 = K_lds + l15 * 256 + ((64 + 16 * kg) ^ (l15 << 4));
  const LAS char* kS2 = K_lds + l15 * 256 + ((128 + 16 * kg) ^ (l15 << 4)); const LAS char* kS3 = K_lds + l15 * 256 + ((192 + 16 * kg) ^ (l15 << 4));
  const LAS char* pE = P_lds + l15 * 128 + ((16 * kg) ^ zsw); const LAS char* pO = P_lds + l15 * 128 + (((16 * kg) ^ zsw) ^ 64);
  unsigned vBc[8];
#pragma unroll
  for (int c = 0; c < 8; ++c) vBc[c] = (unsigned)(uintptr_t)V_lds + (unsigned)((4 * kg + (l15 >> 2)) * VROW + 8 * (l15 & 3) + 32 * (c ^ ((4 * (kg & 1) + (l15 >> 2)) & 7)));
  float m0 = 0.f, m1 = 0.f, lr0 = 0.f, lr1 = 0.f; f32x4q o[2][8];
  f32x4q nm0 = {0.f, 0.f, 0.f, 0.f}, nm1 = {0.f, 0.f, 0.f, 0.f};
#pragma unroll
  for (int qb = 0; qb < 2; ++qb)
#pragma unroll
    for (int c = 0; c < 8; ++c) o[qb][c] = (f32x4q){0.f, 0.f, 0.f, 0.f};
  struct Tile { f32x4q s[4][2]; };
#define M16_RD2(d0_, d1_, A_, O0_, O1_) do { asm volatile("ds_read_b128 %0, %1 offset:%2" : "=v"(d0_) : "v"(A_), "i"(O0_)); asm volatile("ds_read_b128 %0, %1 offset:%2" : "=v"(d1_) : "v"(A_), "i"(O1_)); } while (0)
#define M16_W2(x_, y_) asm volatile("s_waitcnt lgkmcnt(2)" : "+v"(x_), "+v"(y_))
#define M16_W0(x_, y_) asm volatile("s_waitcnt lgkmcnt(0)" : "+v"(x_), "+v"(y_))
#define M16_MM(T_, KB_, x_, y_, S_) do { T_.s[KB_][0] = __builtin_amdgcn_mfma_f32_16x16x32_bf16(x_, qf[0][S_], T_.s[KB_][0], 0, 0, 0); T_.s[KB_][1] = __builtin_amdgcn_mfma_f32_16x16x32_bf16(x_, qf[1][S_], T_.s[KB_][1], 0, 0, 0); \
    T_.s[KB_ + 1][0] = __builtin_amdgcn_mfma_f32_16x16x32_bf16(y_, qf[0][S_], T_.s[KB_ + 1][0], 0, 0, 0); T_.s[KB_ + 1][1] = __builtin_amdgcn_mfma_f32_16x16x32_bf16(y_, qf[1][S_], T_.s[KB_ + 1][1], 0, 0, 0); } while (0)
#define QK16(T_, sl) do { const unsigned ko_ = (unsigned)((sl) * SHM_K), po_ = (unsigned)((sl) * SHM_P); \
    const unsigned a0_ = (unsigned)(uintptr_t)kS0 + ko_, a1_ = (unsigned)(uintptr_t)kS1 + ko_, a2_ = (unsigned)(uintptr_t)kS2 + ko_, a3_ = (unsigned)(uintptr_t)kS3 + ko_, pe_ = (unsigned)(uintptr_t)pE + po_, pq_ = (unsigned)(uintptr_t)pO + po_; \
    _Pragma("unroll") for (int kb = 0; kb < 4; ++kb) { T_.s[kb][0] = nm0; T_.s[kb][1] = nm1; } \
    bf16x8 e0_, e1_, f0_, f1_; \
    M16_RD2(e0_, e1_, a0_, 0, 4096); \
    M16_RD2(f0_, f1_, a0_, 8192, 12288);          M16_W2(e0_, e1_); M16_MM(T_, 0, e0_, e1_, 0); \
    M16_RD2(e0_, e1_, a1_, 0, 4096);              M16_W2(f0_, f1_); M16_MM(T_, 2, f0_, f1_, 0); \
    M16_RD2(f0_, f1_, a1_, 8192, 12288);          M16_W2(e0_, e1_); M16_MM(T_, 0, e0_, e1_, 1); \
    M16_RD2(e0_, e1_, a2_, 0, 4096);              M16_W2(f0_, f1_); M16_MM(T_, 2, f0_, f1_, 1); \
    M16_RD2(f0_, f1_, a2_, 8192, 12288);          M16_W2(e0_, e1_); M16_MM(T_, 0, e0_, e1_, 2); \
    M16_RD2(e0_, e1_, a3_, 0, 4096);              M16_W2(f0_, f1_); M16_MM(T_, 2, f0_, f1_, 2); \
    M16_RD2(f0_, f1_, a3_, 8192, 12288);          M16_W2(e0_, e1_); M16_MM(T_, 0, e0_, e1_, 3); \
    M16_RD2(e0_, e1_, pe_, 0, 2048);              M16_W2(f0_, f1_); M16_MM(T_, 2, f0_, f1_, 3); \
    M16_RD2(f0_, f1_, pe_, 4096, 6144);           M16_W2(e0_, e1_); M16_MM(T_, 0, e0_, e1_, 4); \
    M16_RD2(e0_, e1_, pq_, 0, 2048);              M16_W2(f0_, f1_); M16_MM(T_, 2, f0_, f1_, 4); \
    M16_RD2(f0_, f1_, pq_, 4096, 6144);           M16_W2(e0_, e1_); M16_MM(T_, 0, e0_, e1_, 5); \
                                                  M16_W0(f0_, f1_); M16_MM(T_, 2, f0_, f1_, 5); } while (0)
#define SOFT16(T_, al0_, al1_, FIRST_) do { float x0 = T_.s[0][0][0], x1 = T_.s[0][1][0]; \
    _Pragma("unroll") for (int kb = 0; kb < 4; ++kb) _Pragma("unroll") for (int i = 0; i < 4; ++i) { x0 = fmaxf(x0, T_.s[kb][0][i]); x1 = fmaxf(x1, T_.s[kb][1][i]); } \
    al0_ = 1.f; al1_ = 1.f;                                                                    \
    if ((FIRST_) || !__builtin_expect(__all(x0 <= THR2 && x1 <= THR2), 1)) {                  \
      x0 = fmaxf(x0, xor16(x0)); x1 = fmaxf(x1, xor16(x1)); x0 = xor32_max(x0); x1 = xor32_max(x1); \
      const float d0 = (FIRST_) ? x0 : fmaxf(x0, 0.f), d1 = (FIRST_) ? x1 : fmaxf(x1, 0.f); \
      if (!(FIRST_)) { al0_ = __builtin_amdgcn_exp2f(-d0); al1_ = __builtin_amdgcn_exp2f(-d1); } \
      m0 += d0; m1 += d1; nm0 = (f32x4q){-m0, -m0, -m0, -m0}; nm1 = (f32x4q){-m1, -m1, -m1, -m1}; \
      _Pragma("unroll") for (int kb = 0; kb < 4; ++kb) _Pragma("unroll") for (int i = 0; i < 4; ++i) { T_.s[kb][0][i] -= d0; T_.s[kb][1][i] -= d1; } } \
    float y0 = 0.f, y1 = 0.f; \
    _Pragma("unroll") for (int kb = 0; kb < 4; ++kb) _Pragma("unroll") for (int i = 0; i < 4; ++i) { T_.s[kb][0][i] = __builtin_amdgcn_exp2f(T_.s[kb][0][i]); T_.s[kb][1][i] = __builtin_amdgcn_exp2f(T_.s[kb][1][i]); \
      y0 += T_.s[kb][0][i]; y1 += T_.s[kb][1][i]; } \
    lr0 = lr0 * al0_ + y0; lr1 = lr1 * al1_ + y1;                                             \
    _Pragma("unroll") for (int qb = 0; qb < 2; ++qb) _Pragma("unroll") for (int ks = 0; ks < 2; ++ks) { \
      const v4u w_ = {cvtpk(T_.s[2 * ks][qb][0], T_.s[2 * ks][qb][1]), cvtpk(T_.s[2 * ks][qb][2], T_.s[2 * ks][qb][3]), cvtpk(T_.s[2 * ks + 1][qb][0], T_.s[2 * ks + 1][qb][1]), cvtpk(T_.s[2 * ks + 1][qb][2], T_.s[2 * ks + 1][qb][3])}; \
      pa[qb][ks] = __builtin_bit_cast(bf16x8, w_); } } while (0)
#define RESC16(al0_, al1_) do { if (__any((al0_) < 1.f || (al1_) < 1.f)) { if (kg == 0) { ws[l15] = (al0_); ws[16 + l15] = (al1_); } asm volatile("s_waitcnt lgkmcnt(0)" ::: "memory"); \
    const f32x4q a0_ = *(const LAS f32x4q*)(ws + 4 * kg), a1_ = *(const LAS f32x4q*)(ws + 16 + 4 * kg); \
    _Pragma("unroll") for (int c = 0; c < 8; ++c) { o[0][c] *= a0_; o[1][c] *= a1_; } } } while (0)
#define M16_TR4(a_, b_, c_, d_, A_, C_) do { const unsigned ad_ = vBc[C_] + (A_); asm volatile("ds_read_b64_tr_b16 %0, %1 offset:%2" : "=v"(a_) : "v"(ad_), "i"(0)); asm volatile("ds_read_b64_tr_b16 %0, %1 offset:%2" : "=v"(b_) : "v"(ad_), "i"(16 * VROW)); \
    asm volatile("ds_read_b64_tr_b16 %0, %1 offset:%2" : "=v"(c_) : "v"(ad_), "i"(32 * VROW)); asm volatile("ds_read_b64_tr_b16 %0, %1 offset:%2" : "=v"(d_) : "v"(ad_), "i"(48 * VROW)); } while (0)
#define M16_WV4(a_, b_, c_, d_) asm volatile("s_waitcnt lgkmcnt(4)" : "+v"(a_), "+v"(b_), "+v"(c_), "+v"(d_))
#define M16_WV0(a_, b_, c_, d_) asm volatile("s_waitcnt lgkmcnt(0)" : "+v"(a_), "+v"(b_), "+v"(c_), "+v"(d_))
#define M16_PM(C_, a_, b_, c_, d_) do { const bf16x8 v0_ = __builtin_bit_cast(bf16x8, __builtin_shufflevector(a_, b_, 0, 1, 2, 3, 4, 5, 6, 7)), v1_ = __builtin_bit_cast(bf16x8, __builtin_shufflevector(c_, d_, 0, 1, 2, 3, 4, 5, 6, 7)); \
    o[0][C_] = __builtin_amdgcn_mfma_f32_16x16x32_bf16(pa[0][0], v0_, o[0][C_], 0, 0, 0); o[1][C_] = __builtin_amdgcn_mfma_f32_16x16x32_bf16(pa[1][0], v0_, o[1][C_], 0, 0, 0); \
    o[0][C_] = __builtin_amdgcn_mfma_f32_16x16x32_bf16(pa[0][1], v1_, o[0][C_], 0, 0, 0); o[1][C_] = __builtin_amdgcn_mfma_f32_16x16x32_bf16(pa[1][1], v1_, o[1][C_], 0, 0, 0); } while (0)
#define PV16(sl) do { const unsigned va_ = (unsigned)((sl) * SHM_V); v4i16q a_, b_, c_, d_, e_, f_, g_, h_; \
    M16_TR4(a_, b_, c_, d_, va_, 0); \
    M16_TR4(e_, f_, g_, h_, va_, 1); M16_WV4(a_, b_, c_, d_); M16_PM(0, a_, b_, c_, d_); \
    M16_TR4(a_, b_, c_, d_, va_, 2); M16_WV4(e_, f_, g_, h_); M16_PM(1, e_, f_, g_, h_); \
    M16_TR4(e_, f_, g_, h_, va_, 3); M16_WV4(a_, b_, c_, d_); M16_PM(2, a_, b_, c_, d_); \
    M16_TR4(a_, b_, c_, d_, va_, 4); M16_WV4(e_, f_, g_, h_); M16_PM(3, e_, f_, g_, h_); \
    M16_TR4(e_, f_, g_, h_, va_, 5); M16_WV4(a_, b_, c_, d_); M16_PM(4, a_, b_, c_, d_); \
    M16_TR4(a_, b_, c_, d_, va_, 6); M16_WV4(e_, f_, g_, h_); M16_PM(5, e_, f_, g_, h_); \
    M16_TR4(e_, f_, g_, h_, va_, 7); M16_WV4(a_, b_, c_, d_); M16_PM(6, a_, b_, c_, d_); \
                                     M16_WV0(e_, f_, g_, h_); M16_PM(7, e_, f_, g_, h_); } while (0)
#define M16_WK(n_, x_, y_) asm volatile("s_waitcnt lgkmcnt(" #n_ ")" : "+v"(x_), "+v"(y_))
#define M16_WV(n_, a_, b_, c_, d_) asm volatile("s_waitcnt lgkmcnt(" #n_ ")" : "+v"(a_), "+v"(b_), "+v"(c_), "+v"(d_))
#define MSEG16(T_, slK, slV) do { const unsigned ko_ = (unsigned)((slK) * SHM_K), po_ = (unsigned)((slK) * SHM_P), va_ = (unsigned)((slV) * SHM_V); \
    const unsigned a0_ = (unsigned)(uintptr_t)kS0 + ko_, a1_ = (unsigned)(uintptr_t)kS1 + ko_, a2_ = (unsigned)(uintptr_t)kS2 + ko_, a3_ = (unsigned)(uintptr_t)kS3 + ko_, pe_ = (unsigned)(uintptr_t)pE + po_, pq_ = (unsigned)(uintptr_t)pO + po_; \
    _Pragma("unroll") for (int kb = 0; kb < 4; ++kb) { T_.s[kb][0] = nm0; T_.s[kb][1] = nm1; } \
    bf16x8 e0_, e1_, f0_, f1_, g0_, g1_; v4i16q va0_, va1_, va2_, va3_, vb0_, vb1_, vb2_, vb3_, vc0_, vc1_, vc2_, vc3_; \
    M16_RD2(e0_, e1_, a0_, 0, 4096); M16_RD2(f0_, f1_, a0_, 8192, 12288); \
    M16_RD2(g0_, g1_, a1_, 0, 4096); M16_WK(4, e0_, e1_); M16_MM(T_, 0, e0_, e1_, 0); \
    M16_RD2(e0_, e1_, a1_, 8192, 12288); M16_WK(4, f0_, f1_); M16_MM(T_, 2, f0_, f1_, 0); \
    M16_RD2(f0_, f1_, a2_, 0, 4096); M16_WK(4, g0_, g1_); M16_MM(T_, 0, g0_, g1_, 1); \
    M16_RD2(g0_, g1_, a2_, 8192, 12288); M16_WK(4, e0_, e1_); M16_MM(T_, 2, e0_, e1_, 1); \
    M16_RD2(e0_, e1_, a3_, 0, 4096); M16_WK(4, f0_, f1_); M16_MM(T_, 0, f0_, f1_, 2); \
    M16_RD2(f0_, f1_, a3_, 8192, 12288); M16_WK(4, g0_, g1_); M16_MM(T_, 2, g0_, g1_, 2); \
    M16_RD2(g0_, g1_, pe_, 0, 2048); M16_WK(4, e0_, e1_); M16_MM(T_, 0, e0_, e1_, 3); \
    M16_RD2(e0_, e1_, pe_, 4096, 6144); M16_WK(4, f0_, f1_); M16_MM(T_, 2, f0_, f1_, 3); \
    M16_RD2(f0_, f1_, pq_, 0, 2048); M16_WK(4, g0_, g1_); M16_MM(T_, 0, g0_, g1_, 4); \
    M16_RD2(g0_, g1_, pq_, 4096, 6144); M16_WK(4, e0_, e1_); M16_MM(T_, 2, e0_, e1_, 4); \
    M16_TR4(va0_, va1_, va2_, va3_, va_, 0); M16_WK(6, f0_, f1_); M16_MM(T_, 0, f0_, f1_, 5); \
    M16_TR4(vb0_, vb1_, vb2_, vb3_, va_, 1); M16_WK(8, g0_, g1_); M16_MM(T_, 2, g0_, g1_, 5); \
    M16_TR4(vc0_, vc1_, vc2_, vc3_, va_, 2); M16_WV(8, va0_, va1_, va2_, va3_); M16_PM(0, va0_, va1_, va2_, va3_); \
    M16_TR4(va0_, va1_, va2_, va3_, va_, 3); M16_WV(8, vb0_, vb1_, vb2_, vb3_); M16_PM(1, vb0_, vb1_, vb2_, vb3_); \
    M16_TR4(vb0_, vb1_, vb2_, vb3_, va_, 4); M16_WV(8, vc0_, vc1_, vc2_, vc3_); M16_PM(2, vc0_, vc1_, vc2_, vc3_); \
    M16_TR4(vc0_, vc1_, vc2_, vc3_, va_, 5); M16_WV(8, va0_, va1_, va2_, va3_); M16_PM(3, va0_, va1_, va2_, va3_); \
    M16_TR4(va0_, va1_, va2_, va3_, va_, 6); M16_WV(8, vb0_, vb1_, vb2_, vb3_); M16_PM(4, vb0_, vb1_, vb2_, vb3_); \
    M16_TR4(vb0_, vb1_, vb2_, vb3_, va_, 7); M16_WV(8, vc0_, vc1_, vc2_, vc3_); M16_PM(5, vc0_, vc1_, vc2_, vc3_); \
    M16_WV(4, va0_, va1_, va2_, va3_); M16_PM(6, va0_, va1_, va2_, va3_); \
    M16_WV(0, vb0_, vb1_, vb2_, vb3_); M16_PM(7, vb0_, vb1_, vb2_, vb3_); } while (0)
#define SEG_END_M() do { FA_SBAR(); asm volatile("s_waitcnt vmcnt(0) lgkmcnt(0)" ::: "memory"); __builtin_amdgcn_s_barrier(); asm volatile("" ::: "memory"); FA_SBAR(); } while (0)
#define SEG_END_V() do { FA_SBAR(); asm volatile("s_waitcnt lgkmcnt(0)" ::: "memory"); __builtin_amdgcn_s_barrier(); asm volatile("" ::: "memory"); FA_SBAR(); } while (0)
  Tile tS; bf16x8 pa[2][2]; float al0, al1;
  SEG_END_M();
  if (wid >= 4) { __builtin_amdgcn_s_barrier(); asm volatile("" ::: "memory"); }
  FA_SBAR();
  QK16(tS, 0);
  SEG_END_M();
  DMA_K(2, 2); DMA_V(1, 1);
  SOFT16(tS, al0, al1, true);
  SEG_END_V();
  int s0 = 0, s1 = 1, s2 = 2;
  for (int k = 0; k + 1 < NT; ++k) {
    MSEG16(tS, s1, s0);
    SEG_END_M();
    DMA_K(k + 3, s0); DMA_V(k + 2, s2);
    SOFT16(tS, al0, al1, false);
    RESC16(al0, al1);
    SEG_END_V();
    { const int t_ = s0; s0 = s1; s1 = s2; s2 = t_; }
  }
  PV16(s0);
  SEG_END_M();
  if (wid < 4) { __builtin_amdgcn_s_barrier(); asm volatile("" ::: "memory"); }
  lr0 += xor16(lr0); lr1 += xor16(lr1); lr0 = xor32_sum(lr0); lr1 = xor32_sum(lr1);
  if (kg == 0) { ws[32 + l15] = lr0; ws[48 + l15] = lr1; } asm volatile("s_waitcnt lgkmcnt(0)" ::: "memory");
#pragma unroll
  for (int qb = 0; qb < 2; ++qb) { const f32x4q lv = *(const LAS f32x4q*)(ws + 32 + 16 * qb + 4 * kg);
    bf16* Ow = O + (size_t)(qrow0 + wid * 32 + 16 * qb + 4 * kg) * 2048 + h * 128 + l15;
#pragma unroll
    for (int i = 0; i < 4; ++i) { const float rl = __builtin_amdgcn_rcpf(lv[i]);
#pragma unroll
      for (int c = 0; c < 8; ++c) Ow[(size_t)i * 2048 + 16 * c] = (bf16)(cvtpk(o[qb][c][i] * rl, 0.f) & 0xffffu); } }
  asm volatile("s_waitcnt vmcnt(0)" ::: "memory"); __syncthreads();
#undef DMA_K
#undef M16_BDMA
#undef DMA_V
#undef QK16
#undef M16_RD2
#undef M16_W2
#undef M16_W0
#undef M16_MM
#undef SOFT16
#undef RESC16
#undef PV16
#undef MSEG16
#undef M16_WK
#undef M16_WV
#undef M16_TR4
#undef M16_WV4
#undef M16_WV0
#undef M16_PM
#undef SEG_END_M
#undef SEG_END_V
}
__device__ __forceinline__ void mla_attn_phase16(LAS unsigned char* lds, const bf16* QH, const bf16* KV, const bf16* KPE, const float* cosT, const float* sinT, bf16* O) {
  const int G = gridDim.x, bx = blockIdx.x;
  const int nu = (G == 256) ? (bx < 32 ? 5 : 4) : (1056 - bx + G - 1) / G;
  for (int i = 0; i < nu; ++i) {
    int bh, q0; bool latq;
    if (G == 256) { if (i < 4) { bh = i * 8 + (bx & 7); q0 = (bh >> 4) * 8192 + (bx >> 3) * 256; latq = true; } else { bh = bx; q0 = MLAT + (bh >> 4) * 256; latq = false; } }
    else { const int u = bx + i * G; if (u < 1024) { bh = u >> 5; q0 = (bh >> 4) * 8192 + (u & 31) * 256; latq = true; } else { bh = u - 1024; q0 = MLAT + (bh >> 4) * 256; latq = false; } }
    mla_unit16(lds, QH, KV, KPE, cosT, sinT, O, q0, latq, bh >> 4, bh & 15);
  }
}
}

namespace ml {
using fa::f32x16; using fa::s16x4; using fa::crow; using fa::cvtpk;
typedef float f32x4m __attribute__((ext_vector_type(4)));
constexpr int TQ = 17408, ROWB = 272, SPS = 144;
constexpr int OFF_Q = 0, OFF_K = 2 * TQ, OFF_V = 4 * TQ, OFF_KW = OFF_V + 32768, OFF_SP = OFF_KW + 16384, OFF_QN = OFF_SP + 64 * SPS, OFF_N32 = OFF_QN + 256, OFF_NB = OFF_N32 + 512, OFF_WV = OFF_NB + 256, ML_LDS_END = OFF_WV + 8 * 1280;
#define ML_DMA(gp, lp) __builtin_amdgcn_global_load_lds((const unsigned*)(gp), (LAS unsigned*)(lp), 16, 0, 0)
#define ML_TR(dst, vb, OFF) asm volatile("ds_read_b64_tr_b16 %0, %1 offset:%2" : "=&v"(dst) : "v"(vb), "i"(OFF) : "memory")
#define ML_PK(L, H) (bf16x8){L[0], L[1], L[2], L[3], H[0], H[1], H[2], H[3]}
__device__ __forceinline__ int chunk_base(int n, int dir, int b) { return dir == 0 ? (n < 4 ? MLAT + b * 256 + 64 * n : b * 8192 + 64 * (n - 4)) : (n < 4 ? MLAT + b * 256 + 64 * (3 - n) : b * 8192 + 64 * (131 - n)); }
template <int CTRL, int RM> __device__ __forceinline__ float dppf(float old, float src) { return __int_as_float(__builtin_amdgcn_update_dpp(__float_as_int(old), __float_as_int(src), CTRL, RM, 0xf, false)); }
__device__ __forceinline__ float scan_add(float v) {
  v += dppf<0x111, 0xf>(0.f, v); v += dppf<0x112, 0xf>(0.f, v); v += dppf<0x114, 0xf>(0.f, v); v += dppf<0x118, 0xf>(0.f, v);
  v += dppf<0x142, 0xa>(0.f, v); v += dppf<0x143, 0xc>(0.f, v); return v; }
__device__ __forceinline__ float scan_max(float v) {
  const float NI = -INFINITY;
  v = fmaxf(v, dppf<0x111, 0xf>(NI, v)); v = fmaxf(v, dppf<0x112, 0xf>(NI, v)); v = fmaxf(v, dppf<0x114, 0xf>(NI, v)); v = fmaxf(v, dppf<0x118, 0xf>(NI, v));
  v = fmaxf(v, dppf<0x142, 0xa>(NI, v)); v = fmaxf(v, dppf<0x143, 0xc>(NI, v)); return v; }

constexpr int NGRP = 8;
__host__ __device__ constexpr int grp_start(int g) { return g <= 4 ? 17 * g : 68 + 16 * (g - 4); }
constexpr int OFF_TAB = ML_LDS_END;
template <int MODE> __device__ __forceinline__ void scan_chain(LAS unsigned char* lds, const bf16* __restrict__ QK, const bf16* __restrict__ Z, const float* __restrict__ G, bf16* __restrict__ H, float* __restrict__ Ub, float* __restrict__ Nb, const int chain, const int grp) {
  const int dir = chain & 1, hd = (chain >> 1) & 7, b = chain >> 4; const int n0 = grp_start(grp), n1 = grp_start(grp + 1);
  int tid_ = threadIdx.x; asm volatile("" : "+v"(tid_)); const int tid = tid_, wid = __builtin_amdgcn_readfirstlane(tid >> 6), lane_ = tid & 63;
  LAS char* Lc = (LAS char*)lds;
  LAS float* QN = (LAS float*)(lds + OFF_QN); LAS float* N32 = (LAS float*)(lds + OFF_N32); LAS bf16* NB = (LAS bf16*)(lds + OFF_NB);
  const int lane = lane_;
  unsigned offQ[2], offQx, offV[4];
#pragma unroll
  for (int i = 0; i < 2; ++i) { const int Lb = (2 * wid + i) * 1024 + 16 * lane, row = Lb / ROWB, cB = Lb % ROWB, colB = cB < 256 ? cB : 0; const int srow = dir ? 63 - row : row; offQ[i] = (unsigned)((srow * 2048 + hd * 128) * 2 + colB); }
  { const int Lb = 16 * 1024 + 16 * lane, row = Lb / ROWB, cB = Lb % ROWB, colB = cB < 256 ? cB : 0; const int srow = dir ? 63 - row : row; offQx = (unsigned)((srow * 2048 + hd * 128) * 2 + colB); }
#pragma unroll
  for (int p = 0; p < 4; ++p) { const int Lb = p * 1024 + 16 * lane, sub = Lb >> 9, w_ = Lb & 511, kk = sub * 8 + (w_ >> 6), c = (w_ & 63) >> 1, k = (kk & ~0xC) | ((kk & 4) << 1) | ((kk & 8) >> 1); const int srow = dir ? 63 - k : k;
    offV[p] = (unsigned)((srow * 6400 + 2048 + hd * 256 + 32 * wid + c) * 2); }
  const int grow_off = dir ? 63 - lane : lane;
#define DMA_Q(n, slot) do { const char* g_ = (const char*)(QK + (size_t)chunk_base((n), dir, b) * 2048); LAS char* d_ = Lc + OFF_Q + (slot) * TQ; \
    ML_DMA(g_ + offQ[0], d_ + (2 * wid) * 1024); ML_DMA(g_ + offQ[1], d_ + (2 * wid + 1) * 1024); if (wid == 0) ML_DMA(g_ + offQx, d_ + 16 * 1024); } while (0)
#define DMA_K(n, slot) do { const char* g_ = (const char*)(QK + (size_t)chunk_base((n), dir, b) * 2048 + 1024); LAS char* d_ = Lc + OFF_K + (slot) * TQ; \
    ML_DMA(g_ + offQ[0], d_ + (2 * wid) * 1024); ML_DMA(g_ + offQ[1], d_ + (2 * wid + 1) * 1024); if (wid == 0) ML_DMA(g_ + offQx, d_ + 16 * 1024); } while (0)
#define DMA_VS(n) do { const char* g_ = (const char*)(Z + (size_t)chunk_base((n), dir, b) * 6400); LAS char* d_ = Lc + OFF_V + wid * 4096; \
    ML_DMA(g_ + offV[0], d_); ML_DMA(g_ + offV[1], d_ + 1024); ML_DMA(g_ + offV[2], d_ + 2048); ML_DMA(g_ + offV[3], d_ + 3072); } while (0)
#define LOAD_G(n, li_, lf_) do { const float* g_ = G + (size_t)(chunk_base((n), dir, b) + grow_off) * 32 + dir * 16 + hd; li_ = g_[0]; lf_ = g_[8]; } while (0)
#define BAR_LDS() do { asm volatile("s_waitcnt lgkmcnt(0)" ::: "memory"); __builtin_amdgcn_s_barrier(); asm volatile("" ::: "memory"); } while (0)
  LAS float* TB = (LAS float*)(lds + OFF_TAB); LAS float* TP = TB + 132; LAS float* TM = TB + 264; LAS float* TC = TB + 397;
  { float gl_[17], gf_[17];
#pragma unroll
    for (int i = 0; i < 17; ++i) { const int c = wid + 8 * i; gl_[i] = 0.f; gf_[i] = 0.f; if (c < 132) LOAD_G(c, gl_[i], gf_[i]); }
#pragma unroll
    for (int i = 0; i < 17; ++i) { const int c = wid + 8 * i; const float cb_ = scan_add(gf_[i]), pm_ = scan_max(gl_[i] - cb_); if (c < 132 && lane == 63) { TB[c] = cb_; TP[c] = pm_; } } }
  __syncthreads();
  if (tid == 0) { float m_ = 0.f, bc_ = 0.f;
#pragma unroll 12
    for (int c = 0; c < 132; ++c) { const float tb_ = TB[c], tp_ = TP[c]; TM[c] = m_; TC[c] = bc_; m_ = tb_ + fmaxf(m_, tp_); bc_ += tb_; }
    TM[132] = m_; TC[132] = bc_; }
  __syncthreads();
  if (MODE == 1) { DMA_Q(n0, 0); DMA_Q(n0 + 1, 1); }
  DMA_K(n0, 0); DMA_K(n0 + 1, 1); DMA_VS(n0);
  float li, lf; LOAD_G(n0, li, lf);
  f32x16 C[4];
#pragma unroll
  for (int i = 0; i < 4; ++i) C[i] = f32x16{};
  float nacc = 0.f;
  if (MODE == 1) {
#pragma unroll 1
    for (int j = 0; j < grp; ++j) { const int s1 = grp_start(j + 1); const float w = __expf(TC[n0] - TC[s1] + TM[s1] - TM[n0]);
      const float* up = Ub + ((size_t)(chain * NGRP + j) * 8 + wid) * 4096 + lane;
#pragma unroll
      for (int q = 0; q < 4; ++q) {
#pragma unroll
        for (int r = 0; r < 16; ++r) C[q][r] += w * up[(q * 16 + r) * 64];
        __builtin_amdgcn_sched_barrier(0); }
      if (tid < 128) nacc += w * Nb[(size_t)(chain * NGRP + j) * 128 + tid]; }
  }
  if (tid < 128) { N32[tid] = nacc; NB[tid] = (bf16)(cvtpk(nacc, 0.f) & 0xffffu); }
  float m_prev = TM[n0];
  asm volatile("s_waitcnt vmcnt(0)" ::: "memory"); BAR_LDS();
  float cumb = scan_add(lf), av = li - cumb, pm = scan_max(av);
  unsigned hp[16];
#pragma unroll
  for (int i = 0; i < 16; ++i) hp[i] = 0u;
  for (int n = n0; n < n1; ++n) {
    const int slot = (n - n0) & 1;
    const LAS char* Qs = Lc + OFF_Q + slot * TQ; const LAS char* Ks = Lc + OFF_K + slot * TQ;
    const float mx = fmaxf(m_prev, pm), wint = __expf(m_prev - mx), m_t = cumb + mx;
    const float mx63 = __int_as_float(__builtin_amdgcn_readlane(__float_as_int(mx), 63)), b_end = __int_as_float(__builtin_amdgcn_readlane(__float_as_int(cumb), 63)), m_new = b_end + mx63, decay = __expf(m_prev - mx63);
    { LAS float* WVt = (LAS float*)(lds + OFF_WV + wid * 1280); WVt[128 + lane] = -mx; WVt[192 + lane] = av; WVt[256 + lane] = __expf(av - mx63); }
    if (MODE == 1 && n > n0) {
      int lo_ = lane_; asm volatile("" : "+v"(lo_)); const int cbr = chunk_base(n - 1, dir, b); const int hi_ = lo_ >> 5;
      const unsigned loff = (unsigned)(2 * (lo_ & 31) + (dir ? 1 - hi_ : hi_) * 4 * 4096); char* const Hb = (char*)(H + hd * 256 + 32 * wid);
#pragma unroll
      for (int k = 0; k < 16; ++k) { const int i0 = 2 * (k & 7), tk = 32 * (k >> 3) + (i0 & 3) + 8 * (i0 >> 2); char* const r0 = Hb + (size_t)(cbr + (dir ? 63 - tk - 4 : tk)) * 4096; char* const r1 = dir ? r0 - 4096 : r0 + 4096;
        *(bf16*)(r0 + loff) = (bf16)(hp[k] & 0xffffu); *(bf16*)(r1 + loff) = (bf16)(hp[k] >> 16); }
    }
    __builtin_amdgcn_sched_barrier(0);
    {
      int lane = lane_; asm volatile("" : "+v"(lane));
      const int l15 = lane & 15, kg = lane >> 4;
      if (MODE == 1) {
      const int tb = wid >> 1;
      bf16x8 qa[4];
#pragma unroll
      for (int ks = 0; ks < 4; ++ks) qa[ks] = *(const LAS bf16x8*)(Qs + (16 * tb + l15) * ROWB + kg * 16 + ks * 64);
#pragma unroll
      for (int e = 0; e < 2; ++e) { const int sb = 2 * (wid & 1) + e; f32x4m acc = {0.f, 0.f, 0.f, 0.f};
        if (sb <= tb) {
#pragma unroll
          for (int ks = 0; ks < 4; ++ks) { const bf16x8 kb = *(const LAS bf16x8*)(Ks + (16 * sb + l15) * ROWB + kg * 16 + ks * 64); acc = __builtin_amdgcn_mfma_f32_16x16x32_bf16(qa[ks], kb, acc, 0, 0, 0); }
        }
        const int s = 16 * sb + l15; const LAS float* WVt = (const LAS float*)(lds + OFF_WV + wid * 1280); const float a_s = WVt[192 + s]; const f32x4m e1v = *(const LAS f32x4m*)(WVt + 128 + 16 * tb + 4 * kg);
#pragma unroll
        for (int i = 0; i < 4; ++i) { const int t = 16 * tb + 4 * kg + i; const float v = (s <= t) ? acc[i] * __expf(e1v[i] + a_s) : 0.f;
          *(LAS bf16*)(Lc + OFF_SP + t * SPS + s * 2) = (bf16)(cvtpk(v, 0.f) & 0xffffu); } }
      if (wid < 4) {
        f32x4m acc = {0.f, 0.f, 0.f, 0.f};
#pragma unroll
        for (int ks = 0; ks < 4; ++ks) { const bf16x8 qq = *(const LAS bf16x8*)(Qs + (16 * wid + l15) * ROWB + kg * 16 + ks * 64); const bf16x8 nn = *(const LAS bf16x8*)((const LAS char*)NB + kg * 16 + ks * 64);
          acc = __builtin_amdgcn_mfma_f32_16x16x32_bf16(qq, nn, acc, 0, 0, 0); }
        if (l15 == 0) { *(LAS f32x4m*)(QN + 16 * wid + 4 * kg) = acc; }
      }
      }
      {
        const int s = wid * 8 + (lane >> 3), part = lane & 7; const float es = ((const LAS float*)(lds + OFF_WV + wid * 1280))[256 + s];
        const v4u w0 = *(const LAS v4u*)(Ks + s * ROWB + part * 32), w1 = *(const LAS v4u*)(Ks + s * ROWB + part * 32 + 16);
        float f[16]; unpack8(w0, f); unpack8(w1, f + 8);
        v4u o0 = {cvtpk(f[0] * es, f[1] * es), cvtpk(f[2] * es, f[3] * es), cvtpk(f[4] * es, f[5] * es), cvtpk(f[6] * es, f[7] * es)};
        v4u o1 = {cvtpk(f[8] * es, f[9] * es), cvtpk(f[10] * es, f[11] * es), cvtpk(f[12] * es, f[13] * es), cvtpk(f[14] * es, f[15] * es)};
        *(LAS v4u*)(Lc + OFF_KW + fa::v_st(s, part * 16)) = o0; *(LAS v4u*)(Lc + OFF_KW + fa::v_st(s, part * 16 + 8)) = o1;
      }
    }
    BAR_LDS();
    int lane = lane_; asm volatile("" : "+v"(lane));
    const int r32 = lane & 31, hi = lane >> 5;
    const int vbV = (int)(unsigned)(uintptr_t)(Lc + OFF_V + wid * 4096) + fa::v_rd_base(lane);
    const int vbK = (int)(unsigned)(uintptr_t)(Lc + OFF_KW) + fa::v_rd_base(lane);
    LAS float* WV = (LAS float*)(lds + OFF_WV + wid * 1280);
    s16x4 vl0, vh0, vl1, vh1, vl2, vh2, vl3, vh3;
    ML_TR(vl0, vbV, 0); ML_TR(vh0, vbV, 512); ML_TR(vl1, vbV, 1024); ML_TR(vh1, vbV, 1536); ML_TR(vl2, vbV, 2048); ML_TR(vh2, vbV, 2560); ML_TR(vl3, vbV, 3072); ML_TR(vh3, vbV, 3584);
    asm volatile("s_waitcnt lgkmcnt(0)" ::: "memory"); __builtin_amdgcn_sched_barrier(0);
    const bf16x8 vf0 = ML_PK(vl0, vh0), vf1 = ML_PK(vl1, vh1), vf2 = ML_PK(vl2, vh2), vf3 = ML_PK(vl3, vh3);
    float li_n = 0.f, lf_n = 0.f;
    if (n + 1 < n1) { DMA_VS(n + 1); LOAD_G(n + 1, li_n, lf_n); }
    if (n + 2 < n1) DMA_K(n + 2, slot);
    if (MODE == 1) {
    {
      float rs = 0.f;
#pragma unroll
      for (int j = 0; j < 8; ++j) { float f[8]; unpack8(*(const LAS v4u*)(Lc + OFF_SP + lane * SPS + 16 * j), f);
#pragma unroll
        for (int i = 0; i < 8; ++i) rs += f[i]; }
      const float den = wint * QN[lane] + rs; const float rinv = 1.f / fmaxf(fabsf(den), __expf(-m_t));
      WV[lane] = wint; WV[64 + lane] = rinv;
    }
    __builtin_amdgcn_sched_barrier(0);
    f32x16 aI0 = f32x16{}, aI1 = f32x16{};
#pragma unroll
    for (int dkb = 0; dkb < 4; ++dkb) {
#pragma unroll
      for (int jj = 0; jj < 2; ++jj) {
        const v4u cw = {cvtpk(C[dkb][8 * jj + 0], C[dkb][8 * jj + 1]), cvtpk(C[dkb][8 * jj + 2], C[dkb][8 * jj + 3]), cvtpk(C[dkb][8 * jj + 4], C[dkb][8 * jj + 5]), cvtpk(C[dkb][8 * jj + 6], C[dkb][8 * jj + 7])};
        const bf16x8 cb = __builtin_bit_cast(bf16x8, cw);
        const LAS char* qp = Qs + r32 * ROWB + (32 * dkb + 16 * jj + 4 * hi) * 2;
        typedef unsigned u32x2m __attribute__((ext_vector_type(2)));
        const u32x2m a0 = *(const LAS u32x2m*)(qp), a1 = *(const LAS u32x2m*)(qp + 16), b0 = *(const LAS u32x2m*)(qp + 32 * ROWB), b1 = *(const LAS u32x2m*)(qp + 32 * ROWB + 16);
        const v4u qa0 = {a0.x, a0.y, a1.x, a1.y}, qa1 = {b0.x, b0.y, b1.x, b1.y};
        aI0 = __builtin_amdgcn_mfma_f32_32x32x16_bf16(__builtin_bit_cast(bf16x8, qa0), cb, aI0, 0, 0, 0);
        aI1 = __builtin_amdgcn_mfma_f32_32x32x16_bf16(__builtin_bit_cast(bf16x8, qa1), cb, aI1, 0, 0, 0);
      }
      __builtin_amdgcn_sched_barrier(0);
    }
#pragma unroll
    for (int g = 0; g < 4; ++g) { const f32x4m w0 = *(const LAS f32x4m*)(WV + 8 * g + 4 * hi), w1 = *(const LAS f32x4m*)(WV + 32 + 8 * g + 4 * hi);
#pragma unroll
      for (int i = 0; i < 4; ++i) { aI0[4 * g + i] *= w0[i]; aI1[4 * g + i] *= w1[i]; } }
    {
      const LAS char* sp = Lc + OFF_SP + r32 * SPS + hi * 16;
#define ML_INTRA(ks, vf) do { const bf16x8 s0 = *(const LAS bf16x8*)(sp + (ks) * 32), s1 = *(const LAS bf16x8*)(sp + 32 * SPS + (ks) * 32); \
      aI0 = __builtin_amdgcn_mfma_f32_32x32x16_bf16(s0, vf, aI0, 0, 0, 0); aI1 = __builtin_amdgcn_mfma_f32_32x32x16_bf16(s1, vf, aI1, 0, 0, 0); } while (0)
      ML_INTRA(0, vf0); ML_INTRA(1, vf1); ML_INTRA(2, vf2); ML_INTRA(3, vf3);
#undef ML_INTRA
    }
    __builtin_amdgcn_sched_barrier(0);
    {
#pragma unroll
      for (int tb = 0; tb < 2; ++tb)
#pragma unroll
        for (int g = 0; g < 4; ++g) { const int t0 = 32 * tb + 8 * g + 4 * hi; const f32x4m rv = *(const LAS f32x4m*)(WV + 64 + t0);
          const float h0 = (tb ? aI1[4 * g + 0] : aI0[4 * g + 0]) * rv[0], h1 = (tb ? aI1[4 * g + 1] : aI0[4 * g + 1]) * rv[1], h2 = (tb ? aI1[4 * g + 2] : aI0[4 * g + 2]) * rv[2], h3 = (tb ? aI1[4 * g + 3] : aI0[4 * g + 3]) * rv[3];
          hp[8 * tb + 2 * g] = cvtpk(h0, h1); hp[8 * tb + 2 * g + 1] = cvtpk(h2, h3); }
    }
    __builtin_amdgcn_sched_barrier(0);
    __builtin_amdgcn_sched_barrier(0);
    __builtin_amdgcn_sched_barrier(0);
    }
    {
      int tid_o = tid; asm volatile("" : "+v"(tid_o)); const int d = tid_o >> 2, q4 = tid_o & 3; float a = 0.f;
#pragma unroll
      for (int j = 0; j < 16; ++j) a += bf1(*(const LAS bf16*)(Lc + OFF_KW + fa::v_st(16 * q4 + j, d)));
      a += __shfl_xor(a, 1); a += __shfl_xor(a, 2);
      if (q4 == 0) { const float nn = decay * N32[d] + a; N32[d] = nn; NB[d] = (bf16)(cvtpk(nn, 0.f) & 0xffffu); }
    }
    __builtin_amdgcn_sched_barrier(0);
#pragma unroll
    for (int dkb = 0; dkb < 4; ++dkb) {
#pragma unroll
      for (int r = 0; r < 16; ++r) { float c_ = C[dkb][r]; asm("v_mul_f32 %0, %1, %2" : "=v"(c_) : "v"(c_), "v"(decay)); C[dkb][r] = c_; }
    }
#define ML_U(DKB) do { s16x4 kl0, kh0, kl1, kh1, kl2, kh2, kl3, kh3; \
      ML_TR(kl0, vbK, fa::v_rd_off(DKB, 0, 0)); ML_TR(kh0, vbK, fa::v_rd_off(DKB, 0, 1)); ML_TR(kl1, vbK, fa::v_rd_off(DKB, 1, 0)); ML_TR(kh1, vbK, fa::v_rd_off(DKB, 1, 1)); \
      ML_TR(kl2, vbK, fa::v_rd_off(DKB, 2, 0)); ML_TR(kh2, vbK, fa::v_rd_off(DKB, 2, 1)); ML_TR(kl3, vbK, fa::v_rd_off(DKB, 3, 0)); ML_TR(kh3, vbK, fa::v_rd_off(DKB, 3, 1)); \
      asm volatile("s_waitcnt lgkmcnt(0)" ::: "memory"); __builtin_amdgcn_sched_barrier(0); \
      C[DKB] = __builtin_amdgcn_mfma_f32_32x32x16_bf16(ML_PK(kl0, kh0), vf0, C[DKB], 0, 0, 0); C[DKB] = __builtin_amdgcn_mfma_f32_32x32x16_bf16(ML_PK(kl1, kh1), vf1, C[DKB], 0, 0, 0); \
      C[DKB] = __builtin_amdgcn_mfma_f32_32x32x16_bf16(ML_PK(kl2, kh2), vf2, C[DKB], 0, 0, 0); C[DKB] = __builtin_amdgcn_mfma_f32_32x32x16_bf16(ML_PK(kl3, kh3), vf3, C[DKB], 0, 0, 0); } while (0)
    ML_U(0); ML_U(1); ML_U(2); ML_U(3);
#undef ML_U
    m_prev = m_new;
    if (n + 1 < n1) { cumb = scan_add(lf_n); av = li_n - cumb; pm = scan_max(av); }
    asm volatile("s_waitcnt vmcnt(0)" ::: "memory"); BAR_LDS();
    if (MODE == 1 && n + 2 < n1) DMA_Q(n + 2, slot);
  }
  if (MODE == 1) { int lo_ = lane_; asm volatile("" : "+v"(lo_)); const int cbr = chunk_base(n1 - 1, dir, b); const int hi_ = lo_ >> 5;
    const unsigned loff = (unsigned)(2 * (lo_ & 31) + (dir ? 1 - hi_ : hi_) * 4 * 4096); char* const Hb = (char*)(H + hd * 256 + 32 * wid);
#pragma unroll
    for (int k = 0; k < 16; ++k) { const int i0 = 2 * (k & 7), tk = 32 * (k >> 3) + (i0 & 3) + 8 * (i0 >> 2); char* const r0 = Hb + (size_t)(cbr + (dir ? 63 - tk - 4 : tk)) * 4096; char* const r1 = dir ? r0 - 4096 : r0 + 4096;
      *(bf16*)(r0 + loff) = (bf16)(hp[k] & 0xffffu); *(bf16*)(r1 + loff) = (bf16)(hp[k] >> 16); } }
  if (MODE == 0) {
    float* up = Ub + ((size_t)(chain * NGRP + grp) * 8 + wid) * 4096 + lane;
#pragma unroll
    for (int q = 0; q < 4; ++q)
#pragma unroll
      for (int r = 0; r < 16; ++r) up[(q * 16 + r) * 64] = C[q][r];
    if (tid < 128) Nb[(size_t)(chain * NGRP + grp) * 128 + tid] = N32[tid];
  }
  asm volatile("s_waitcnt vmcnt(0)" ::: "memory"); __syncthreads();
#undef DMA_Q
#undef DMA_K
#undef DMA_VS
#undef LOAD_G
#undef BAR_LDS
}
__device__ __forceinline__ void scan_phase_a(LAS unsigned char* lds, const bf16* QK, const bf16* Z, const float* G, float* Ub, float* Nb) {
  for (int u = blockIdx.x; u < 32 * (NGRP - 1); u += gridDim.x) { const int chain = u / (NGRP - 1), grp = u % (NGRP - 1); scan_chain<0>(lds, QK, Z, G, nullptr, Ub, Nb, chain, grp); }
}
__device__ __forceinline__ void scan_phase_b(LAS unsigned char* lds, const bf16* QK, const bf16* Z, const float* G, bf16* HF, bf16* HB, float* Ub, float* Nb) {
  for (int u = blockIdx.x; u < 32 * NGRP; u += gridDim.x) { const int chain = u / NGRP, grp = u % NGRP; scan_chain<1>(lds, QK, Z, G, (chain & 1) ? HB : HF, Ub, Nb, chain, grp); }
}
}

#define TRD_BEGIN(tab_) int nm_ = 0, base_ = 0; LAS TrDesc* const tb_ = (tab_); for (int i_ = 0; i_ < TR_NMAT; ++i_) tb_[i_].base = 0x7fffffff
#define TRD(W_, K_, N_, NP_, WT_) do { tb_[nm_].W = (W_); tb_[nm_].WT = (WT_); tb_[nm_].K = (K_); tb_[nm_].N = (N_); tb_[nm_].Npad = (NP_); tb_[nm_].base = base_; base_ += ((K_) / 64) * ((NP_) / 256); ++nm_; } while (0)
#define TRD_END() (((LAS int*)(X.lds + TR_LDS_OFF + TR_NMAT * 32))[0] = base_)
#define TRD_TOTAL() (((const LAS int*)(X.lds + TR_LDS_OFF + TR_NMAT * 32))[0])
struct Args { const float* in[23]; float* out; unsigned char* ws; int ph_lo, ph_hi; };
constexpr int PH_LAYER0 = 3, PH_PER_LAYER = 10, NPHASES = PH_LAYER0 + DEPTH * PH_PER_LAYER;
__host__ __device__ constexpr bool phase_active(int p) { return p < PH_LAYER0 ? true : ((((p - PH_LAYER0) / PH_PER_LAYER) % 3 == 0) ? !(((p - PH_LAYER0) % PH_PER_LAYER) >= 2 && ((p - PH_LAYER0) % PH_PER_LAYER) <= 4) : ((((p - PH_LAYER0) / PH_PER_LAYER) % 3 == 1) ? ((p - PH_LAYER0) % PH_PER_LAYER) != 4 : true)); }

#define IN(k) (lo <= (k) && (k) < hi)
#define SEAM(k) do { if (single && (k) + 1 < hi) xcd_barrier(bar); } while (0)
template <int L> __device__ __forceinline__ void run_layer(const Ctx& X, const Args& args, const XcdBarrier& bar, const int lo, const int hi, const bool single) {
    unsigned char* ws = args.ws; const int G = gridDim.x;
    const float* norm_g = args.in[6];
    float* mod = (float*)(ws + WS_MOD); float* cosT = (float*)(ws + WS_ROPE); float* sinT = cosT + 2048;
    hfp* h = (hfp*)(ws + WS_H); bf16* a = (bf16*)(ws + WS_A); bf16* y = (bf16*)(ws + WS_Y); bf16* o = (bf16*)(ws + WS_O); unsigned char* big = ws + WS_BIG;
        constexpr int kind = L % 3, jj = L / 3, pb = PH_LAYER0 + L * PH_PER_LAYER;
        const bf16* wo_t;
        if constexpr (kind == 0) {
            bf16* QKV = (bf16*)(big + BIG_QKV); wo_t = (const bf16*)(ws + WS_NAWO) + (size_t)jj * D * D;
            if (IN(pb + 0)) { pg8::Gemm g{a, (const bf16*)(ws + WS_NAQKV) + (size_t)jj * D * 6144, M, 6144, D}; pg8::StaticOrder S; S.init(M, 6144, G, (int)blockIdx.x, WGM_IN); pg8::EpiBf16<0> E{QKV, 6144};
                REPEAT_REP_IN(pg8::gemm_phase<pg8::EpiBf16<0>, pg8::StaticOrder, true, true>(X.lds, g, S, E);)
                if (L == 0) { if (G == 256 && (int)blockIdx.x >= 48) { LAS TrDesc* tab = (LAS TrDesc*)(X.lds + TR_LDS_OFF); if (X.tid == 0) { TRD_BEGIN(tab); TRD(args.in[12], D, 1088, 1280, (bf16*)(ws + WS_MLAIN)); TRD(args.in[15], 512, 3072, 3072, (bf16*)(ws + WS_MLAUQ)); TRD(args.in[16], 512, 4096, 4096, (bf16*)(ws + WS_MLAUKV)); TRD(args.in[17], D, D, D, (bf16*)(ws + WS_MLAWO)); TRD_END(); } __syncthreads(); tr_all(X, tab, TRD_TOTAL(), (int)blockIdx.x - 48, 256 - 48); } } SEAM(pb + 0); }
            if (IN(pb + 1)) { REPEAT_REP_NA(fa::na_attn_phase(X.lds, QKV, args.in[10] + (size_t)jj * 16 * 15 * 31, o, L < DEPTH - 1);) SEAM(pb + 1); }
        } else if constexpr (kind == 1) {
            bf16* Z = (bf16*)(big + BIG_MZ); bf16* QH = (bf16*)(big + BIG_QH); bf16* KV = (bf16*)(big + BIG_KV); bf16* CQN = (bf16*)(big + BIG_CQN); bf16* CKVN = (bf16*)(big + BIG_CKVN); bf16* KPE = (bf16*)(big + BIG_KPE);
            wo_t = (const bf16*)(ws + WS_MLAWO);
            if (IN(pb + 0)) { pg8::Gemm g{a, (const bf16*)(ws + WS_MLAIN), M, 1280, D}; pg8::StaticOrder S; S.init(M, 1280, G, (int)blockIdx.x, WGM_IN); pg8::EpiBf16<0> E{Z, 1280};
                REPEAT_REP_IN(pg8::gemm_phase<pg8::EpiBf16<0>, pg8::StaticOrder, true, true>(X.lds, g, S, E);)
                if (G == 256 && (int)blockIdx.x >= 74) { LAS TrDesc* tab = (LAS TrDesc*)(X.lds + TR_LDS_OFF); if (X.tid == 0) { TRD_BEGIN(tab); TRD(args.in[18], D, 6176, 6400, (bf16*)(ws + WS_MLIN)); TRD(args.in[22], D, D, D, (bf16*)(ws + WS_MLWO)); TRD_END(); } __syncthreads(); tr_all(X, tab, TRD_TOTAL(), (int)blockIdx.x - 74, 256 - 74); } SEAM(pb + 0); }
            if (IN(pb + 1)) { mla_rows(X, Z, args.in[13], args.in[14], cosT, sinT, CQN, CKVN, KPE); SEAM(pb + 1); }
            if (IN(pb + 2)) {
                { pg8::Gemm g{CQN, (const bf16*)(ws + WS_MLAUQ), M, 3072, 512}; pg8::StaticOrder S; S.init(M, 3072, G, (int)blockIdx.x, WGM_UQ); pg8::EpiBf16<0> E{QH, 3072};
                  pg8::gemm_phase<pg8::EpiBf16<0>, pg8::StaticOrder, true, true>(X.lds, g, S, E); }
                { pg8::Gemm g{CKVN, (const bf16*)(ws + WS_MLAUKV), M, 4096, 512}; pg8::StaticOrder S; S.init(M, 4096, G, (int)blockIdx.x, WGM_UQ); pg8::EpiBf16<0> E{KV, 4096};
                  pg8::gemm_phase<pg8::EpiBf16<0>, pg8::StaticOrder, true, true>(X.lds, g, S, E); }
                SEAM(pb + 2); }
            if (IN(pb + 3)) { m16::mla_attn_phase16(X.lds, QH, KV, KPE, cosT, sinT, o); SEAM(pb + 3); }
        } else {
            bf16* Z = (bf16*)(big + BIG_LZ); bf16* QK = (bf16*)(big + BIG_LQK); float* GT = (float*)(big + BIG_LG);
            wo_t = (const bf16*)(ws + WS_MLWO);
            if (IN(pb + 0)) { pg8::Gemm g{a, (const bf16*)(ws + WS_MLIN), M, 6400, D}; pg8::StaticOrder S; S.init(M, 6400, G, (int)blockIdx.x, WGM_IN); pg8::EpiBf16<0> E{Z, 6400};
                REPEAT_REP_IN(pg8::gemm_phase<pg8::EpiBf16<0>, pg8::StaticOrder, true, true>(X.lds, g, S, E);)
                if (G == 256 && (int)blockIdx.x >= 114) { LAS TrDesc* tab = (LAS TrDesc*)(X.lds + TR_LDS_OFF); if (X.tid == 0) { TRD_BEGIN(tab); TRD(args.in[9] + (size_t)D * 6144, D, 6144, 6144, (bf16*)(ws + WS_NAQKV) + (size_t)D * 6144); TRD(args.in[11] + (size_t)D * D, D, D, D, (bf16*)(ws + WS_NAWO) + (size_t)D * D); TRD_END(); } __syncthreads(); tr_all(X, tab, TRD_TOTAL(), (int)blockIdx.x - 114, 256 - 114); } SEAM(pb + 0); }
            if (IN(pb + 1)) { ml_rows(X, Z, args.in[20], args.in[19], QK, GT); SEAM(pb + 1); }
            float* Ub = (float*)(ws + WS_SLAB); float* Nb = Ub + (size_t)32 * ml::NGRP * 8 * 4096;
            if (IN(pb + 2)) { ml::scan_phase_a(X.lds, QK, Z, GT, Ub, Nb); SEAM(pb + 2); }
            if (IN(pb + 3)) { ml::scan_phase_b(X.lds, QK, Z, GT, y, a, Ub, Nb); SEAM(pb + 3); }
            if (IN(pb + 4)) { ml_gate_rows(X, Z, y, a, args.in[21], o); SEAM(pb + 4); }
        }
        constexpr bool LASTL = (L == DEPTH - 1); float* slab = (float*)(ws + WS_SLAB);
        if (IN(pb + 5)) { { pg8::Gemm g{o, wo_t, MLAT, D, D}; pg8::StaticOrder S; S.init(MLAT, D, G, (int)blockIdx.x, WGM_WO); pg8::EpiBf16<0> E{y, D};
            REPEAT_REP_WO(pg8::gemm_phase<pg8::EpiBf16<0>, pg8::StaticOrder, true, true>(X.lds, g, S, E);) }
            if (!LASTL) { pg8::Gemm g{o + (size_t)MLAT * D, wo_t, MCTX, D, 256, D}; pg8::SplitKOrder S; S.init(MCTX, D, 8, G, (int)blockIdx.x); pg8::EpiF32Slab E{slab, D, (size_t)MCTX * D};
                pg8::gemm_phase<pg8::EpiF32Slab, pg8::SplitKOrder, true, true>(X.lds, g, S, E); }
            SEAM(pb + 5); }
        if (IN(pb + 6)) { vec_setup(X, mod, norm_g, true, L, 2, 1, true, L, 2, 3, 4); npost<0, false>(X, y, h, a, nullptr, slab, 0, 0, MLAT); if (!LASTL) npost<0, true>(X, y, h, a, nullptr, slab, 8, MLAT, M); __syncthreads(); SEAM(pb + 6); }
        bf16* HID = (bf16*)(big + BIG_HID);
        if (IN(pb + 7)) { constexpr int MR = LASTL ? MLAT : M; pg8::Gemm g{a, (const bf16*)(ws + WS_W1T) + (size_t)L * D * DFF, MR, DFF, D}; pg8::StaticOrder S; S.init(MR, DFF, G, (int)blockIdx.x, WGM_F1); pg8::EpiBf16<2> E{HID, DFF};
            const bool tailwg = !LASTL && G == 256 && blockIdx.x >= 64; const int r_ = (int)blockIdx.x - 64; const int npre = tailwg ? 2 * (((int)blockIdx.x & 7) >> 1) : 0; const bool pre = npre > 0;
            LAS TrDesc* tab = (LAS TrDesc*)(X.lds + TR_LDS_OFF);
            if (tailwg) {
                if (X.tid == 0) { for (int i = 0; i < TR_NMAT; ++i) tab[i].base = 0x7fffffff;
                    tab[0].W = args.in[7] + (size_t)(L + 1) * D * DFF; tab[0].WT = (bf16*)(ws + WS_W1T) + (size_t)(L + 1) * D * DFF; tab[0].K = D; tab[0].N = DFF; tab[0].Npad = DFF; tab[0].base = 0;
                    tab[1].W = args.in[8] + (size_t)(L + 1) * D * DFF; tab[1].WT = (bf16*)(ws + WS_W2T) + (size_t)(L + 1) * D * DFF; tab[1].K = DFF; tab[1].N = D; tab[1].Npad = D; tab[1].base = 1024; }
                __syncthreads();
                if (pre) tr_all(X, tab, min(2048, r_ + 192 * npre), r_, 192); }
            REPEAT_REP_FFN1(pg8::gemm_phase<pg8::EpiBf16<2>, pg8::StaticOrder, true, true>(X.lds, g, S, E);)
            if (tailwg) tr_all(X, tab, 2048, r_ + 192 * npre, 192);
            SEAM(pb + 7); }
        if (IN(pb + 8)) { { pg8::Gemm g{HID, (const bf16*)(ws + WS_W2T) + (size_t)L * D * DFF, MLAT, D, DFF}; pg8::StaticOrder S; S.init(MLAT, D, G, (int)blockIdx.x, WGM_F2); pg8::EpiBf16<0> E{y, D};
            REPEAT_REP_FFN2(pg8::gemm_phase<pg8::EpiBf16<0>, pg8::StaticOrder, true, true>(X.lds, g, S, E);) }
            if (!LASTL) { pg8::Gemm g{HID + (size_t)MLAT * DFF, (const bf16*)(ws + WS_W2T) + (size_t)L * D * DFF, MCTX, D, 512, DFF}; pg8::SplitKOrder S; S.init(MCTX, D, 16, G, (int)blockIdx.x); pg8::EpiF32Slab E{slab, D, (size_t)MCTX * D};
                pg8::gemm_phase<pg8::EpiF32Slab, pg8::SplitKOrder, true, true>(X.lds, g, S, E); }
            SEAM(pb + 8); }
        if (IN(pb + 9)) {
            if (L < DEPTH - 1) { vec_setup(X, mod, norm_g, true, L, 5, 3, true, L + 1, 0, 0, 1); npost<0, false>(X, y, h, a, nullptr, slab, 0, 0, MLAT); npost<0, true>(X, y, h, a, nullptr, slab, 16, MLAT, M); }
            else { vec_setup(X, mod, norm_g, true, L, 5, 3, false, 0, 0, 0, 0); npost<1, false>(X, y, h, nullptr, args.out, slab, 0, 0, MLAT); }
            __syncthreads(); SEAM(pb + 9); }
}
__global__ void __launch_bounds__(NTHR, 2) mega_fwd(Args args) {
    extern __shared__ __attribute__((aligned(16))) unsigned char lds_raw[];
    Ctx X; X.lds = (LAS unsigned char*)lds_raw; X.tid = threadIdx.x; X.lane = X.tid & 63; X.wave = __builtin_amdgcn_readfirstlane(X.tid >> 6);
    X.gw = blockIdx.x * NWAVES + X.wave; X.ngw = gridDim.x * NWAVES;
    volatile LAS unsigned* MISC = (volatile LAS unsigned*)(X.lds + MISC_OFF);
    for (int u = X.tid; u < (LDS_BYTES - RING_BYTES) / 4; u += NTHR) ((LAS unsigned*)(X.lds + RING_BYTES))[u] = 0u;
    __syncthreads();
    unsigned char* ws = args.ws;
    const int lo = args.ph_lo, hi = args.ph_hi; const bool single = (hi - lo) > 1;
    XcdBarrier bar; bar.bar = (unsigned*)(ws + WS_CTL) + CW_BAR; bar.x = 0; bar.st = nullptr;
    if (single) bar = xcd_barrier_post((unsigned*)(ws + WS_CTL) + CW_BAR, MISC + 8);
    const float* x = args.in[0]; const float* c = args.in[1]; const float* ctx = args.in[2]; const float* c_ctx = args.in[3]; const float* ada_w = args.in[4]; const float* ada_b = args.in[5]; const float* norm_g = args.in[6];
    float* mod = (float*)(ws + WS_MOD); float* cosT = (float*)(ws + WS_ROPE); float* sinT = cosT + 2048; float* part = (float*)(ws + WS_PART);
    hfp* h = (hfp*)(ws + WS_H); bf16* a = (bf16*)(ws + WS_A); bf16* y = (bf16*)(ws + WS_Y); bf16* o = (bf16*)(ws + WS_O); unsigned char* big = ws + WS_BIG;
    const int G = gridDim.x;

    if (IN(0)) { for (int rep_ = 0; rep_ < REP_P0; ++rep_) {
        ada_partials(X, c, c_ctx, ada_w, part);
        rope_table(X, cosT, sinT);
        { LAS TrDesc* tab = (LAS TrDesc*)(X.lds + TR_LDS_OFF);
          if (X.tid == 0) { TRD_BEGIN(tab); const bool all = gridDim.x != 256;
            for (int l = 0; l < (all ? 4 : 1); ++l) { TRD(args.in[7] + (size_t)l * D * DFF, D, DFF, DFF, (bf16*)(ws + WS_W1T) + (size_t)l * D * DFF); TRD(args.in[8] + (size_t)l * D * DFF, DFF, D, D, (bf16*)(ws + WS_W2T) + (size_t)l * D * DFF); }
            for (int j = 0; j < (all ? 2 : 1); ++j) { TRD(args.in[9] + (size_t)j * D * 6144, D, 6144, 6144, (bf16*)(ws + WS_NAQKV) + (size_t)j * D * 6144); TRD(args.in[11] + (size_t)j * D * D, D, D, D, (bf16*)(ws + WS_NAWO) + (size_t)j * D * D); }
            if (all) { TRD(args.in[12], D, 1088, 1280, (bf16*)(ws + WS_MLAIN)); TRD(args.in[15], 512, 3072, 3072, (bf16*)(ws + WS_MLAUQ)); TRD(args.in[16], 512, 4096, 4096, (bf16*)(ws + WS_MLAUKV)); TRD(args.in[17], D, D, D, (bf16*)(ws + WS_MLAWO));
                       TRD(args.in[18], D, 6176, 6400, (bf16*)(ws + WS_MLIN)); TRD(args.in[22], D, D, D, (bf16*)(ws + WS_MLWO)); }
            TRD_END(); }
          __syncthreads();
          tr_all(X, tab, TRD_TOTAL(), (int)blockIdx.x, (int)gridDim.x); }
        __syncthreads(); }
        SEAM(0);
    }
    if (IN(1)) {
        for (int i = blockIdx.x * NTHR + X.tid; i < 4 * 3 * NMOD; i += G * NTHR) { const int l = i / (3 * NMOD), rem = i % (3 * NMOD), j = rem % NMOD; float s = ada_b[l * NMOD + j];
            for (int sl = 0; sl < 16; ++sl) s += part[((size_t)(sl * 4 + l) * 3) * NMOD + rem];
            mod[i] = s; }
        SEAM(1);
    }
    if (IN(2)) {
        vec_setup(X, mod, norm_g, false, 0, 0, 0, true, 0, 0, 0, 1);
        first_norm(X, x, ctx, h, a);
        __syncthreads();
        SEAM(2);
    }
    run_layer<0>(X, args, bar, lo, hi, single); run_layer<1>(X, args, bar, lo, hi, single); run_layer<2>(X, args, bar, lo, hi, single); run_layer<3>(X, args, bar, lo, hi, single);
#undef IN
#undef SEAM
}

#ifndef MK_SINGLE
#define MK_SINGLE 1
#endif
extern "C" void kernel_launch(void* const* d_in, const int* in_sizes, int n_in, void* d_out, int out_size, void* d_ws, size_t ws_size, hipStream_t stream) {
    static int grid = 0;
    if (grid == 0) {
        if (n_in != 23 || in_sizes[0] != MLAT * D || out_size != MLAT * D || ws_size < WS_END) { fprintf(stderr, "kernel_launch: shape mismatch n_in %d in0 %d out %d ws %zu (need %zu)\n", n_in, n_in > 0 ? in_sizes[0] : -1, out_size, ws_size, (size_t)WS_END); grid = -1; return; }
        int dev = 0, cus = 0;
        if (hipGetDevice(&dev) != hipSuccess || hipDeviceGetAttribute(&cus, hipDeviceAttributeMultiprocessorCount, dev) != hipSuccess) { grid = -1; return; }
        if (hipFuncSetAttribute((const void*)mega_fwd, hipFuncAttributeMaxDynamicSharedMemorySize, LDS_BYTES) != hipSuccess) { fprintf(stderr, "kernel_launch: hipFuncSetAttribute failed\n"); grid = -1; return; }
        int per_cu = 0;
        if (hipOccupancyMaxActiveBlocksPerMultiprocessor(&per_cu, (const void*)mega_fwd, NTHR, LDS_BYTES) != hipSuccess || per_cu < 1) fprintf(stderr, "kernel_launch: occupancy query reports %d\n", per_cu);
        (void)hipGetLastError();
        grid = cus;
    }
    if (grid < 0) return;
    if (hipMemsetAsync((char*)d_ws + WS_CTL, 0, CTL_ZERO_BYTES, stream) != hipSuccess) return;
    Args a{};
    for (int i = 0; i < 23; ++i) a.in[i] = (const float*)d_in[i];
    a.out = (float*)d_out; a.ws = (unsigned char*)d_ws;
#if MK_SINGLE
    a.ph_lo = 0; a.ph_hi = NPHASES;
    hipLaunchKernelGGL(mega_fwd, dim3(grid), dim3(NTHR), LDS_BYTES, stream, a);
#else
    for (int p = 0; p < NPHASES; ++p) { if (!phase_active(p)) continue; a.ph_lo = p; a.ph_hi = p + 1; hipLaunchKernelGGL(mega_fwd, dim3(grid), dim3(NTHR), LDS_BYTES, stream, a); }
#endif
    const hipError_t le = hipPeekAtLastError();
    if (le != hipSuccess) fprintf(stderr, "kernel_launch: launch failed: %s\n", hipGetErrorName(le));
}
```
